# Optimizing an MI355X kernel written in HIP

```python
import jax, jax.numpy as jnp
from jax import lax
import numpy as np

D_MODEL = 1024
BATCH = 8
SEQ = 4096
DEPTH = 2

GRID_W = 64
CTX_LEN = 256
N_MIXERS = 2
HEAD_DIM = 64
N_HEADS = D_MODEL // HEAD_DIM
DECAY_LORA = 64
AAA_LORA = 64
GATE_LORA = 128
CONV_W = 3
N_EXPERTS = 16
N_GROUPS = 4
EXPERTS_PER_GROUP = N_EXPERTS // N_GROUPS
TOP_K = 2
EXPERT_DIM = 512
N_RWKV = (DEPTH + N_MIXERS - 1) // N_MIXERS
N_SCONV = DEPTH // N_MIXERS
RMS_EPS = 1e-6
GN_EPS = 64e-5
L2_EPS = 1e-12

kernel_name = 'hybrid_rwkv7_shortconv_grouped_moe_prefix_dit'


def _rmsnorm(x, g):
    xf = x.astype(jnp.float32)
    xf = xf * lax.rsqrt(jnp.mean(xf * xf, axis=-1, keepdims=True) + RMS_EPS)
    return (xf * g.astype(jnp.float32)).astype(x.dtype)


def _modulate(x, shift, scale):
    return x * (1 + scale) + shift


def _row_neighbours(x, n_rows, row_len):
    b, t, d = x.shape
    xr = x.reshape(b, n_rows, row_len, d)
    pad = jnp.zeros_like(xr[:, :, :1])
    prev = jnp.concatenate([pad, xr[:, :, :-1]], axis=2).reshape(b, t, d)
    nxt = jnp.concatenate([xr[:, :, 1:], pad], axis=2).reshape(b, t, d)
    return prev, nxt


def _heads(z):
    b, t = z.shape[0], z.shape[1]
    return z.astype(jnp.float32).reshape(b, t, N_HEADS, HEAD_DIM)


def _rwkv_shared(xn, n_rows, row_len, mu, w_rkv, g1, g2, k_k):
    prev, nxt = _row_neighbours(xn, n_rows, row_len)
    xx = 0.5 * (prev + nxt) - xn
    x_rkv = jnp.stack([xn + xx * mu[0], xn + xx * mu[1], xn + xx * mu[2]])
    r, k, v = jnp.einsum('pbtd,pde->pbte', x_rkv, w_rkv)
    g = jax.nn.sigmoid((xn + xx * mu[5]) @ g1) @ g2
    r, k, v = _heads(r), _heads(k), _heads(v)
    kk = k * k_k.astype(jnp.float32).reshape(N_HEADS, HEAD_DIM)
    kk = kk * lax.rsqrt(jnp.maximum(jnp.sum(kk * kk, axis=-1, keepdims=True), L2_EPS * L2_EPS))
    return xx, r, k, v, kk, g


def _rwkv_direction(xn, xx, mu, k, w0, w1, w2, a0, a1, a2, k_a):
    xw = xn + xx * mu[3]
    xa = xn + xx * mu[4]
    w_log = -jax.nn.softplus(-(w0 + jnp.tanh(xw @ w1) @ w2).astype(jnp.float32)) - 0.5
    decay = _heads(jnp.exp(-jnp.exp(w_log)))
    a = _heads(jax.nn.sigmoid((a0 + (xa @ a1) @ a2).astype(jnp.float32)))
    k_dir = k * (1 + (a - 1) * k_a.astype(jnp.float32).reshape(N_HEADS, HEAD_DIM))
    return decay, a, k_dir


def _wkv_scan(decay, k, v, kk, a, r, s0, reverse):
    with_output = r is not None
    xs = jax.tree_util.tree_map(lambda z: jnp.moveaxis(z, 1, 0), (decay, k, v, kk, a, r))

    def step(s, inp):
        w_t, k_t, v_t, kk_t, a_t, r_t = inp
        sa = jnp.einsum('bhvk,bhk->bhv', s, -kk_t)
        s = (s * w_t[:, :, None, :] + sa[..., None] * (kk_t * a_t)[:, :, None, :]
             + v_t[..., None] * k_t[:, :, None, :])
        y = jnp.einsum('bhvk,bhk->bhv', s, r_t) if with_output else None
        return s, y

    s_final, ys = lax.scan(step, s0, xs, reverse=reverse)
    return s_final, (jnp.moveaxis(ys, 0, 1) if with_output else None)


def _bonus(r, k_dir, v, r_k):
    return jnp.sum(r * k_dir * r_k.astype(jnp.float32), axis=-1, keepdims=True) * v


def _rwkv_readout(y, g, gn_w, gn_b, w_o, dtype):
    b, t = y.shape[0], y.shape[1]
    mean = jnp.mean(y, axis=-1, keepdims=True)
    var = jnp.mean(jnp.square(y - mean), axis=-1, keepdims=True)
    y = ((y - mean) * lax.rsqrt(var + GN_EPS)).reshape(b, t, D_MODEL)
    y = (y * gn_w.astype(jnp.float32) + gn_b.astype(jnp.float32)).astype(dtype)
    return (y * g) @ w_o


def _rwkv_mixer(xn, n_rows, xnc, ctx_out, mu, w_rkv, w0, w1, w2, a0, a1, a2, g1, g2,
                k_k, k_a, r_k, gn_w, gn_b, w_o):
    ctx_len = xnc.shape[1]
    xx_l, r_l, k_l, v_l, kk_l, g_l = _rwkv_shared(xn, n_rows, GRID_W, mu, w_rkv, g1, g2, k_k)
    xx_c, r_c, k_c, v_c, kk_c, g_c = _rwkv_shared(xnc, 1, ctx_len, mu, w_rkv, g1, g2, k_k)
    s0 = jnp.zeros((xn.shape[0], N_HEADS, HEAD_DIM, HEAD_DIM), jnp.float32)
    y_lat, y_ctx = [], []
    for p, reverse in enumerate((False, True)):
        dec_l, a_l, kd_l = _rwkv_direction(xn, xx_l, mu, k_l, w0[p], w1[p], w2[p], a0[p], a1[p], a2[p], k_a)
        dec_c, a_c, kd_c = _rwkv_direction(xnc, xx_c, mu, k_c, w0[p], w1[p], w2[p], a0[p], a1[p], a2[p], k_a)
        s_ctx, yc = _wkv_scan(dec_c, kd_c, v_c, kk_c, a_c, r_c if ctx_out else None, s0, reverse)
        _, yl = _wkv_scan(dec_l, kd_l, v_l, kk_l, a_l, r_l, s_ctx, reverse)
        y_lat.append(yl + _bonus(r_l, kd_l, v_l, r_k))
        if ctx_out:
            y_ctx.append(yc + _bonus(r_c, kd_c, v_c, r_k))
    out_lat = _rwkv_readout(y_lat[0] + y_lat[1], g_l, gn_w, gn_b, w_o, xn.dtype)
    out_ctx = _rwkv_readout(y_ctx[0] + y_ctx[1], g_c, gn_w, gn_b, w_o, xnc.dtype) if ctx_out else None
    return out_lat, out_ctx


def _short_conv(xn, n_rows, row_len, w_in, conv_w, w_out):
    bg, cg, xin = jnp.split(xn @ w_in, 3, axis=-1)
    u = cg * xin
    prev, nxt = _row_neighbours(u, n_rows, row_len)
    conv = conv_w[0] * prev + conv_w[1] * u + conv_w[2] * nxt
    return (bg * conv) @ w_out


def _moe(h, router_w, router_b, w_gate, w_up, w_down):
    b, t, d = h.shape
    hf = h.reshape(b * t, d)
    s = jax.nn.sigmoid(jnp.einsum('nd,de->ne', hf.astype(jnp.float32), router_w.astype(jnp.float32)))
    sel = (s + router_b.astype(jnp.float32)).reshape(-1, N_GROUPS, EXPERTS_PER_GROUP)
    group_score = jnp.sum(lax.top_k(sel, TOP_K)[0], axis=-1)
    g_idx = jnp.argmax(group_score, axis=-1)
    in_group = jnp.take_along_axis(sel, g_idx[:, None, None], axis=1)[:, 0]
    _, local = lax.top_k(in_group, TOP_K)
    experts = g_idx[:, None] * EXPERTS_PER_GROUP + local
    gate = jnp.take_along_axis(s, experts, axis=1)
    gate = gate / jnp.sum(gate, axis=-1, keepdims=True)
    combine = jnp.einsum('nk,nke->ne', gate, jax.nn.one_hot(experts, N_EXPERTS, dtype=jnp.float32)).astype(h.dtype)
    out = jnp.zeros_like(hf)
    for e in range(N_EXPERTS):
        he = jax.nn.silu(hf @ w_gate[e]) * (hf @ w_up[e])
        out = out + combine[:, e:e + 1] * (he @ w_down[e])
    return out.reshape(b, t, d)


def setup_inputs(seed: int = 0) -> dict:
    key = jax.random.key(seed)
    ks = iter(jax.random.split(key, 48))

    def nrm(shape, scale):
        return scale * jax.random.normal(next(ks), shape, jnp.float32)

    def uni(shape, lo, hi):
        return jax.random.uniform(next(ks), shape, jnp.float32, lo, hi)

    d, na, nb = D_MODEL, N_RWKV, N_SCONV
    inv = d ** -0.5
    return {
        'x': nrm((BATCH, SEQ, d), 1.0),
        'c': nrm((BATCH, d), 1.0),
        'ctx': nrm((BATCH, CTX_LEN, d), 1.0),
        'c_ctx': nrm((d,), 1.0),
        'ada_w': nrm((DEPTH, d, 6 * d), 0.5 * inv),
        'ada_b': nrm((DEPTH, 6 * d), 0.01),
        'norm_g': 1.0 + nrm((DEPTH, 2, d), 0.02),
        'rw_mu': uni((na, 6, d), 0.0, 1.0),
        'rw_w_rkv': nrm((na, 3, d, d), inv),
        'rw_w0': uni((na, 2, d), -6.0, -1.0),
        'rw_w1': nrm((na, 2, d, DECAY_LORA), inv),
        'rw_w2': nrm((na, 2, DECAY_LORA, d), 0.1 * DECAY_LORA ** -0.5),
        'rw_a0': nrm((na, 2, d), 0.1),
        'rw_a1': nrm((na, 2, d, AAA_LORA), inv),
        'rw_a2': nrm((na, 2, AAA_LORA, d), 0.5 * AAA_LORA ** -0.5),
        'rw_g1': nrm((na, d, GATE_LORA), inv),
        'rw_g2': nrm((na, GATE_LORA, d), GATE_LORA ** -0.5),
        'rw_k_k': 0.85 + nrm((na, d), 0.05),
        'rw_k_a': 1.0 + nrm((na, d), 0.05),
        'rw_r_k': nrm((na, N_HEADS, HEAD_DIM), 0.1),
        'rw_gn_w': 1.0 + nrm((na, d), 0.02),
        'rw_gn_b': nrm((na, d), 0.01),
        'rw_w_o': nrm((na, d, d), inv),
        'sc_w_in': nrm((nb, d, 3 * d), inv),
        'sc_conv': nrm((nb, CONV_W, d), CONV_W ** -0.5),
        'sc_w_out': nrm((nb, d, d), inv),
        'router_w': nrm((d, N_EXPERTS), inv),
        'router_b': nrm((N_EXPERTS,), 0.01),
        'moe_w_gate': nrm((DEPTH, N_EXPERTS, d, EXPERT_DIM), inv),
        'moe_w_up': nrm((DEPTH, N_EXPERTS, d, EXPERT_DIM), inv),
        'moe_w_down': nrm((DEPTH, N_EXPERTS, EXPERT_DIM, d), EXPERT_DIM ** -0.5),
        'final_g': 1.0 + nrm((d,), 0.02),
    }


def reference(x, c, ctx, c_ctx, ada_w, ada_b, norm_g, rw_mu, rw_w_rkv, rw_w0, rw_w1, rw_w2,
              rw_a0, rw_a1, rw_a2, rw_g1, rw_g2, rw_k_k, rw_k_a, rw_r_k, rw_gn_w, rw_gn_b, rw_w_o,
              sc_w_in, sc_conv, sc_w_out, router_w, router_b, moe_w_gate, moe_w_up, moe_w_down,
              final_g):
    rows = x.shape[1] // GRID_W
    ctx_len = ctx.shape[1]
    mod_lat = jnp.einsum('bd,lde->lbe', jax.nn.silu(c), ada_w) + ada_b[:, None, :]
    mod_ctx = jnp.einsum('d,lde->le', jax.nn.silu(c_ctx), ada_w) + ada_b
    h, hc = x, ctx
    for i in range(DEPTH):
        kind = i % N_MIXERS
        idx = i // N_MIXERS
        ctx_live = any(j % N_MIXERS == 0 for j in range(i + 1, DEPTH))
        sh1, sc1, gt1, sh2, sc2, gt2 = jnp.split(mod_lat[i][:, None, :], 6, axis=-1)
        csh1, csc1, cgt1, csh2, csc2, cgt2 = jnp.split(mod_ctx[i][None, None, :], 6, axis=-1)
        xn = _modulate(_rmsnorm(h, norm_g[i, 0]), sh1, sc1)
        xnc = _modulate(_rmsnorm(hc, norm_g[i, 0]), csh1, csc1) if (kind == 0 or ctx_live) else None
        if kind == 0:
            y, yc = _rwkv_mixer(xn, rows, xnc, ctx_live, rw_mu[idx], rw_w_rkv[idx], rw_w0[idx],
                                rw_w1[idx], rw_w2[idx], rw_a0[idx], rw_a1[idx], rw_a2[idx],
                                rw_g1[idx], rw_g2[idx], rw_k_k[idx], rw_k_a[idx], rw_r_k[idx],
                                rw_gn_w[idx], rw_gn_b[idx], rw_w_o[idx])
        else:
            y = _short_conv(xn, rows, GRID_W, sc_w_in[idx], sc_conv[idx], sc_w_out[idx])
            yc = _short_conv(xnc, 1, ctx_len, sc_w_in[idx], sc_conv[idx], sc_w_out[idx]) if ctx_live else None
        h = h + gt1 * y
        h = h + gt2 * _moe(_modulate(_rmsnorm(h, norm_g[i, 1]), sh2, sc2), router_w, router_b,
                           moe_w_gate[i], moe_w_up[i], moe_w_down[i])
        if ctx_live:
            hc = hc + cgt1 * yc
            hc = hc + cgt2 * _moe(_modulate(_rmsnorm(hc, norm_g[i, 1]), csh2, csc2), router_w, router_b,
                                  moe_w_gate[i], moe_w_up[i], moe_w_down[i])
    return _rmsnorm(h, final_g)
```

```cpp
#include <hip/hip_runtime.h>
#include <cstdio>
#include <cstdint>

#ifndef MK_N_LAUNCHES
#define MK_N_LAUNCHES 0
#endif

#define GAS __attribute__((address_space(1)))
#define LAS __attribute__((address_space(3)))
typedef unsigned short bf16_t;
typedef short bf16x8 __attribute__((ext_vector_type(8)));
typedef float f32x4 __attribute__((ext_vector_type(4)));
typedef float f32x2 __attribute__((ext_vector_type(2)));
typedef unsigned u32x4 __attribute__((ext_vector_type(4)));
typedef unsigned u32x2 __attribute__((ext_vector_type(2)));

constexpr int D = 1024, NBATCH = 8, TL = 4096, TCX = 256, ML = NBATCH * TL, MC = NBATCH * TCX, MA = ML + MC;
constexpr int NH = 16, HD = 64, NE = 16, ED = 512, GRIDW = 64;
constexpr int XM_LD = 5 * D;
constexpr int NWAVES = 8, NTHREADS = 512;
constexpr float RMS_EPS = 1e-6f, GN_EPS = 64e-5f;
constexpr int MAXTILES = 272;

constexpr size_t MiB = 1u << 20;
constexpr size_t WS_CTL = 0, CTL_ZERO_BYTES = 1 * MiB;
constexpr size_t WS_MOD = 1 * MiB;
constexpr size_t WS_EIDX = 2 * MiB;
constexpr size_t WS_GATE = WS_EIDX + 128 * 1024;
constexpr size_t WS_POS = WS_GATE + 256 * 1024;
constexpr size_t WS_CC = WS_POS + 256 * 1024;
constexpr size_t WS_TILE = WS_CC + 128 * 1024;
constexpr size_t WS_WRKV = 4 * MiB;
constexpr size_t WS_WL = 16 * MiB;
constexpr size_t WS_G2 = 18 * MiB;
constexpr size_t WS_WO = 19 * MiB;
constexpr size_t WS_WIN = 21 * MiB;
constexpr size_t WS_WOUT = 27 * MiB;
constexpr size_t WS_ACT = 32 * MiB;
constexpr size_t WS_XM = WS_ACT;
constexpr size_t WS_V = 372 * MiB;
constexpr size_t WS_KC = 440 * MiB;
constexpr size_t WS_LWA = 444 * MiB;
constexpr size_t WS_LG = 461 * MiB;
constexpr size_t WS_G = 32 * MiB;
constexpr size_t WS_Y0 = 96 * MiB, WS_Y1 = 160 * MiB;
constexpr size_t WS_ZO = 272 * MiB;
constexpr size_t WS_MOEW0 = 384 * MiB, WS_MOEW1 = 432 * MiB;
constexpr size_t WS_XN = 32 * MiB;
constexpr size_t WS_XP = 96 * MiB;
constexpr size_t WS_H = 232 * MiB;
constexpr size_t WS_BG = 232 * MiB, WS_U = 296 * MiB;
constexpr size_t WS_Z = 96 * MiB;
constexpr size_t WS_END = 480 * MiB;

constexpr int CW_BAR = 4096;

constexpr int RING_BYTES = 131072;
constexpr int LDSCTL_OFF = RING_BYTES, MISC_OFF = LDSCTL_OFF + 320;
constexpr int LDS_X_OFF = RING_BYTES + 1024;
constexpr int LDS_BYTES = 147456;

__device__ __forceinline__ unsigned f2bf(float f) { unsigned u = __builtin_bit_cast(unsigned, f); return (u + 0x7fffu + ((u >> 16) & 1u)) >> 16; }
__device__ __forceinline__ unsigned pk2(float lo, float hi) { return f2bf(lo) | (f2bf(hi) << 16); }
__device__ __forceinline__ float bflo(unsigned u) { return __builtin_bit_cast(float, u << 16); }
__device__ __forceinline__ float bfhi(unsigned u) { return __builtin_bit_cast(float, u & 0xffff0000u); }
__device__ __forceinline__ float wave_sum(float v) {
#pragma unroll
    for (int o = 1; o < 64; o <<= 1) v += __shfl_xor(v, o);
    return v;
}
__device__ __forceinline__ float sigmoidf_(float x) { return 1.f / (1.f + __expf(-x)); }
#define LDS_WAIT() asm volatile("s_waitcnt lgkmcnt(0)" ::: "memory")

namespace pg8 {
constexpr int BM = 256, BK = 64, HALF = 128, HTB = HALF * BK * 2, STAGE_BYTES = 8 * HTB, NXCD = 8, WGM = 8;
__host__ __device__ __forceinline__ int lds_byte(int r, int c) { const int st = (r >> 4) * 2 + (c >> 5), rr = r & 15, cc = c & 31, ob = rr * 64 + cc * 2; return st * 1024 + (ob ^ (((ob >> 9) & 1) << 5)); }
__host__ __device__ __forceinline__ void stage_rc(int b, int& R, int& C) { const int st = b / 1024, sb = b % 1024, swz = sb ^ (((sb >> 9) & 1) << 5); R = (st >> 1) * 16 + swz / 64; C = (st & 1) * 32 + (swz % 64) / 2; }
__host__ __device__ __forceinline__ int perm32(int rho) { const int n = rho >> 4, i = rho & 15; return 8 * (i >> 2) + 4 * n + (i & 3); }

struct Unit { int pm, pn; const char* a; const char* b; int nt; };

__device__ __forceinline__ void swz_tile(int L, int nM, int nN, int& pm, int& pn) {
    const int nwg = nM * nN; int wgid = L;
    { const int q = nwg / NXCD, r = nwg % NXCD, xcd = wgid % NXCD, off = wgid / NXCD; wgid = (xcd < r ? xcd * (q + 1) : r * (q + 1) + (xcd - r) * q) + off; }
    const int nig = WGM * nN, gid = wgid / nig, fm = gid * WGM, gsz = (nM - fm) < WGM ? (nM - fm) : WGM;
    pm = fm + ((wgid % nig) % gsz); pn = (wgid % nig) / gsz;
}

__device__ __forceinline__ unsigned cvt_pk_bf16(float lo, float hi) { unsigned r; asm volatile("v_cvt_pk_bf16_f32 %0, %1, %2" : "=v"(r) : "v"(lo), "v"(hi)); return r; }

template <class Epi, class Sched, bool ALIGN_EPI = true, bool SP2 = true>
__device__ __forceinline__ void gemm_phase(LAS unsigned char* lds, const int lda, const int ldb, const Sched& S, const Epi& E) {
    const int tid = threadIdx.x, wid = __builtin_amdgcn_readfirstlane(tid >> 6), lane = tid & 63, wr = wid >> 2, wc = wid & 3, fr = lane & 15, fq = lane >> 4;
    unsigned voffA[2], voffB[2];
#pragma unroll
    for (int i = 0; i < 2; ++i) { int R, C; stage_rc(tid * 16 + i * 8192, R, C); const int Rb = Epi::PERM ? ((R & ~31) + perm32(R & 31)) : R;
        voffA[i] = (unsigned)(R * lda + C) * 2u; voffB[i] = (unsigned)(Rb * ldb + C) * 2u; }
    const size_t kstep = (size_t)(BK * 2);
    const size_t hstepA = (size_t)HALF * lda * 2, hstepB = (size_t)HALF * ldb * 2;
    const unsigned ldsw = (unsigned)wid * 1024u;
    const int aoff = lds_byte(wr * 64 + fr, fq * 8), boff = lds_byte(wc * 32 + fr, fq * 8);
#define PG8_SA(b, h) (((b) * 2 + (h)) * HTB)
#define PG8_SB(b, h) ((4 + (b) * 2 + (h)) * HTB)
#define PG8_STAGE(bufoff, gbase, voff) do { _Pragma("unroll") for (int _i = 0; _i < 2; ++_i) \
        __builtin_amdgcn_global_load_lds((const unsigned*)((const char*)(gbase) + (voff)[_i]), (LAS unsigned*)(lds + (bufoff) + ldsw + _i * 8192), 16, 0, 0); } while (0)
#define PG8_LDA(dst, b, h) do { _Pragma("unroll") for (int m = 0; m < 4; ++m) _Pragma("unroll") for (int k = 0; k < 2; ++k) dst[m][k] = *(const LAS bf16x8*)(lds + PG8_SA(b, h) + aoff + m * 2048 + k * 1024); } while (0)
#define PG8_LDB(dst, b, h) do { _Pragma("unroll") for (int n = 0; n < 2; ++n) _Pragma("unroll") for (int k = 0; k < 2; ++k) dst[n][k] = *(const LAS bf16x8*)(lds + PG8_SB(b, h) + boff + n * 2048 + k * 1024); } while (0)
#define PG8_MMA(ai, bj, At, Bt) do { __builtin_amdgcn_s_setprio(1); _Pragma("unroll") for (int m = 0; m < 4; ++m) _Pragma("unroll") for (int n = 0; n < 2; ++n) _Pragma("unroll") for (int k = 0; k < 2; ++k) \
        acc[ai][bj][m][n] = __builtin_amdgcn_mfma_f32_16x16x32_bf16(Bt[n][k], At[m][k], acc[ai][bj][m][n], 0, 0, 0); __builtin_amdgcn_s_setprio(0); } while (0)
#define PG8_WAIT_V(n) asm volatile("s_waitcnt vmcnt(" #n ")" ::: "memory")
#define PG8_WAIT_L(n) asm volatile("s_waitcnt lgkmcnt(" #n ")" ::: "memory")
#define PG8_BAR __builtin_amdgcn_s_barrier()
#define PG8_SCHED __builtin_amdgcn_sched_barrier(0)
    Unit cur, nxt; int ui = 0;
    if (!S.next(0, cur)) return;
    f32x4 acc[2][2][4][2];
#pragma unroll
    for (int a = 0; a < 2; ++a)
#pragma unroll
        for (int b = 0; b < 2; ++b)
#pragma unroll
            for (int m = 0; m < 4; ++m)
#pragma unroll
                for (int n = 0; n < 2; ++n) acc[a][b][m][n] = (f32x4){0.f, 0.f, 0.f, 0.f};
    bf16x8 At[4][2], B0[2][2], B1[2][2];
    const char* cA = cur.a; const char* cB = cur.b;
    if constexpr (SP2) {
        PG8_STAGE(PG8_SB(0, 0), cB, voffB); PG8_STAGE(PG8_SB(0, 1), cB + hstepB, voffB); PG8_STAGE(PG8_SA(0, 0), cA, voffA); PG8_STAGE(PG8_SA(0, 1), cA + hstepA, voffA);
        if (wr == 1) PG8_BAR;
        PG8_WAIT_V(2); PG8_BAR;
        PG8_STAGE(PG8_SB(1, 0), cB + kstep, voffB); PG8_STAGE(PG8_SA(1, 0), cA + kstep, voffA); PG8_STAGE(PG8_SB(1, 1), cB + hstepB + kstep, voffB);
        PG8_WAIT_V(6); PG8_BAR;
    } else {
        PG8_STAGE(PG8_SB(0, 0), cB, voffB); PG8_STAGE(PG8_SA(0, 0), cA, voffA); PG8_STAGE(PG8_SB(0, 1), cB + hstepB, voffB); PG8_STAGE(PG8_SA(0, 1), cA + hstepA, voffA);
        if (wr == 1) PG8_BAR;
        PG8_WAIT_V(4); PG8_BAR;
        PG8_STAGE(PG8_SB(1, 0), cB + kstep, voffB); PG8_STAGE(PG8_SA(1, 0), cA + kstep, voffA); PG8_STAGE(PG8_SB(1, 1), cB + hstepB + kstep, voffB);
        PG8_WAIT_V(6); PG8_BAR;
    }
    for (;;) {
        const bool has_next = S.next(ui + 1, nxt);
        const char* nA = has_next ? nxt.a : cA; const char* nB = has_next ? nxt.b : cB;
        const int nt = cur.nt;
        for (int t = 0; t < nt; t += 2) {
            const bool last = (t == nt - 2);
            const char* a1 = cA + (size_t)(t + 1) * kstep;
            const char* a2 = last ? nA : cA + (size_t)(t + 2) * kstep; const char* b2 = last ? nB : cB + (size_t)(t + 2) * kstep;
            const char* a3 = a2 + kstep; const char* b3 = b2 + kstep;
            if constexpr (SP2) {
            PG8_LDB(B0, 0, 0); PG8_LDB(B1, 0, 1); PG8_SCHED; PG8_LDA(At, 0, 0); PG8_STAGE(PG8_SA(1, 1), a1 + hstepA, voffA);
            PG8_WAIT_V(8); PG8_WAIT_L(0); PG8_BAR; PG8_MMA(0, 0, At, B0); PG8_MMA(0, 1, At, B1); PG8_BAR; PG8_SCHED;
            PG8_LDA(At, 0, 1); PG8_STAGE(PG8_SB(0, 0), b2, voffB); PG8_STAGE(PG8_SB(0, 1), b2 + hstepB, voffB); PG8_STAGE(PG8_SA(0, 0), a2, voffA);
            PG8_WAIT_V(8); PG8_WAIT_L(0); PG8_BAR; PG8_MMA(1, 0, At, B0); PG8_MMA(1, 1, At, B1); PG8_BAR; PG8_SCHED;
            PG8_LDB(B0, 1, 0); PG8_LDB(B1, 1, 1); PG8_SCHED; PG8_LDA(At, 1, 0); PG8_STAGE(PG8_SA(0, 1), a2 + hstepA, voffA);
            PG8_WAIT_V(8); PG8_WAIT_L(0); PG8_BAR; PG8_MMA(0, 0, At, B0); PG8_MMA(0, 1, At, B1); PG8_BAR; PG8_SCHED;
            PG8_LDA(At, 1, 1); PG8_STAGE(PG8_SB(1, 0), b3, voffB); PG8_STAGE(PG8_SB(1, 1), b3 + hstepB, voffB); PG8_STAGE(PG8_SA(1, 0), a3, voffA);
            PG8_WAIT_V(8); PG8_WAIT_L(0); PG8_BAR; PG8_MMA(1, 0, At, B0); PG8_MMA(1, 1, At, B1); PG8_BAR; PG8_SCHED;
            } else {
            PG8_LDB(B0, 0, 0); PG8_SCHED; PG8_LDA(At, 0, 0); PG8_STAGE(PG8_SA(1, 1), a1 + hstepA, voffA);
            PG8_WAIT_L(8); PG8_BAR; PG8_WAIT_L(0); PG8_MMA(0, 0, At, B0); PG8_BAR; PG8_SCHED;
            PG8_LDB(B1, 0, 1); PG8_STAGE(PG8_SB(0, 0), b2, voffB);
            PG8_BAR; PG8_WAIT_L(0); PG8_MMA(0, 1, At, B1); PG8_BAR;
            PG8_LDA(At, 0, 1); PG8_STAGE(PG8_SA(0, 0), a2, voffA);
            PG8_BAR; PG8_WAIT_L(0); PG8_MMA(1, 0, At, B0); PG8_BAR; PG8_SCHED;
            PG8_STAGE(PG8_SB(0, 1), b2 + hstepB, voffB);
            PG8_WAIT_V(6); PG8_BAR; PG8_MMA(1, 1, At, B1); PG8_BAR;
            PG8_LDB(B0, 1, 0); PG8_SCHED; PG8_LDA(At, 1, 0); PG8_STAGE(PG8_SA(0, 1), a2 + hstepA, voffA);
            PG8_WAIT_L(8); PG8_BAR; PG8_WAIT_L(0); PG8_MMA(0, 0, At, B0); PG8_BAR; PG8_SCHED;
            PG8_LDB(B1, 1, 1); PG8_STAGE(PG8_SB(1, 0), b3, voffB);
            PG8_BAR; PG8_WAIT_L(0); PG8_MMA(0, 1, At, B1); PG8_BAR;
            PG8_LDA(At, 1, 1); PG8_STAGE(PG8_SA(1, 0), a3, voffA);
            PG8_BAR; PG8_WAIT_L(0); PG8_MMA(1, 0, At, B0); PG8_BAR; PG8_SCHED;
            PG8_STAGE(PG8_SB(1, 1), b3 + hstepB, voffB);
            PG8_WAIT_V(6); PG8_BAR; PG8_MMA(1, 1, At, B1); PG8_BAR;
            }
        }
        if constexpr (ALIGN_EPI) { if (wr == 0) PG8_BAR; }
        E(acc, cur, wr, wc, fr, fq);
        if (!has_next) break;
#pragma unroll
        for (int a = 0; a < 2; ++a)
#pragma unroll
            for (int b = 0; b < 2; ++b)
#pragma unroll
                for (int m = 0; m < 4; ++m)
#pragma unroll
                    for (int n = 0; n < 2; ++n) acc[a][b][m][n] = (f32x4){0.f, 0.f, 0.f, 0.f};
        cur = nxt; cA = nA; cB = nB; ++ui;
        if constexpr (ALIGN_EPI) { if (wr == 1) PG8_BAR; }
    }
    PG8_WAIT_V(0);
    if constexpr (!ALIGN_EPI) { if (wr == 0) PG8_BAR; }
    PG8_BAR;
#undef PG8_SA
#undef PG8_SB
#undef PG8_STAGE
#undef PG8_LDA
#undef PG8_LDB
#undef PG8_MMA
#undef PG8_WAIT_V
#undef PG8_WAIT_L
#undef PG8_BAR
#undef PG8_SCHED
}
}

#define XB_TMO      128
#define XB_XCNT(j)  (256  + 64 * (j))
#define XB_XSUB(j)  (1280 + 64 * (j))
#define XB_XGEN(j)  (2304 + 64 * (j))
#define XB_TOP      3328
#define XB_TOPGEN   3392
#define XCD_BAR_WORDS 3456
#define XB_SPIN_CAP (1u << 18)

__device__ __forceinline__ unsigned xb_ld(unsigned* p)              { return __hip_atomic_load(p, __ATOMIC_RELAXED, __HIP_MEMORY_SCOPE_AGENT); }
__device__ __forceinline__ unsigned xb_add(unsigned* p, unsigned v) { return __hip_atomic_fetch_add(p, v, __ATOMIC_RELAXED, __HIP_MEMORY_SCOPE_AGENT); }
__device__ __forceinline__ unsigned xb_xcc_id() { return (unsigned)__builtin_amdgcn_s_getreg((3 << 11) | 20) & 0xFu; }
#define XB_SPIN(cond, bar) do { unsigned _sp = 0; while (cond) { __builtin_amdgcn_s_sleep(1); \
    if ((++_sp & 255u) == 0u) { if (xb_ld(&(bar)[XB_TMO])) break; if (_sp > XB_SPIN_CAP) { atomicAdd(&(bar)[XB_TMO], 1u); break; } } } } while (0)

struct XcdBarrier { unsigned* bar; unsigned x; volatile LAS unsigned* st; };

__device__ __forceinline__ XcdBarrier xcd_barrier_post(unsigned* bar, volatile LAS unsigned* st) {
    XcdBarrier b; b.bar = bar; b.x = xb_xcc_id(); b.st = st;
    if (threadIdx.x == 0) (void)xb_add(&bar[XB_XCNT(b.x)], 1u);
    return b;
}
__device__ __forceinline__ void xcd_barrier_complete(unsigned* bar, unsigned x, unsigned& nloc, unsigned& nx) {
    const unsigned G = gridDim.x * gridDim.y * gridDim.z;
    unsigned sum, cnt, mine, sp = 0u;
    for (;;) {
        sum = 0u; cnt = 0u; mine = 0u;
#pragma unroll
        for (unsigned j = 0; j < 16; ++j) { const unsigned c = xb_ld(&bar[XB_XCNT(j)]); sum += c; cnt += (c > 0u) ? 1u : 0u; mine = (j == x) ? c : mine; }
        if (sum == G) break;
        __builtin_amdgcn_s_sleep(1);
        if ((++sp & 255u) == 0u) { if (xb_ld(&bar[XB_TMO])) break; if (sp > XB_SPIN_CAP) { atomicAdd(&bar[XB_TMO], 1u); break; } }
    }
    nloc = mine > 0u ? mine : 1u; nx = cnt > 0u ? cnt : 1u;
}
__device__ __forceinline__ void xcd_barrier(const XcdBarrier& b) {
    asm volatile("s_waitcnt vmcnt(0)" ::: "memory");
    __syncthreads();
    if (threadIdx.x == 0) {
        unsigned* bar = b.bar;
        __builtin_amdgcn_s_waitcnt(0);
        unsigned nloc = b.st[0], nx = b.st[1];
        if (nloc == 0u) { xcd_barrier_complete(bar, b.x, nloc, nx); b.st[0] = nloc; b.st[1] = nx; }
        const unsigned old = xb_add(&bar[XB_XSUB(b.x)], 1u);
        const unsigned gen = old / nloc;
        if (old + 1u == (gen + 1u) * nloc) {
            __builtin_amdgcn_fence(__ATOMIC_RELEASE, "agent");
            asm volatile("s_waitcnt vmcnt(0)" ::: "memory");
            const unsigned og = xb_add(&bar[XB_TOP], 1u);
            const unsigned tg = og / nx;
            if (og + 1u == (tg + 1u) * nx) xb_add(&bar[XB_TOPGEN], 1u);
            else XB_SPIN(xb_ld(&bar[XB_TOPGEN]) == tg, bar);
            __builtin_amdgcn_fence(__ATOMIC_ACQUIRE, "agent");
            xb_add(&bar[XB_XGEN(b.x)], 1u);
            asm volatile("s_waitcnt vmcnt(0)" ::: "memory");
        } else {
            XB_SPIN(xb_ld(&bar[XB_XGEN(b.x)]) == gen, bar);
            __builtin_amdgcn_fence(__ATOMIC_ACQUIRE, "agent");
            asm volatile("s_waitcnt vmcnt(0)" ::: "memory");
        }
    }
    __syncthreads();
}

struct Args { const float* in[32]; float* out; unsigned char* ws; int ph_lo, ph_hi; };
enum { I_X = 0, I_C, I_CTX, I_CCTX, I_ADAW, I_ADAB, I_NORMG, I_MU, I_WRKV, I_W0, I_W1, I_W2, I_A0, I_A1, I_A2, I_G1, I_G2, I_KK, I_KA, I_RK, I_GNW, I_GNB, I_WO,
       I_WIN, I_CONV, I_WOUT, I_ROUTW, I_ROUTB, I_MGATE, I_MUP, I_MDOWN, I_FINALG };

struct Frame {
    LAS unsigned char* lds;
    int tid, lane, wave, G, vcu, gw, NGW;
};


__device__ __forceinline__ void tr_item(const float* W, int ldw, int k0, int n0, bf16_t* dst, int ldd, int drow0, const float* mu, LAS float* scr, int lane) {
#pragma unroll 8
    for (int i = 0; i < 32; ++i) { const int kk = 2 * i + (lane >> 5); scr[kk * 33 + (lane & 31)] = W[(size_t)(k0 + kk) * ldw + n0 + (lane & 31)]; }
    LDS_WAIT(); asm volatile("" ::: "memory");
    const int c = lane & 7;
    float m[8];
#pragma unroll
    for (int q = 0; q < 8; ++q) m[q] = mu ? mu[k0 + 8 * c + q] : 0.f;
#pragma unroll
    for (int j = 0; j < 4; ++j) { const int n = (lane >> 3) + 8 * j; const LAS float* s = scr + (8 * c) * 33 + n;
        float v[8];
#pragma unroll
        for (int q = 0; q < 8; ++q) v[q] = s[q * 33];
        bf16_t* drow = dst + (size_t)(drow0 + n) * ldd + k0 + 8 * c;
        if (!mu) {
            u32x4 o; o.x = pk2(v[0], v[1]); o.y = pk2(v[2], v[3]); o.z = pk2(v[4], v[5]); o.w = pk2(v[6], v[7]);
            *(u32x4*)drow = o;
        } else {
            u32x4 o; o.x = pk2(v[0] * (1.f - m[0]), v[1] * (1.f - m[1])); o.y = pk2(v[2] * (1.f - m[2]), v[3] * (1.f - m[3]));
            o.z = pk2(v[4] * (1.f - m[4]), v[5] * (1.f - m[5])); o.w = pk2(v[6] * (1.f - m[6]), v[7] * (1.f - m[7]));
            *(u32x4*)drow = o;
            u32x4 p; p.x = pk2(v[0] * 0.5f * m[0], v[1] * 0.5f * m[1]); p.y = pk2(v[2] * 0.5f * m[2], v[3] * 0.5f * m[3]);
            p.z = pk2(v[4] * 0.5f * m[4], v[5] * 0.5f * m[5]); p.w = pk2(v[6] * 0.5f * m[6], v[7] * 0.5f * m[7]);
            *(u32x4*)(drow + 1024) = p;
        }
    }
    LDS_WAIT(); asm volatile("" ::: "memory");
}
__device__ __forceinline__ void tr_job_item(const float* W, int ldw, int N, bf16_t* dst, int ldd, int drow_base, bool il, const float* mu, int item, LAS float* scr, int lane) {
    const int nblk = N / 32, kb = item / nblk, nb = item % nblk, n0 = 32 * nb;
    const int dr = drow_base + (il ? ((n0 >> 7) * 256 + (n0 & 127)) : n0);
    tr_item(W, ldw, 64 * kb, n0, dst, ldd, dr, mu, scr, lane);
}

__device__ __forceinline__ void p0_prologue(const Frame& F, const Args& A) {
    unsigned char* ws = A.ws;
    LAS float* scr = (LAS float*)(F.lds + F.wave * 16384);
    bf16_t* WRKV = (bf16_t*)(ws + WS_WRKV); bf16_t* WL = (bf16_t*)(ws + WS_WL); bf16_t* G2 = (bf16_t*)(ws + WS_G2);
    bf16_t* WO = (bf16_t*)(ws + WS_WO); bf16_t* WIN = (bf16_t*)(ws + WS_WIN); bf16_t* WOUT = (bf16_t*)(ws + WS_WOUT);
    const float* mu = A.in[I_MU];
    constexpr int NIT = 3 * 512 + 4 * 32 + 64 + 64 + 512 + 3 * 512 + 512;
    for (int it = F.gw; it < NIT; it += F.NGW) {
        int r = it;
        if (r < 1536) { const int p = r / 512; tr_job_item(A.in[I_WRKV] + (size_t)p * D * D, D, D, WRKV, 2048, p * 1024, false, nullptr, r % 512, scr, F.lane); continue; } r -= 1536;
        if (r < 64) { const int dir = r / 32; tr_job_item(A.in[I_W1] + (size_t)dir * D * 64, 64, 64, WL, 2048, dir * 64, false, mu + 3 * D, r % 32, scr, F.lane); continue; } r -= 64;
        if (r < 64) { const int dir = r / 32; tr_job_item(A.in[I_A1] + (size_t)dir * D * 64, 64, 64, WL, 2048, 128 + dir * 64, false, mu + 4 * D, r % 32, scr, F.lane); continue; } r -= 64;
        if (r < 64) { tr_job_item(A.in[I_G1], 128, 128, WL, 2048, 256, false, mu + 5 * D, r, scr, F.lane); continue; } r -= 64;
        if (r < 64) { tr_job_item(A.in[I_G2], D, D, G2, 256, 0, false, nullptr, r, scr, F.lane); continue; } r -= 64;
        if (r < 512) { tr_job_item(A.in[I_WO], D, D, WO, D, 0, false, nullptr, r, scr, F.lane); continue; } r -= 512;
        if (r < 512) { tr_job_item(A.in[I_WIN], 3 * D, D, WIN, D, 0, false, nullptr, r, scr, F.lane); continue; } r -= 512;
        if (r < 512) { tr_job_item(A.in[I_WIN] + D, 3 * D, D, WIN, D, 1024, true, nullptr, r, scr, F.lane); continue; } r -= 512;
        if (r < 512) { tr_job_item(A.in[I_WIN] + 2 * D, 3 * D, D, WIN, D, 1024 + 128, true, nullptr, r, scr, F.lane); continue; } r -= 512;
        tr_job_item(A.in[I_WOUT], D, D, WOUT, D, 0, false, nullptr, r, scr, F.lane);
    }
    {
        const int gt = F.vcu * NTHREADS + F.tid, NGT = F.G * NTHREADS;
        u32x4 z = (u32x4){0u, 0u, 0u, 0u};
        for (int i = gt; i < 32768; i += NGT) ((u32x4*)(WL + (size_t)384 * 2048))[i] = z;
        for (int i = gt; i < 16384; i += NGT) { const int row = i >> 4, q = i & 15; *(u32x4*)(G2 + (size_t)row * 256 + 128 + q * 8) = z; }
    }
    __syncthreads();
    {
        LAS float* st = (LAS float*)F.lds;
        LAS float* red = st + 9 * 1024;
        for (int i = F.tid; i < 9 * 1024; i += NTHREADS) { const float v = (i < 8192) ? A.in[I_C][i] : A.in[I_CCTX][i - 8192]; st[i] = v / (1.f + __expf(-v)); }
        __syncthreads();
        float* MOD = (float*)(ws + WS_MOD);
        for (int u = blockIdx.x; u < 256; u += F.G) {
            const int l = u >> 7, e0 = (u & 127) * 48;
            if (F.tid < 384) {
                const int q = F.tid % 12, dg = F.tid / 12;
                f32x4 acc[9];
#pragma unroll
                for (int r = 0; r < 9; ++r) acc[r] = (f32x4){0.f, 0.f, 0.f, 0.f};
                const float* wb = A.in[I_ADAW] + (size_t)l * D * 6144 + e0 + 4 * q;
#pragma unroll 4
                for (int i = 0; i < 32; ++i) { const int d = dg + 32 * i; const f32x4 w = *(const f32x4*)(wb + (size_t)d * 6144);
#pragma unroll
                    for (int r = 0; r < 9; ++r) acc[r] += st[r * 1024 + d] * w; }
#pragma unroll
                for (int r = 0; r < 9; ++r) *(LAS f32x4*)(red + (dg * 9 + r) * 48 + 4 * q) = acc[r];
            }
            __syncthreads();
            if (F.tid < 432) { const int r = F.tid / 48, ci = F.tid % 48; float s = A.in[I_ADAB][l * 6144 + e0 + ci];
                for (int dg = 0; dg < 32; ++dg) s += red[(dg * 9 + r) * 48 + ci];
                MOD[((size_t)l * 9 + r) * 6144 + e0 + ci] = s; }
            __syncthreads();
        }
    }
}

__device__ __forceinline__ void p1_load_norm(const float* row, const f32x4 (&gsc)[4], const f32x4 (&sh)[4], f32x4 (&o)[4], int lane) {
    const f32x4* xr = (const f32x4*)row + lane; float s = 0.f;
#pragma unroll
    for (int j = 0; j < 4; ++j) { o[j] = xr[64 * j]; s += (o[j].x * o[j].x + o[j].y * o[j].y) + (o[j].z * o[j].z + o[j].w * o[j].w); }
    const float rstd = rsqrtf(wave_sum(s) * (1.f / D) + RMS_EPS);
#pragma unroll
    for (int j = 0; j < 4; ++j) o[j] = o[j] * rstd * gsc[j] + sh[j];
}
__device__ __forceinline__ void st_bf4(bf16_t* p, const f32x4 v) { u32x2 w; w.x = pk2(v.x, v.y); w.y = pk2(v.z, v.w); *(u32x2*)p = w; }

__device__ __forceinline__ void p1_mix(const Frame& F, const Args& A) {
    const float* MOD = (const float*)(A.ws + WS_MOD);
    bf16_t* XM = (bf16_t*)(A.ws + WS_XM);
    const float* mu = A.in[I_MU]; const float* ng = A.in[I_NORMG];
    for (int u = F.gw; u < 2176; u += F.NGW) {
        const bool isctx = u >= 2048; int t0, rowlen, modrow; const float* src; size_t orow0;
        if (!isctx) { t0 = u * 16; rowlen = GRIDW; modrow = t0 / TL; src = A.in[I_X] + (size_t)t0 * D; orow0 = t0; }
        else { t0 = (u - 2048) * 16; rowlen = TCX; modrow = 8; src = A.in[I_CTX] + (size_t)t0 * D; orow0 = (size_t)ML + t0; }
        const int pos0 = t0 % rowlen;
        const float* mrow = MOD + (size_t)modrow * 6144;
        f32x4 gsc[4], sh[4], m0[4], m1[4], m2[4];
#pragma unroll
        for (int j = 0; j < 4; ++j) { const int c = 4 * F.lane + 256 * j;
            const f32x4 g = *(const f32x4*)(ng + c), sc = *(const f32x4*)(mrow + 1024 + c);
            gsc[j] = g * (1.f + sc); sh[j] = *(const f32x4*)(mrow + c);
            m0[j] = *(const f32x4*)(mu + c); m1[j] = *(const f32x4*)(mu + D + c); m2[j] = *(const f32x4*)(mu + 2 * D + c); }
        f32x4 prev[4], cur[4], nxt[4];
        if (pos0 > 0) p1_load_norm(src - D, gsc, sh, prev, F.lane);
        else {
#pragma unroll
            for (int j = 0; j < 4; ++j) prev[j] = (f32x4){0.f, 0.f, 0.f, 0.f}; }
        p1_load_norm(src, gsc, sh, cur, F.lane);
        for (int i = 0; i < 16; ++i) {
            if (pos0 + i + 1 < rowlen) p1_load_norm(src + (size_t)(i + 1) * D, gsc, sh, nxt, F.lane);
            else {
#pragma unroll
                for (int j = 0; j < 4; ++j) nxt[j] = (f32x4){0.f, 0.f, 0.f, 0.f}; }
            bf16_t* orow = XM + (orow0 + i) * XM_LD + 4 * F.lane;
#pragma unroll
            for (int j = 0; j < 4; ++j) {
                const f32x4 s = prev[j] + nxt[j], xx = 0.5f * s - cur[j];
                st_bf4(orow + 256 * j, cur[j] + xx * m0[j]);
                st_bf4(orow + D + 256 * j, cur[j] + xx * m1[j]);
                st_bf4(orow + 2 * D + 256 * j, cur[j] + xx * m2[j]);
                st_bf4(orow + 3 * D + 256 * j, cur[j]);
                st_bf4(orow + 4 * D + 256 * j, s);
                prev[j] = cur[j]; cur[j] = nxt[j];
            }
        }
    }
}

struct SchedRKV {
    const char* xm; const char* w; int G, c;
    __device__ __forceinline__ bool next(int i, pg8::Unit& u) const {
        const int L = i * G + c; if (L >= 1600) return false;
        if (L < 1536) pg8::swz_tile(L, 128, 12, u.pm, u.pn); else { const int r = L - 1536; u.pm = 128 + (r >> 3); u.pn = 4 + (r & 7); }
        u.a = xm + (size_t)u.pm * 256 * XM_LD * 2 + (size_t)(u.pn >> 2) * D * 2; u.b = w + (size_t)u.pn * 256 * 2048 * 2; u.nt = 16; return true;
    }
};
struct EpiRKV {
    static constexpr bool PERM = true;
    bf16_t *R, *K, *KC, *V;
    __device__ __forceinline__ void operator()(const f32x4 (&acc)[2][2][4][2], const pg8::Unit& u, int wr, int wc, int fr, int fq) const {
        const int grp = u.pn >> 2; int prow = u.pm * 256; bf16_t* base;
        if (grp == 0) base = R; else if (grp == 1) { if (u.pm < 128) base = K; else { base = KC; prow -= ML; } } else base = V;
        const int row0 = prow + wr * 64 + fr, col0 = (u.pn & 3) * 256 + wc * 32 + 8 * fq;
#pragma unroll
        for (int ai = 0; ai < 2; ++ai)
#pragma unroll
            for (int m = 0; m < 4; ++m) { bf16_t* rowp = base + (size_t)(row0 + ai * 128 + m * 16) * D + col0;
#pragma unroll
                for (int bj = 0; bj < 2; ++bj) { const f32x4 v0 = acc[ai][bj][m][0], v1 = acc[ai][bj][m][1];
                    u32x4 w; w.x = pg8::cvt_pk_bf16(v0[0], v0[1]); w.y = pg8::cvt_pk_bf16(v0[2], v0[3]); w.z = pg8::cvt_pk_bf16(v1[0], v1[1]); w.w = pg8::cvt_pk_bf16(v1[2], v1[3]);
                    *(u32x4*)(rowp + bj * 128) = w; } }
    }
};
struct SchedLora {
    const char* xm; const char* w; int G, c;
    __device__ __forceinline__ bool next(int i, pg8::Unit& u) const {
        const int L = i * G + c; if (L >= 272) return false;
        u.pm = L >> 1; u.pn = L & 1;
        u.a = xm + (size_t)u.pm * 256 * XM_LD * 2 + (size_t)3 * D * 2; u.b = w + (size_t)u.pn * 256 * 2048 * 2; u.nt = 32; return true;
    }
};
struct EpiLora {
    static constexpr bool PERM = true;
    bf16_t *LWA, *LG;
    __device__ __forceinline__ void operator()(const f32x4 (&acc)[2][2][4][2], const pg8::Unit& u, int wr, int wc, int fr, int fq) const {
        bf16_t* base = u.pn ? LG : LWA;
        const int row0 = u.pm * 256 + wr * 64 + fr, col0 = wc * 32 + 8 * fq;
#pragma unroll
        for (int ai = 0; ai < 2; ++ai)
#pragma unroll
            for (int m = 0; m < 4; ++m) { bf16_t* rowp = base + (size_t)(row0 + ai * 128 + m * 16) * 256 + col0;
#pragma unroll
                for (int bj = 0; bj < 2; ++bj) { f32x4 v0 = acc[ai][bj][m][0], v1 = acc[ai][bj][m][1];
                    if (bj == 0) {
                        if (u.pn == 0) {
#pragma unroll
                            for (int q = 0; q < 4; ++q) { v0[q] = 1.f - 2.f / (__expf(2.f * v0[q]) + 1.f); v1[q] = 1.f - 2.f / (__expf(2.f * v1[q]) + 1.f); }
                        } else {
#pragma unroll
                            for (int q = 0; q < 4; ++q) { v0[q] = sigmoidf_(v0[q]); v1[q] = sigmoidf_(v1[q]); }
                        }
                    } else if (u.pn == 1) { v0 = (f32x4){0.f, 0.f, 0.f, 0.f}; v1 = v0; }
                    u32x4 w; w.x = pg8::cvt_pk_bf16(v0[0], v0[1]); w.y = pg8::cvt_pk_bf16(v0[2], v0[3]); w.z = pg8::cvt_pk_bf16(v1[0], v1[1]); w.w = pg8::cvt_pk_bf16(v1[2], v1[3]);
                    *(u32x4*)(rowp + bj * 128) = w; } }
    }
};
struct SchedPlain {
    const char* a; const char* b; int nM, nN, lda, ldb, nt, G, c;
    __device__ __forceinline__ bool next(int i, pg8::Unit& u) const {
        const int L = i * G + c; if (L >= nM * nN) return false;
        pg8::swz_tile(L, nM, nN, u.pm, u.pn);
        u.a = a + (size_t)u.pm * 256 * lda * 2; u.b = b + (size_t)u.pn * 256 * ldb * 2; u.nt = nt; return true;
    }
};
struct EpiBf16 {
    static constexpr bool PERM = true;
    bf16_t* O; int ldc;
    __device__ __forceinline__ void operator()(const f32x4 (&acc)[2][2][4][2], const pg8::Unit& u, int wr, int wc, int fr, int fq) const {
        const int row0 = u.pm * 256 + wr * 64 + fr, col0 = u.pn * 256 + wc * 32 + 8 * fq;
#pragma unroll
        for (int ai = 0; ai < 2; ++ai)
#pragma unroll
            for (int m = 0; m < 4; ++m) { bf16_t* rowp = O + (size_t)(row0 + ai * 128 + m * 16) * ldc + col0;
#pragma unroll
                for (int bj = 0; bj < 2; ++bj) { const f32x4 v0 = acc[ai][bj][m][0], v1 = acc[ai][bj][m][1];
                    u32x4 w; w.x = pg8::cvt_pk_bf16(v0[0], v0[1]); w.y = pg8::cvt_pk_bf16(v0[2], v0[3]); w.z = pg8::cvt_pk_bf16(v1[0], v1[1]); w.w = pg8::cvt_pk_bf16(v1[2], v1[3]);
                    *(u32x4*)(rowp + bj * 128) = w; } }
    }
};
struct EpiRes {
    static constexpr bool PERM = false;
    const float* base; float* out; const float* gate;
    __device__ __forceinline__ void operator()(const f32x4 (&acc)[2][2][4][2], const pg8::Unit& u, int wr, int wc, int fr, int fq) const {
        const int row0 = u.pm * 256 + wr * 64 + fr, col0 = u.pn * 256 + wc * 32 + 4 * fq;
        const float* gp = gate + (size_t)(u.pm >> 4) * 6144 + col0;
        f32x4 gv[2][2];
#pragma unroll
        for (int bj = 0; bj < 2; ++bj)
#pragma unroll
            for (int n = 0; n < 2; ++n) gv[bj][n] = *(const f32x4*)(gp + bj * 128 + n * 16);
#pragma unroll
        for (int ai = 0; ai < 2; ++ai)
#pragma unroll
            for (int m = 0; m < 4; ++m) { const size_t ro = (size_t)(row0 + ai * 128 + m * 16) * D + col0;
#pragma unroll
                for (int bj = 0; bj < 2; ++bj)
#pragma unroll
                    for (int n = 0; n < 2; ++n) { const f32x4 b = *(const f32x4*)(base + ro + bj * 128 + n * 16);
                        *(f32x4*)(out + ro + bj * 128 + n * 16) = b + gv[bj][n] * acc[ai][bj][m][n]; } }
    }
};
struct SchedMoe {
    const char* a; const char* b; const int* tile; int lda, ldb, nt, G, c; size_t estride;
    __device__ __forceinline__ bool next(int i, pg8::Unit& u) const {
        const int ntl = tile[0]; const int L = i * G + c; if (L >= ntl * 4) return false;
        u.pm = L >> 2; u.pn = L & 3; const int e = tile[16 + u.pm];
        u.a = a + (size_t)u.pm * 256 * lda * 2; u.b = b + (size_t)e * estride + (size_t)u.pn * 256 * ldb * 2; u.nt = nt; return true;
    }
};
struct EpiGateUp {
    static constexpr bool PERM = true;
    bf16_t* H;
    __device__ __forceinline__ void operator()(const f32x4 (&acc)[2][2][4][2], const pg8::Unit& u, int wr, int wc, int fr, int fq) const {
        const int row0 = u.pm * 256 + wr * 64 + fr, col0 = u.pn * 128 + wc * 32 + 8 * fq;
#pragma unroll
        for (int ai = 0; ai < 2; ++ai)
#pragma unroll
            for (int m = 0; m < 4; ++m) { bf16_t* rowp = H + (size_t)(row0 + ai * 128 + m * 16) * ED + col0;
                f32x4 h0, h1;
#pragma unroll
                for (int q = 0; q < 4; ++q) { const float g0 = acc[ai][0][m][0][q], g1 = acc[ai][0][m][1][q];
                    h0[q] = g0 / (1.f + __expf(-g0)) * acc[ai][1][m][0][q]; h1[q] = g1 / (1.f + __expf(-g1)) * acc[ai][1][m][1][q]; }
                u32x4 w; w.x = pg8::cvt_pk_bf16(h0[0], h0[1]); w.y = pg8::cvt_pk_bf16(h0[2], h0[3]); w.z = pg8::cvt_pk_bf16(h1[0], h1[1]); w.w = pg8::cvt_pk_bf16(h1[2], h1[3]);
                *(u32x4*)rowp = w; }
    }
};
struct EpiWin {
    static constexpr bool PERM = true;
    bf16_t *BG, *U;
    __device__ __forceinline__ void operator()(const f32x4 (&acc)[2][2][4][2], const pg8::Unit& u, int wr, int wc, int fr, int fq) const {
        const int row0 = u.pm * 256 + wr * 64 + fr;
        if (u.pn < 4) {
            const int col0 = u.pn * 256 + wc * 32 + 8 * fq;
#pragma unroll
            for (int ai = 0; ai < 2; ++ai)
#pragma unroll
                for (int m = 0; m < 4; ++m) { bf16_t* rowp = BG + (size_t)(row0 + ai * 128 + m * 16) * D + col0;
#pragma unroll
                    for (int bj = 0; bj < 2; ++bj) { const f32x4 v0 = acc[ai][bj][m][0], v1 = acc[ai][bj][m][1];
                        u32x4 w; w.x = pg8::cvt_pk_bf16(v0[0], v0[1]); w.y = pg8::cvt_pk_bf16(v0[2], v0[3]); w.z = pg8::cvt_pk_bf16(v1[0], v1[1]); w.w = pg8::cvt_pk_bf16(v1[2], v1[3]);
                        *(u32x4*)(rowp + bj * 128) = w; } }
        } else {
            const int col0 = (u.pn - 4) * 128 + wc * 32 + 8 * fq;
#pragma unroll
            for (int ai = 0; ai < 2; ++ai)
#pragma unroll
                for (int m = 0; m < 4; ++m) { bf16_t* rowp = U + (size_t)(row0 + ai * 128 + m * 16) * D + col0;
                    const f32x4 v0 = acc[ai][0][m][0] * acc[ai][1][m][0], v1 = acc[ai][0][m][1] * acc[ai][1][m][1];
                    u32x4 w; w.x = pg8::cvt_pk_bf16(v0[0], v0[1]); w.y = pg8::cvt_pk_bf16(v0[2], v0[3]); w.z = pg8::cvt_pk_bf16(v1[0], v1[1]); w.w = pg8::cvt_pk_bf16(v1[2], v1[3]);
                    *(u32x4*)rowp = w; }
        }
    }
};

__device__ __forceinline__ void p3_scan(const Frame& F, const Args& A) {
    unsigned char* ws = A.ws;
    LAS float* OPS = (LAS float*)F.lds;
    LAS float* VY = OPS + 5 * 4096;
    LAS float* W2S = VY + 4096;
    LAS float* A2S = W2S + 4096;
    LAS float* BON = (LAS float*)(F.lds + LDS_X_OFF);
    const bf16_t* R = (const bf16_t*)A.out; const bf16_t* K = R + (size_t)ML * D;
    const bf16_t* KC = (const bf16_t*)(ws + WS_KC); const bf16_t* V = (const bf16_t*)(ws + WS_V); const bf16_t* LWA = (const bf16_t*)(ws + WS_LWA);
    const int i = F.tid >> 3, cg = F.tid & 7;
    for (int s = blockIdx.x; s < 256; s += F.G) {
        const int dir = s & 1, h = (s >> 1) & 15, b = s >> 5, c0 = h * HD;
        bf16_t* Y = (bf16_t*)(ws + (dir ? WS_Y1 : WS_Y0));
        __syncthreads();
#pragma unroll 1
        for (int q = F.tid; q < 4096; q += NTHREADS) { const int j = q >> 6, c = q & 63;
            W2S[q] = A.in[I_W2][((size_t)dir * 64 + j) * D + c0 + c]; A2S[q] = A.in[I_A2][((size_t)dir * 64 + j) * D + c0 + c]; }
        float S[64];
#pragma unroll
        for (int k = 0; k < 64; ++k) S[k] = 0.f;
        for (int seg = 0; seg < 2; ++seg) {
            const int Tseg = seg ? TL : TCX, nch = Tseg / 64;
            for (int ci = 0; ci < nch; ++ci) {
                __syncthreads();
                const int tl = ci * 64 + i, t = dir ? (Tseg - 1 - tl) : tl;
                const size_t arow = seg ? ((size_t)b * TL + t) : ((size_t)ML + (size_t)b * TCX + t);
                const bf16_t* lrow = LWA + arow * 256 + dir * 64;
                float accw[8], acca[8];
#pragma unroll
                for (int q = 0; q < 8; ++q) { const int c = c0 + cg * 8 + q; accw[q] = A.in[I_W0][dir * D + c]; acca[q] = A.in[I_A0][dir * D + c]; }
#pragma unroll 1
                for (int j8 = 0; j8 < 8; ++j8) {
                    const u32x4 lw = *(const u32x4*)(lrow + j8 * 8), la = *(const u32x4*)(lrow + 128 + j8 * 8);
                    float lwf[8] = {bflo(lw.x), bfhi(lw.x), bflo(lw.y), bfhi(lw.y), bflo(lw.z), bfhi(lw.z), bflo(lw.w), bfhi(lw.w)};
                    float laf[8] = {bflo(la.x), bfhi(la.x), bflo(la.y), bfhi(la.y), bflo(la.z), bfhi(la.z), bflo(la.w), bfhi(la.w)};
#pragma unroll
                    for (int jj = 0; jj < 8; ++jj) { const int j = j8 * 8 + jj;
                        const f32x4 wa = *(const LAS f32x4*)(W2S + j * 64 + cg * 8), wb = *(const LAS f32x4*)(W2S + j * 64 + cg * 8 + 4);
                        const f32x4 aa = *(const LAS f32x4*)(A2S + j * 64 + cg * 8), ab = *(const LAS f32x4*)(A2S + j * 64 + cg * 8 + 4);
#pragma unroll
                        for (int q = 0; q < 4; ++q) { accw[q] += lwf[jj] * wa[q]; accw[4 + q] += lwf[jj] * wb[q]; acca[q] += laf[jj] * aa[q]; acca[4 + q] += laf[jj] * ab[q]; }
                        asm volatile("" : "+v"(accw[0]), "+v"(accw[1]), "+v"(accw[2]), "+v"(accw[3]), "+v"(accw[4]), "+v"(accw[5]), "+v"(accw[6]), "+v"(accw[7]),
                                          "+v"(acca[0]), "+v"(acca[1]), "+v"(acca[2]), "+v"(acca[3]), "+v"(acca[4]), "+v"(acca[5]), "+v"(acca[6]), "+v"(acca[7]) :: "memory"); }
                }
                const bf16_t* krow = seg ? (K + ((size_t)b * TL + t) * D) : (KC + ((size_t)b * TCX + t) * D);
                const u32x4 k8 = *(const u32x4*)(krow + c0 + cg * 8), v8 = *(const u32x4*)(V + arow * D + c0 + cg * 8);
                u32x4 r8 = (u32x4){0u, 0u, 0u, 0u};
                if (seg) r8 = *(const u32x4*)(R + ((size_t)b * TL + t) * D + c0 + cg * 8);
                float kf[8] = {bflo(k8.x), bfhi(k8.x), bflo(k8.y), bfhi(k8.y), bflo(k8.z), bfhi(k8.z), bflo(k8.w), bfhi(k8.w)};
                float vf[8] = {bflo(v8.x), bfhi(v8.x), bflo(v8.y), bfhi(v8.y), bflo(v8.z), bfhi(v8.z), bflo(v8.w), bfhi(v8.w)};
                float rf[8] = {bflo(r8.x), bfhi(r8.x), bflo(r8.y), bfhi(r8.y), bflo(r8.z), bfhi(r8.z), bflo(r8.w), bfhi(r8.w)};
                float kkr[8], kav[8], rkv[8], ss = 0.f;
#pragma unroll
                for (int q = 0; q < 8; ++q) { const int c = c0 + cg * 8 + q; kkr[q] = kf[q] * A.in[I_KK][c]; ss += kkr[q] * kkr[q]; kav[q] = A.in[I_KA][c]; rkv[q] = A.in[I_RK][c]; }
                ss += __shfl_xor(ss, 1); ss += __shfl_xor(ss, 2); ss += __shfl_xor(ss, 4);
                const float inv = rsqrtf(fmaxf(ss, 1e-24f));
                float bon = 0.f;
                float wd[8], nk[8], bb[8], kd[8];
#pragma unroll
                for (int q = 0; q < 8; ++q) {
                    const float e = 0.60653066f * sigmoidf_(accw[q]);
                    wd[q] = __expf(-e);
                    const float a = sigmoidf_(acca[q]);
                    const float kk = kkr[q] * inv;
                    nk[q] = -kk; bb[q] = kk * a; kd[q] = kf[q] * (1.f + (a - 1.f) * kav[q]);
                    bon += rf[q] * kd[q] * rkv[q];
                }
                bon += __shfl_xor(bon, 1); bon += __shfl_xor(bon, 2); bon += __shfl_xor(bon, 4);
                LAS float* o = OPS + i * 64 + cg * 8;
                *(LAS f32x4*)(o) = (f32x4){wd[0], wd[1], wd[2], wd[3]}; *(LAS f32x4*)(o + 4) = (f32x4){wd[4], wd[5], wd[6], wd[7]};
                *(LAS f32x4*)(o + 4096) = (f32x4){nk[0], nk[1], nk[2], nk[3]}; *(LAS f32x4*)(o + 4096 + 4) = (f32x4){nk[4], nk[5], nk[6], nk[7]};
                *(LAS f32x4*)(o + 8192) = (f32x4){bb[0], bb[1], bb[2], bb[3]}; *(LAS f32x4*)(o + 8192 + 4) = (f32x4){bb[4], bb[5], bb[6], bb[7]};
                *(LAS f32x4*)(o + 12288) = (f32x4){kd[0], kd[1], kd[2], kd[3]}; *(LAS f32x4*)(o + 12288 + 4) = (f32x4){kd[4], kd[5], kd[6], kd[7]};
                *(LAS f32x4*)(o + 16384) = (f32x4){rf[0], rf[1], rf[2], rf[3]}; *(LAS f32x4*)(o + 16384 + 4) = (f32x4){rf[4], rf[5], rf[6], rf[7]};
                *(LAS f32x4*)(VY + i * 64 + cg * 8) = (f32x4){vf[0], vf[1], vf[2], vf[3]}; *(LAS f32x4*)(VY + i * 64 + cg * 8 + 4) = (f32x4){vf[4], vf[5], vf[6], vf[7]};
                if (cg == 0) BON[i] = bon;
                __syncthreads();
                if (F.wave == 0) {
#pragma unroll 1
                    for (int st = 0; st < 64; ++st) {
                        const LAS float* op = OPS + st * 64;
                        const float v = VY[st * 64 + F.lane];
                        float sa0 = 0.f, sa1 = 0.f, sa2 = 0.f, sa3 = 0.f;
#pragma unroll
                        for (int kg = 0; kg < 2; ++kg) {
#pragma unroll
                            for (int kq = 0; kq < 8; ++kq) { const int k4 = kg * 8 + kq; const f32x4 n4 = *(const LAS f32x4*)(op + 4096 + 4 * k4);
                                sa0 += S[4 * k4] * n4.x; sa1 += S[4 * k4 + 1] * n4.y; sa2 += S[4 * k4 + 2] * n4.z; sa3 += S[4 * k4 + 3] * n4.w; }
                            asm volatile("" : "+v"(sa0), "+v"(sa1), "+v"(sa2), "+v"(sa3) :: "memory"); }
                        const float sa = (sa0 + sa1) + (sa2 + sa3);
                        asm volatile("" ::: "memory"); __builtin_amdgcn_sched_barrier(0);
                        float y0 = 0.f, y1 = 0.f, y2 = 0.f, y3 = 0.f;
#pragma unroll
                        for (int kg = 0; kg < 8; ++kg) {
#pragma unroll
                            for (int kq = 0; kq < 2; ++kq) { const int k4 = kg * 2 + kq;
                                const f32x4 w4 = *(const LAS f32x4*)(op + 4 * k4), b4 = *(const LAS f32x4*)(op + 8192 + 4 * k4), d4 = *(const LAS f32x4*)(op + 12288 + 4 * k4), r4 = *(const LAS f32x4*)(op + 16384 + 4 * k4);
                                S[4 * k4] = S[4 * k4] * w4.x + (sa * b4.x + v * d4.x); y0 += S[4 * k4] * r4.x;
                                S[4 * k4 + 1] = S[4 * k4 + 1] * w4.y + (sa * b4.y + v * d4.y); y1 += S[4 * k4 + 1] * r4.y;
                                S[4 * k4 + 2] = S[4 * k4 + 2] * w4.z + (sa * b4.z + v * d4.z); y2 += S[4 * k4 + 2] * r4.z;
                                S[4 * k4 + 3] = S[4 * k4 + 3] * w4.w + (sa * b4.w + v * d4.w); y3 += S[4 * k4 + 3] * r4.w;
                            }
                            asm volatile("" : "+v"(y0), "+v"(y1), "+v"(y2), "+v"(y3) :: "memory");
                        }
                        const float y = (y0 + y1) + (y2 + y3);
                        VY[st * 64 + F.lane] = y + BON[st] * v;
                    }
                }
                __syncthreads();
                if (seg) {
                    const f32x4 y0 = *(const LAS f32x4*)(VY + i * 64 + cg * 8), y1 = *(const LAS f32x4*)(VY + i * 64 + cg * 8 + 4);
                    u32x4 w; w.x = pk2(y0.x, y0.y); w.y = pk2(y0.z, y0.w); w.z = pk2(y1.x, y1.y); w.w = pk2(y1.z, y1.w);
                    *(u32x4*)(Y + ((size_t)b * TL + t) * D + c0 + cg * 8) = w;
                }
            }
        }
    }
    __syncthreads();
}

__device__ __forceinline__ void p4_readout(const Frame& F, const Args& A) {
    unsigned char* ws = A.ws;
    {
        LAS float* scr = (LAS float*)(F.lds + F.wave * 16384);
        constexpr int NIT = 2 * 16 * 3 * 256;
        for (int it = F.gw; it < NIT; it += F.NGW) {
            const int mat = it >> 8, item = it & 255;
            const int kind = mat % 3, le = mat / 3, l = le >> 4, e = le & 15;
            unsigned char* mw = ws + (l ? WS_MOEW1 : WS_MOEW0);
            if (kind == 0) tr_job_item(A.in[I_MGATE] + (size_t)le * D * ED, ED, ED, (bf16_t*)mw, D, e * 1024, true, nullptr, item, scr, F.lane);
            else if (kind == 1) tr_job_item(A.in[I_MUP] + (size_t)le * D * ED, ED, ED, (bf16_t*)mw, D, e * 1024 + 128, true, nullptr, item, scr, F.lane);
            else tr_job_item(A.in[I_MDOWN] + (size_t)le * ED * D, D, D, (bf16_t*)(mw + 32 * MiB), ED, e * 1024, false, nullptr, item, scr, F.lane);
        }
    }
    const bf16_t* Y0 = (const bf16_t*)(ws + WS_Y0); const bf16_t* Y1 = (const bf16_t*)(ws + WS_Y1); const bf16_t* Gt = (const bf16_t*)(ws + WS_G);
    bf16_t* ZO = (bf16_t*)(ws + WS_ZO);
    float gw_[16], gb_[16];
#pragma unroll
    for (int j = 0; j < 2; ++j)
#pragma unroll
        for (int q = 0; q < 8; ++q) { const int c = 8 * F.lane + 512 * j + q; gw_[j * 8 + q] = A.in[I_GNW][c]; gb_[j * 8 + q] = A.in[I_GNB][c]; }
    for (int t = F.gw; t < ML; t += F.NGW) {
#pragma unroll
        for (int j = 0; j < 2; ++j) {
            const size_t off = (size_t)t * D + 8 * F.lane + 512 * j;
            const u32x4 a = *(const u32x4*)(Y0 + off), b = *(const u32x4*)(Y1 + off), g = *(const u32x4*)(Gt + off);
            float y[8] = {bflo(a.x) + bflo(b.x), bfhi(a.x) + bfhi(b.x), bflo(a.y) + bflo(b.y), bfhi(a.y) + bfhi(b.y), bflo(a.z) + bflo(b.z), bfhi(a.z) + bfhi(b.z), bflo(a.w) + bflo(b.w), bfhi(a.w) + bfhi(b.w)};
            float gg[8] = {bflo(g.x), bfhi(g.x), bflo(g.y), bfhi(g.y), bflo(g.z), bfhi(g.z), bflo(g.w), bfhi(g.w)};
            float s = 0.f;
#pragma unroll
            for (int q = 0; q < 8; ++q) s += y[q];
            s += __shfl_xor(s, 1); s += __shfl_xor(s, 2); s += __shfl_xor(s, 4);
            const float mean = s * (1.f / 64.f); float s2 = 0.f;
#pragma unroll
            for (int q = 0; q < 8; ++q) { y[q] -= mean; s2 += y[q] * y[q]; }
            s2 += __shfl_xor(s2, 1); s2 += __shfl_xor(s2, 2); s2 += __shfl_xor(s2, 4);
            const float rstd = rsqrtf(s2 * (1.f / 64.f) + GN_EPS);
            float z[8];
#pragma unroll
            for (int q = 0; q < 8; ++q) z[q] = (y[q] * rstd * gw_[j * 8 + q] + gb_[j * 8 + q]) * gg[q];
            u32x4 w; w.x = pk2(z[0], z[1]); w.y = pk2(z[2], z[3]); w.z = pk2(z[4], z[5]); w.w = pk2(z[6], z[7]);
            *(u32x4*)(ZO + off) = w;
        }
    }
}

__device__ __forceinline__ void p6_route(const Frame& F, const Args& A, const int layer) {
    unsigned char* ws = A.ws;
    LAS float* RW = (LAS float*)F.lds;
    __syncthreads();
    for (int i = F.tid; i < D * NE; i += NTHREADS) { const int d = i >> 4, e = i & 15; const int j = d >> 8, l = (d & 255) >> 2, jj = d & 3, dj = j * 4 + jj;
        RW[((dj * 4 + (e >> 2)) * 64 + l) * 4 + (e & 3)] = A.in[I_ROUTW][i]; }
    __syncthreads();
    const float* MOD = (const float*)(ws + WS_MOD) + (size_t)layer * 9 * 6144;
    const float* ng = A.in[I_NORMG] + (size_t)(layer * 2 + 1) * D;
    const float* h = A.out;
    bf16_t* XN = (bf16_t*)(ws + WS_XN);
    unsigned* EIDX = (unsigned*)(ws + WS_EIDX); float* GATE = (float*)(ws + WS_GATE); int* CC = (int*)(ws + WS_CC);
    float rb[16];
#pragma unroll
    for (int e = 0; e < 16; ++e) rb[e] = A.in[I_ROUTB][e];
    for (int ch = F.gw; ch < 2048; ch += F.NGW) {
        const int t0 = ch * 16, b = t0 / TL;
        const float* mrow = MOD + (size_t)b * 6144;
        f32x4 gsc[4], sh[4];
#pragma unroll
        for (int j = 0; j < 4; ++j) { const int c = 4 * F.lane + 256 * j; gsc[j] = *(const f32x4*)(ng + c) * (1.f + *(const f32x4*)(mrow + 4096 + c)); sh[j] = *(const f32x4*)(mrow + 3072 + c); }
        int cnt = 0;
        for (int i = 0; i < 16; ++i) {
            const int t = t0 + i;
            f32x4 v[4];
            p1_load_norm(h + (size_t)t * D, gsc, sh, v, F.lane);
            bf16_t* orow = XN + (size_t)t * D + 4 * F.lane;
#pragma unroll
            for (int j = 0; j < 4; ++j) st_bf4(orow + 256 * j, v[j]);
            float lg[16];
#pragma unroll
            for (int e = 0; e < 16; ++e) lg[e] = 0.f;
#pragma unroll
            for (int j = 0; j < 4; ++j)
#pragma unroll
                for (int jj = 0; jj < 4; ++jj) { const float xv = v[j][jj]; const int dj = j * 4 + jj;
#pragma unroll
                    for (int q = 0; q < 4; ++q) { const f32x4 w = *(const LAS f32x4*)(RW + ((dj * 4 + q) * 64 + F.lane) * 4);
                        lg[4 * q] += xv * w.x; lg[4 * q + 1] += xv * w.y; lg[4 * q + 2] += xv * w.z; lg[4 * q + 3] += xv * w.w; }
                    asm volatile("" : "+v"(lg[0]), "+v"(lg[1]), "+v"(lg[2]), "+v"(lg[3]), "+v"(lg[4]), "+v"(lg[5]), "+v"(lg[6]), "+v"(lg[7]),
                                      "+v"(lg[8]), "+v"(lg[9]), "+v"(lg[10]), "+v"(lg[11]), "+v"(lg[12]), "+v"(lg[13]), "+v"(lg[14]), "+v"(lg[15]) :: "memory"); }
#pragma unroll
            for (int e = 0; e < 16; ++e) lg[e] = wave_sum(lg[e]);
            float best = -3.0e38f; int be0 = 0, be1 = 1; float bs0 = 0.f, bs1 = 0.f;
#pragma unroll
            for (int g = 0; g < 4; ++g) {
                float s[4], sel[4];
#pragma unroll
                for (int q = 0; q < 4; ++q) { s[q] = 1.f / (1.f + expf(-lg[4 * g + q])); sel[q] = s[q] + rb[4 * g + q]; }
                int i1 = 0; float v1 = sel[0], s1 = s[0];
#pragma unroll
                for (int q = 1; q < 4; ++q) if (sel[q] > v1) { i1 = q; v1 = sel[q]; s1 = s[q]; }
                int i2 = -1; float v2 = -3.0e38f, s2 = 0.f;
#pragma unroll
                for (int q = 0; q < 4; ++q) if (q != i1 && sel[q] > v2) { i2 = q; v2 = sel[q]; s2 = s[q]; }
                const float gs = v1 + v2;
                if (gs > best) { best = gs; be0 = 4 * g + i1; be1 = 4 * g + i2; bs0 = s1; bs1 = s2; }
            }
            const float inv = 1.f / (bs0 + bs1);
            if (F.lane == 0) { EIDX[t] = (unsigned)be0 | ((unsigned)be1 << 8); GATE[2 * t] = bs0 * inv; GATE[2 * t + 1] = bs1 * inv; }
            cnt += (F.lane == be0) + (F.lane == be1);
        }
        if (F.lane < 16) CC[ch * 16 + F.lane] = cnt;
    }
    __syncthreads();
}

__device__ __forceinline__ void p7_permute(const Frame& F, const Args& A) {
    unsigned char* ws = A.ws;
    LAS int* cc = (LAS int*)F.lds;
    LAS int* ps = (LAS int*)(F.lds + LDS_X_OFF);
    LAS int* seg = ps + 512;
    const int* CC = (const int*)(ws + WS_CC);
    const unsigned* EIDX = (const unsigned*)(ws + WS_EIDX); int* POS = (int*)(ws + WS_POS); int* TILE = (int*)(ws + WS_TILE);
    const bf16_t* XN = (const bf16_t*)(ws + WS_XN); bf16_t* XP = (bf16_t*)(ws + WS_XP);
    __syncthreads();
    for (int i = F.tid; i < 2048 * 16 / 4; i += NTHREADS) ((LAS u32x4*)cc)[i] = ((const u32x4*)CC)[i];
    __syncthreads();
    { const int e = F.tid & 15, part = F.tid >> 4; int s = 0; for (int q = 0; q < 64; ++q) s += cc[(part * 64 + q) * 16 + e]; ps[part * 16 + e] = s; }
    __syncthreads();
    if (F.tid < 16) { int run = 0; for (int p = 0; p < 32; ++p) { const int v = ps[p * 16 + F.tid]; ps[p * 16 + F.tid] = run; run += v; } seg[F.tid] = run; }
    __syncthreads();
    if (F.tid == 0) { int off = 0, nt = 0;
        for (int e = 0; e < 16; ++e) { const int tot = seg[e]; seg[e] = off; const int tl = (tot + 255) >> 8;
            if (blockIdx.x == 0) for (int q = 0; q < tl; ++q) TILE[16 + nt + q] = e;
            nt += tl; off += tl * 256; }
        if (blockIdx.x == 0) TILE[0] = nt; }
    __syncthreads();
    for (int ch = F.gw; ch < 2048; ch += F.NGW) {
        int base = 0;
        if (F.lane < 16) { base = seg[F.lane] + ps[(ch >> 6) * 16 + F.lane]; for (int q = (ch & ~63); q < ch; ++q) base += cc[q * 16 + F.lane]; }
        for (int i = 0; i < 16; ++i) {
            const int t = ch * 16 + i; const unsigned ei = EIDX[t]; const int e0 = ei & 255, e1 = (ei >> 8) & 255;
            const int p0 = __shfl(base, e0); base += (F.lane == e0);
            const int p1 = __shfl(base, e1); base += (F.lane == e1);
            if (F.lane == 0) { POS[2 * t] = p0; POS[2 * t + 1] = p1; }
            const u32x4* src = (const u32x4*)(XN + (size_t)t * D) + F.lane;
            const u32x4 a = src[0], b = src[64];
            u32x4* d0 = (u32x4*)(XP + (size_t)p0 * D) + F.lane; u32x4* d1 = (u32x4*)(XP + (size_t)p1 * D) + F.lane;
            d0[0] = a; d0[64] = b; d1[0] = a; d1[64] = b;
        }
    }
    __syncthreads();
}

template <bool FINAL>
__device__ __forceinline__ void p10_combine(const Frame& F, const Args& A, const int layer) {
    unsigned char* ws = A.ws;
    const float* MOD = (const float*)(ws + WS_MOD);
    const bf16_t* O = (const bf16_t*)(ws + WS_XP); const int* POS = (const int*)(ws + WS_POS); const float* GATE = (const float*)(ws + WS_GATE);
    bf16_t* XN = (bf16_t*)(ws + WS_XN);
    float* h = A.out;
    for (int ch = F.gw; ch < 2048; ch += F.NGW) {
        const int t0 = ch * 16, b = t0 / TL;
        const float* mcur = MOD + ((size_t)layer * 9 + b) * 6144;
        f32x4 gt2[4], gsc[4], sh[4];
#pragma unroll
        for (int j = 0; j < 4; ++j) { const int c = 4 * F.lane + 256 * j; gt2[j] = *(const f32x4*)(mcur + 5120 + c);
            if (FINAL) { gsc[j] = *(const f32x4*)(A.in[I_FINALG] + c); sh[j] = (f32x4){0.f, 0.f, 0.f, 0.f}; }
            else { const float* mn = MOD + ((size_t)9 + b) * 6144; gsc[j] = *(const f32x4*)(A.in[I_NORMG] + 2 * D + c) * (1.f + *(const f32x4*)(mn + 1024 + c)); sh[j] = *(const f32x4*)(mn + c); } }
        for (int i = 0; i < 16; ++i) {
            const int t = t0 + i; const int p0 = POS[2 * t], p1 = POS[2 * t + 1]; const float w0 = GATE[2 * t], w1 = GATE[2 * t + 1];
            f32x4 v[4]; float s = 0.f;
#pragma unroll
            for (int j = 0; j < 4; ++j) { const int c = 4 * F.lane + 256 * j;
                const u32x2 oa = *(const u32x2*)(O + (size_t)p0 * D + c), ob = *(const u32x2*)(O + (size_t)p1 * D + c);
                const f32x4 m = w0 * (f32x4){bflo(oa.x), bfhi(oa.x), bflo(oa.y), bfhi(oa.y)} + w1 * (f32x4){bflo(ob.x), bfhi(ob.x), bflo(ob.y), bfhi(ob.y)};
                v[j] = *(const f32x4*)(h + (size_t)t * D + c) + gt2[j] * m;
                s += (v[j].x * v[j].x + v[j].y * v[j].y) + (v[j].z * v[j].z + v[j].w * v[j].w); }
            const float rstd = rsqrtf(wave_sum(s) * (1.f / D) + RMS_EPS);
            if (FINAL) {
#pragma unroll
                for (int j = 0; j < 4; ++j) *(f32x4*)(h + (size_t)t * D + 4 * F.lane + 256 * j) = v[j] * rstd * gsc[j];
            } else {
#pragma unroll
                for (int j = 0; j < 4; ++j) { *(f32x4*)(h + (size_t)t * D + 4 * F.lane + 256 * j) = v[j]; st_bf4(XN + (size_t)t * D + 4 * F.lane + 256 * j, v[j] * rstd * gsc[j] + sh[j]); }
            }
        }
    }
}

__device__ __forceinline__ void ld_bf16row(const bf16_t* row, float (&o)[16], int lane) {
#pragma unroll
    for (int j = 0; j < 2; ++j) { const u32x4 a = *(const u32x4*)(row + 8 * lane + 512 * j);
        o[8 * j] = bflo(a.x); o[8 * j + 1] = bfhi(a.x); o[8 * j + 2] = bflo(a.y); o[8 * j + 3] = bfhi(a.y); o[8 * j + 4] = bflo(a.z); o[8 * j + 5] = bfhi(a.z); o[8 * j + 6] = bflo(a.w); o[8 * j + 7] = bfhi(a.w); }
}
__device__ __forceinline__ void p12_conv(const Frame& F, const Args& A) {
    unsigned char* ws = A.ws;
    const bf16_t* BG = (const bf16_t*)(ws + WS_BG); const bf16_t* U = (const bf16_t*)(ws + WS_U); bf16_t* Z = (bf16_t*)(ws + WS_Z);
    float c0[16], c1[16], c2[16];
#pragma unroll
    for (int j = 0; j < 2; ++j)
#pragma unroll
        for (int q = 0; q < 8; ++q) { const int c = 8 * F.lane + 512 * j + q; c0[8 * j + q] = A.in[I_CONV][c]; c1[8 * j + q] = A.in[I_CONV][D + c]; c2[8 * j + q] = A.in[I_CONV][2 * D + c]; }
    for (int u = F.gw; u < 2048; u += F.NGW) {
        const int t0 = u * 16, pos0 = t0 % GRIDW;
        float prev[16], cur[16], nxt[16], bg[16];
        if (pos0 > 0) ld_bf16row(U + (size_t)(t0 - 1) * D, prev, F.lane);
        else {
#pragma unroll
            for (int q = 0; q < 16; ++q) prev[q] = 0.f; }
        ld_bf16row(U + (size_t)t0 * D, cur, F.lane);
        for (int i = 0; i < 16; ++i) {
            if (pos0 + i + 1 < GRIDW) ld_bf16row(U + (size_t)(t0 + i + 1) * D, nxt, F.lane);
            else {
#pragma unroll
                for (int q = 0; q < 16; ++q) nxt[q] = 0.f; }
            ld_bf16row(BG + (size_t)(t0 + i) * D, bg, F.lane);
            float z[16];
#pragma unroll
            for (int q = 0; q < 16; ++q) { z[q] = bg[q] * (c0[q] * prev[q] + c1[q] * cur[q] + c2[q] * nxt[q]); prev[q] = cur[q]; cur[q] = nxt[q]; }
#pragma unroll
            for (int j = 0; j < 2; ++j) { u32x4 w; w.x = pk2(z[8 * j], z[8 * j + 1]); w.y = pk2(z[8 * j + 2], z[8 * j + 3]); w.z = pk2(z[8 * j + 4], z[8 * j + 5]); w.w = pk2(z[8 * j + 6], z[8 * j + 7]);
                *(u32x4*)(Z + (size_t)(t0 + i) * D + 8 * F.lane + 512 * j) = w; }
        }
    }
}

constexpr int N_PHASES = 20;
__global__ void __launch_bounds__(NTHREADS, 2) fwd(Args args) {
    extern __shared__ __attribute__((aligned(16))) unsigned char lds_raw[];
    Frame F;
    F.lds = (LAS unsigned char*)lds_raw;
    F.tid = threadIdx.x; F.lane = F.tid & 63; F.wave = __builtin_amdgcn_readfirstlane(F.tid >> 6);
    F.G = gridDim.x; { const int bx = blockIdx.x; F.vcu = (F.G % 8 == 0) ? (bx % 8) * (F.G / 8) + bx / 8 : bx; }
    F.gw = F.vcu * NWAVES + F.wave; F.NGW = F.G * NWAVES;
    unsigned char* ws = args.ws;
    for (int u = F.tid; u < (LDS_BYTES - LDSCTL_OFF) / 4; u += NTHREADS) ((LAS unsigned*)(F.lds + LDSCTL_OFF))[u] = 0u;
    __syncthreads();
    volatile LAS unsigned* MISC = (volatile LAS unsigned*)(F.lds + MISC_OFF);
    XcdBarrier bar; bar.bar = (unsigned*)(ws + WS_CTL) + CW_BAR; bar.x = 0; bar.st = nullptr;
    const int lo = args.ph_lo, hi = args.ph_hi;
    if (hi - lo > 1) bar = xcd_barrier_post((unsigned*)(ws + WS_CTL) + CW_BAR, MISC + 8);
#ifndef PH_MASK
#define PH_MASK 0xFFFFFu
#endif
#define IN(k) (((PH_MASK >> (k)) & 1u) && lo <= (k) && (k) < hi)
#define SEAM(k) do { if (IN(k) && IN((k) + 1)) xcd_barrier(bar); } while (0)
    const float* MOD = (const float*)(ws + WS_MOD);
    const int bx = (int)blockIdx.x;

    if (IN(0)) { p0_prologue(F, args); SEAM(0); }
    if (IN(1)) { p1_mix(F, args); SEAM(1); }
    if (IN(2)) {
        { SchedRKV S{(const char*)(ws + WS_XM), (const char*)(ws + WS_WRKV), F.G, bx};
          EpiRKV E{(bf16_t*)args.out, (bf16_t*)args.out + (size_t)ML * D, (bf16_t*)(ws + WS_KC), (bf16_t*)(ws + WS_V)};
          pg8::gemm_phase<EpiRKV, SchedRKV>(F.lds, XM_LD, 2048, S, E); }
        { SchedLora S{(const char*)(ws + WS_XM), (const char*)(ws + WS_WL), F.G, (bx + F.G / 2) % F.G};
          EpiLora E{(bf16_t*)(ws + WS_LWA), (bf16_t*)(ws + WS_LG)};
          pg8::gemm_phase<EpiLora, SchedLora>(F.lds, XM_LD, 2048, S, E); }
        SEAM(2);
    }
    if (IN(3)) {
        SchedPlain S{(const char*)(ws + WS_LG), (const char*)(ws + WS_G2), 128, 4, 256, 256, 4, F.G, bx};
        EpiBf16 E{(bf16_t*)(ws + WS_G), D};
        pg8::gemm_phase<EpiBf16, SchedPlain>(F.lds, 256, 256, S, E);
        SEAM(3);
    }
    if (IN(4)) { p3_scan(F, args); SEAM(4); }
    if (IN(5)) { p4_readout(F, args); SEAM(5); }
    if (IN(6)) {
        SchedPlain S{(const char*)(ws + WS_ZO), (const char*)(ws + WS_WO), 128, 4, D, D, 16, F.G, bx};
        EpiRes E{args.in[I_X], args.out, MOD + 2048};
        pg8::gemm_phase<EpiRes, SchedPlain>(F.lds, D, D, S, E);
        SEAM(6);
    }
    if (IN(7)) { p6_route(F, args, 0); SEAM(7); }
    if (IN(8)) { p7_permute(F, args); SEAM(8); }
    if (IN(9)) {
        SchedMoe S{(const char*)(ws + WS_XP), (const char*)(ws + WS_MOEW0), (const int*)(ws + WS_TILE), D, D, 16, F.G, bx, (size_t)2 * MiB};
        EpiGateUp E{(bf16_t*)(ws + WS_H)};
        pg8::gemm_phase<EpiGateUp, SchedMoe>(F.lds, D, D, S, E);
        SEAM(9);
    }
    if (IN(10)) {
        SchedMoe S{(const char*)(ws + WS_H), (const char*)(ws + WS_MOEW0 + 32 * MiB), (const int*)(ws + WS_TILE), ED, ED, 8, F.G, bx, (size_t)1 * MiB};
        EpiBf16 E{(bf16_t*)(ws + WS_XP), D};
        pg8::gemm_phase<EpiBf16, SchedMoe>(F.lds, ED, ED, S, E);
        SEAM(10);
    }
    if (IN(11)) { p10_combine<false>(F, args, 0); SEAM(11); }
    if (IN(12)) {
        SchedPlain S{(const char*)(ws + WS_XN), (const char*)(ws + WS_WIN), 128, 12, D, D, 16, F.G, bx};
        EpiWin E{(bf16_t*)(ws + WS_BG), (bf16_t*)(ws + WS_U)};
        pg8::gemm_phase<EpiWin, SchedPlain>(F.lds, D, D, S, E);
        SEAM(12);
    }
    if (IN(13)) { p12_conv(F, args); SEAM(13); }
    if (IN(14)) {
        SchedPlain S{(const char*)(ws + WS_Z), (const char*)(ws + WS_WOUT), 128, 4, D, D, 16, F.G, bx};
        EpiRes E{args.out, args.out, MOD + 9 * 6144 + 2048};
        pg8::gemm_phase<EpiRes, SchedPlain>(F.lds, D, D, S, E);
        SEAM(14);
    }
    if (IN(15)) { p6_route(F, args, 1); SEAM(15); }
    if (IN(16)) { p7_permute(F, args); SEAM(16); }
    if (IN(17)) {
        SchedMoe S{(const char*)(ws + WS_XP), (const char*)(ws + WS_MOEW1), (const int*)(ws + WS_TILE), D, D, 16, F.G, bx, (size_t)2 * MiB};
        EpiGateUp E{(bf16_t*)(ws + WS_H)};
        pg8::gemm_phase<EpiGateUp, SchedMoe>(F.lds, D, D, S, E);
        SEAM(17);
    }
    if (IN(18)) {
        SchedMoe S{(const char*)(ws + WS_H), (const char*)(ws + WS_MOEW1 + 32 * MiB), (const int*)(ws + WS_TILE), ED, ED, 8, F.G, bx, (size_t)1 * MiB};
        EpiBf16 E{(bf16_t*)(ws + WS_XP), D};
        pg8::gemm_phase<EpiBf16, SchedMoe>(F.lds, ED, ED, S, E);
        SEAM(18);
    }
    if (IN(19)) { p10_combine<true>(F, args, 1); }
}

extern "C" void kernel_launch(void* const* d_in, const int* in_sizes, int n_in, void* d_out, int out_size, void* d_ws, size_t ws_size, hipStream_t stream) {
    static int grid = 0;
    if (grid == 0) {
        if (n_in != 32 || out_size != ML * D || ws_size < WS_END) { fprintf(stderr, "kernel_launch: unexpected problem (n_in %d, out %d, ws %zu)\n", n_in, out_size, ws_size); grid = -1; return; }
        int dev = 0, cus = 0;
        if (hipGetDevice(&dev) != hipSuccess || hipDeviceGetAttribute(&cus, hipDeviceAttributeMultiprocessorCount, dev) != hipSuccess) { grid = -1; return; }
        if (hipFuncSetAttribute((const void*)fwd, hipFuncAttributeMaxDynamicSharedMemorySize, LDS_BYTES) != hipSuccess) { grid = -1; return; }
        int per_cu = 0;
        if (hipOccupancyMaxActiveBlocksPerMultiprocessor(&per_cu, (const void*)fwd, NTHREADS, LDS_BYTES) != hipSuccess || per_cu < 1) { fprintf(stderr, "kernel_launch: occupancy query says %d\n", per_cu); grid = -1; return; }
        grid = cus > 256 ? 256 : cus;
    }
    if (grid < 0) return;
    (void)in_sizes;
    hipMemsetAsync((char*)d_ws + WS_CTL, 0, CTL_ZERO_BYTES, stream);
    Args a{};
    for (int i = 0; i < 32; ++i) a.in[i] = (const float*)d_in[i];
    a.out = (float*)d_out; a.ws = (unsigned char*)d_ws;
#if MK_N_LAUNCHES == 1
    a.ph_lo = 0; a.ph_hi = N_PHASES;
    hipLaunchKernelGGL(fwd, dim3(grid), dim3(NTHREADS), LDS_BYTES, stream, a);
#else
    for (int k = 0; k < N_PHASES; ++k) { a.ph_lo = k; a.ph_hi = k + 1; hipLaunchKernelGGL(fwd, dim3(grid), dim3(NTHREADS), LDS_BYTES, stream, a); }
#endif
}
```

```cpp
#include <hip/hip_runtime.h>
#include <cstdio>
#include <cstdint>

#ifndef MK_N_LAUNCHES
#define MK_N_LAUNCHES 1
#endif

#define GAS __attribute__((address_space(1)))
#define LAS __attribute__((address_space(3)))
typedef unsigned short bf16_t;
typedef short bf16x8 __attribute__((ext_vector_type(8)));
typedef float f32x4 __attribute__((ext_vector_type(4)));
typedef float f32x2 __attribute__((ext_vector_type(2)));
typedef unsigned u32x4 __attribute__((ext_vector_type(4)));
typedef unsigned u32x2 __attribute__((ext_vector_type(2)));

constexpr int D = 1024, NBATCH = 8, TL = 4096, TCX = 256, ML = NBATCH * TL, MC = NBATCH * TCX, MA = ML + MC;
constexpr int NH = 16, HD = 64, NE = 16, ED = 512, GRIDW = 64;
constexpr int XM_LD = 5 * D;
constexpr int NWAVES = 8, NTHREADS = 512;
constexpr float RMS_EPS = 1e-6f, GN_EPS = 64e-5f;
constexpr int MAXTILES = 272;

constexpr size_t MiB = 1u << 20;
constexpr size_t WS_CTL = 0, CTL_ZERO_BYTES = 1 * MiB;
constexpr size_t WS_MOD = 1 * MiB;
constexpr size_t WS_EIDX = 2 * MiB;
constexpr size_t WS_GATE = WS_EIDX + 128 * 1024;
constexpr size_t WS_POS = WS_GATE + 256 * 1024;
constexpr size_t WS_CC = WS_POS + 256 * 1024;
constexpr size_t WS_TILE = WS_CC + 128 * 1024;
constexpr size_t WS_WRKV = 4 * MiB;
constexpr size_t WS_WL = 16 * MiB;
constexpr size_t WS_G2 = 18 * MiB;
constexpr size_t WS_WO = 19 * MiB;
constexpr size_t WS_WIN = 21 * MiB;
constexpr size_t WS_WOUT = 27 * MiB;
constexpr size_t WS_ACT = 32 * MiB;
constexpr size_t WS_XM = WS_ACT;
constexpr size_t WS_V = 372 * MiB;
constexpr size_t WS_KC = 440 * MiB;
constexpr size_t WS_LWA = 444 * MiB;
constexpr size_t WS_LG = 461 * MiB;
constexpr size_t WS_G = 32 * MiB;
constexpr size_t WS_Y0 = 96 * MiB, WS_Y1 = 160 * MiB;
constexpr size_t WS_ZO = 272 * MiB;
constexpr size_t WS_MOEW0 = 384 * MiB, WS_MOEW1 = 432 * MiB;
constexpr size_t WS_XN = 32 * MiB;
constexpr size_t WS_XP = 96 * MiB;
constexpr size_t WS_H = 232 * MiB;
constexpr size_t WS_BG = 232 * MiB, WS_U = 296 * MiB;
constexpr size_t WS_Z = 96 * MiB;
constexpr size_t WS_END = 480 * MiB;

constexpr int CW_BAR = 4096;

constexpr int RING_BYTES = 131072;
constexpr int LDSCTL_OFF = RING_BYTES, MISC_OFF = LDSCTL_OFF + 320;
constexpr int LDS_X_OFF = RING_BYTES + 1024;
constexpr int LDS_BYTES = 147456;

__device__ __forceinline__ unsigned f2bf(float f) { unsigned u = __builtin_bit_cast(unsigned, f); return (u + 0x7fffu + ((u >> 16) & 1u)) >> 16; }
__device__ __forceinline__ unsigned pk2(float lo, float hi) { return f2bf(lo) | (f2bf(hi) << 16); }
__device__ __forceinline__ float bflo(unsigned u) { return __builtin_bit_cast(float, u << 16); }
__device__ __forceinline__ float bfhi(unsigned u) { return __builtin_bit_cast(float, u & 0xffff0000u); }
__device__ __forceinline__ float wave_sum(float v) {
#pragma unroll
    for (int o = 1; o < 64; o <<= 1) v += __shfl_xor(v, o);
    return v;
}
__device__ __forceinline__ float sigmoidf_(float x) { return 1.f / (1.f + __expf(-x)); }
#define LDS_WAIT() asm volatile("s_waitcnt lgkmcnt(0)" ::: "memory")

namespace pg8 {
constexpr int BM = 256, BK = 64, HALF = 128, HTB = HALF * BK * 2, STAGE_BYTES = 8 * HTB, NXCD = 8, WGM = 8;
__host__ __device__ __forceinline__ int lds_byte(int r, int c) { const int st = (r >> 4) * 2 + (c >> 5), rr = r & 15, cc = c & 31, ob = rr * 64 + cc * 2; return st * 1024 + (ob ^ (((ob >> 9) & 1) << 5)); }
__host__ __device__ __forceinline__ void stage_rc(int b, int& R, int& C) { const int st = b / 1024, sb = b % 1024, swz = sb ^ (((sb >> 9) & 1) << 5); R = (st >> 1) * 16 + swz / 64; C = (st & 1) * 32 + (swz % 64) / 2; }
__host__ __device__ __forceinline__ int perm32(int rho) { const int n = rho >> 4, i = rho & 15; return 8 * (i >> 2) + 4 * n + (i & 3); }

struct Unit { int pm, pn; const char* a; const char* b; int nt; };

__device__ __forceinline__ void swz_tile(int L, int nM, int nN, int& pm, int& pn) {
    const int nwg = nM * nN; int wgid = L;
    { const int q = nwg / NXCD, r = nwg % NXCD, xcd = wgid % NXCD, off = wgid / NXCD; wgid = (xcd < r ? xcd * (q + 1) : r * (q + 1) + (xcd - r) * q) + off; }
    const int nig = WGM * nN, gid = wgid / nig, fm = gid * WGM, gsz = (nM - fm) < WGM ? (nM - fm) : WGM;
    pm = fm + ((wgid % nig) % gsz); pn = (wgid % nig) / gsz;
}

__device__ __forceinline__ unsigned cvt_pk_bf16(float lo, float hi) { unsigned r; asm volatile("v_cvt_pk_bf16_f32 %0, %1, %2" : "=v"(r) : "v"(lo), "v"(hi)); return r; }

template <class Epi, class Sched, bool ALIGN_EPI = true, bool SP2 = true>
__device__ __forceinline__ void gemm_phase(LAS unsigned char* lds, const int lda, const int ldb, const Sched& S, const Epi& E) {
    const int tid = threadIdx.x, wid = __builtin_amdgcn_readfirstlane(tid >> 6), lane = tid & 63, wr = wid >> 2, wc = wid & 3, fr = lane & 15, fq = lane >> 4;
    unsigned voffA[2], voffB[2];
#pragma unroll
    for (int i = 0; i < 2; ++i) { int R, C; stage_rc(tid * 16 + i * 8192, R, C); const int Rb = Epi::PERM ? ((R & ~31) + perm32(R & 31)) : R;
        voffA[i] = (unsigned)(R * lda + C) * 2u; voffB[i] = (unsigned)(Rb * ldb + C) * 2u; }
    const size_t kstep = (size_t)(BK * 2);
    const size_t hstepA = (size_t)HALF * lda * 2, hstepB = (size_t)HALF * ldb * 2;
    const unsigned ldsw = (unsigned)wid * 1024u;
    const int aoff = lds_byte(wr * 64 + fr, fq * 8), boff = lds_byte(wc * 32 + fr, fq * 8);
#define PG8_SA(b, h) (((b) * 2 + (h)) * HTB)
#define PG8_SB(b, h) ((4 + (b) * 2 + (h)) * HTB)
#define PG8_STAGE(bufoff, gbase, voff) do { _Pragma("unroll") for (int _i = 0; _i < 2; ++_i) \
        __builtin_amdgcn_global_load_lds((const unsigned*)((const char*)(gbase) + (voff)[_i]), (LAS unsigned*)(lds + (bufoff) + ldsw + _i * 8192), 16, 0, 0); } while (0)
#define PG8_LDA(dst, b, h) do { _Pragma("unroll") for (int m = 0; m < 4; ++m) _Pragma("unroll") for (int k = 0; k < 2; ++k) dst[m][k] = *(const LAS bf16x8*)(lds + PG8_SA(b, h) + aoff + m * 2048 + k * 1024); } while (0)
#define PG8_LDB(dst, b, h) do { _Pragma("unroll") for (int n = 0; n < 2; ++n) _Pragma("unroll") for (int k = 0; k < 2; ++k) dst[n][k] = *(const LAS bf16x8*)(lds + PG8_SB(b, h) + boff + n * 2048 + k * 1024); } while (0)
#define PG8_MMA(ai, bj, At, Bt) do { __builtin_amdgcn_s_setprio(1); _Pragma("unroll") for (int m = 0; m < 4; ++m) _Pragma("unroll") for (int n = 0; n < 2; ++n) _Pragma("unroll") for (int k = 0; k < 2; ++k) \
        acc[ai][bj][m][n] = __builtin_amdgcn_mfma_f32_16x16x32_bf16(Bt[n][k], At[m][k], acc[ai][bj][m][n], 0, 0, 0); __builtin_amdgcn_s_setprio(0); } while (0)
#define PG8_WAIT_V(n) asm volatile("s_waitcnt vmcnt(" #n ")" ::: "memory")
#define PG8_WAIT_L(n) asm volatile("s_waitcnt lgkmcnt(" #n ")" ::: "memory")
#define PG8_BAR __builtin_amdgcn_s_barrier()
#define PG8_SCHED __builtin_amdgcn_sched_barrier(0)
    Unit cur, nxt; int ui = 0;
    if (!S.next(0, cur)) return;
    f32x4 acc[2][2][4][2];
#pragma unroll
    for (int a = 0; a < 2; ++a)
#pragma unroll
        for (int b = 0; b < 2; ++b)
#pragma unroll
            for (int m = 0; m < 4; ++m)
#pragma unroll
                for (int n = 0; n < 2; ++n) acc[a][b][m][n] = (f32x4){0.f, 0.f, 0.f, 0.f};
    bf16x8 At[4][2], B0[2][2], B1[2][2];
    const char* cA = cur.a; const char* cB = cur.b;
    if constexpr (SP2) {
        PG8_STAGE(PG8_SB(0, 0), cB, voffB); PG8_STAGE(PG8_SB(0, 1), cB + hstepB, voffB); PG8_STAGE(PG8_SA(0, 0), cA, voffA); PG8_STAGE(PG8_SA(0, 1), cA + hstepA, voffA);
        if (wr == 1) PG8_BAR;
        PG8_WAIT_V(2); PG8_BAR;
        PG8_STAGE(PG8_SB(1, 0), cB + kstep, voffB); PG8_STAGE(PG8_SA(1, 0), cA + kstep, voffA); PG8_STAGE(PG8_SB(1, 1), cB + hstepB + kstep, voffB);
        PG8_WAIT_V(6); PG8_BAR;
    } else {
        PG8_STAGE(PG8_SB(0, 0), cB, voffB); PG8_STAGE(PG8_SA(0, 0), cA, voffA); PG8_STAGE(PG8_SB(0, 1), cB + hstepB, voffB); PG8_STAGE(PG8_SA(0, 1), cA + hstepA, voffA);
        if (wr == 1) PG8_BAR;
        PG8_WAIT_V(4); PG8_BAR;
        PG8_STAGE(PG8_SB(1, 0), cB + kstep, voffB); PG8_STAGE(PG8_SA(1, 0), cA + kstep, voffA); PG8_STAGE(PG8_SB(1, 1), cB + hstepB + kstep, voffB);
        PG8_WAIT_V(6); PG8_BAR;
    }
    for (;;) {
        const bool has_next = S.next(ui + 1, nxt);
        const char* nA = has_next ? nxt.a : cA; const char* nB = has_next ? nxt.b : cB;
        const int nt = cur.nt;
        for (int t = 0; t < nt; t += 2) {
            const bool last = (t == nt - 2);
            const char* a1 = cA + (size_t)(t + 1) * kstep;
            const char* a2 = last ? nA : cA + (size_t)(t + 2) * kstep; const char* b2 = last ? nB : cB + (size_t)(t + 2) * kstep;
            const char* a3 = a2 + kstep; const char* b3 = b2 + kstep;
            if constexpr (SP2) {
            PG8_LDB(B0, 0, 0); PG8_LDB(B1, 0, 1); PG8_SCHED; PG8_LDA(At, 0, 0); PG8_STAGE(PG8_SA(1, 1), a1 + hstepA, voffA);
            PG8_WAIT_V(8); PG8_WAIT_L(0); PG8_BAR; PG8_MMA(0, 0, At, B0); PG8_MMA(0, 1, At, B1); PG8_BAR; PG8_SCHED;
            PG8_LDA(At, 0, 1); PG8_STAGE(PG8_SB(0, 0), b2, voffB); PG8_STAGE(PG8_SB(0, 1), b2 + hstepB, voffB); PG8_STAGE(PG8_SA(0, 0), a2, voffA);
            PG8_WAIT_V(8); PG8_WAIT_L(0); PG8_BAR; PG8_MMA(1, 0, At, B0); PG8_MMA(1, 1, At, B1); PG8_BAR; PG8_SCHED;
            PG8_LDB(B0, 1, 0); PG8_LDB(B1, 1, 1); PG8_SCHED; PG8_LDA(At, 1, 0); PG8_STAGE(PG8_SA(0, 1), a2 + hstepA, voffA);
            PG8_WAIT_V(8); PG8_WAIT_L(0); PG8_BAR; PG8_MMA(0, 0, At, B0); PG8_MMA(0, 1, At, B1); PG8_BAR; PG8_SCHED;
            PG8_LDA(At, 1, 1); PG8_STAGE(PG8_SB(1, 0), b3, voffB); PG8_STAGE(PG8_SB(1, 1), b3 + hstepB, voffB); PG8_STAGE(PG8_SA(1, 0), a3, voffA);
            PG8_WAIT_V(8); PG8_WAIT_L(0); PG8_BAR; PG8_MMA(1, 0, At, B0); PG8_MMA(1, 1, At, B1); PG8_BAR; PG8_SCHED;
            } else {
            PG8_LDB(B0, 0, 0); PG8_SCHED; PG8_LDA(At, 0, 0); PG8_STAGE(PG8_SA(1, 1), a1 + hstepA, voffA);
            PG8_WAIT_L(8); PG8_BAR; PG8_WAIT_L(0); PG8_MMA(0, 0, At, B0); PG8_BAR; PG8_SCHED;
            PG8_LDB(B1, 0, 1); PG8_STAGE(PG8_SB(0, 0), b2, voffB);
            PG8_BAR; PG8_WAIT_L(0); PG8_MMA(0, 1, At, B1); PG8_BAR;
            PG8_LDA(At, 0, 1); PG8_STAGE(PG8_SA(0, 0), a2, voffA);
            PG8_BAR; PG8_WAIT_L(0); PG8_MMA(1, 0, At, B0); PG8_BAR; PG8_SCHED;
            PG8_STAGE(PG8_SB(0, 1), b2 + hstepB, voffB);
            PG8_WAIT_V(6); PG8_BAR; PG8_MMA(1, 1, At, B1); PG8_BAR;
            PG8_LDB(B0, 1, 0); PG8_SCHED; PG8_LDA(At, 1, 0); PG8_STAGE(PG8_SA(0, 1), a2 + hstepA, voffA);
            PG8_WAIT_L(8); PG8_BAR; PG8_WAIT_L(0); PG8_MMA(0, 0, At, B0); PG8_BAR; PG8_SCHED;
            PG8_LDB(B1, 1, 1); PG8_STAGE(PG8_SB(1, 0), b3, voffB);
            PG8_BAR; PG8_WAIT_L(0); PG8_MMA(0, 1, At, B1); PG8_BAR;
            PG8_LDA(At, 1, 1); PG8_STAGE(PG8_SA(1, 0), a3, voffA);
            PG8_BAR; PG8_WAIT_L(0); PG8_MMA(1, 0, At, B0); PG8_BAR; PG8_SCHED;
            PG8_STAGE(PG8_SB(1, 1), b3 + hstepB, voffB);
            PG8_WAIT_V(6); PG8_BAR; PG8_MMA(1, 1, At, B1); PG8_BAR;
            }
        }
        if constexpr (ALIGN_EPI) { if (wr == 0) PG8_BAR; }
        E(acc, cur, wr, wc, fr, fq);
        if (!has_next) break;
#pragma unroll
        for (int a = 0; a < 2; ++a)
#pragma unroll
            for (int b = 0; b < 2; ++b)
#pragma unroll
                for (int m = 0; m < 4; ++m)
#pragma unroll
                    for (int n = 0; n < 2; ++n) acc[a][b][m][n] = (f32x4){0.f, 0.f, 0.f, 0.f};
        cur = nxt; cA = nA; cB = nB; ++ui;
        if constexpr (ALIGN_EPI) { if (wr == 1) PG8_BAR; }
    }
    PG8_WAIT_V(0);
    if constexpr (!ALIGN_EPI) { if (wr == 0) PG8_BAR; }
    PG8_BAR;
#undef PG8_SA
#undef PG8_SB
#undef PG8_STAGE
#undef PG8_LDA
#undef PG8_LDB
#undef PG8_MMA
#undef PG8_WAIT_V
#undef PG8_WAIT_L
#undef PG8_BAR
#undef PG8_SCHED
}
}

#define XB_TMO      128
#define XB_XCNT(j)  (256  + 64 * (j))
#define XB_XSUB(j)  (1280 + 64 * (j))
#define XB_XGEN(j)  (2304 + 64 * (j))
#define XB_TOP      3328
#define XB_TOPGEN   3392
#define XCD_BAR_WORDS 3456
#define XB_SPIN_CAP (1u << 18)

__device__ __forceinline__ unsigned xb_ld(unsigned* p)              { return __hip_atomic_load(p, __ATOMIC_RELAXED, __HIP_MEMORY_SCOPE_AGENT); }
__device__ __forceinline__ unsigned xb_add(unsigned* p, unsigned v) { return __hip_atomic_fetch_add(p, v, __ATOMIC_RELAXED, __HIP_MEMORY_SCOPE_AGENT); }
__device__ __forceinline__ unsigned xb_xcc_id() { return (unsigned)__builtin_amdgcn_s_getreg((3 << 11) | 20) & 0xFu; }
#define XB_SPIN(cond, bar) do { unsigned _sp = 0; while (cond) { __builtin_amdgcn_s_sleep(1); \
    if ((++_sp & 255u) == 0u) { if (xb_ld(&(bar)[XB_TMO])) break; if (_sp > XB_SPIN_CAP) { atomicAdd(&(bar)[XB_TMO], 1u); break; } } } } while (0)

struct XcdBarrier { unsigned* bar; unsigned x; volatile LAS unsigned* st; };

__device__ __forceinline__ XcdBarrier xcd_barrier_post(unsigned* bar, volatile LAS unsigned* st) {
    XcdBarrier b; b.bar = bar; b.x = xb_xcc_id(); b.st = st;
    if (threadIdx.x == 0) (void)xb_add(&bar[XB_XCNT(b.x)], 1u);
    return b;
}
__device__ __forceinline__ void xcd_barrier_complete(unsigned* bar, unsigned x, unsigned& nloc, unsigned& nx) {
    const unsigned G = gridDim.x * gridDim.y * gridDim.z;
    unsigned sum, cnt, mine, sp = 0u;
    for (;;) {
        sum = 0u; cnt = 0u; mine = 0u;
#pragma unroll
        for (unsigned j = 0; j < 16; ++j) { const unsigned c = xb_ld(&bar[XB_XCNT(j)]); sum += c; cnt += (c > 0u) ? 1u : 0u; mine = (j == x) ? c : mine; }
        if (sum == G) break;
        __builtin_amdgcn_s_sleep(1);
        if ((++sp & 255u) == 0u) { if (xb_ld(&bar[XB_TMO])) break; if (sp > XB_SPIN_CAP) { atomicAdd(&bar[XB_TMO], 1u); break; } }
    }
    nloc = mine > 0u ? mine : 1u; nx = cnt > 0u ? cnt : 1u;
}
__device__ __forceinline__ void xcd_barrier(const XcdBarrier& b) {
    asm volatile("s_waitcnt vmcnt(0)" ::: "memory");
    __syncthreads();
    if (threadIdx.x == 0) {
        unsigned* bar = b.bar;
        __builtin_amdgcn_s_waitcnt(0);
        unsigned nloc = b.st[0], nx = b.st[1];
        if (nloc == 0u) { xcd_barrier_complete(bar, b.x, nloc, nx); b.st[0] = nloc; b.st[1] = nx; }
        const unsigned old = xb_add(&bar[XB_XSUB(b.x)], 1u);
        const unsigned gen = old / nloc;
        if (old + 1u == (gen + 1u) * nloc) {
            __builtin_amdgcn_fence(__ATOMIC_RELEASE, "agent");
            asm volatile("s_waitcnt vmcnt(0)" ::: "memory");
            const unsigned og = xb_add(&bar[XB_TOP], 1u);
            const unsigned tg = og / nx;
            if (og + 1u == (tg + 1u) * nx) xb_add(&bar[XB_TOPGEN], 1u);
            else XB_SPIN(xb_ld(&bar[XB_TOPGEN]) == tg, bar);
            __builtin_amdgcn_fence(__ATOMIC_ACQUIRE, "agent");
            xb_add(&bar[XB_XGEN(b.x)], 1u);
            asm volatile("s_waitcnt vmcnt(0)" ::: "memory");
        } else {
            XB_SPIN(xb_ld(&bar[XB_XGEN(b.x)]) == gen, bar);
            __builtin_amdgcn_fence(__ATOMIC_ACQUIRE, "agent");
            asm volatile("s_waitcnt vmcnt(0)" ::: "memory");
        }
    }
    __syncthreads();
}

struct Args { const float* in[32]; float* out; unsigned char* ws; int ph_lo, ph_hi; };
enum { I_X = 0, I_C, I_CTX, I_CCTX, I_ADAW, I_ADAB, I_NORMG, I_MU, I_WRKV, I_W0, I_W1, I_W2, I_A0, I_A1, I_A2, I_G1, I_G2, I_KK, I_KA, I_RK, I_GNW, I_GNB, I_WO,
       I_WIN, I_CONV, I_WOUT, I_ROUTW, I_ROUTB, I_MGATE, I_MUP, I_MDOWN, I_FINALG };

struct Frame {
    LAS unsigned char* lds;
    int tid, lane, wave, G, vcu, gw, NGW;
};


__device__ __forceinline__ void tr_item(const float* W, int ldw, int k0, int n0, bf16_t* dst, int ldd, int drow0, const float* mu, LAS float* scr, int lane) {
#pragma unroll 8
    for (int i = 0; i < 32; ++i) { const int kk = 2 * i + (lane >> 5); scr[kk * 33 + (lane & 31)] = W[(size_t)(k0 + kk) * ldw + n0 + (lane & 31)]; }
    LDS_WAIT(); asm volatile("" ::: "memory");
    const int c = lane & 7;
    float m[8];
#pragma unroll
    for (int q = 0; q < 8; ++q) m[q] = mu ? mu[k0 + 8 * c + q] : 0.f;
#pragma unroll
    for (int j = 0; j < 4; ++j) { const int n = (lane >> 3) + 8 * j; const LAS float* s = scr + (8 * c) * 33 + n;
        float v[8];
#pragma unroll
        for (int q = 0; q < 8; ++q) v[q] = s[q * 33];
        bf16_t* drow = dst + (size_t)(drow0 + n) * ldd + k0 + 8 * c;
        if (!mu) {
            u32x4 o; o.x = pk2(v[0], v[1]); o.y = pk2(v[2], v[3]); o.z = pk2(v[4], v[5]); o.w = pk2(v[6], v[7]);
            *(u32x4*)drow = o;
        } else {
            u32x4 o; o.x = pk2(v[0] * (1.f - m[0]), v[1] * (1.f - m[1])); o.y = pk2(v[2] * (1.f - m[2]), v[3] * (1.f - m[3]));
            o.z = pk2(v[4] * (1.f - m[4]), v[5] * (1.f - m[5])); o.w = pk2(v[6] * (1.f - m[6]), v[7] * (1.f - m[7]));
            *(u32x4*)drow = o;
            u32x4 p; p.x = pk2(v[0] * 0.5f * m[0], v[1] * 0.5f * m[1]); p.y = pk2(v[2] * 0.5f * m[2], v[3] * 0.5f * m[3]);
            p.z = pk2(v[4] * 0.5f * m[4], v[5] * 0.5f * m[5]); p.w = pk2(v[6] * 0.5f * m[6], v[7] * 0.5f * m[7]);
            *(u32x4*)(drow + 1024) = p;
        }
    }
    LDS_WAIT(); asm volatile("" ::: "memory");
}
__device__ __forceinline__ void tr_job_item(const float* W, int ldw, int N, bf16_t* dst, int ldd, int drow_base, bool il, const float* mu, int item, LAS float* scr, int lane) {
    const int nblk = N / 32, kb = item / nblk, nb = item % nblk, n0 = 32 * nb;
    const int dr = drow_base + (il ? ((n0 >> 7) * 256 + (n0 & 127)) : n0);
    tr_item(W, ldw, 64 * kb, n0, dst, ldd, dr, mu, scr, lane);
}

__device__ __forceinline__ void p0_prologue(const Frame& F, const Args& A) {
    unsigned char* ws = A.ws;
    LAS float* scr = (LAS float*)(F.lds + F.wave * 16384);
    bf16_t* WRKV = (bf16_t*)(ws + WS_WRKV); bf16_t* WL = (bf16_t*)(ws + WS_WL); bf16_t* G2 = (bf16_t*)(ws + WS_G2);
    bf16_t* WO = (bf16_t*)(ws + WS_WO); bf16_t* WIN = (bf16_t*)(ws + WS_WIN); bf16_t* WOUT = (bf16_t*)(ws + WS_WOUT);
    const float* mu = A.in[I_MU];
    constexpr int NIT = 3 * 512 + 4 * 32 + 64 + 64 + 512 + 3 * 512 + 512;
    for (int it = F.gw; it < NIT; it += F.NGW) {
        int r = it;
        if (r < 1536) { const int p = r / 512; tr_job_item(A.in[I_WRKV] + (size_t)p * D * D, D, D, WRKV, 2048, p * 1024, false, nullptr, r % 512, scr, F.lane); continue; } r -= 1536;
        if (r < 64) { const int dir = r / 32; tr_job_item(A.in[I_W1] + (size_t)dir * D * 64, 64, 64, WL, 2048, dir * 64, false, mu + 3 * D, r % 32, scr, F.lane); continue; } r -= 64;
        if (r < 64) { const int dir = r / 32; tr_job_item(A.in[I_A1] + (size_t)dir * D * 64, 64, 64, WL, 2048, 128 + dir * 64, false, mu + 4 * D, r % 32, scr, F.lane); continue; } r -= 64;
        if (r < 64) { tr_job_item(A.in[I_G1], 128, 128, WL, 2048, 256, false, mu + 5 * D, r, scr, F.lane); continue; } r -= 64;
        if (r < 64) { tr_job_item(A.in[I_G2], D, D, G2, 256, 0, false, nullptr, r, scr, F.lane); continue; } r -= 64;
        if (r < 512) { tr_job_item(A.in[I_WO], D, D, WO, D, 0, false, nullptr, r, scr, F.lane); continue; } r -= 512;
        if (r < 512) { tr_job_item(A.in[I_WIN], 3 * D, D, WIN, D, 0, false, nullptr, r, scr, F.lane); continue; } r -= 512;
        if (r < 512) { tr_job_item(A.in[I_WIN] + D, 3 * D, D, WIN, D, 1024, true, nullptr, r, scr, F.lane); continue; } r -= 512;
        if (r < 512) { tr_job_item(A.in[I_WIN] + 2 * D, 3 * D, D, WIN, D, 1024 + 128, true, nullptr, r, scr, F.lane); continue; } r -= 512;
        tr_job_item(A.in[I_WOUT], D, D, WOUT, D, 0, false, nullptr, r, scr, F.lane);
    }
    {
        const int gt = F.vcu * NTHREADS + F.tid, NGT = F.G * NTHREADS;
        u32x4 z = (u32x4){0u, 0u, 0u, 0u};
        for (int i = gt; i < 32768; i += NGT) ((u32x4*)(WL + (size_t)384 * 2048))[i] = z;
        for (int i = gt; i < 16384; i += NGT) { const int row = i >> 4, q = i & 15; *(u32x4*)(G2 + (size_t)row * 256 + 128 + q * 8) = z; }
    }
    __syncthreads();
    {
        LAS float* st = (LAS float*)F.lds;
        LAS float* red = st + 9 * 1024;
        for (int i = F.tid; i < 9 * 1024; i += NTHREADS) { const float v = (i < 8192) ? A.in[I_C][i] : A.in[I_CCTX][i - 8192]; st[i] = v / (1.f + __expf(-v)); }
        __syncthreads();
        float* MOD = (float*)(ws + WS_MOD);
        for (int u = blockIdx.x; u < 256; u += F.G) {
            const int l = u >> 7, e0 = (u & 127) * 48;
            if (F.tid < 384) {
                const int q = F.tid % 12, dg = F.tid / 12;
                f32x4 acc[9];
#pragma unroll
                for (int r = 0; r < 9; ++r) acc[r] = (f32x4){0.f, 0.f, 0.f, 0.f};
                const float* wb = A.in[I_ADAW] + (size_t)l * D * 6144 + e0 + 4 * q;
#pragma unroll 4
                for (int i = 0; i < 32; ++i) { const int d = dg + 32 * i; const f32x4 w = *(const f32x4*)(wb + (size_t)d * 6144);
#pragma unroll
                    for (int r = 0; r < 9; ++r) acc[r] += st[r * 1024 + d] * w; }
#pragma unroll
                for (int r = 0; r < 9; ++r) *(LAS f32x4*)(red + (dg * 9 + r) * 48 + 4 * q) = acc[r];
            }
            __syncthreads();
            if (F.tid < 432) { const int r = F.tid / 48, ci = F.tid % 48; float s = A.in[I_ADAB][l * 6144 + e0 + ci];
                for (int dg = 0; dg < 32; ++dg) s += red[(dg * 9 + r) * 48 + ci];
                MOD[((size_t)l * 9 + r) * 6144 + e0 + ci] = s; }
            __syncthreads();
        }
    }
}

__device__ __forceinline__ void p1_load_norm(const float* row, const f32x4 (&gsc)[4], const f32x4 (&sh)[4], f32x4 (&o)[4], int lane) {
    const f32x4* xr = (const f32x4*)row + lane; float s = 0.f;
#pragma unroll
    for (int j = 0; j < 4; ++j) { o[j] = xr[64 * j]; s += (o[j].x * o[j].x + o[j].y * o[j].y) + (o[j].z * o[j].z + o[j].w * o[j].w); }
    const float rstd = rsqrtf(wave_sum(s) * (1.f / D) + RMS_EPS);
#pragma unroll
    for (int j = 0; j < 4; ++j) o[j] = o[j] * rstd * gsc[j] + sh[j];
}
__device__ __forceinline__ void st_bf4(bf16_t* p, const f32x4 v) { u32x2 w; w.x = pk2(v.x, v.y); w.y = pk2(v.z, v.w); *(u32x2*)p = w; }

__device__ __forceinline__ void p1_mix(const Frame& F, const Args& A) {
    const float* MOD = (const float*)(A.ws + WS_MOD);
    bf16_t* XM = (bf16_t*)(A.ws + WS_XM);
    const float* mu = A.in[I_MU]; const float* ng = A.in[I_NORMG];
    for (int u = F.gw; u < 2176; u += F.NGW) {
        const bool isctx = u >= 2048; int t0, rowlen, modrow; const float* src; size_t orow0;
        if (!isctx) { t0 = u * 16; rowlen = GRIDW; modrow = t0 / TL; src = A.in[I_X] + (size_t)t0 * D; orow0 = t0; }
        else { t0 = (u - 2048) * 16; rowlen = TCX; modrow = 8; src = A.in[I_CTX] + (size_t)t0 * D; orow0 = (size_t)ML + t0; }
        const int pos0 = t0 % rowlen;
        const float* mrow = MOD + (size_t)modrow * 6144;
        f32x4 gsc[4], sh[4], m0[4], m1[4], m2[4];
#pragma unroll
        for (int j = 0; j < 4; ++j) { const int c = 4 * F.lane + 256 * j;
            const f32x4 g = *(const f32x4*)(ng + c), sc = *(const f32x4*)(mrow + 1024 + c);
            gsc[j] = g * (1.f + sc); sh[j] = *(const f32x4*)(mrow + c);
            m0[j] = *(const f32x4*)(mu + c); m1[j] = *(const f32x4*)(mu + D + c); m2[j] = *(const f32x4*)(mu + 2 * D + c); }
        f32x4 prev[4], cur[4], nxt[4];
        if (pos0 > 0) p1_load_norm(src - D, gsc, sh, prev, F.lane);
        else {
#pragma unroll
            for (int j = 0; j < 4; ++j) prev[j] = (f32x4){0.f, 0.f, 0.f, 0.f}; }
        p1_load_norm(src, gsc, sh, cur, F.lane);
        for (int i = 0; i < 16; ++i) {
            if (pos0 + i + 1 < rowlen) p1_load_norm(src + (size_t)(i + 1) * D, gsc, sh, nxt, F.lane);
            else {
#pragma unroll
                for (int j = 0; j < 4; ++j) nxt[j] = (f32x4){0.f, 0.f, 0.f, 0.f}; }
            bf16_t* orow = XM + (orow0 + i) * XM_LD + 4 * F.lane;
#pragma unroll
            for (int j = 0; j < 4; ++j) {
                const f32x4 s = prev[j] + nxt[j], xx = 0.5f * s - cur[j];
                st_bf4(orow + 256 * j, cur[j] + xx * m0[j]);
                st_bf4(orow + D + 256 * j, cur[j] + xx * m1[j]);
                st_bf4(orow + 2 * D + 256 * j, cur[j] + xx * m2[j]);
                st_bf4(orow + 3 * D + 256 * j, cur[j]);
                st_bf4(orow + 4 * D + 256 * j, s);
                prev[j] = cur[j]; cur[j] = nxt[j];
            }
        }
    }
}

struct SchedRKV {
    const char* xm; const char* w; int G, c;
    __device__ __forceinline__ bool next(int i, pg8::Unit& u) const {
        const int L = i * G + c; if (L >= 1600) return false;
        if (L < 1536) pg8::swz_tile(L, 128, 12, u.pm, u.pn); else { const int r = L - 1536; u.pm = 128 + (r >> 3); u.pn = 4 + (r & 7); }
        u.a = xm + (size_t)u.pm * 256 * XM_LD * 2 + (size_t)(u.pn >> 2) * D * 2; u.b = w + (size_t)u.pn * 256 * 2048 * 2; u.nt = 16; return true;
    }
};
struct EpiRKV {
    static constexpr bool PERM = true;
    bf16_t *R, *K, *KC, *V;
    __device__ __forceinline__ void operator()(const f32x4 (&acc)[2][2][4][2], const pg8::Unit& u, int wr, int wc, int fr, int fq) const {
        const int grp = u.pn >> 2; int prow = u.pm * 256; bf16_t* base;
        if (grp == 0) base = R; else if (grp == 1) { if (u.pm < 128) base = K; else { base = KC; prow -= ML; } } else base = V;
        const int row0 = prow + wr * 64 + fr, col0 = (u.pn & 3) * 256 + wc * 32 + 8 * fq;
#pragma unroll
        for (int ai = 0; ai < 2; ++ai)
#pragma unroll
            for (int m = 0; m < 4; ++m) { bf16_t* rowp = base + (size_t)(row0 + ai * 128 + m * 16) * D + col0;
#pragma unroll
                for (int bj = 0; bj < 2; ++bj) { const f32x4 v0 = acc[ai][bj][m][0], v1 = acc[ai][bj][m][1];
                    u32x4 w; w.x = pg8::cvt_pk_bf16(v0[0], v0[1]); w.y = pg8::cvt_pk_bf16(v0[2], v0[3]); w.z = pg8::cvt_pk_bf16(v1[0], v1[1]); w.w = pg8::cvt_pk_bf16(v1[2], v1[3]);
                    *(u32x4*)(rowp + bj * 128) = w; } }
    }
};
struct SchedLora {
    const char* xm; const char* w; int G, c;
    __device__ __forceinline__ bool next(int i, pg8::Unit& u) const {
        const int L = i * G + c; if (L >= 272) return false;
        u.pm = L >> 1; u.pn = L & 1;
        u.a = xm + (size_t)u.pm * 256 * XM_LD * 2 + (size_t)3 * D * 2; u.b = w + (size_t)u.pn * 256 * 2048 * 2; u.nt = 32; return true;
    }
};
struct EpiLora {
    static constexpr bool PERM = true;
    bf16_t *LWA, *LG;
    __device__ __forceinline__ void operator()(const f32x4 (&acc)[2][2][4][2], const pg8::Unit& u, int wr, int wc, int fr, int fq) const {
        bf16_t* base = u.pn ? LG : LWA;
        const int row0 = u.pm * 256 + wr * 64 + fr, col0 = wc * 32 + 8 * fq;
#pragma unroll
        for (int ai = 0; ai < 2; ++ai)
#pragma unroll
            for (int m = 0; m < 4; ++m) { bf16_t* rowp = base + (size_t)(row0 + ai * 128 + m * 16) * 256 + col0;
#pragma unroll
                for (int bj = 0; bj < 2; ++bj) { f32x4 v0 = acc[ai][bj][m][0], v1 = acc[ai][bj][m][1];
                    if (bj == 0) {
                        if (u.pn == 0) {
#pragma unroll
                            for (int q = 0; q < 4; ++q) { v0[q] = 1.f - 2.f / (__expf(2.f * v0[q]) + 1.f); v1[q] = 1.f - 2.f / (__expf(2.f * v1[q]) + 1.f); }
                        } else {
#pragma unroll
                            for (int q = 0; q < 4; ++q) { v0[q] = sigmoidf_(v0[q]); v1[q] = sigmoidf_(v1[q]); }
                        }
                    } else if (u.pn == 1) { v0 = (f32x4){0.f, 0.f, 0.f, 0.f}; v1 = v0; }
                    u32x4 w; w.x = pg8::cvt_pk_bf16(v0[0], v0[1]); w.y = pg8::cvt_pk_bf16(v0[2], v0[3]); w.z = pg8::cvt_pk_bf16(v1[0], v1[1]); w.w = pg8::cvt_pk_bf16(v1[2], v1[3]);
                    *(u32x4*)(rowp + bj * 128) = w; } }
    }
};
struct SchedPlain {
    const char* a; const char* b; int nM, nN, lda, ldb, nt, G, c;
    __device__ __forceinline__ bool next(int i, pg8::Unit& u) const {
        const int L = i * G + c; if (L >= nM * nN) return false;
        pg8::swz_tile(L, nM, nN, u.pm, u.pn);
        u.a = a + (size_t)u.pm * 256 * lda * 2; u.b = b + (size_t)u.pn * 256 * ldb * 2; u.nt = nt; return true;
    }
};
struct EpiBf16 {
    static constexpr bool PERM = true;
    bf16_t* O; int ldc;
    __device__ __forceinline__ void operator()(const f32x4 (&acc)[2][2][4][2], const pg8::Unit& u, int wr, int wc, int fr, int fq) const {
        const int row0 = u.pm * 256 + wr * 64 + fr, col0 = u.pn * 256 + wc * 32 + 8 * fq;
#pragma unroll
        for (int ai = 0; ai < 2; ++ai)
#pragma unroll
            for (int m = 0; m < 4; ++m) { bf16_t* rowp = O + (size_t)(row0 + ai * 128 + m * 16) * ldc + col0;
#pragma unroll
                for (int bj = 0; bj < 2; ++bj) { const f32x4 v0 = acc[ai][bj][m][0], v1 = acc[ai][bj][m][1];
                    u32x4 w; w.x = pg8::cvt_pk_bf16(v0[0], v0[1]); w.y = pg8::cvt_pk_bf16(v0[2], v0[3]); w.z = pg8::cvt_pk_bf16(v1[0], v1[1]); w.w = pg8::cvt_pk_bf16(v1[2], v1[3]);
                    *(u32x4*)(rowp + bj * 128) = w; } }
    }
};
struct EpiRes {
    static constexpr bool PERM = false;
    const float* base; float* out; const float* gate;
    __device__ __forceinline__ void operator()(const f32x4 (&acc)[2][2][4][2], const pg8::Unit& u, int wr, int wc, int fr, int fq) const {
        const int row0 = u.pm * 256 + wr * 64 + fr, col0 = u.pn * 256 + wc * 32 + 4 * fq;
        const float* gp = gate + (size_t)(u.pm >> 4) * 6144 + col0;
        f32x4 gv[2][2];
#pragma unroll
        for (int bj = 0; bj < 2; ++bj)
#pragma unroll
            for (int n = 0; n < 2; ++n) gv[bj][n] = *(const f32x4*)(gp + bj * 128 + n * 16);
#pragma unroll
        for (int ai = 0; ai < 2; ++ai)
#pragma unroll
            for (int m = 0; m < 4; ++m) { const size_t ro = (size_t)(row0 + ai * 128 + m * 16) * D + col0;
#pragma unroll
                for (int bj = 0; bj < 2; ++bj)
#pragma unroll
                    for (int n = 0; n < 2; ++n) { const f32x4 b = *(const f32x4*)(base + ro + bj * 128 + n * 16);
                        *(f32x4*)(out + ro + bj * 128 + n * 16) = b + gv[bj][n] * acc[ai][bj][m][n]; } }
    }
};
struct SchedMoe {
    const char* a; const char* b; const int* tile; int lda, ldb, nt, G, c; size_t estride;
    __device__ __forceinline__ bool next(int i, pg8::Unit& u) const {
        const int ntl = tile[0]; const int L = i * G + c; if (L >= ntl * 4) return false;
        u.pm = L >> 2; u.pn = L & 3; const int e = tile[16 + u.pm];
        u.a = a + (size_t)u.pm * 256 * lda * 2; u.b = b + (size_t)e * estride + (size_t)u.pn * 256 * ldb * 2; u.nt = nt; return true;
    }
};
struct EpiGateUp {
    static constexpr bool PERM = true;
    bf16_t* H;
    __device__ __forceinline__ void operator()(const f32x4 (&acc)[2][2][4][2], const pg8::Unit& u, int wr, int wc, int fr, int fq) const {
        const int row0 = u.pm * 256 + wr * 64 + fr, col0 = u.pn * 128 + wc * 32 + 8 * fq;
#pragma unroll
        for (int ai = 0; ai < 2; ++ai)
#pragma unroll
            for (int m = 0; m < 4; ++m) { bf16_t* rowp = H + (size_t)(row0 + ai * 128 + m * 16) * ED + col0;
                f32x4 h0, h1;
#pragma unroll
                for (int q = 0; q < 4; ++q) { const float g0 = acc[ai][0][m][0][q], g1 = acc[ai][0][m][1][q];
                    h0[q] = g0 / (1.f + __expf(-g0)) * acc[ai][1][m][0][q]; h1[q] = g1 / (1.f + __expf(-g1)) * acc[ai][1][m][1][q]; }
                u32x4 w; w.x = pg8::cvt_pk_bf16(h0[0], h0[1]); w.y = pg8::cvt_pk_bf16(h0[2], h0[3]); w.z = pg8::cvt_pk_bf16(h1[0], h1[1]); w.w = pg8::cvt_pk_bf16(h1[2], h1[3]);
                *(u32x4*)rowp = w; }
    }
};
struct EpiWin {
    static constexpr bool PERM = true;
    bf16_t *BG, *U;
    __device__ __forceinline__ void operator()(const f32x4 (&acc)[2][2][4][2], const pg8::Unit& u, int wr, int wc, int fr, int fq) const {
        const int row0 = u.pm * 256 + wr * 64 + fr;
        if (u.pn < 4) {
            const int col0 = u.pn * 256 + wc * 32 + 8 * fq;
#pragma unroll
            for (int ai = 0; ai < 2; ++ai)
#pragma unroll
                for (int m = 0; m < 4; ++m) { bf16_t* rowp = BG + (size_t)(row0 + ai * 128 + m * 16) * D + col0;
#pragma unroll
                    for (int bj = 0; bj < 2; ++bj) { const f32x4 v0 = acc[ai][bj][m][0], v1 = acc[ai][bj][m][1];
                        u32x4 w; w.x = pg8::cvt_pk_bf16(v0[0], v0[1]); w.y = pg8::cvt_pk_bf16(v0[2], v0[3]); w.z = pg8::cvt_pk_bf16(v1[0], v1[1]); w.w = pg8::cvt_pk_bf16(v1[2], v1[3]);
                        *(u32x4*)(rowp + bj * 128) = w; } }
        } else {
            const int col0 = (u.pn - 4) * 128 + wc * 32 + 8 * fq;
#pragma unroll
            for (int ai = 0; ai < 2; ++ai)
#pragma unroll
                for (int m = 0; m < 4; ++m) { bf16_t* rowp = U + (size_t)(row0 + ai * 128 + m * 16) * D + col0;
                    const f32x4 v0 = acc[ai][0][m][0] * acc[ai][1][m][0], v1 = acc[ai][0][m][1] * acc[ai][1][m][1];
                    u32x4 w; w.x = pg8::cvt_pk_bf16(v0[0], v0[1]); w.y = pg8::cvt_pk_bf16(v0[2], v0[3]); w.z = pg8::cvt_pk_bf16(v1[0], v1[1]); w.w = pg8::cvt_pk_bf16(v1[2], v1[3]);
                    *(u32x4*)rowp = w; }
        }
    }
};

__device__ __forceinline__ void p3_scan(const Frame& F, const Args& A) {
    unsigned char* ws = A.ws;
    LAS float* OPS = (LAS float*)F.lds;
    LAS float* VY = OPS + 5 * 4096;
    LAS float* W2S = VY + 4096;
    LAS float* A2S = W2S + 4096;
    LAS float* BON = (LAS float*)(F.lds + LDS_X_OFF);
    const bf16_t* R = (const bf16_t*)A.out; const bf16_t* K = R + (size_t)ML * D;
    const bf16_t* KC = (const bf16_t*)(ws + WS_KC); const bf16_t* V = (const bf16_t*)(ws + WS_V); const bf16_t* LWA = (const bf16_t*)(ws + WS_LWA);
    const int i = F.tid >> 3, cg = F.tid & 7;
    for (int s = blockIdx.x; s < 256; s += F.G) {
        const int dir = s & 1, h = (s >> 1) & 15, b = s >> 5, c0 = h * HD;
        bf16_t* Y = (bf16_t*)(ws + (dir ? WS_Y1 : WS_Y0));
        __syncthreads();
#pragma unroll 1
        for (int q = F.tid; q < 4096; q += NTHREADS) { const int j = q >> 6, c = q & 63;
            W2S[q] = A.in[I_W2][((size_t)dir * 64 + j) * D + c0 + c]; A2S[q] = A.in[I_A2][((size_t)dir * 64 + j) * D + c0 + c]; }
        float S[64];
#pragma unroll
        for (int k = 0; k < 64; ++k) S[k] = 0.f;
        for (int seg = 0; seg < 2; ++seg) {
            const int Tseg = seg ? TL : TCX, nch = Tseg / 64;
            for (int ci = 0; ci < nch; ++ci) {
                __syncthreads();
                const int tl = ci * 64 + i, t = dir ? (Tseg - 1 - tl) : tl;
                const size_t arow = seg ? ((size_t)b * TL + t) : ((size_t)ML + (size_t)b * TCX + t);
                const bf16_t* lrow = LWA + arow * 256 + dir * 64;
                float accw[8], acca[8];
#pragma unroll
                for (int q = 0; q < 8; ++q) { const int c = c0 + cg * 8 + q; accw[q] = A.in[I_W0][dir * D + c]; acca[q] = A.in[I_A0][dir * D + c]; }
#pragma unroll 1
                for (int j8 = 0; j8 < 8; ++j8) {
                    const u32x4 lw = *(const u32x4*)(lrow + j8 * 8), la = *(const u32x4*)(lrow + 128 + j8 * 8);
                    float lwf[8] = {bflo(lw.x), bfhi(lw.x), bflo(lw.y), bfhi(lw.y), bflo(lw.z), bfhi(lw.z), bflo(lw.w), bfhi(lw.w)};
                    float laf[8] = {bflo(la.x), bfhi(la.x), bflo(la.y), bfhi(la.y), bflo(la.z), bfhi(la.z), bflo(la.w), bfhi(la.w)};
#pragma unroll
                    for (int jj = 0; jj < 8; ++jj) { const int j = j8 * 8 + jj;
                        const f32x4 wa = *(const LAS f32x4*)(W2S + j * 64 + cg * 8), wb = *(const LAS f32x4*)(W2S + j * 64 + cg * 8 + 4);
                        const f32x4 aa = *(const LAS f32x4*)(A2S + j * 64 + cg * 8), ab = *(const LAS f32x4*)(A2S + j * 64 + cg * 8 + 4);
#pragma unroll
                        for (int q = 0; q < 4; ++q) { accw[q] += lwf[jj] * wa[q]; accw[4 + q] += lwf[jj] * wb[q]; acca[q] += laf[jj] * aa[q]; acca[4 + q] += laf[jj] * ab[q]; }
                        asm volatile("" : "+v"(accw[0]), "+v"(accw[1]), "+v"(accw[2]), "+v"(accw[3]), "+v"(accw[4]), "+v"(accw[5]), "+v"(accw[6]), "+v"(accw[7]),
                                          "+v"(acca[0]), "+v"(acca[1]), "+v"(acca[2]), "+v"(acca[3]), "+v"(acca[4]), "+v"(acca[5]), "+v"(acca[6]), "+v"(acca[7]) :: "memory"); }
                }
                const bf16_t* krow = seg ? (K + ((size_t)b * TL + t) * D) : (KC + ((size_t)b * TCX + t) * D);
                const u32x4 k8 = *(const u32x4*)(krow + c0 + cg * 8), v8 = *(const u32x4*)(V + arow * D + c0 + cg * 8);
                u32x4 r8 = (u32x4){0u, 0u, 0u, 0u};
                if (seg) r8 = *(const u32x4*)(R + ((size_t)b * TL + t) * D + c0 + cg * 8);
                float kf[8] = {bflo(k8.x), bfhi(k8.x), bflo(k8.y), bfhi(k8.y), bflo(k8.z), bfhi(k8.z), bflo(k8.w), bfhi(k8.w)};
                float vf[8] = {bflo(v8.x), bfhi(v8.x), bflo(v8.y), bfhi(v8.y), bflo(v8.z), bfhi(v8.z), bflo(v8.w), bfhi(v8.w)};
                float rf[8] = {bflo(r8.x), bfhi(r8.x), bflo(r8.y), bfhi(r8.y), bflo(r8.z), bfhi(r8.z), bflo(r8.w), bfhi(r8.w)};
                float kkr[8], kav[8], rkv[8], ss = 0.f;
#pragma unroll
                for (int q = 0; q < 8; ++q) { const int c = c0 + cg * 8 + q; kkr[q] = kf[q] * A.in[I_KK][c]; ss += kkr[q] * kkr[q]; kav[q] = A.in[I_KA][c]; rkv[q] = A.in[I_RK][c]; }
                ss += __shfl_xor(ss, 1); ss += __shfl_xor(ss, 2); ss += __shfl_xor(ss, 4);
                const float inv = rsqrtf(fmaxf(ss, 1e-24f));
                float bon = 0.f;
                float wd[8], nk[8], bb[8], kd[8];
#pragma unroll
                for (int q = 0; q < 8; ++q) {
                    const float e = 0.60653066f * sigmoidf_(accw[q]);
                    wd[q] = __expf(-e);
                    const float a = sigmoidf_(acca[q]);
                    const float kk = kkr[q] * inv;
                    nk[q] = -kk; bb[q] = kk * a; kd[q] = kf[q] * (1.f + (a - 1.f) * kav[q]);
                    bon += rf[q] * kd[q] * rkv[q];
                }
                bon += __shfl_xor(bon, 1); bon += __shfl_xor(bon, 2); bon += __shfl_xor(bon, 4);
                LAS float* o = OPS + i * 64 + cg * 8;
                *(LAS f32x4*)(o) = (f32x4){wd[0], wd[1], wd[2], wd[3]}; *(LAS f32x4*)(o + 4) = (f32x4){wd[4], wd[5], wd[6], wd[7]};
                *(LAS f32x4*)(o + 4096) = (f32x4){nk[0], nk[1], nk[2], nk[3]}; *(LAS f32x4*)(o + 4096 + 4) = (f32x4){nk[4], nk[5], nk[6], nk[7]};
                *(LAS f32x4*)(o + 8192) = (f32x4){bb[0], bb[1], bb[2], bb[3]}; *(LAS f32x4*)(o + 8192 + 4) = (f32x4){bb[4], bb[5], bb[6], bb[7]};
                *(LAS f32x4*)(o + 12288) = (f32x4){kd[0], kd[1], kd[2], kd[3]}; *(LAS f32x4*)(o + 12288 + 4) = (f32x4){kd[4], kd[5], kd[6], kd[7]};
                *(LAS f32x4*)(o + 16384) = (f32x4){rf[0], rf[1], rf[2], rf[3]}; *(LAS f32x4*)(o + 16384 + 4) = (f32x4){rf[4], rf[5], rf[6], rf[7]};
                *(LAS f32x4*)(VY + i * 64 + cg * 8) = (f32x4){vf[0], vf[1], vf[2], vf[3]}; *(LAS f32x4*)(VY + i * 64 + cg * 8 + 4) = (f32x4){vf[4], vf[5], vf[6], vf[7]};
                if (cg == 0) BON[i] = bon;
                __syncthreads();
                if (F.wave == 0) {
#pragma unroll 1
                    for (int st = 0; st < 64; ++st) {
                        const LAS float* op = OPS + st * 64;
                        const float v = VY[st * 64 + F.lane];
                        float sa0 = 0.f, sa1 = 0.f, sa2 = 0.f, sa3 = 0.f;
#pragma unroll
                        for (int kg = 0; kg < 2; ++kg) {
#pragma unroll
                            for (int kq = 0; kq < 8; ++kq) { const int k4 = kg * 8 + kq; const f32x4 n4 = *(const LAS f32x4*)(op + 4096 + 4 * k4);
                                sa0 += S[4 * k4] * n4.x; sa1 += S[4 * k4 + 1] * n4.y; sa2 += S[4 * k4 + 2] * n4.z; sa3 += S[4 * k4 + 3] * n4.w; }
                            asm volatile("" : "+v"(sa0), "+v"(sa1), "+v"(sa2), "+v"(sa3) :: "memory"); }
                        const float sa = (sa0 + sa1) + (sa2 + sa3);
                        asm volatile("" ::: "memory"); __builtin_amdgcn_sched_barrier(0);
                        float y0 = 0.f, y1 = 0.f, y2 = 0.f, y3 = 0.f;
#pragma unroll
                        for (int kg = 0; kg < 8; ++kg) {
#pragma unroll
                            for (int kq = 0; kq < 2; ++kq) { const int k4 = kg * 2 + kq;
                                const f32x4 w4 = *(const LAS f32x4*)(op + 4 * k4), b4 = *(const LAS f32x4*)(op + 8192 + 4 * k4), d4 = *(const LAS f32x4*)(op + 12288 + 4 * k4), r4 = *(const LAS f32x4*)(op + 16384 + 4 * k4);
                                S[4 * k4] = S[4 * k4] * w4.x + (sa * b4.x + v * d4.x); y0 += S[4 * k4] * r4.x;
                                S[4 * k4 + 1] = S[4 * k4 + 1] * w4.y + (sa * b4.y + v * d4.y); y1 += S[4 * k4 + 1] * r4.y;
                                S[4 * k4 + 2] = S[4 * k4 + 2] * w4.z + (sa * b4.z + v * d4.z); y2 += S[4 * k4 + 2] * r4.z;
                                S[4 * k4 + 3] = S[4 * k4 + 3] * w4.w + (sa * b4.w + v * d4.w); y3 += S[4 * k4 + 3] * r4.w;
                            }
                            asm volatile("" : "+v"(y0), "+v"(y1), "+v"(y2), "+v"(y3) :: "memory");
                        }
                        const float y = (y0 + y1) + (y2 + y3);
                        VY[st * 64 + F.lane] = y + BON[st] * v;
                    }
                }
                __syncthreads();
                if (seg) {
                    const f32x4 y0 = *(const LAS f32x4*)(VY + i * 64 + cg * 8), y1 = *(const LAS f32x4*)(VY + i * 64 + cg * 8 + 4);
                    u32x4 w; w.x = pk2(y0.x, y0.y); w.y = pk2(y0.z, y0.w); w.z = pk2(y1.x, y1.y); w.w = pk2(y1.z, y1.w);
                    *(u32x4*)(Y + ((size_t)b * TL + t) * D + c0 + cg * 8) = w;
                }
            }
        }
    }
    __syncthreads();
}

__device__ __forceinline__ void p4_readout(const Frame& F, const Args& A) {
    unsigned char* ws = A.ws;
    {
        LAS float* scr = (LAS float*)(F.lds + F.wave * 16384);
        constexpr int NIT = 2 * 16 * 3 * 256;
        for (int it = F.gw; it < NIT; it += F.NGW) {
            const int mat = it >> 8, item = it & 255;
            const int kind = mat % 3, le = mat / 3, l = le >> 4, e = le & 15;
            unsigned char* mw = ws + (l ? WS_MOEW1 : WS_MOEW0);
            if (kind == 0) tr_job_item(A.in[I_MGATE] + (size_t)le * D * ED, ED, ED, (bf16_t*)mw, D, e * 1024, true, nullptr, item, scr, F.lane);
            else if (kind == 1) tr_job_item(A.in[I_MUP] + (size_t)le * D * ED, ED, ED, (bf16_t*)mw, D, e * 1024 + 128, true, nullptr, item, scr, F.lane);
            else tr_job_item(A.in[I_MDOWN] + (size_t)le * ED * D, D, D, (bf16_t*)(mw + 32 * MiB), ED, e * 1024, false, nullptr, item, scr, F.lane);
        }
    }
    const bf16_t* Y0 = (const bf16_t*)(ws + WS_Y0); const bf16_t* Y1 = (const bf16_t*)(ws + WS_Y1); const bf16_t* Gt = (const bf16_t*)(ws + WS_G);
    bf16_t* ZO = (bf16_t*)(ws + WS_ZO);
    float gw_[16], gb_[16];
#pragma unroll
    for (int j = 0; j < 2; ++j)
#pragma unroll
        for (int q = 0; q < 8; ++q) { const int c = 8 * F.lane + 512 * j + q; gw_[j * 8 + q] = A.in[I_GNW][c]; gb_[j * 8 + q] = A.in[I_GNB][c]; }
    for (int t = F.gw; t < ML; t += F.NGW) {
#pragma unroll
        for (int j = 0; j < 2; ++j) {
            const size_t off = (size_t)t * D + 8 * F.lane + 512 * j;
            const u32x4 a = *(const u32x4*)(Y0 + off), b = *(const u32x4*)(Y1 + off), g = *(const u32x4*)(Gt + off);
            float y[8] = {bflo(a.x) + bflo(b.x), bfhi(a.x) + bfhi(b.x), bflo(a.y) + bflo(b.y), bfhi(a.y) + bfhi(b.y), bflo(a.z) + bflo(b.z), bfhi(a.z) + bfhi(b.z), bflo(a.w) + bflo(b.w), bfhi(a.w) + bfhi(b.w)};
            float gg[8] = {bflo(g.x), bfhi(g.x), bflo(g.y), bfhi(g.y), bflo(g.z), bfhi(g.z), bflo(g.w), bfhi(g.w)};
            float s = 0.f;
#pragma unroll
            for (int q = 0; q < 8; ++q) s += y[q];
            s += __shfl_xor(s, 1); s += __shfl_xor(s, 2); s += __shfl_xor(s, 4);
            const float mean = s * (1.f / 64.f); float s2 = 0.f;
#pragma unroll
            for (int q = 0; q < 8; ++q) { y[q] -= mean; s2 += y[q] * y[q]; }
            s2 += __shfl_xor(s2, 1); s2 += __shfl_xor(s2, 2); s2 += __shfl_xor(s2, 4);
            const float rstd = rsqrtf(s2 * (1.f / 64.f) + GN_EPS);
            float z[8];
#pragma unroll
            for (int q = 0; q < 8; ++q) z[q] = (y[q] * rstd * gw_[j * 8 + q] + gb_[j * 8 + q]) * gg[q];
            u32x4 w; w.x = pk2(z[0], z[1]); w.y = pk2(z[2], z[3]); w.z = pk2(z[4], z[5]); w.w = pk2(z[6], z[7]);
            *(u32x4*)(ZO + off) = w;
        }
    }
}

__device__ __forceinline__ void p6_route(const Frame& F, const Args& A, const int layer) {
    unsigned char* ws = A.ws;
    LAS float* RW = (LAS float*)F.lds;
    __syncthreads();
    for (int i = F.tid; i < D * NE; i += NTHREADS) { const int d = i >> 4, e = i & 15; const int j = d >> 8, l = (d & 255) >> 2, jj = d & 3, dj = j * 4 + jj;
        RW[((dj * 4 + (e >> 2)) * 64 + l) * 4 + (e & 3)] = A.in[I_ROUTW][i]; }
    __syncthreads();
    const float* MOD = (const float*)(ws + WS_MOD) + (size_t)layer * 9 * 6144;
    const float* ng = A.in[I_NORMG] + (size_t)(layer * 2 + 1) * D;
    const float* h = A.out;
    bf16_t* XN = (bf16_t*)(ws + WS_XN);
    unsigned* EIDX = (unsigned*)(ws + WS_EIDX); float* GATE = (float*)(ws + WS_GATE); int* CC = (int*)(ws + WS_CC);
    float rb[16];
#pragma unroll
    for (int e = 0; e < 16; ++e) rb[e] = A.in[I_ROUTB][e];
    for (int ch = F.gw; ch < 2048; ch += F.NGW) {
        const int t0 = ch * 16, b = t0 / TL;
        const float* mrow = MOD + (size_t)b * 6144;
        f32x4 gsc[4], sh[4];
#pragma unroll
        for (int j = 0; j < 4; ++j) { const int c = 4 * F.lane + 256 * j; gsc[j] = *(const f32x4*)(ng + c) * (1.f + *(const f32x4*)(mrow + 4096 + c)); sh[j] = *(const f32x4*)(mrow + 3072 + c); }
        int cnt = 0;
        for (int i = 0; i < 16; ++i) {
            const int t = t0 + i;
            f32x4 v[4];
            p1_load_norm(h + (size_t)t * D, gsc, sh, v, F.lane);
            bf16_t* orow = XN + (size_t)t * D + 4 * F.lane;
#pragma unroll
            for (int j = 0; j < 4; ++j) st_bf4(orow + 256 * j, v[j]);
            float lg[16];
#pragma unroll
            for (int e = 0; e < 16; ++e) lg[e] = 0.f;
#pragma unroll
            for (int j = 0; j < 4; ++j)
#pragma unroll
                for (int jj = 0; jj < 4; ++jj) { const float xv = v[j][jj]; const int dj = j * 4 + jj;
#pragma unroll
                    for (int q = 0; q < 4; ++q) { const f32x4 w = *(const LAS f32x4*)(RW + ((dj * 4 + q) * 64 + F.lane) * 4);
                        lg[4 * q] += xv * w.x; lg[4 * q + 1] += xv * w.y; lg[4 * q + 2] += xv * w.z; lg[4 * q + 3] += xv * w.w; }
                    asm volatile("" : "+v"(lg[0]), "+v"(lg[1]), "+v"(lg[2]), "+v"(lg[3]), "+v"(lg[4]), "+v"(lg[5]), "+v"(lg[6]), "+v"(lg[7]),
                                      "+v"(lg[8]), "+v"(lg[9]), "+v"(lg[10]), "+v"(lg[11]), "+v"(lg[12]), "+v"(lg[13]), "+v"(lg[14]), "+v"(lg[15]) :: "memory"); }
#pragma unroll
            for (int e = 0; e < 16; ++e) lg[e] = wave_sum(lg[e]);
            float best = -3.0e38f; int be0 = 0, be1 = 1; float bs0 = 0.f, bs1 = 0.f;
#pragma unroll
            for (int g = 0; g < 4; ++g) {
                float s[4], sel[4];
#pragma unroll
                for (int q = 0; q < 4; ++q) { s[q] = 1.f / (1.f + expf(-lg[4 * g + q])); sel[q] = s[q] + rb[4 * g + q]; }
                int i1 = 0; float v1 = sel[0], s1 = s[0];
#pragma unroll
                for (int q = 1; q < 4; ++q) if (sel[q] > v1) { i1 = q; v1 = sel[q]; s1 = s[q]; }
                int i2 = -1; float v2 = -3.0e38f, s2 = 0.f;
#pragma unroll
                for (int q = 0; q < 4; ++q) if (q != i1 && sel[q] > v2) { i2 = q; v2 = sel[q]; s2 = s[q]; }
                const float gs = v1 + v2;
                if (gs > best) { best = gs; be0 = 4 * g + i1; be1 = 4 * g + i2; bs0 = s1; bs1 = s2; }
            }
            const float inv = 1.f / (bs0 + bs1);
            if (F.lane == 0) { EIDX[t] = (unsigned)be0 | ((unsigned)be1 << 8); GATE[2 * t] = bs0 * inv; GATE[2 * t + 1] = bs1 * inv; }
            cnt += (F.lane == be0) + (F.lane == be1);
        }
        if (F.lane < 16) CC[ch * 16 + F.lane] = cnt;
    }
    __syncthreads();
}

__device__ __forceinline__ void p7_permute(const Frame& F, const Args& A) {
    unsigned char* ws = A.ws;
    LAS int* cc = (LAS int*)F.lds;
    LAS int* ps = (LAS int*)(F.lds + LDS_X_OFF);
    LAS int* seg = ps + 512;
    const int* CC = (const int*)(ws + WS_CC);
    const unsigned* EIDX = (const unsigned*)(ws + WS_EIDX); int* POS = (int*)(ws + WS_POS); int* TILE = (int*)(ws + WS_TILE);
    const bf16_t* XN = (const bf16_t*)(ws + WS_XN); bf16_t* XP = (bf16_t*)(ws + WS_XP);
    __syncthreads();
    for (int i = F.tid; i < 2048 * 16 / 4; i += NTHREADS) ((LAS u32x4*)cc)[i] = ((const u32x4*)CC)[i];
    __syncthreads();
    { const int e = F.tid & 15, part = F.tid >> 4; int s = 0; for (int q = 0; q < 64; ++q) s += cc[(part * 64 + q) * 16 + e]; ps[part * 16 + e] = s; }
    __syncthreads();
    if (F.tid < 16) { int run = 0; for (int p = 0; p < 32; ++p) { const int v = ps[p * 16 + F.tid]; ps[p * 16 + F.tid] = run; run += v; } seg[F.tid] = run; }
    __syncthreads();
    if (F.tid == 0) { int off = 0, nt = 0;
        for (int e = 0; e < 16; ++e) { const int tot = seg[e]; seg[e] = off; const int tl = (tot + 255) >> 8;
            if (blockIdx.x == 0) for (int q = 0; q < tl; ++q) TILE[16 + nt + q] = e;
            nt += tl; off += tl * 256; }
        if (blockIdx.x == 0) TILE[0] = nt; }
    __syncthreads();
    for (int ch = F.gw; ch < 2048; ch += F.NGW) {
        int base = 0;
        if (F.lane < 16) { base = seg[F.lane] + ps[(ch >> 6) * 16 + F.lane]; for (int q = (ch & ~63); q < ch; ++q) base += cc[q * 16 + F.lane]; }
        for (int i = 0; i < 16; ++i) {
            const int t = ch * 16 + i; const unsigned ei = EIDX[t]; const int e0 = ei & 255, e1 = (ei >> 8) & 255;
            const int p0 = __shfl(base, e0); base += (F.lane == e0);
            const int p1 = __shfl(base, e1); base += (F.lane == e1);
            if (F.lane == 0) { POS[2 * t] = p0; POS[2 * t + 1] = p1; }
            const u32x4* src = (const u32x4*)(XN + (size_t)t * D) + F.lane;
            const u32x4 a = src[0], b = src[64];
            u32x4* d0 = (u32x4*)(XP + (size_t)p0 * D) + F.lane; u32x4* d1 = (u32x4*)(XP + (size_t)p1 * D) + F.lane;
            d0[0] = a; d0[64] = b; d1[0] = a; d1[64] = b;
        }
    }
    __syncthreads();
}

template <bool FINAL>
__device__ __forceinline__ void p10_combine(const Frame& F, const Args& A, const int layer) {
    unsigned char* ws = A.ws;
    const float* MOD = (const float*)(ws + WS_MOD);
    const bf16_t* O = (const bf16_t*)(ws + WS_XP); const int* POS = (const int*)(ws + WS_POS); const float* GATE = (const float*)(ws + WS_GATE);
    bf16_t* XN = (bf16_t*)(ws + WS_XN);
    float* h = A.out;
    for (int ch = F.gw; ch < 2048; ch += F.NGW) {
        const int t0 = ch * 16, b = t0 / TL;
        const float* mcur = MOD + ((size_t)layer * 9 + b) * 6144;
        f32x4 gt2[4], gsc[4], sh[4];
#pragma unroll
        for (int j = 0; j < 4; ++j) { const int c = 4 * F.lane + 256 * j; gt2[j] = *(const f32x4*)(mcur + 5120 + c);
            if (FINAL) { gsc[j] = *(const f32x4*)(A.in[I_FINALG] + c); sh[j] = (f32x4){0.f, 0.f, 0.f, 0.f}; }
            else { const float* mn = MOD + ((size_t)9 + b) * 6144; gsc[j] = *(const f32x4*)(A.in[I_NORMG] + 2 * D + c) * (1.f + *(const f32x4*)(mn + 1024 + c)); sh[j] = *(const f32x4*)(mn + c); } }
        for (int i = 0; i < 16; ++i) {
            const int t = t0 + i; const int p0 = POS[2 * t], p1 = POS[2 * t + 1]; const float w0 = GATE[2 * t], w1 = GATE[2 * t + 1];
            f32x4 v[4]; float s = 0.f;
#pragma unroll
            for (int j = 0; j < 4; ++j) { const int c = 4 * F.lane + 256 * j;
                const u32x2 oa = *(const u32x2*)(O + (size_t)p0 * D + c), ob = *(const u32x2*)(O + (size_t)p1 * D + c);
                const f32x4 m = w0 * (f32x4){bflo(oa.x), bfhi(oa.x), bflo(oa.y), bfhi(oa.y)} + w1 * (f32x4){bflo(ob.x), bfhi(ob.x), bflo(ob.y), bfhi(ob.y)};
                v[j] = *(const f32x4*)(h + (size_t)t * D + c) + gt2[j] * m;
                s += (v[j].x * v[j].x + v[j].y * v[j].y) + (v[j].z * v[j].z + v[j].w * v[j].w); }
            const float rstd = rsqrtf(wave_sum(s) * (1.f / D) + RMS_EPS);
            if (FINAL) {
#pragma unroll
                for (int j = 0; j < 4; ++j) *(f32x4*)(h + (size_t)t * D + 4 * F.lane + 256 * j) = v[j] * rstd * gsc[j];
            } else {
#pragma unroll
                for (int j = 0; j < 4; ++j) { *(f32x4*)(h + (size_t)t * D + 4 * F.lane + 256 * j) = v[j]; st_bf4(XN + (size_t)t * D + 4 * F.lane + 256 * j, v[j] * rstd * gsc[j] + sh[j]); }
            }
        }
    }
}

__device__ __forceinline__ void ld_bf16row(const bf16_t* row, float (&o)[16], int lane) {
#pragma unroll
    for (int j = 0; j < 2; ++j) { const u32x4 a = *(const u32x4*)(row + 8 * lane + 512 * j);
        o[8 * j] = bflo(a.x); o[8 * j + 1] = bfhi(a.x); o[8 * j + 2] = bflo(a.y); o[8 * j + 3] = bfhi(a.y); o[8 * j + 4] = bflo(a.z); o[8 * j + 5] = bfhi(a.z); o[8 * j + 6] = bflo(a.w); o[8 * j + 7] = bfhi(a.w); }
}
__device__ __forceinline__ void p12_conv(const Frame& F, const Args& A) {
    unsigned char* ws = A.ws;
    const bf16_t* BG = (const bf16_t*)(ws + WS_BG); const bf16_t* U = (const bf16_t*)(ws + WS_U); bf16_t* Z = (bf16_t*)(ws + WS_Z);
    float c0[16], c1[16], c2[16];
#pragma unroll
    for (int j = 0; j < 2; ++j)
#pragma unroll
        for (int q = 0; q < 8; ++q) { const int c = 8 * F.lane + 512 * j + q; c0[8 * j + q] = A.in[I_CONV][c]; c1[8 * j + q] = A.in[I_CONV][D + c]; c2[8 * j + q] = A.in[I_CONV][2 * D + c]; }
    for (int u = F.gw; u < 2048; u += F.NGW) {
        const int t0 = u * 16, pos0 = t0 % GRIDW;
        float prev[16], cur[16], nxt[16], bg[16];
        if (pos0 > 0) ld_bf16row(U + (size_t)(t0 - 1) * D, prev, F.lane);
        else {
#pragma unroll
            for (int q = 0; q < 16; ++q) prev[q] = 0.f; }
        ld_bf16row(U + (size_t)t0 * D, cur, F.lane);
        for (int i = 0; i < 16; ++i) {
            if (pos0 + i + 1 < GRIDW) ld_bf16row(U + (size_t)(t0 + i + 1) * D, nxt, F.lane);
            else {
#pragma unroll
                for (int q = 0; q < 16; ++q) nxt[q] = 0.f; }
            ld_bf16row(BG + (size_t)(t0 + i) * D, bg, F.lane);
            float z[16];
#pragma unroll
            for (int q = 0; q < 16; ++q) { z[q] = bg[q] * (c0[q] * prev[q] + c1[q] * cur[q] + c2[q] * nxt[q]); prev[q] = cur[q]; cur[q] = nxt[q]; }
#pragma unroll
            for (int j = 0; j < 2; ++j) { u32x4 w; w.x = pk2(z[8 * j], z[8 * j + 1]); w.y = pk2(z[8 * j + 2], z[8 * j + 3]); w.z = pk2(z[8 * j + 4], z[8 * j + 5]); w.w = pk2(z[8 * j + 6], z[8 * j + 7]);
                *(u32x4*)(Z + (size_t)(t0 + i) * D + 8 * F.lane + 512 * j) = w; }
        }
    }
}

constexpr int N_PHASES = 20;
__global__ void __launch_bounds__(NTHREADS, 2) fwd(Args args) {
    extern __shared__ __attribute__((aligned(16))) unsigned char lds_raw[];
    Frame F;
    F.lds = (LAS unsigned char*)lds_raw;
    F.tid = threadIdx.x; F.lane = F.tid & 63; F.wave = __builtin_amdgcn_readfirstlane(F.tid >> 6);
    F.G = gridDim.x; { const int bx = blockIdx.x; F.vcu = (F.G % 8 == 0) ? (bx % 8) * (F.G / 8) + bx / 8 : bx; }
    F.gw = F.vcu * NWAVES + F.wave; F.NGW = F.G * NWAVES;
    unsigned char* ws = args.ws;
    for (int u = F.tid; u < (LDS_BYTES - LDSCTL_OFF) / 4; u += NTHREADS) ((LAS unsigned*)(F.lds + LDSCTL_OFF))[u] = 0u;
    __syncthreads();
    volatile LAS unsigned* MISC = (volatile LAS unsigned*)(F.lds + MISC_OFF);
    XcdBarrier bar; bar.bar = (unsigned*)(ws + WS_CTL) + CW_BAR; bar.x = 0; bar.st = nullptr;
    const int lo = args.ph_lo, hi = args.ph_hi;
    if (hi - lo > 1) bar = xcd_barrier_post((unsigned*)(ws + WS_CTL) + CW_BAR, MISC + 8);
#ifndef PH_MASK
#define PH_MASK 0xFFFFFu
#endif
#define IN(k) (((PH_MASK >> (k)) & 1u) && lo <= (k) && (k) < hi)
#define SEAM(k) do { if (IN(k) && IN((k) + 1)) xcd_barrier(bar); } while (0)
    const float* MOD = (const float*)(ws + WS_MOD);
    const int bx = (int)blockIdx.x;

    if (IN(0)) { p0_prologue(F, args); SEAM(0); }
    if (IN(1)) { p1_mix(F, args); SEAM(1); }
    if (IN(2)) {
        { SchedRKV S{(const char*)(ws + WS_XM), (const char*)(ws + WS_WRKV), F.G, bx};
          EpiRKV E{(bf16_t*)args.out, (bf16_t*)args.out + (size_t)ML * D, (bf16_t*)(ws + WS_KC), (bf16_t*)(ws + WS_V)};
          pg8::gemm_phase<EpiRKV, SchedRKV>(F.lds, XM_LD, 2048, S, E); }
        { SchedLora S{(const char*)(ws + WS_XM), (const char*)(ws + WS_WL), F.G, (bx + F.G / 2) % F.G};
          EpiLora E{(bf16_t*)(ws + WS_LWA), (bf16_t*)(ws + WS_LG)};
          pg8::gemm_phase<EpiLora, SchedLora>(F.lds, XM_LD, 2048, S, E); }
        SEAM(2);
    }
    if (IN(3)) {
        SchedPlain S{(const char*)(ws + WS_LG), (const char*)(ws + WS_G2), 128, 4, 256, 256, 4, F.G, bx};
        EpiBf16 E{(bf16_t*)(ws + WS_G), D};
        pg8::gemm_phase<EpiBf16, SchedPlain>(F.lds, 256, 256, S, E);
        SEAM(3);
    }
    if (IN(4)) { p3_scan(F, args); SEAM(4); }
    if (IN(5)) { p4_readout(F, args); SEAM(5); }
    if (IN(6)) {
        SchedPlain S{(const char*)(ws + WS_ZO), (const char*)(ws + WS_WO), 128, 4, D, D, 16, F.G, bx};
        EpiRes E{args.in[I_X], args.out, MOD + 2048};
        pg8::gemm_phase<EpiRes, SchedPlain>(F.lds, D, D, S, E);
        SEAM(6);
    }
    if (IN(7)) { p6_route(F, args, 0); SEAM(7); }
    if (IN(8)) { p7_permute(F, args); SEAM(8); }
    if (IN(9)) {
        SchedMoe S{(const char*)(ws + WS_XP), (const char*)(ws + WS_MOEW0), (const int*)(ws + WS_TILE), D, D, 16, F.G, bx, (size_t)2 * MiB};
        EpiGateUp E{(bf16_t*)(ws + WS_H)};
        pg8::gemm_phase<EpiGateUp, SchedMoe>(F.lds, D, D, S, E);
        SEAM(9);
    }
    if (IN(10)) {
        SchedMoe S{(const char*)(ws + WS_H), (const char*)(ws + WS_MOEW0 + 32 * MiB), (const int*)(ws + WS_TILE), ED, ED, 8, F.G, bx, (size_t)1 * MiB};
        EpiBf16 E{(bf16_t*)(ws + WS_XP), D};
        pg8::gemm_phase<EpiBf16, SchedMoe>(F.lds, ED, ED, S, E);
        SEAM(10);
    }
    if (IN(11)) { p10_combine<false>(F, args, 0); SEAM(11); }
    if (IN(12)) {
        SchedPlain S{(const char*)(ws + WS_XN), (const char*)(ws + WS_WIN), 128, 12, D, D, 16, F.G, bx};
        EpiWin E{(bf16_t*)(ws + WS_BG), (bf16_t*)(ws + WS_U)};
        pg8::gemm_phase<EpiWin, SchedPlain>(F.lds, D, D, S, E);
        SEAM(12);
    }
    if (IN(13)) { p12_conv(F, args); SEAM(13); }
    if (IN(14)) {
        SchedPlain S{(const char*)(ws + WS_Z), (const char*)(ws + WS_WOUT), 128, 4, D, D, 16, F.G, bx};
        EpiRes E{args.out, args.out, MOD + 9 * 6144 + 2048};
        pg8::gemm_phase<EpiRes, SchedPlain>(F.lds, D, D, S, E);
        SEAM(14);
    }
    if (IN(15)) { p6_route(F, args, 1); SEAM(15); }
    if (IN(16)) { p7_permute(F, args); SEAM(16); }
    if (IN(17)) {
        SchedMoe S{(const char*)(ws + WS_XP), (const char*)(ws + WS_MOEW1), (const int*)(ws + WS_TILE), D, D, 16, F.G, bx, (size_t)2 * MiB};
        EpiGateUp E{(bf16_t*)(ws + WS_H)};
        pg8::gemm_phase<EpiGateUp, SchedMoe>(F.lds, D, D, S, E);
        SEAM(17);
    }
    if (IN(18)) {
        SchedMoe S{(const char*)(ws + WS_H), (const char*)(ws + WS_MOEW1 + 32 * MiB), (const int*)(ws + WS_TILE), ED, ED, 8, F.G, bx, (size_t)1 * MiB};
        EpiBf16 E{(bf16_t*)(ws + WS_XP), D};
        pg8::gemm_phase<EpiBf16, SchedMoe>(F.lds, ED, ED, S, E);
        SEAM(18);
    }
    if (IN(19)) { p10_combine<true>(F, args, 1); }
}

extern "C" void kernel_launch(void* const* d_in, const int* in_sizes, int n_in, void* d_out, int out_size, void* d_ws, size_t ws_size, hipStream_t stream) {
    static int grid = 0;
    if (grid == 0) {
        if (n_in != 32 || out_size != ML * D || ws_size < WS_END) { fprintf(stderr, "kernel_launch: unexpected problem (n_in %d, out %d, ws %zu)\n", n_in, out_size, ws_size); grid = -1; return; }
        int dev = 0, cus = 0;
        if (hipGetDevice(&dev) != hipSuccess || hipDeviceGetAttribute(&cus, hipDeviceAttributeMultiprocessorCount, dev) != hipSuccess) { grid = -1; return; }
        if (hipFuncSetAttribute((const void*)fwd, hipFuncAttributeMaxDynamicSharedMemorySize, LDS_BYTES) != hipSuccess) { grid = -1; return; }
        int per_cu = 0;
        if (hipOccupancyMaxActiveBlocksPerMultiprocessor(&per_cu, (const void*)fwd, NTHREADS, LDS_BYTES) != hipSuccess || per_cu < 1) { fprintf(stderr, "kernel_launch: occupancy query says %d\n", per_cu); grid = -1; return; }
        grid = cus > 256 ? 256 : cus;
    }
    if (grid < 0) return;
    (void)in_sizes;
    hipMemsetAsync((char*)d_ws + WS_CTL, 0, CTL_ZERO_BYTES, stream);
    Args a{};
    for (int i = 0; i < 32; ++i) a.in[i] = (const float*)d_in[i];
    a.out = (float*)d_out; a.ws = (unsigned char*)d_ws;
#if MK_N_LAUNCHES == 1
    a.ph_lo = 0; a.ph_hi = N_PHASES;
    hipLaunchKernelGGL(fwd, dim3(grid), dim3(NTHREADS), LDS_BYTES, stream, a);
#else
    for (int k = 0; k < N_PHASES; ++k) { a.ph_lo = k; a.ph_hi = k + 1; hipLaunchKernelGGL(fwd, dim3(grid), dim3(NTHREADS), LDS_BYTES, stream, a); }
#endif
}
```

```cpp
#include <hip/hip_runtime.h>
#include <cstdio>
#include <cstdint>

#ifndef MK_N_LAUNCHES
#define MK_N_LAUNCHES 1
#endif

#define GAS __attribute__((address_space(1)))
#define LAS __attribute__((address_space(3)))
typedef unsigned short bf16_t;
typedef short bf16x8 __attribute__((ext_vector_type(8)));
typedef float f32x4 __attribute__((ext_vector_type(4)));
typedef float f32x2 __attribute__((ext_vector_type(2)));
typedef unsigned u32x4 __attribute__((ext_vector_type(4)));
typedef unsigned u32x2 __attribute__((ext_vector_type(2)));

constexpr int D = 1024, NBATCH = 8, TL = 4096, TCX = 256, ML = NBATCH * TL, MC = NBATCH * TCX, MA = ML + MC;
constexpr int NH = 16, HD = 64, NE = 16, ED = 512, GRIDW = 64;
constexpr int XM_LD = 5 * D;
constexpr int NWAVES = 8, NTHREADS = 512;
constexpr float RMS_EPS = 1e-6f, GN_EPS = 64e-5f;
constexpr int MAXTILES = 272;

constexpr size_t MiB = 1u << 20;
constexpr size_t WS_CTL = 0, CTL_ZERO_BYTES = 1 * MiB;
constexpr size_t WS_MOD = 1 * MiB;
constexpr size_t WS_EIDX = 2 * MiB;
constexpr size_t WS_GATE = WS_EIDX + 128 * 1024;
constexpr size_t WS_POS = WS_GATE + 256 * 1024;
constexpr size_t WS_CC = WS_POS + 256 * 1024;
constexpr size_t WS_TILE = WS_CC + 128 * 1024;
constexpr size_t WS_WRKV = 4 * MiB;
constexpr size_t WS_WL = 16 * MiB;
constexpr size_t WS_G2 = 18 * MiB;
constexpr size_t WS_WO = 19 * MiB;
constexpr size_t WS_WIN = 21 * MiB;
constexpr size_t WS_WOUT = 27 * MiB;
constexpr size_t WS_ACT = 32 * MiB;
constexpr size_t WS_XM = WS_ACT;
constexpr size_t WS_V = 372 * MiB;
constexpr size_t WS_KC = 440 * MiB;
constexpr size_t WS_LWA = 444 * MiB;
constexpr size_t WS_LG = 461 * MiB;
constexpr size_t WS_G = 32 * MiB;
constexpr size_t WS_Y0 = 96 * MiB, WS_Y1 = 160 * MiB;
constexpr size_t WS_ZO = 272 * MiB;
constexpr size_t WS_MOEW0 = 384 * MiB, WS_MOEW1 = 432 * MiB;
constexpr size_t WS_XN = 32 * MiB;
constexpr size_t WS_XP = 96 * MiB;
constexpr size_t WS_H = 232 * MiB;
constexpr size_t WS_BG = 232 * MiB, WS_U = 296 * MiB;
constexpr size_t WS_Z = 96 * MiB;
constexpr size_t WS_END = 480 * MiB;

constexpr int CW_BAR = 4096;

constexpr int RING_BYTES = 131072;
constexpr int LDS_BYTES = 147456;
constexpr int LDSCTL_OFF = LDS_BYTES - 512, MISC_OFF = LDSCTL_OFF + 64;
constexpr int LDS_X_OFF = RING_BYTES;

typedef __bf16 bf16x2v __attribute__((ext_vector_type(2)));
__device__ __forceinline__ unsigned pk2(float lo, float hi) { const f32x2 v = {lo, hi}; return __builtin_bit_cast(unsigned, __builtin_convertvector(v, bf16x2v)); }
__device__ __forceinline__ unsigned f2bf(float f) { return pk2(f, 0.f) & 0xffffu; }
__device__ __forceinline__ float bflo(unsigned u) { return __builtin_bit_cast(float, u << 16); }
__device__ __forceinline__ float bfhi(unsigned u) { return __builtin_bit_cast(float, u & 0xffff0000u); }
__device__ __forceinline__ float wave_sum(float v) {
#pragma unroll
    for (int o = 1; o < 64; o <<= 1) v += __shfl_xor(v, o);
    return v;
}
__device__ __forceinline__ float sigmoidf_(float x) { return 1.f / (1.f + __expf(-x)); }
#define LDS_WAIT() asm volatile("s_waitcnt lgkmcnt(0)" ::: "memory")

namespace pg8 {
constexpr int BM = 256, BK = 64, HALF = 128, HTB = HALF * BK * 2, STAGE_BYTES = 8 * HTB, NXCD = 8, WGM = 8;
__host__ __device__ __forceinline__ int lds_byte(int r, int c) { const int st = (r >> 4) * 2 + (c >> 5), rr = r & 15, cc = c & 31, ob = rr * 64 + cc * 2; return st * 1024 + (ob ^ (((ob >> 9) & 1) << 5)); }
__host__ __device__ __forceinline__ void stage_rc(int b, int& R, int& C) { const int st = b / 1024, sb = b % 1024, swz = sb ^ (((sb >> 9) & 1) << 5); R = (st >> 1) * 16 + swz / 64; C = (st & 1) * 32 + (swz % 64) / 2; }
__host__ __device__ __forceinline__ int perm32(int rho) { const int n = rho >> 4, i = rho & 15; return 8 * (i >> 2) + 4 * n + (i & 3); }

struct Unit { int pm, pn; const char* a; const char* b; int nt; };

__device__ __forceinline__ void swz_tile(int L, int nM, int nN, int& pm, int& pn) {
    const int nwg = nM * nN; int wgid = L;
    { const int q = nwg / NXCD, r = nwg % NXCD, xcd = wgid % NXCD, off = wgid / NXCD; wgid = (xcd < r ? xcd * (q + 1) : r * (q + 1) + (xcd - r) * q) + off; }
    const int nig = WGM * nN, gid = wgid / nig, fm = gid * WGM, gsz = (nM - fm) < WGM ? (nM - fm) : WGM;
    pm = fm + ((wgid % nig) % gsz); pn = (wgid % nig) / gsz;
}

__device__ __forceinline__ unsigned cvt_pk_bf16(float lo, float hi) { return pk2(lo, hi); }

template <class Epi, class Sched, bool ALIGN_EPI = true, bool SP2 = true>
__device__ __forceinline__ void gemm_phase(LAS unsigned char* lds, const int lda, const int ldb, const Sched& S, const Epi& E) {
    const int tid = threadIdx.x, wid = __builtin_amdgcn_readfirstlane(tid >> 6), lane = tid & 63, wr = wid >> 2, wc = wid & 3, fr = lane & 15, fq = lane >> 4;
    unsigned voffA[2], voffB[2];
#pragma unroll
    for (int i = 0; i < 2; ++i) { int R, C; stage_rc(tid * 16 + i * 8192, R, C); const int Rb = Epi::PERM ? ((R & ~31) + perm32(R & 31)) : R;
        voffA[i] = (unsigned)(R * lda + C) * 2u; voffB[i] = (unsigned)(Rb * ldb + C) * 2u; }
    const size_t kstep = (size_t)(BK * 2);
    const size_t hstepA = (size_t)HALF * lda * 2, hstepB = (size_t)HALF * ldb * 2;
    const unsigned ldsw = (unsigned)wid * 1024u;
    const int aoff = lds_byte(wr * 64 + fr, fq * 8), boff = lds_byte(wc * 32 + fr, fq * 8);
#define PG8_SA(b, h) (((b) * 2 + (h)) * HTB)
#define PG8_SB(b, h) ((4 + (b) * 2 + (h)) * HTB)
#define PG8_STAGE(bufoff, gbase, voff) do { _Pragma("unroll") for (int _i = 0; _i < 2; ++_i) \
        __builtin_amdgcn_global_load_lds((const unsigned*)((const char*)(gbase) + (voff)[_i]), (LAS unsigned*)(lds + (bufoff) + ldsw + _i * 8192), 16, 0, 0); } while (0)
#define PG8_LDA(dst, b, h) do { _Pragma("unroll") for (int m = 0; m < 4; ++m) _Pragma("unroll") for (int k = 0; k < 2; ++k) dst[m][k] = *(const LAS bf16x8*)(lds + PG8_SA(b, h) + aoff + m * 2048 + k * 1024); } while (0)
#define PG8_LDB(dst, b, h) do { _Pragma("unroll") for (int n = 0; n < 2; ++n) _Pragma("unroll") for (int k = 0; k < 2; ++k) dst[n][k] = *(const LAS bf16x8*)(lds + PG8_SB(b, h) + boff + n * 2048 + k * 1024); } while (0)
#define PG8_MMA(ai, bj, At, Bt) do { __builtin_amdgcn_s_setprio(1); _Pragma("unroll") for (int m = 0; m < 4; ++m) _Pragma("unroll") for (int n = 0; n < 2; ++n) _Pragma("unroll") for (int k = 0; k < 2; ++k) \
        acc[ai][bj][m][n] = __builtin_amdgcn_mfma_f32_16x16x32_bf16(Bt[n][k], At[m][k], acc[ai][bj][m][n], 0, 0, 0); __builtin_amdgcn_s_setprio(0); } while (0)
#define PG8_WAIT_V(n) asm volatile("s_waitcnt vmcnt(" #n ")" ::: "memory")
#define PG8_WAIT_L(n) asm volatile("s_waitcnt lgkmcnt(" #n ")" ::: "memory")
#define PG8_BAR __builtin_amdgcn_s_barrier()
#define PG8_SCHED __builtin_amdgcn_sched_barrier(0)
    Unit cur, nxt; int ui = 0;
    if (!S.next(0, cur)) return;
    f32x4 acc[2][2][4][2];
#pragma unroll
    for (int a = 0; a < 2; ++a)
#pragma unroll
        for (int b = 0; b < 2; ++b)
#pragma unroll
            for (int m = 0; m < 4; ++m)
#pragma unroll
                for (int n = 0; n < 2; ++n) acc[a][b][m][n] = (f32x4){0.f, 0.f, 0.f, 0.f};
    bf16x8 At[4][2], B0[2][2], B1[2][2];
    const char* cA = cur.a; const char* cB = cur.b;
    if constexpr (SP2) {
        PG8_STAGE(PG8_SB(0, 0), cB, voffB); PG8_STAGE(PG8_SB(0, 1), cB + hstepB, voffB); PG8_STAGE(PG8_SA(0, 0), cA, voffA); PG8_STAGE(PG8_SA(0, 1), cA + hstepA, voffA);
        if (wr == 1) PG8_BAR;
        PG8_WAIT_V(2); PG8_BAR;
        PG8_STAGE(PG8_SB(1, 0), cB + kstep, voffB); PG8_STAGE(PG8_SA(1, 0), cA + kstep, voffA); PG8_STAGE(PG8_SB(1, 1), cB + hstepB + kstep, voffB);
        PG8_WAIT_V(6); PG8_BAR;
    } else {
        PG8_STAGE(PG8_SB(0, 0), cB, voffB); PG8_STAGE(PG8_SA(0, 0), cA, voffA); PG8_STAGE(PG8_SB(0, 1), cB + hstepB, voffB); PG8_STAGE(PG8_SA(0, 1), cA + hstepA, voffA);
        if (wr == 1) PG8_BAR;
        PG8_WAIT_V(4); PG8_BAR;
        PG8_STAGE(PG8_SB(1, 0), cB + kstep, voffB); PG8_STAGE(PG8_SA(1, 0), cA + kstep, voffA); PG8_STAGE(PG8_SB(1, 1), cB + hstepB + kstep, voffB);
        PG8_WAIT_V(6); PG8_BAR;
    }
    for (;;) {
        const bool has_next = S.next(ui + 1, nxt);
        const char* nA = has_next ? nxt.a : cA; const char* nB = has_next ? nxt.b : cB;
        const int nt = cur.nt;
        for (int t = 0; t < nt; t += 2) {
            const bool last = (t == nt - 2);
            const char* a1 = cA + (size_t)(t + 1) * kstep;
            const char* a2 = last ? nA : cA + (size_t)(t + 2) * kstep; const char* b2 = last ? nB : cB + (size_t)(t + 2) * kstep;
            const char* a3 = a2 + kstep; const char* b3 = b2 + kstep;
            if constexpr (SP2) {
            PG8_LDB(B0, 0, 0); PG8_LDB(B1, 0, 1); PG8_SCHED; PG8_LDA(At, 0, 0); PG8_STAGE(PG8_SA(1, 1), a1 + hstepA, voffA);
            PG8_WAIT_V(8); PG8_WAIT_L(0); PG8_BAR; PG8_MMA(0, 0, At, B0); PG8_MMA(0, 1, At, B1); PG8_BAR; PG8_SCHED;
            PG8_LDA(At, 0, 1); PG8_STAGE(PG8_SB(0, 0), b2, voffB); PG8_STAGE(PG8_SB(0, 1), b2 + hstepB, voffB); PG8_STAGE(PG8_SA(0, 0), a2, voffA);
            PG8_WAIT_V(8); PG8_WAIT_L(0); PG8_BAR; PG8_MMA(1, 0, At, B0); PG8_MMA(1, 1, At, B1); PG8_BAR; PG8_SCHED;
            PG8_LDB(B0, 1, 0); PG8_LDB(B1, 1, 1); PG8_SCHED; PG8_LDA(At, 1, 0); PG8_STAGE(PG8_SA(0, 1), a2 + hstepA, voffA);
            PG8_WAIT_V(8); PG8_WAIT_L(0); PG8_BAR; PG8_MMA(0, 0, At, B0); PG8_MMA(0, 1, At, B1); PG8_BAR; PG8_SCHED;
            PG8_LDA(At, 1, 1); PG8_STAGE(PG8_SB(1, 0), b3, voffB); PG8_STAGE(PG8_SB(1, 1), b3 + hstepB, voffB); PG8_STAGE(PG8_SA(1, 0), a3, voffA);
            PG8_WAIT_V(8); PG8_WAIT_L(0); PG8_BAR; PG8_MMA(1, 0, At, B0); PG8_MMA(1, 1, At, B1); PG8_BAR; PG8_SCHED;
            } else {
            PG8_LDB(B0, 0, 0); PG8_SCHED; PG8_LDA(At, 0, 0); PG8_STAGE(PG8_SA(1, 1), a1 + hstepA, voffA);
            PG8_WAIT_L(8); PG8_BAR; PG8_WAIT_L(0); PG8_MMA(0, 0, At, B0); PG8_BAR; PG8_SCHED;
            PG8_LDB(B1, 0, 1); PG8_STAGE(PG8_SB(0, 0), b2, voffB);
            PG8_BAR; PG8_WAIT_L(0); PG8_MMA(0, 1, At, B1); PG8_BAR;
            PG8_LDA(At, 0, 1); PG8_STAGE(PG8_SA(0, 0), a2, voffA);
            PG8_BAR; PG8_WAIT_L(0); PG8_MMA(1, 0, At, B0); PG8_BAR; PG8_SCHED;
            PG8_STAGE(PG8_SB(0, 1), b2 + hstepB, voffB);
            PG8_WAIT_V(6); PG8_BAR; PG8_MMA(1, 1, At, B1); PG8_BAR;
            PG8_LDB(B0, 1, 0); PG8_SCHED; PG8_LDA(At, 1, 0); PG8_STAGE(PG8_SA(0, 1), a2 + hstepA, voffA);
            PG8_WAIT_L(8); PG8_BAR; PG8_WAIT_L(0); PG8_MMA(0, 0, At, B0); PG8_BAR; PG8_SCHED;
            PG8_LDB(B1, 1, 1); PG8_STAGE(PG8_SB(1, 0), b3, voffB);
            PG8_BAR; PG8_WAIT_L(0); PG8_MMA(0, 1, At, B1); PG8_BAR;
            PG8_LDA(At, 1, 1); PG8_STAGE(PG8_SA(1, 0), a3, voffA);
            PG8_BAR; PG8_WAIT_L(0); PG8_MMA(1, 0, At, B0); PG8_BAR; PG8_SCHED;
            PG8_STAGE(PG8_SB(1, 1), b3 + hstepB, voffB);
            PG8_WAIT_V(6); PG8_BAR; PG8_MMA(1, 1, At, B1); PG8_BAR;
            }
        }
        if constexpr (ALIGN_EPI) { if (wr == 0) PG8_BAR; }
        E(acc, cur, wr, wc, fr, fq);
        if (!has_next) break;
#pragma unroll
        for (int a = 0; a < 2; ++a)
#pragma unroll
            for (int b = 0; b < 2; ++b)
#pragma unroll
                for (int m = 0; m < 4; ++m)
#pragma unroll
                    for (int n = 0; n < 2; ++n) acc[a][b][m][n] = (f32x4){0.f, 0.f, 0.f, 0.f};
        cur = nxt; cA = nA; cB = nB; ++ui;
        if constexpr (ALIGN_EPI) { if (wr == 1) PG8_BAR; }
    }
    PG8_WAIT_V(0);
    if constexpr (!ALIGN_EPI) { if (wr == 0) PG8_BAR; }
    PG8_BAR;
#undef PG8_SA
#undef PG8_SB
#undef PG8_STAGE
#undef PG8_LDA
#undef PG8_LDB
#undef PG8_MMA
#undef PG8_WAIT_V
#undef PG8_WAIT_L
#undef PG8_BAR
#undef PG8_SCHED
}
}

#define XB_TMO      128
#define XB_XCNT(j)  (256  + 64 * (j))
#define XB_XSUB(j)  (1280 + 64 * (j))
#define XB_XGEN(j)  (2304 + 64 * (j))
#define XB_TOP      3328
#define XB_TOPGEN   3392
#define XCD_BAR_WORDS 3456
#define XB_SPIN_CAP (1u << 18)

__device__ __forceinline__ unsigned xb_ld(unsigned* p)              { return __hip_atomic_load(p, __ATOMIC_RELAXED, __HIP_MEMORY_SCOPE_AGENT); }
__device__ __forceinline__ unsigned xb_add(unsigned* p, unsigned v) { return __hip_atomic_fetch_add(p, v, __ATOMIC_RELAXED, __HIP_MEMORY_SCOPE_AGENT); }
__device__ __forceinline__ unsigned xb_xcc_id() { return (unsigned)__builtin_amdgcn_s_getreg((3 << 11) | 20) & 0xFu; }
#define XB_SPIN(cond, bar) do { unsigned _sp = 0; while (cond) { __builtin_amdgcn_s_sleep(1); \
    if ((++_sp & 255u) == 0u) { if (xb_ld(&(bar)[XB_TMO])) break; if (_sp > XB_SPIN_CAP) { atomicAdd(&(bar)[XB_TMO], 1u); break; } } } } while (0)

struct XcdBarrier { unsigned* bar; unsigned x; volatile LAS unsigned* st; };

__device__ __forceinline__ XcdBarrier xcd_barrier_post(unsigned* bar, volatile LAS unsigned* st) {
    XcdBarrier b; b.bar = bar; b.x = xb_xcc_id(); b.st = st;
    if (threadIdx.x == 0) (void)xb_add(&bar[XB_XCNT(b.x)], 1u);
    return b;
}
__device__ __forceinline__ void xcd_barrier_complete(unsigned* bar, unsigned x, unsigned& nloc, unsigned& nx) {
    const unsigned G = gridDim.x * gridDim.y * gridDim.z;
    unsigned sum, cnt, mine, sp = 0u;
    for (;;) {
        sum = 0u; cnt = 0u; mine = 0u;
#pragma unroll
        for (unsigned j = 0; j < 16; ++j) { const unsigned c = xb_ld(&bar[XB_XCNT(j)]); sum += c; cnt += (c > 0u) ? 1u : 0u; mine = (j == x) ? c : mine; }
        if (sum == G) break;
        __builtin_amdgcn_s_sleep(1);
        if ((++sp & 255u) == 0u) { if (xb_ld(&bar[XB_TMO])) break; if (sp > XB_SPIN_CAP) { atomicAdd(&bar[XB_TMO], 1u); break; } }
    }
    nloc = mine > 0u ? mine : 1u; nx = cnt > 0u ? cnt : 1u;
}
__device__ __forceinline__ void xcd_barrier(const XcdBarrier& b) {
    asm volatile("s_waitcnt vmcnt(0)" ::: "memory");
    __syncthreads();
    if (threadIdx.x == 0) {
        unsigned* bar = b.bar;
        __builtin_amdgcn_s_waitcnt(0);
        unsigned nloc = b.st[0], nx = b.st[1];
        if (nloc == 0u) { xcd_barrier_complete(bar, b.x, nloc, nx); b.st[0] = nloc; b.st[1] = nx; }
        const unsigned old = xb_add(&bar[XB_XSUB(b.x)], 1u);
        const unsigned gen = old / nloc;
        if (old + 1u == (gen + 1u) * nloc) {
            __builtin_amdgcn_fence(__ATOMIC_RELEASE, "agent");
            asm volatile("s_waitcnt vmcnt(0)" ::: "memory");
            const unsigned og = xb_add(&bar[XB_TOP], 1u);
            const unsigned tg = og / nx;
            if (og + 1u == (tg + 1u) * nx) xb_add(&bar[XB_TOPGEN], 1u);
            else XB_SPIN(xb_ld(&bar[XB_TOPGEN]) == tg, bar);
            __builtin_amdgcn_fence(__ATOMIC_ACQUIRE, "agent");
            xb_add(&bar[XB_XGEN(b.x)], 1u);
            asm volatile("s_waitcnt vmcnt(0)" ::: "memory");
        } else {
            XB_SPIN(xb_ld(&bar[XB_XGEN(b.x)]) == gen, bar);
            __builtin_amdgcn_fence(__ATOMIC_ACQUIRE, "agent");
            asm volatile("s_waitcnt vmcnt(0)" ::: "memory");
        }
    }
    __syncthreads();
}

struct Args { const float* in[32]; float* out; unsigned char* ws; int ph_lo, ph_hi; };
enum { I_X = 0, I_C, I_CTX, I_CCTX, I_ADAW, I_ADAB, I_NORMG, I_MU, I_WRKV, I_W0, I_W1, I_W2, I_A0, I_A1, I_A2, I_G1, I_G2, I_KK, I_KA, I_RK, I_GNW, I_GNB, I_WO,
       I_WIN, I_CONV, I_WOUT, I_ROUTW, I_ROUTB, I_MGATE, I_MUP, I_MDOWN, I_FINALG };

struct Frame {
    LAS unsigned char* lds;
    int tid, lane, wave, G, vcu, gw, NGW;
};


__device__ __forceinline__ void tr_item(const float* W, int ldw, int k0, int n0, bf16_t* dst, int ldd, int drow0, const float* mu, LAS float* scr, int lane) {
#pragma unroll 8
    for (int i = 0; i < 32; ++i) { const int kk = 2 * i + (lane >> 5); scr[kk * 33 + (lane & 31)] = W[(size_t)(k0 + kk) * ldw + n0 + (lane & 31)]; }
    LDS_WAIT(); asm volatile("" ::: "memory");
    const int c = lane & 7;
    float m[8];
#pragma unroll
    for (int q = 0; q < 8; ++q) m[q] = mu ? mu[k0 + 8 * c + q] : 0.f;
#pragma unroll
    for (int j = 0; j < 4; ++j) { const int n = (lane >> 3) + 8 * j; const LAS float* s = scr + (8 * c) * 33 + n;
        float v[8];
#pragma unroll
        for (int q = 0; q < 8; ++q) v[q] = s[q * 33];
        bf16_t* drow = dst + (size_t)(drow0 + n) * ldd + k0 + 8 * c;
        if (!mu) {
            u32x4 o; o.x = pk2(v[0], v[1]); o.y = pk2(v[2], v[3]); o.z = pk2(v[4], v[5]); o.w = pk2(v[6], v[7]);
            *(u32x4*)drow = o;
        } else {
            u32x4 o; o.x = pk2(v[0] * (1.f - m[0]), v[1] * (1.f - m[1])); o.y = pk2(v[2] * (1.f - m[2]), v[3] * (1.f - m[3]));
            o.z = pk2(v[4] * (1.f - m[4]), v[5] * (1.f - m[5])); o.w = pk2(v[6] * (1.f - m[6]), v[7] * (1.f - m[7]));
            *(u32x4*)drow = o;
            u32x4 p; p.x = pk2(v[0] * 0.5f * m[0], v[1] * 0.5f * m[1]); p.y = pk2(v[2] * 0.5f * m[2], v[3] * 0.5f * m[3]);
            p.z = pk2(v[4] * 0.5f * m[4], v[5] * 0.5f * m[5]); p.w = pk2(v[6] * 0.5f * m[6], v[7] * 0.5f * m[7]);
            *(u32x4*)(drow + 1024) = p;
        }
    }
    LDS_WAIT(); asm volatile("" ::: "memory");
}
__device__ __forceinline__ void tr_job_item(const float* W, int ldw, int N, bf16_t* dst, int ldd, int drow_base, bool il, const float* mu, int item, LAS float* scr, int lane) {
    const int nblk = N / 32, kb = item / nblk, nb = item % nblk, n0 = 32 * nb;
    const int dr = drow_base + (il ? ((n0 >> 7) * 256 + (n0 & 127)) : n0);
    tr_item(W, ldw, 64 * kb, n0, dst, ldd, dr, mu, scr, lane);
}

__device__ __forceinline__ void p0_prologue(const Frame& F, const Args& A) {
    unsigned char* ws = A.ws;
    LAS float* scr = (LAS float*)(F.lds + F.wave * 16384);
    bf16_t* WRKV = (bf16_t*)(ws + WS_WRKV); bf16_t* WL = (bf16_t*)(ws + WS_WL); bf16_t* G2 = (bf16_t*)(ws + WS_G2);
    bf16_t* WO = (bf16_t*)(ws + WS_WO); bf16_t* WIN = (bf16_t*)(ws + WS_WIN); bf16_t* WOUT = (bf16_t*)(ws + WS_WOUT);
    const float* mu = A.in[I_MU];
    constexpr int NIT = 3 * 512 + 4 * 32 + 64 + 64 + 512 + 3 * 512 + 512;
    for (int it = F.gw; it < NIT; it += F.NGW) {
        int r = it;
        if (r < 1536) { const int p = r / 512; tr_job_item(A.in[I_WRKV] + (size_t)p * D * D, D, D, WRKV, 2048, p * 1024, false, nullptr, r % 512, scr, F.lane); continue; } r -= 1536;
        if (r < 64) { const int dir = r / 32; tr_job_item(A.in[I_W1] + (size_t)dir * D * 64, 64, 64, WL, 2048, dir * 64, false, mu + 3 * D, r % 32, scr, F.lane); continue; } r -= 64;
        if (r < 64) { const int dir = r / 32; tr_job_item(A.in[I_A1] + (size_t)dir * D * 64, 64, 64, WL, 2048, 128 + dir * 64, false, mu + 4 * D, r % 32, scr, F.lane); continue; } r -= 64;
        if (r < 64) { tr_job_item(A.in[I_G1], 128, 128, WL, 2048, 256, false, mu + 5 * D, r, scr, F.lane); continue; } r -= 64;
        if (r < 64) { tr_job_item(A.in[I_G2], D, D, G2, 256, 0, false, nullptr, r, scr, F.lane); continue; } r -= 64;
        if (r < 512) { tr_job_item(A.in[I_WO], D, D, WO, D, 0, false, nullptr, r, scr, F.lane); continue; } r -= 512;
        if (r < 512) { tr_job_item(A.in[I_WIN], 3 * D, D, WIN, D, 0, false, nullptr, r, scr, F.lane); continue; } r -= 512;
        if (r < 512) { tr_job_item(A.in[I_WIN] + D, 3 * D, D, WIN, D, 1024, true, nullptr, r, scr, F.lane); continue; } r -= 512;
        if (r < 512) { tr_job_item(A.in[I_WIN] + 2 * D, 3 * D, D, WIN, D, 1024 + 128, true, nullptr, r, scr, F.lane); continue; } r -= 512;
        tr_job_item(A.in[I_WOUT], D, D, WOUT, D, 0, false, nullptr, r, scr, F.lane);
    }
    {
        const int gt = F.vcu * NTHREADS + F.tid, NGT = F.G * NTHREADS;
        u32x4 z = (u32x4){0u, 0u, 0u, 0u};
        for (int i = gt; i < 32768; i += NGT) ((u32x4*)(WL + (size_t)384 * 2048))[i] = z;
        for (int i = gt; i < 16384; i += NGT) { const int row = i >> 4, q = i & 15; *(u32x4*)(G2 + (size_t)row * 256 + 128 + q * 8) = z; }
    }
    __syncthreads();
    {
        LAS float* st = (LAS float*)F.lds;
        LAS float* red = st + 9 * 1024;
        for (int i = F.tid; i < 9 * 1024; i += NTHREADS) { const float v = (i < 8192) ? A.in[I_C][i] : A.in[I_CCTX][i - 8192]; st[i] = v / (1.f + __expf(-v)); }
        __syncthreads();
        float* MOD = (float*)(ws + WS_MOD);
        for (int u = blockIdx.x; u < 256; u += F.G) {
            const int l = u >> 7, e0 = (u & 127) * 48;
            if (F.tid < 384) {
                const int q = F.tid % 12, dg = F.tid / 12;
                f32x4 acc[9];
#pragma unroll
                for (int r = 0; r < 9; ++r) acc[r] = (f32x4){0.f, 0.f, 0.f, 0.f};
                const float* wb = A.in[I_ADAW] + (size_t)l * D * 6144 + e0 + 4 * q;
#pragma unroll 4
                for (int i = 0; i < 32; ++i) { const int d = dg + 32 * i; const f32x4 w = *(const f32x4*)(wb + (size_t)d * 6144);
#pragma unroll
                    for (int r = 0; r < 9; ++r) acc[r] += st[r * 1024 + d] * w; }
#pragma unroll
                for (int r = 0; r < 9; ++r) *(LAS f32x4*)(red + (dg * 9 + r) * 48 + 4 * q) = acc[r];
            }
            __syncthreads();
            if (F.tid < 432) { const int r = F.tid / 48, ci = F.tid % 48; float s = A.in[I_ADAB][l * 6144 + e0 + ci];
                for (int dg = 0; dg < 32; ++dg) s += red[(dg * 9 + r) * 48 + ci];
                MOD[((size_t)l * 9 + r) * 6144 + e0 + ci] = s; }
            __syncthreads();
        }
    }
}

__device__ __forceinline__ void p1_load_norm(const float* row, const f32x4 (&gsc)[4], const f32x4 (&sh)[4], f32x4 (&o)[4], int lane) {
    const f32x4* xr = (const f32x4*)row + lane; float s = 0.f;
#pragma unroll
    for (int j = 0; j < 4; ++j) { o[j] = xr[64 * j]; s += (o[j].x * o[j].x + o[j].y * o[j].y) + (o[j].z * o[j].z + o[j].w * o[j].w); }
    const float rstd = rsqrtf(wave_sum(s) * (1.f / D) + RMS_EPS);
#pragma unroll
    for (int j = 0; j < 4; ++j) o[j] = o[j] * rstd * gsc[j] + sh[j];
}
__device__ __forceinline__ void st_bf4(bf16_t* p, const f32x4 v) { u32x2 w; w.x = pk2(v.x, v.y); w.y = pk2(v.z, v.w); *(u32x2*)p = w; }

__device__ __forceinline__ void p1_mix(const Frame& F, const Args& A) {
    const float* MOD = (const float*)(A.ws + WS_MOD);
    bf16_t* XM = (bf16_t*)(A.ws + WS_XM);
    const float* mu = A.in[I_MU]; const float* ng = A.in[I_NORMG];
    for (int u = F.gw; u < 2176; u += F.NGW) {
        const bool isctx = u >= 2048; int t0, rowlen, modrow; const float* src; size_t orow0;
        if (!isctx) { t0 = u * 16; rowlen = GRIDW; modrow = t0 / TL; src = A.in[I_X] + (size_t)t0 * D; orow0 = t0; }
        else { t0 = (u - 2048) * 16; rowlen = TCX; modrow = 8; src = A.in[I_CTX] + (size_t)t0 * D; orow0 = (size_t)ML + t0; }
        const int pos0 = t0 % rowlen;
        const float* mrow = MOD + (size_t)modrow * 6144;
        f32x4 gsc[4], sh[4], m0[4], m1[4], m2[4];
#pragma unroll
        for (int j = 0; j < 4; ++j) { const int c = 4 * F.lane + 256 * j;
            const f32x4 g = *(const f32x4*)(ng + c), sc = *(const f32x4*)(mrow + 1024 + c);
            gsc[j] = g * (1.f + sc); sh[j] = *(const f32x4*)(mrow + c);
            m0[j] = *(const f32x4*)(mu + c); m1[j] = *(const f32x4*)(mu + D + c); m2[j] = *(const f32x4*)(mu + 2 * D + c); }
        f32x4 prev[4], cur[4], nxt[4];
        if (pos0 > 0) p1_load_norm(src - D, gsc, sh, prev, F.lane);
        else {
#pragma unroll
            for (int j = 0; j < 4; ++j) prev[j] = (f32x4){0.f, 0.f, 0.f, 0.f}; }
        p1_load_norm(src, gsc, sh, cur, F.lane);
        for (int i = 0; i < 16; ++i) {
            if (pos0 + i + 1 < rowlen) p1_load_norm(src + (size_t)(i + 1) * D, gsc, sh, nxt, F.lane);
            else {
#pragma unroll
                for (int j = 0; j < 4; ++j) nxt[j] = (f32x4){0.f, 0.f, 0.f, 0.f}; }
            bf16_t* orow = XM + (orow0 + i) * XM_LD + 4 * F.lane;
#pragma unroll
            for (int j = 0; j < 4; ++j) {
                const f32x4 s = prev[j] + nxt[j], xx = 0.5f * s - cur[j];
                st_bf4(orow + 256 * j, cur[j] + xx * m0[j]);
                st_bf4(orow + D + 256 * j, cur[j] + xx * m1[j]);
                st_bf4(orow + 2 * D + 256 * j, cur[j] + xx * m2[j]);
                st_bf4(orow + 3 * D + 256 * j, cur[j]);
                st_bf4(orow + 4 * D + 256 * j, s);
                prev[j] = cur[j]; cur[j] = nxt[j];
            }
        }
    }
}

struct SchedRKV {
    const char* xm; const char* w; int G, c;
    __device__ __forceinline__ bool next(int i, pg8::Unit& u) const {
        const int L = i * G + c; if (L >= 1600) return false;
        if (L < 1536) pg8::swz_tile(L, 128, 12, u.pm, u.pn); else { const int r = L - 1536; u.pm = 128 + (r >> 3); u.pn = 4 + (r & 7); }
        u.a = xm + (size_t)u.pm * 256 * XM_LD * 2 + (size_t)(u.pn >> 2) * D * 2; u.b = w + (size_t)u.pn * 256 * 2048 * 2; u.nt = 16; return true;
    }
};
struct EpiRKV {
    static constexpr bool PERM = true;
    bf16_t *R, *K, *KC, *V;
    __device__ __forceinline__ void operator()(const f32x4 (&acc)[2][2][4][2], const pg8::Unit& u, int wr, int wc, int fr, int fq) const {
        const int grp = u.pn >> 2; int prow = u.pm * 256; bf16_t* base;
        if (grp == 0) base = R; else if (grp == 1) { if (u.pm < 128) base = K; else { base = KC; prow -= ML; } } else base = V;
        const int row0 = prow + wr * 64 + fr, col0 = (u.pn & 3) * 256 + wc * 32 + 8 * fq;
#pragma unroll
        for (int ai = 0; ai < 2; ++ai)
#pragma unroll
            for (int m = 0; m < 4; ++m) { bf16_t* rowp = base + (size_t)(row0 + ai * 128 + m * 16) * D + col0;
#pragma unroll
                for (int bj = 0; bj < 2; ++bj) { const f32x4 v0 = acc[ai][bj][m][0], v1 = acc[ai][bj][m][1];
                    u32x4 w; w.x = pg8::cvt_pk_bf16(v0[0], v0[1]); w.y = pg8::cvt_pk_bf16(v0[2], v0[3]); w.z = pg8::cvt_pk_bf16(v1[0], v1[1]); w.w = pg8::cvt_pk_bf16(v1[2], v1[3]);
                    *(u32x4*)(rowp + bj * 128) = w; } }
    }
};
struct SchedLora {
    const char* xm; const char* w; int G, c;
    __device__ __forceinline__ bool next(int i, pg8::Unit& u) const {
        const int L = i * G + c; if (L >= 272) return false;
        u.pm = L >> 1; u.pn = L & 1;
        u.a = xm + (size_t)u.pm * 256 * XM_LD * 2 + (size_t)3 * D * 2; u.b = w + (size_t)u.pn * 256 * 2048 * 2; u.nt = 32; return true;
    }
};
struct EpiLora {
    static constexpr bool PERM = true;
    bf16_t *LWA, *LG;
    __device__ __forceinline__ void operator()(const f32x4 (&acc)[2][2][4][2], const pg8::Unit& u, int wr, int wc, int fr, int fq) const {
        bf16_t* base = u.pn ? LG : LWA;
        const int row0 = u.pm * 256 + wr * 64 + fr, col0 = wc * 32 + 8 * fq;
#pragma unroll
        for (int ai = 0; ai < 2; ++ai)
#pragma unroll
            for (int m = 0; m < 4; ++m) { bf16_t* rowp = base + (size_t)(row0 + ai * 128 + m * 16) * 256 + col0;
#pragma unroll
                for (int bj = 0; bj < 2; ++bj) { f32x4 v0 = acc[ai][bj][m][0], v1 = acc[ai][bj][m][1];
                    if (bj == 0) {
                        if (u.pn == 0) {
#pragma unroll
                            for (int q = 0; q < 4; ++q) { v0[q] = 1.f - 2.f / (__expf(2.f * v0[q]) + 1.f); v1[q] = 1.f - 2.f / (__expf(2.f * v1[q]) + 1.f); }
                        } else {
#pragma unroll
                            for (int q = 0; q < 4; ++q) { v0[q] = sigmoidf_(v0[q]); v1[q] = sigmoidf_(v1[q]); }
                        }
                    } else if (u.pn == 1) { v0 = (f32x4){0.f, 0.f, 0.f, 0.f}; v1 = v0; }
                    u32x4 w; w.x = pg8::cvt_pk_bf16(v0[0], v0[1]); w.y = pg8::cvt_pk_bf16(v0[2], v0[3]); w.z = pg8::cvt_pk_bf16(v1[0], v1[1]); w.w = pg8::cvt_pk_bf16(v1[2], v1[3]);
                    *(u32x4*)(rowp + bj * 128) = w; } }
    }
};
struct SchedPlain {
    const char* a; const char* b; int nM, nN, lda, ldb, nt, G, c;
    __device__ __forceinline__ bool next(int i, pg8::Unit& u) const {
        const int L = i * G + c; if (L >= nM * nN) return false;
        pg8::swz_tile(L, nM, nN, u.pm, u.pn);
        u.a = a + (size_t)u.pm * 256 * lda * 2; u.b = b + (size_t)u.pn * 256 * ldb * 2; u.nt = nt; return true;
    }
};
struct EpiBf16 {
    static constexpr bool PERM = true;
    bf16_t* O; int ldc;
    __device__ __forceinline__ void operator()(const f32x4 (&acc)[2][2][4][2], const pg8::Unit& u, int wr, int wc, int fr, int fq) const {
        const int row0 = u.pm * 256 + wr * 64 + fr, col0 = u.pn * 256 + wc * 32 + 8 * fq;
#pragma unroll
        for (int ai = 0; ai < 2; ++ai)
#pragma unroll
            for (int m = 0; m < 4; ++m) { bf16_t* rowp = O + (size_t)(row0 + ai * 128 + m * 16) * ldc + col0;
#pragma unroll
                for (int bj = 0; bj < 2; ++bj) { const f32x4 v0 = acc[ai][bj][m][0], v1 = acc[ai][bj][m][1];
                    u32x4 w; w.x = pg8::cvt_pk_bf16(v0[0], v0[1]); w.y = pg8::cvt_pk_bf16(v0[2], v0[3]); w.z = pg8::cvt_pk_bf16(v1[0], v1[1]); w.w = pg8::cvt_pk_bf16(v1[2], v1[3]);
                    *(u32x4*)(rowp + bj * 128) = w; } }
    }
};
struct EpiRes {
    static constexpr bool PERM = false;
    const float* base; float* out; const float* gate;
    __device__ __forceinline__ void operator()(const f32x4 (&acc)[2][2][4][2], const pg8::Unit& u, int wr, int wc, int fr, int fq) const {
        const int row0 = u.pm * 256 + wr * 64 + fr, col0 = u.pn * 256 + wc * 32 + 4 * fq;
        const float* gp = gate + (size_t)(u.pm >> 4) * 6144 + col0;
        f32x4 gv[2][2];
#pragma unroll
        for (int bj = 0; bj < 2; ++bj)
#pragma unroll
            for (int n = 0; n < 2; ++n) gv[bj][n] = *(const f32x4*)(gp + bj * 128 + n * 16);
#pragma unroll
        for (int ai = 0; ai < 2; ++ai)
#pragma unroll
            for (int m = 0; m < 4; ++m) { const size_t ro = (size_t)(row0 + ai * 128 + m * 16) * D + col0;
#pragma unroll
                for (int bj = 0; bj < 2; ++bj)
#pragma unroll
                    for (int n = 0; n < 2; ++n) { const f32x4 b = *(const f32x4*)(base + ro + bj * 128 + n * 16);
                        *(f32x4*)(out + ro + bj * 128 + n * 16) = b + gv[bj][n] * acc[ai][bj][m][n]; } }
    }
};
struct SchedMoe {
    const char* a; const char* b; const int* tile; int lda, ldb, nt, G, c; size_t estride;
    __device__ __forceinline__ bool next(int i, pg8::Unit& u) const {
        const int ntl = tile[0]; const int L = i * G + c; if (L >= ntl * 4) return false;
        u.pm = L >> 2; u.pn = L & 3; const int e = tile[16 + u.pm];
        u.a = a + (size_t)u.pm * 256 * lda * 2; u.b = b + (size_t)e * estride + (size_t)u.pn * 256 * ldb * 2; u.nt = nt; return true;
    }
};
struct EpiGateUp {
    static constexpr bool PERM = true;
    bf16_t* H;
    __device__ __forceinline__ void operator()(const f32x4 (&acc)[2][2][4][2], const pg8::Unit& u, int wr, int wc, int fr, int fq) const {
        const int row0 = u.pm * 256 + wr * 64 + fr, col0 = u.pn * 128 + wc * 32 + 8 * fq;
#pragma unroll
        for (int ai = 0; ai < 2; ++ai)
#pragma unroll
            for (int m = 0; m < 4; ++m) { bf16_t* rowp = H + (size_t)(row0 + ai * 128 + m * 16) * ED + col0;
                f32x4 h0, h1;
#pragma unroll
                for (int q = 0; q < 4; ++q) { const float g0 = acc[ai][0][m][0][q], g1 = acc[ai][0][m][1][q];
                    h0[q] = g0 / (1.f + __expf(-g0)) * acc[ai][1][m][0][q]; h1[q] = g1 / (1.f + __expf(-g1)) * acc[ai][1][m][1][q]; }
                u32x4 w; w.x = pg8::cvt_pk_bf16(h0[0], h0[1]); w.y = pg8::cvt_pk_bf16(h0[2], h0[3]); w.z = pg8::cvt_pk_bf16(h1[0], h1[1]); w.w = pg8::cvt_pk_bf16(h1[2], h1[3]);
                *(u32x4*)rowp = w; }
    }
};
struct EpiWin {
    static constexpr bool PERM = true;
    bf16_t *BG, *U;
    __device__ __forceinline__ void operator()(const f32x4 (&acc)[2][2][4][2], const pg8::Unit& u, int wr, int wc, int fr, int fq) const {
        const int row0 = u.pm * 256 + wr * 64 + fr;
        if (u.pn < 4) {
            const int col0 = u.pn * 256 + wc * 32 + 8 * fq;
#pragma unroll
            for (int ai = 0; ai < 2; ++ai)
#pragma unroll
                for (int m = 0; m < 4; ++m) { bf16_t* rowp = BG + (size_t)(row0 + ai * 128 + m * 16) * D + col0;
#pragma unroll
                    for (int bj = 0; bj < 2; ++bj) { const f32x4 v0 = acc[ai][bj][m][0], v1 = acc[ai][bj][m][1];
                        u32x4 w; w.x = pg8::cvt_pk_bf16(v0[0], v0[1]); w.y = pg8::cvt_pk_bf16(v0[2], v0[3]); w.z = pg8::cvt_pk_bf16(v1[0], v1[1]); w.w = pg8::cvt_pk_bf16(v1[2], v1[3]);
                        *(u32x4*)(rowp + bj * 128) = w; } }
        } else {
            const int col0 = (u.pn - 4) * 128 + wc * 32 + 8 * fq;
#pragma unroll
            for (int ai = 0; ai < 2; ++ai)
#pragma unroll
                for (int m = 0; m < 4; ++m) { bf16_t* rowp = U + (size_t)(row0 + ai * 128 + m * 16) * D + col0;
                    const f32x4 v0 = acc[ai][0][m][0] * acc[ai][1][m][0], v1 = acc[ai][0][m][1] * acc[ai][1][m][1];
                    u32x4 w; w.x = pg8::cvt_pk_bf16(v0[0], v0[1]); w.y = pg8::cvt_pk_bf16(v0[2], v0[3]); w.z = pg8::cvt_pk_bf16(v1[0], v1[1]); w.w = pg8::cvt_pk_bf16(v1[2], v1[3]);
                    *(u32x4*)rowp = w; }
        }
    }
};

namespace sc {
constexpr int MPB = 144;
constexpr int MB = 64 * MPB;
constexpr int B_RAWK = 0, B_NAB = 0, B_RAWR = 1, B_NAK = 1, B_LW = 2, B_MRB = 2, B_LA = 3, B_MRK = 3, B_AT = 4, B_TT = 4, B_BT = 5, B_TA = 5, B_KT = 6, B_PS = 6,
              B_RT = 7, B_ATT = 8, B_BBT = 9, B_KBT = 10, B_VTT = 11, B_T = 12;
constexpr int B_W2T = 13, B_A2T = 14;
constexpr int O_INVN = 15 * MB, O_BONP = O_INVN + 256, O_PV = O_BONP + 1024;
static_assert(O_PV + 256 <= LDSCTL_OFF, "scan LDS");
__device__ __forceinline__ bf16x8 ldf(const LAS unsigned char* p) { return *(const LAS bf16x8*)p; }
__device__ __forceinline__ bf16x8 ldfp(const LAS unsigned char* p) {
    const u32x2 lo = *(const LAS u32x2*)p, hi = *(const LAS u32x2*)(p + 32);
    return __builtin_bit_cast(bf16x8, (u32x4){lo.x, lo.y, hi.x, hi.y});
}
__device__ __forceinline__ bf16x8 packfrag(const f32x4 x0, const f32x4 x1) {
    return __builtin_bit_cast(bf16x8, (u32x4){pg8::cvt_pk_bf16(x0[0], x0[1]), pg8::cvt_pk_bf16(x0[2], x0[3]), pg8::cvt_pk_bf16(x1[0], x1[1]), pg8::cvt_pk_bf16(x1[2], x1[3])});
}
__device__ __forceinline__ void st4(LAS unsigned char* p, const f32x4 d) { *(LAS u32x2*)p = (u32x2){pg8::cvt_pk_bf16(d[0], d[1]), pg8::cvt_pk_bf16(d[2], d[3])}; }
__device__ __forceinline__ f32x4 mma(const bf16x8 a, const bf16x8 b, const f32x4 c) { return __builtin_amdgcn_mfma_f32_16x16x32_bf16(a, b, c, 0, 0, 0); }
__device__ __forceinline__ float ld1(const LAS unsigned char* p) { return __builtin_bit_cast(float, (unsigned)(*(const LAS unsigned short*)p) << 16); }
__device__ __forceinline__ void st1(LAS unsigned char* p, float v) { *(LAS unsigned short*)p = (unsigned short)f2bf(v); }
}

__device__ __forceinline__ void p3_scan(const Frame& F, const Args& A) {
    using namespace sc;
    unsigned char* ws = A.ws;
    LAS unsigned char* L = F.lds;
    const bf16_t* Rg = (const bf16_t*)A.out; const bf16_t* Kg = Rg + (size_t)ML * D;
    const bf16_t* KCg = (const bf16_t*)(ws + WS_KC); const bf16_t* Vg = (const bf16_t*)(ws + WS_V); const bf16_t* LWAg = (const bf16_t*)(ws + WS_LWA);
    const int wv = F.wave;
    const f32x4 z4 = (f32x4){0.f, 0.f, 0.f, 0.f};
    for (int s = blockIdx.x; s < 256; s += F.G) {
        const int dir = s & 1, h = (s >> 1) & 15, b = s >> 5, c0 = h * HD;
        bf16_t* Yg = (bf16_t*)(ws + (dir ? WS_Y1 : WS_Y0));
        __syncthreads();
        for (int q = F.tid; q < MB / 16; q += NTHREADS) ((LAS u32x4*)(L + B_T * MB))[q] = (u32x4){0u, 0u, 0u, 0u};
        for (int q = F.tid; q < 4096; q += NTHREADS) { const int j = q >> 6, c = q & 63;
            sc::st1(L + B_W2T * MB + c * MPB + j * 2, A.in[I_W2][((size_t)dir * 64 + j) * D + c0 + c]); sc::st1(L + B_A2T * MB + c * MPB + j * 2, A.in[I_A2][((size_t)dir * 64 + j) * D + c0 + c]); }
        const int ce = c0 + 16 * (wv & 3) + (F.lane & 15);
        const float w0c = A.in[I_W0][dir * D + ce], a0c = A.in[I_A0][dir * D + ce], kkc = A.in[I_KK][ce], kac = A.in[I_KA][ce], rkc = A.in[I_RK][ce];
        f32x4 S[4];
#pragma unroll
        for (int q = 0; q < 4; ++q) S[q] = z4;
        u32x4 pk_, pr_, pv_, plw_, pla_;
#define SCAN_PREFETCH(gc_, ti_, cg_) do { const int seg_ = (gc_) >= 4, ci_ = seg_ ? (gc_) - 4 : (gc_), Ts_ = seg_ ? TL : TCX; const int tl_ = ci_ * 64 + (ti_), t_ = dir ? (Ts_ - 1 - tl_) : tl_; \
            const size_t arow_ = seg_ ? ((size_t)b * TL + t_) : ((size_t)ML + (size_t)b * TCX + t_); \
            const bf16_t* krow_ = seg_ ? (Kg + ((size_t)b * TL + t_) * D) : (KCg + ((size_t)b * TCX + t_) * D); \
            pk_ = *(const u32x4*)(krow_ + c0 + 8 * (cg_)); pv_ = *(const u32x4*)(Vg + arow_ * D + c0 + 8 * (cg_)); \
            pr_ = (u32x4){0u, 0u, 0u, 0u}; if (seg_) pr_ = *(const u32x4*)(Rg + ((size_t)b * TL + t_) * D + c0 + 8 * (cg_)); \
            plw_ = *(const u32x4*)(LWAg + arow_ * 256 + dir * 64 + 8 * (cg_)); pla_ = *(const u32x4*)(LWAg + arow_ * 256 + 128 + dir * 64 + 8 * (cg_)); } while (0)
        SCAN_PREFETCH(0, (F.tid >> 3), (F.tid & 7));
        __syncthreads();
#pragma unroll 1
        for (int gc = 0; gc < 68; ++gc) {
            const int seg = gc >= 4, ci = seg ? gc - 4 : gc, Tseg = seg ? TL : TCX;
            int tz = F.tid; asm volatile("" : "+v"(tz));
            const int lane = tz & 63, r = lane & 15, g = lane >> 4, ti_ = tz >> 3, cg = tz & 7;
            const int o16 = r * MPB + g * 16;
            const int o8 = r * MPB + g * 8;
            const int oE = g * (4 * MPB) + r * 2;
            {
                LAS unsigned char* st = L + ti_ * MPB + cg * 16;
                *(LAS u32x4*)(st + B_RAWK * MB) = pk_; *(LAS u32x4*)(st + B_RAWR * MB) = pr_; *(LAS u32x4*)(st + B_LW * MB) = plw_; *(LAS u32x4*)(st + B_LA * MB) = pla_;
                const unsigned vw[4] = {pv_.x, pv_.y, pv_.z, pv_.w}, kw[4] = {pk_.x, pk_.y, pk_.z, pk_.w};
                LAS unsigned char* vt = L + B_VTT * MB + cg * (8 * MPB) + ti_ * 2;
                float ss = 0.f;
#pragma unroll
                for (int q = 0; q < 4; ++q) {
                    *(LAS unsigned short*)(vt + (2 * q) * MPB) = (unsigned short)(vw[q] & 0xffffu);
                    *(LAS unsigned short*)(vt + (2 * q + 1) * MPB) = (unsigned short)(vw[q] >> 16);
                    const float k0 = bflo(kw[q]) * A.in[I_KK][c0 + 8 * cg + 2 * q], k1 = bfhi(kw[q]) * A.in[I_KK][c0 + 8 * cg + 2 * q + 1]; ss += k0 * k0 + k1 * k1; }
                ss += __shfl_xor(ss, 1); ss += __shfl_xor(ss, 2); ss += __shfl_xor(ss, 4);
                if (cg == 0) *(LAS float*)(L + O_INVN + ti_ * 4) = rsqrtf(fmaxf(ss, 1e-24f));
            }
            __syncthreads();
            if (gc + 1 < 68) SCAN_PREFETCH(gc + 1, ti_, cg);
            if (wv < 4) {
                const int ct = wv;
                f32x4 wacc[4], aacc[4];
                bf16x8 w2f[2], a2f[2];
#pragma unroll
                for (int ks = 0; ks < 2; ++ks) { w2f[ks] = ldf(L + B_W2T * MB + 16 * ct * MPB + 64 * ks + o16); a2f[ks] = ldf(L + B_A2T * MB + 16 * ct * MPB + 64 * ks + o16); }
#pragma unroll
                for (int t = 0; t < 4; ++t) { wacc[t] = z4; aacc[t] = z4;
#pragma unroll
                    for (int ks = 0; ks < 2; ++ks) { wacc[t] = mma(ldf(L + B_LW * MB + 16 * t * MPB + 64 * ks + o16), w2f[ks], wacc[t]); aacc[t] = mma(ldf(L + B_LA * MB + 16 * t * MPB + 64 * ks + o16), a2f[ks], aacc[t]); }
                    asm volatile("" : "+v"(wacc[t]), "+v"(aacc[t]) :: "memory"); }
                float carry = 0.f;
                float ev[16], Li[16];
#pragma unroll
                for (int t = 0; t < 4; ++t) {
#pragma unroll
                    for (int q = 0; q < 4; ++q) ev[4 * t + q] = 0.60653066f * sigmoidf_(wacc[t][q] + w0c);
                    const float p0 = ev[4 * t], p1 = p0 + ev[4 * t + 1], p2 = p1 + ev[4 * t + 2], p3 = p2 + ev[4 * t + 3];
                    const float t0 = __shfl(p3, r), t1 = __shfl(p3, r + 16), t2 = __shfl(p3, r + 32), t3 = __shfl(p3, r + 48);
                    const float offs = carry + (g > 0 ? t0 : 0.f) + (g > 1 ? t1 : 0.f) + (g > 2 ? t2 : 0.f);
                    Li[4 * t] = offs + p0; Li[4 * t + 1] = offs + p1; Li[4 * t + 2] = offs + p2; Li[4 * t + 3] = offs + p3;
                    carry += (t0 + t1) + (t2 + t3);
                }
                const float Pc = __expf(-carry);
                if (g == 0) *(LAS float*)(L + O_PV + (16 * ct + r) * 4) = Pc;
                LAS unsigned char* eb = L + oE + 32 * ct;
                LAS unsigned char* cb = L + o8 + 16 * ct * MPB;
#pragma unroll
                for (int t = 0; t < 4; ++t) {
                    const f32x4 inv4 = *(const LAS f32x4*)(L + O_INVN + 64 * t + g * 16);
                    f32x4 atv, bbv, kbv;
#pragma unroll
                    for (int q = 0; q < 4; ++q) {
                        const int idx = 4 * t + q, ro = (16 * t + q) * MPB;
                        const float kv = ld1(eb + B_RAWK * MB + ro), rv = ld1(eb + B_RAWR * MB + ro);
                        const float a = sigmoidf_(aacc[t][q] + a0c);
                        const float kkn = kv * kkc * inv4[q];
                        const float beta = kkn * a, kd = kv * (1.f + (a - 1.f) * kac);
                        const float em = __expf(-Li[idx]), ep = __builtin_amdgcn_rcpf(em), eex = __expf(ev[idx] - Li[idx]);
                        const float at = -kkn * eex, bt = beta * ep, kt = kd * ep, rt = rv * em;
                        atv[q] = at; bbv[q] = bt * Pc; kbv[q] = kt * Pc;
                        st1(eb + B_AT * MB + ro, at); st1(eb + B_BT * MB + ro, bt); st1(eb + B_KT * MB + ro, kt); st1(eb + B_RT * MB + ro, rt);
                        float bp = rv * kd * rkc;
                        bp += __shfl_xor(bp, 1); bp += __shfl_xor(bp, 2); bp += __shfl_xor(bp, 4); bp += __shfl_xor(bp, 8);
                        if (r == 0) *(LAS float*)(L + O_BONP + ct * 256 + (16 * t + q) * 4 + g * 16) = bp;
                    }
                    st4(cb + B_ATT * MB + 32 * t, atv); st4(cb + B_BBT * MB + 32 * t, bbv); st4(cb + B_KBT * MB + 32 * t, kbv);
                    asm volatile("" ::: "memory");
                }
            }
            __syncthreads();
            {
                const int m = wv >> 1, half = wv & 1;
                const LAS unsigned char* X = L + ((m & 1) ? B_KT : B_BT) * MB + o16; const LAS unsigned char* Z = L + (m < 2 ? B_AT : B_RT) * MB + o16;
                LAS unsigned char* O = L + m * MB + o8;
                const int strict = (m < 2) ? 1 : 0;
#pragma unroll
                for (int tq = 0; tq < 2; ++tq) {
                    const int ti = tq ? 3 - half : half;
                    const bf16x8 zf0 = ldf(Z + 16 * ti * MPB), zf1 = ldf(Z + 16 * ti * MPB + 64);
                    const int i = 16 * ti + r;
#pragma unroll
                    for (int ts = 0; ts < 4; ++ts) {
                        f32x4 d = z4;
                        if (ts <= ti) {
                            d = mma(ldf(X + 16 * ts * MPB), zf0, d); d = mma(ldf(X + 16 * ts * MPB + 64), zf1, d);
                            const int s0 = 16 * ts + 4 * g + strict;
#pragma unroll
                            for (int q = 0; q < 4; ++q) d[q] = (s0 + q <= i) ? d[q] : 0.f;
                        }
                        st4(O + 16 * ti * MPB + 32 * ts, d);
                    }
                    asm volatile("" ::: "memory");
                }
            }
            __syncthreads();
            f32x4 W2[4], Y[4], U[4]; bf16x8 vb[2], Sb[2];
            if (wv == 7) {
                const int oD = g * (16 * MPB + 32);
                float tc[16];
#pragma unroll
                for (int i = 0; i < 16; ++i) {
                    float acc = (i == r) ? 1.f : 0.f;
                    if (i > 0) {
                        const u32x4 n0 = *(const LAS u32x4*)(L + B_NAB * MB + oD + i * MPB), n1 = *(const LAS u32x4*)(L + B_NAB * MB + oD + i * MPB + 16);
                        const float nv[16] = {bflo(n0.x), bfhi(n0.x), bflo(n0.y), bfhi(n0.y), bflo(n0.z), bfhi(n0.z), bflo(n0.w), bfhi(n0.w),
                                              bflo(n1.x), bfhi(n1.x), bflo(n1.y), bfhi(n1.y), bflo(n1.z), bfhi(n1.z), bflo(n1.w), bfhi(n1.w)};
#pragma unroll
                        for (int s2 = 0; s2 < i; ++s2) acc += nv[s2] * tc[s2];
                    }
                    tc[i] = acc;
                    st1(L + B_T * MB + oD + i * MPB + r * 2, acc);
                }
                { u32x4 o0, o1; o0.x = pk2(tc[0], tc[1]); o0.y = pk2(tc[2], tc[3]); o0.z = pk2(tc[4], tc[5]); o0.w = pk2(tc[6], tc[7]);
                  o1.x = pk2(tc[8], tc[9]); o1.y = pk2(tc[10], tc[11]); o1.z = pk2(tc[12], tc[13]); o1.w = pk2(tc[14], tc[15]);
                  LAS unsigned char* tt = L + B_TT * MB + oD + r * MPB;
                  *(LAS u32x4*)tt = o0; *(LAS u32x4*)(tt + 16) = o1;
                  if (g == 1) { *(LAS u32x4*)(L + B_TT * MB + (16 + r) * MPB) = (u32x4){0u, 0u, 0u, 0u}; *(LAS u32x4*)(L + B_TT * MB + (16 + r) * MPB + 16) = (u32x4){0u, 0u, 0u, 0u}; } }
                LDS_WAIT(); asm volatile("" ::: "memory");
                const bf16x8 zf = __builtin_bit_cast(bf16x8, (u32x4){0u, 0u, 0u, 0u});
#pragma unroll
                for (int pr2 = 0; pr2 < 2; ++pr2) {
                    const int q0 = 2 * pr2, q1 = q0 + 1;
                    bf16x8 a = zf, bb = zf;
                    if (g < 2) { a = ldf(L + B_NAB * MB + 16 * q1 * MPB + 32 * q0 + o16); bb = ldf(L + B_TT * MB + 16 * q0 * MPB + 32 * q0 + o16); }
                    const f32x4 p1 = mma(a, bb, z4);
                    st4(L + B_PS * MB + 16 * pr2 * MPB + o8, p1);
                }
                LDS_WAIT(); asm volatile("" ::: "memory");
#pragma unroll
                for (int pr2 = 0; pr2 < 2; ++pr2) {
                    const int q0 = 2 * pr2, q1 = q0 + 1;
                    bf16x8 a = zf, bb = zf;
                    if (g < 2) { a = ldf(L + B_PS * MB + 16 * pr2 * MPB + o16); bb = ldf(L + B_T * MB + 16 * q1 * MPB + 32 * q1 + o16); }
                    const f32x4 t10 = mma(a, bb, z4);
                    st4(L + B_T * MB + 16 * q1 * MPB + 32 * q0 + o8, t10);
                    if (pr2 == 0) {
#pragma unroll
                        for (int qq = 0; qq < 4; ++qq) st1(L + B_TT * MB + oE + qq * MPB + 32, t10[qq]);
                    }
                }
                LDS_WAIT(); asm volatile("" ::: "memory");
#pragma unroll
                for (int ti = 0; ti < 2; ++ti)
#pragma unroll
                    for (int tj = 0; tj < 2; ++tj) {
                        const f32x4 p2 = mma(ldf(L + B_NAB * MB + (32 + 16 * ti) * MPB + o16), ldf(L + B_TT * MB + 16 * tj * MPB + o16), z4);
                        st4(L + B_PS * MB + (32 + 16 * tj) * MPB + 32 * ti + o8, p2);
                    }
                LDS_WAIT(); asm volatile("" ::: "memory");
#pragma unroll
                for (int ti = 0; ti < 2; ++ti)
#pragma unroll
                    for (int tj = 0; tj < 2; ++tj) {
                        const f32x4 tl = mma(ldf(L + B_PS * MB + (32 + 16 * tj) * MPB + o16), ldf(L + B_T * MB + (32 + 16 * ti) * MPB + 64 + o16), z4);
                        st4(L + B_T * MB + (32 + 16 * ti) * MPB + 32 * tj + o8, tl);
                    }
            } else if (wv < 4) {
                const int vs = wv;
                vb[0] = ldf(L + B_VTT * MB + 16 * vs * MPB + o16); vb[1] = ldf(L + B_VTT * MB + 16 * vs * MPB + 64 + o16);
                Sb[0] = packfrag(S[0], S[1]); Sb[1] = packfrag(S[2], S[3]);
#pragma unroll
                for (int t = 0; t < 4; ++t) {
                    f32x4 d = z4;
                    d = mma(ldf(L + B_NAK * MB + 16 * t * MPB + o16), vb[0], d); d = mma(ldf(L + B_NAK * MB + 16 * t * MPB + 64 + o16), vb[1], d); W2[t] = d;
                    const f32x4 p4 = *(const LAS f32x4*)(L + O_PV + 64 * t + g * 16);
                    f32x4 e2 = S[t] * p4;
                    e2 = mma(ldf(L + B_KBT * MB + 16 * t * MPB + o16), vb[0], e2); e2 = mma(ldf(L + B_KBT * MB + 16 * t * MPB + 64 + o16), vb[1], e2); S[t] = e2;
                    f32x4 y = z4;
                    if (seg) {
                        y = mma(ldf(L + B_MRK * MB + 16 * t * MPB + o16), vb[0], y); y = mma(ldf(L + B_MRK * MB + 16 * t * MPB + 64 + o16), vb[1], y);
                        y = mma(ldfp(L + B_RT * MB + 16 * t * MPB + o8), Sb[0], y); y = mma(ldfp(L + B_RT * MB + 16 * t * MPB + 64 + o8), Sb[1], y);
                    }
                    Y[t] = y;
                    asm volatile("" : "+v"(W2[t]), "+v"(S[t]), "+v"(Y[t]) :: "memory");
                }
            }
            __syncthreads();
            if (wv >= 4) {
                const int ti = wv - 4;
                const bf16x8 tb0 = ldf(L + B_T * MB + 16 * ti * MPB + o16), tb1 = ldf(L + B_T * MB + 16 * ti * MPB + 64 + o16);
#pragma unroll
                for (int tk = 0; tk < 4; ++tk) {
                    f32x4 d = z4;
                    d = mma(ldf(L + B_ATT * MB + 16 * tk * MPB + o16), tb0, d); d = mma(ldf(L + B_ATT * MB + 16 * tk * MPB + 64 + o16), tb1, d);
                    st4(L + B_TA * MB + 16 * ti * MPB + 32 * tk + o8, d);
                }
            } else {
                const bf16x8 w0 = packfrag(W2[0], W2[1]), w1 = packfrag(W2[2], W2[3]);
#pragma unroll
                for (int t = 0; t < 4; ++t) { f32x4 d = z4;
                    d = mma(ldfp(L + B_T * MB + 16 * t * MPB + o8), w0, d); d = mma(ldfp(L + B_T * MB + 16 * t * MPB + 64 + o8), w1, d); U[t] = d; asm volatile("" : "+v"(U[t]) :: "memory"); }
            }
            __syncthreads();
            if (wv < 4) {
                const int vs = wv;
#pragma unroll
                for (int t = 0; t < 4; ++t) { U[t] = mma(ldfp(L + B_TA * MB + 16 * t * MPB + o8), Sb[0], U[t]); U[t] = mma(ldfp(L + B_TA * MB + 16 * t * MPB + 64 + o8), Sb[1], U[t]); asm volatile("" : "+v"(U[t]) :: "memory"); }
                const bf16x8 u0 = packfrag(U[0], U[1]), u1 = packfrag(U[2], U[3]);
#pragma unroll
                for (int t = 0; t < 4; ++t) {
                    S[t] = mma(ldfp(L + B_BBT * MB + 16 * t * MPB + o8), u0, S[t]); S[t] = mma(ldfp(L + B_BBT * MB + 16 * t * MPB + 64 + o8), u1, S[t]);
                    asm volatile("" : "+v"(S[t]) :: "memory");
                }
                if (seg) {
                    const int vcol = c0 + 16 * vs + r;
#pragma unroll
                    for (int t = 0; t < 4; ++t) {
                        f32x4 y = Y[t];
                        y = mma(ldfp(L + B_MRB * MB + 16 * t * MPB + o8), u0, y); y = mma(ldfp(L + B_MRB * MB + 16 * t * MPB + 64 + o8), u1, y);
                        const LAS float* bp = (const LAS float*)(L + O_BONP + 64 * t + g * 16);
                        const f32x4 bon = (*(const LAS f32x4*)bp + *(const LAS f32x4*)(bp + 64)) + (*(const LAS f32x4*)(bp + 128) + *(const LAS f32x4*)(bp + 192));
                        const u32x2 vv = *(const LAS u32x2*)(L + B_VTT * MB + 16 * vs * MPB + 32 * t + o8);
                        y[0] += bon[0] * bflo(vv.x); y[1] += bon[1] * bfhi(vv.x); y[2] += bon[2] * bflo(vv.y); y[3] += bon[3] * bfhi(vv.y);
#pragma unroll
                        for (int q = 0; q < 4; ++q) { const int tl = ci * 64 + 16 * t + 4 * g + q, tt = dir ? (Tseg - 1 - tl) : tl;
                            Yg[((size_t)b * TL + tt) * D + vcol] = (bf16_t)f2bf(y[q]); }
                        asm volatile("" ::: "memory");
                    }
                }
            }
            __syncthreads();
        }
#undef SCAN_PREFETCH
    }
    __syncthreads();
}

__device__ __forceinline__ void p4_readout(const Frame& F, const Args& A) {
    unsigned char* ws = A.ws;
    {
        LAS float* scr = (LAS float*)(F.lds + F.wave * 16384);
        constexpr int NIT = 2 * 16 * 3 * 256;
        for (int it = F.gw; it < NIT; it += F.NGW) {
            const int mat = it >> 8, item = it & 255;
            const int kind = mat % 3, le = mat / 3, l = le >> 4, e = le & 15;
            unsigned char* mw = ws + (l ? WS_MOEW1 : WS_MOEW0);
            if (kind == 0) tr_job_item(A.in[I_MGATE] + (size_t)le * D * ED, ED, ED, (bf16_t*)mw, D, e * 1024, true, nullptr, item, scr, F.lane);
            else if (kind == 1) tr_job_item(A.in[I_MUP] + (size_t)le * D * ED, ED, ED, (bf16_t*)mw, D, e * 1024 + 128, true, nullptr, item, scr, F.lane);
            else tr_job_item(A.in[I_MDOWN] + (size_t)le * ED * D, D, D, (bf16_t*)(mw + 32 * MiB), ED, e * 1024, false, nullptr, item, scr, F.lane);
        }
    }
    const bf16_t* Y0 = (const bf16_t*)(ws + WS_Y0); const bf16_t* Y1 = (const bf16_t*)(ws + WS_Y1); const bf16_t* Gt = (const bf16_t*)(ws + WS_G);
    bf16_t* ZO = (bf16_t*)(ws + WS_ZO);
    float gw_[16], gb_[16];
#pragma unroll
    for (int j = 0; j < 2; ++j)
#pragma unroll
        for (int q = 0; q < 8; ++q) { const int c = 8 * F.lane + 512 * j + q; gw_[j * 8 + q] = A.in[I_GNW][c]; gb_[j * 8 + q] = A.in[I_GNB][c]; }
    for (int t = F.gw; t < ML; t += F.NGW) {
#pragma unroll
        for (int j = 0; j < 2; ++j) {
            const size_t off = (size_t)t * D + 8 * F.lane + 512 * j;
            const u32x4 a = *(const u32x4*)(Y0 + off), b = *(const u32x4*)(Y1 + off), g = *(const u32x4*)(Gt + off);
            float y[8] = {bflo(a.x) + bflo(b.x), bfhi(a.x) + bfhi(b.x), bflo(a.y) + bflo(b.y), bfhi(a.y) + bfhi(b.y), bflo(a.z) + bflo(b.z), bfhi(a.z) + bfhi(b.z), bflo(a.w) + bflo(b.w), bfhi(a.w) + bfhi(b.w)};
            float gg[8] = {bflo(g.x), bfhi(g.x), bflo(g.y), bfhi(g.y), bflo(g.z), bfhi(g.z), bflo(g.w), bfhi(g.w)};
            float s = 0.f;
#pragma unroll
            for (int q = 0; q < 8; ++q) s += y[q];
            s += __shfl_xor(s, 1); s += __shfl_xor(s, 2); s += __shfl_xor(s, 4);
            const float mean = s * (1.f / 64.f); float s2 = 0.f;
#pragma unroll
            for (int q = 0; q < 8; ++q) { y[q] -= mean; s2 += y[q] * y[q]; }
            s2 += __shfl_xor(s2, 1); s2 += __shfl_xor(s2, 2); s2 += __shfl_xor(s2, 4);
            const float rstd = rsqrtf(s2 * (1.f / 64.f) + GN_EPS);
            float z[8];
#pragma unroll
            for (int q = 0; q < 8; ++q) z[q] = (y[q] * rstd * gw_[j * 8 + q] + gb_[j * 8 + q]) * gg[q];
            u32x4 w; w.x = pk2(z[0], z[1]); w.y = pk2(z[2], z[3]); w.z = pk2(z[4], z[5]); w.w = pk2(z[6], z[7]);
            *(u32x4*)(ZO + off) = w;
        }
    }
}

__device__ __forceinline__ void p6_route(const Frame& F, const Args& A, const int layer) {
    unsigned char* ws = A.ws;
    LAS float* RW = (LAS float*)F.lds;
    __syncthreads();
    for (int i = F.tid; i < D * NE; i += NTHREADS) { const int d = i >> 4, e = i & 15; const int j = d >> 8, l = (d & 255) >> 2, jj = d & 3, dj = j * 4 + jj;
        RW[((dj * 4 + (e >> 2)) * 64 + l) * 4 + (e & 3)] = A.in[I_ROUTW][i]; }
    __syncthreads();
    const float* MOD = (const float*)(ws + WS_MOD) + (size_t)layer * 9 * 6144;
    const float* ng = A.in[I_NORMG] + (size_t)(layer * 2 + 1) * D;
    const float* h = A.out;
    bf16_t* XN = (bf16_t*)(ws + WS_XN);
    unsigned* EIDX = (unsigned*)(ws + WS_EIDX); float* GATE = (float*)(ws + WS_GATE); int* CC = (int*)(ws + WS_CC);
    float rb[16];
#pragma unroll
    for (int e = 0; e < 16; ++e) rb[e] = A.in[I_ROUTB][e];
    for (int ch = F.gw; ch < 2048; ch += F.NGW) {
        const int t0 = ch * 16, b = t0 / TL;
        const float* mrow = MOD + (size_t)b * 6144;
        f32x4 gsc[4], sh[4];
#pragma unroll
        for (int j = 0; j < 4; ++j) { const int c = 4 * F.lane + 256 * j; gsc[j] = *(const f32x4*)(ng + c) * (1.f + *(const f32x4*)(mrow + 4096 + c)); sh[j] = *(const f32x4*)(mrow + 3072 + c); }
        int cnt = 0;
        for (int i = 0; i < 16; ++i) {
            const int t = t0 + i;
            f32x4 v[4];
            p1_load_norm(h + (size_t)t * D, gsc, sh, v, F.lane);
            bf16_t* orow = XN + (size_t)t * D + 4 * F.lane;
#pragma unroll
            for (int j = 0; j < 4; ++j) st_bf4(orow + 256 * j, v[j]);
            float lg[16];
#pragma unroll
            for (int e = 0; e < 16; ++e) lg[e] = 0.f;
#pragma unroll
            for (int j = 0; j < 4; ++j)
#pragma unroll
                for (int jj = 0; jj < 4; ++jj) { const float xv = v[j][jj]; const int dj = j * 4 + jj;
#pragma unroll
                    for (int q = 0; q < 4; ++q) { const f32x4 w = *(const LAS f32x4*)(RW + ((dj * 4 + q) * 64 + F.lane) * 4);
                        lg[4 * q] += xv * w.x; lg[4 * q + 1] += xv * w.y; lg[4 * q + 2] += xv * w.z; lg[4 * q + 3] += xv * w.w; }
                    asm volatile("" : "+v"(lg[0]), "+v"(lg[1]), "+v"(lg[2]), "+v"(lg[3]), "+v"(lg[4]), "+v"(lg[5]), "+v"(lg[6]), "+v"(lg[7]),
                                      "+v"(lg[8]), "+v"(lg[9]), "+v"(lg[10]), "+v"(lg[11]), "+v"(lg[12]), "+v"(lg[13]), "+v"(lg[14]), "+v"(lg[15]) :: "memory"); }
#pragma unroll
            for (int e = 0; e < 16; ++e) lg[e] = wave_sum(lg[e]);
            float best = -3.0e38f; int be0 = 0, be1 = 1; float bs0 = 0.f, bs1 = 0.f;
#pragma unroll
            for (int g = 0; g < 4; ++g) {
                float s[4], sel[4];
#pragma unroll
                for (int q = 0; q < 4; ++q) { s[q] = 1.f / (1.f + expf(-lg[4 * g + q])); sel[q] = s[q] + rb[4 * g + q]; }
                int i1 = 0; float v1 = sel[0], s1 = s[0];
#pragma unroll
                for (int q = 1; q < 4; ++q) if (sel[q] > v1) { i1 = q; v1 = sel[q]; s1 = s[q]; }
                int i2 = -1; float v2 = -3.0e38f, s2 = 0.f;
#pragma unroll
                for (int q = 0; q < 4; ++q) if (q != i1 && sel[q] > v2) { i2 = q; v2 = sel[q]; s2 = s[q]; }
                const float gs = v1 + v2;
                if (gs > best) { best = gs; be0 = 4 * g + i1; be1 = 4 * g + i2; bs0 = s1; bs1 = s2; }
            }
            const float inv = 1.f / (bs0 + bs1);
            if (F.lane == 0) { EIDX[t] = (unsigned)be0 | ((unsigned)be1 << 8); GATE[2 * t] = bs0 * inv; GATE[2 * t + 1] = bs1 * inv; }
            cnt += (F.lane == be0) + (F.lane == be1);
        }
        if (F.lane < 16) CC[ch * 16 + F.lane] = cnt;
    }
    __syncthreads();
}

__device__ __forceinline__ void p7_permute(const Frame& F, const Args& A) {
    unsigned char* ws = A.ws;
    LAS int* cc = (LAS int*)F.lds;
    LAS int* ps = (LAS int*)(F.lds + LDS_X_OFF);
    LAS int* seg = ps + 512;
    const int* CC = (const int*)(ws + WS_CC);
    const unsigned* EIDX = (const unsigned*)(ws + WS_EIDX); int* POS = (int*)(ws + WS_POS); int* TILE = (int*)(ws + WS_TILE);
    const bf16_t* XN = (const bf16_t*)(ws + WS_XN); bf16_t* XP = (bf16_t*)(ws + WS_XP);
    __syncthreads();
    for (int i = F.tid; i < 2048 * 16 / 4; i += NTHREADS) ((LAS u32x4*)cc)[i] = ((const u32x4*)CC)[i];
    __syncthreads();
    { const int e = F.tid & 15, part = F.tid >> 4; int s = 0; for (int q = 0; q < 64; ++q) s += cc[(part * 64 + q) * 16 + e]; ps[part * 16 + e] = s; }
    __syncthreads();
    if (F.tid < 16) { int run = 0; for (int p = 0; p < 32; ++p) { const int v = ps[p * 16 + F.tid]; ps[p * 16 + F.tid] = run; run += v; } seg[F.tid] = run; }
    __syncthreads();
    if (F.tid == 0) { int off = 0, nt = 0;
        for (int e = 0; e < 16; ++e) { const int tot = seg[e]; seg[e] = off; const int tl = (tot + 255) >> 8;
            if (blockIdx.x == 0) for (int q = 0; q < tl; ++q) TILE[16 + nt + q] = e;
            nt += tl; off += tl * 256; }
        if (blockIdx.x == 0) TILE[0] = nt; }
    __syncthreads();
    for (int ch = F.gw; ch < 2048; ch += F.NGW) {
        int base = 0;
        if (F.lane < 16) { base = seg[F.lane] + ps[(ch >> 6) * 16 + F.lane]; for (int q = (ch & ~63); q < ch; ++q) base += cc[q * 16 + F.lane]; }
        for (int i = 0; i < 16; ++i) {
            const int t = ch * 16 + i; const unsigned ei = EIDX[t]; const int e0 = ei & 255, e1 = (ei >> 8) & 255;
            const int p0 = __shfl(base, e0); base += (F.lane == e0);
            const int p1 = __shfl(base, e1); base += (F.lane == e1);
            if (F.lane == 0) { POS[2 * t] = p0; POS[2 * t + 1] = p1; }
            const u32x4* src = (const u32x4*)(XN + (size_t)t * D) + F.lane;
            const u32x4 a = src[0], b = src[64];
            u32x4* d0 = (u32x4*)(XP + (size_t)p0 * D) + F.lane; u32x4* d1 = (u32x4*)(XP + (size_t)p1 * D) + F.lane;
            d0[0] = a; d0[64] = b; d1[0] = a; d1[64] = b;
        }
    }
    __syncthreads();
}

template <bool FINAL>
__device__ __forceinline__ void p10_combine(const Frame& F, const Args& A, const int layer) {
    unsigned char* ws = A.ws;
    const float* MOD = (const float*)(ws + WS_MOD);
    const bf16_t* O = (const bf16_t*)(ws + WS_XP); const int* POS = (const int*)(ws + WS_POS); const float* GATE = (const float*)(ws + WS_GATE);
    bf16_t* XN = (bf16_t*)(ws + WS_XN);
    float* h = A.out;
    for (int ch = F.gw; ch < 2048; ch += F.NGW) {
        const int t0 = ch * 16, b = t0 / TL;
        const float* mcur = MOD + ((size_t)layer * 9 + b) * 6144;
        f32x4 gt2[4], gsc[4], sh[4];
#pragma unroll
        for (int j = 0; j < 4; ++j) { const int c = 4 * F.lane + 256 * j; gt2[j] = *(const f32x4*)(mcur + 5120 + c);
            if (FINAL) { gsc[j] = *(const f32x4*)(A.in[I_FINALG] + c); sh[j] = (f32x4){0.f, 0.f, 0.f, 0.f}; }
            else { const float* mn = MOD + ((size_t)9 + b) * 6144; gsc[j] = *(const f32x4*)(A.in[I_NORMG] + 2 * D + c) * (1.f + *(const f32x4*)(mn + 1024 + c)); sh[j] = *(const f32x4*)(mn + c); } }
        for (int i = 0; i < 16; ++i) {
            const int t = t0 + i; const int p0 = POS[2 * t], p1 = POS[2 * t + 1]; const float w0 = GATE[2 * t], w1 = GATE[2 * t + 1];
            f32x4 v[4]; float s = 0.f;
#pragma unroll
            for (int j = 0; j < 4; ++j) { const int c = 4 * F.lane + 256 * j;
                const u32x2 oa = *(const u32x2*)(O + (size_t)p0 * D + c), ob = *(const u32x2*)(O + (size_t)p1 * D + c);
                const f32x4 m = w0 * (f32x4){bflo(oa.x), bfhi(oa.x), bflo(oa.y), bfhi(oa.y)} + w1 * (f32x4){bflo(ob.x), bfhi(ob.x), bflo(ob.y), bfhi(ob.y)};
                v[j] = *(const f32x4*)(h + (size_t)t * D + c) + gt2[j] * m;
                s += (v[j].x * v[j].x + v[j].y * v[j].y) + (v[j].z * v[j].z + v[j].w * v[j].w); }
            const float rstd = rsqrtf(wave_sum(s) * (1.f / D) + RMS_EPS);
            if (FINAL) {
#pragma unroll
                for (int j = 0; j < 4; ++j) *(f32x4*)(h + (size_t)t * D + 4 * F.lane + 256 * j) = v[j] * rstd * gsc[j];
            } else {
#pragma unroll
                for (int j = 0; j < 4; ++j) { *(f32x4*)(h + (size_t)t * D + 4 * F.lane + 256 * j) = v[j]; st_bf4(XN + (size_t)t * D + 4 * F.lane + 256 * j, v[j] * rstd * gsc[j] + sh[j]); }
            }
        }
    }
}

__device__ __forceinline__ void ld_bf16row(const bf16_t* row, float (&o)[16], int lane) {
#pragma unroll
    for (int j = 0; j < 2; ++j) { const u32x4 a = *(const u32x4*)(row + 8 * lane + 512 * j);
        o[8 * j] = bflo(a.x); o[8 * j + 1] = bfhi(a.x); o[8 * j + 2] = bflo(a.y); o[8 * j + 3] = bfhi(a.y); o[8 * j + 4] = bflo(a.z); o[8 * j + 5] = bfhi(a.z); o[8 * j + 6] = bflo(a.w); o[8 * j + 7] = bfhi(a.w); }
}
__device__ __forceinline__ void p12_conv(const Frame& F, const Args& A) {
    unsigned char* ws = A.ws;
    const bf16_t* BG = (const bf16_t*)(ws + WS_BG); const bf16_t* U = (const bf16_t*)(ws + WS_U); bf16_t* Z = (bf16_t*)(ws + WS_Z);
    float c0[16], c1[16], c2[16];
#pragma unroll
    for (int j = 0; j < 2; ++j)
#pragma unroll
        for (int q = 0; q < 8; ++q) { const int c = 8 * F.lane + 512 * j + q; c0[8 * j + q] = A.in[I_CONV][c]; c1[8 * j + q] = A.in[I_CONV][D + c]; c2[8 * j + q] = A.in[I_CONV][2 * D + c]; }
    for (int u = F.gw; u < 2048; u += F.NGW) {
        const int t0 = u * 16, pos0 = t0 % GRIDW;
        float prev[16], cur[16], nxt[16], bg[16];
        if (pos0 > 0) ld_bf16row(U + (size_t)(t0 - 1) * D, prev, F.lane);
        else {
#pragma unroll
            for (int q = 0; q < 16; ++q) prev[q] = 0.f; }
        ld_bf16row(U + (size_t)t0 * D, cur, F.lane);
        for (int i = 0; i < 16; ++i) {
            if (pos0 + i + 1 < GRIDW) ld_bf16row(U + (size_t)(t0 + i + 1) * D, nxt, F.lane);
            else {
#pragma unroll
                for (int q = 0; q < 16; ++q) nxt[q] = 0.f; }
            ld_bf16row(BG + (size_t)(t0 + i) * D, bg, F.lane);
            float z[16];
#pragma unroll
            for (int q = 0; q < 16; ++q) { z[q] = bg[q] * (c0[q] * prev[q] + c1[q] * cur[q] + c2[q] * nxt[q]); prev[q] = cur[q]; cur[q] = nxt[q]; }
#pragma unroll
            for (int j = 0; j < 2; ++j) { u32x4 w; w.x = pk2(z[8 * j], z[8 * j + 1]); w.y = pk2(z[8 * j + 2], z[8 * j + 3]); w.z = pk2(z[8 * j + 4], z[8 * j + 5]); w.w = pk2(z[8 * j + 6], z[8 * j + 7]);
                *(u32x4*)(Z + (size_t)(t0 + i) * D + 8 * F.lane + 512 * j) = w; }
        }
    }
}

constexpr int N_PHASES = 20;
__global__ void __launch_bounds__(NTHREADS, 2) fwd(Args args) {
    extern __shared__ __attribute__((aligned(16))) unsigned char lds_raw[];
    Frame F;
    F.lds = (LAS unsigned char*)lds_raw;
    F.tid = threadIdx.x; F.lane = F.tid & 63; F.wave = __builtin_amdgcn_readfirstlane(F.tid >> 6);
    F.G = gridDim.x; { const int bx = blockIdx.x; F.vcu = (F.G % 8 == 0) ? (bx % 8) * (F.G / 8) + bx / 8 : bx; }
    F.gw = F.vcu * NWAVES + F.wave; F.NGW = F.G * NWAVES;
    unsigned char* ws = args.ws;
    for (int u = F.tid; u < (LDS_BYTES - LDSCTL_OFF) / 4; u += NTHREADS) ((LAS unsigned*)(F.lds + LDSCTL_OFF))[u] = 0u;
    __syncthreads();
    volatile LAS unsigned* MISC = (volatile LAS unsigned*)(F.lds + MISC_OFF);
    XcdBarrier bar; bar.bar = (unsigned*)(ws + WS_CTL) + CW_BAR; bar.x = 0; bar.st = nullptr;
    const int lo = args.ph_lo, hi = args.ph_hi;
    if (hi - lo > 1) bar = xcd_barrier_post((unsigned*)(ws + WS_CTL) + CW_BAR, MISC + 8);
#ifndef PH_MASK
#define PH_MASK 0xFFFFFu
#endif
#define IN(k) (((PH_MASK >> (k)) & 1u) && lo <= (k) && (k) < hi)
#define SEAM(k) do { if (IN(k) && IN((k) + 1)) xcd_barrier(bar); } while (0)
    const float* MOD = (const float*)(ws + WS_MOD);
    const int bx = (int)blockIdx.x;

    if (IN(0)) { p0_prologue(F, args); SEAM(0); }
    if (IN(1)) { p1_mix(F, args); SEAM(1); }
    if (IN(2)) {
        { SchedRKV S{(const char*)(ws + WS_XM), (const char*)(ws + WS_WRKV), F.G, bx};
          EpiRKV E{(bf16_t*)args.out, (bf16_t*)args.out + (size_t)ML * D, (bf16_t*)(ws + WS_KC), (bf16_t*)(ws + WS_V)};
          pg8::gemm_phase<EpiRKV, SchedRKV>(F.lds, XM_LD, 2048, S, E); }
        { SchedLora S{(const char*)(ws + WS_XM), (const char*)(ws + WS_WL), F.G, (bx + F.G / 2) % F.G};
          EpiLora E{(bf16_t*)(ws + WS_LWA), (bf16_t*)(ws + WS_LG)};
          pg8::gemm_phase<EpiLora, SchedLora>(F.lds, XM_LD, 2048, S, E); }
        SEAM(2);
    }
    if (IN(3)) {
        SchedPlain S{(const char*)(ws + WS_LG), (const char*)(ws + WS_G2), 128, 4, 256, 256, 4, F.G, bx};
        EpiBf16 E{(bf16_t*)(ws + WS_G), D};
        pg8::gemm_phase<EpiBf16, SchedPlain>(F.lds, 256, 256, S, E);
        SEAM(3);
    }
    if (IN(4)) { p3_scan(F, args); SEAM(4); }
    if (IN(5)) { p4_readout(F, args); SEAM(5); }
    if (IN(6)) {
        SchedPlain S{(const char*)(ws + WS_ZO), (const char*)(ws + WS_WO), 128, 4, D, D, 16, F.G, bx};
        EpiRes E{args.in[I_X], args.out, MOD + 2048};
        pg8::gemm_phase<EpiRes, SchedPlain>(F.lds, D, D, S, E);
        SEAM(6);
    }
    if (IN(7)) { p6_route(F, args, 0); SEAM(7); }
    if (IN(8)) { p7_permute(F, args); SEAM(8); }
    if (IN(9)) {
        SchedMoe S{(const char*)(ws + WS_XP), (const char*)(ws + WS_MOEW0), (const int*)(ws + WS_TILE), D, D, 16, F.G, bx, (size_t)2 * MiB};
        EpiGateUp E{(bf16_t*)(ws + WS_H)};
        pg8::gemm_phase<EpiGateUp, SchedMoe>(F.lds, D, D, S, E);
        SEAM(9);
    }
    if (IN(10)) {
        SchedMoe S{(const char*)(ws + WS_H), (const char*)(ws + WS_MOEW0 + 32 * MiB), (const int*)(ws + WS_TILE), ED, ED, 8, F.G, bx, (size_t)1 * MiB};
        EpiBf16 E{(bf16_t*)(ws + WS_XP), D};
        pg8::gemm_phase<EpiBf16, SchedMoe>(F.lds, ED, ED, S, E);
        SEAM(10);
    }
    if (IN(11)) { p10_combine<false>(F, args, 0); SEAM(11); }
    if (IN(12)) {
        SchedPlain S{(const char*)(ws + WS_XN), (const char*)(ws + WS_WIN), 128, 12, D, D, 16, F.G, bx};
        EpiWin E{(bf16_t*)(ws + WS_BG), (bf16_t*)(ws + WS_U)};
        pg8::gemm_phase<EpiWin, SchedPlain>(F.lds, D, D, S, E);
        SEAM(12);
    }
    if (IN(13)) { p12_conv(F, args); SEAM(13); }
    if (IN(14)) {
        SchedPlain S{(const char*)(ws + WS_Z), (const char*)(ws + WS_WOUT), 128, 4, D, D, 16, F.G, bx};
        EpiRes E{args.out, args.out, MOD + 9 * 6144 + 2048};
        pg8::gemm_phase<EpiRes, SchedPlain>(F.lds, D, D, S, E);
        SEAM(14);
    }
    if (IN(15)) { p6_route(F, args, 1); SEAM(15); }
    if (IN(16)) { p7_permute(F, args); SEAM(16); }
    if (IN(17)) {
        SchedMoe S{(const char*)(ws + WS_XP), (const char*)(ws + WS_MOEW1), (const int*)(ws + WS_TILE), D, D, 16, F.G, bx, (size_t)2 * MiB};
        EpiGateUp E{(bf16_t*)(ws + WS_H)};
        pg8::gemm_phase<EpiGateUp, SchedMoe>(F.lds, D, D, S, E);
        SEAM(17);
    }
    if (IN(18)) {
        SchedMoe S{(const char*)(ws + WS_H), (const char*)(ws + WS_MOEW1 + 32 * MiB), (const int*)(ws + WS_TILE), ED, ED, 8, F.G, bx, (size_t)1 * MiB};
        EpiBf16 E{(bf16_t*)(ws + WS_XP), D};
        pg8::gemm_phase<EpiBf16, SchedMoe>(F.lds, ED, ED, S, E);
        SEAM(18);
    }
    if (IN(19)) { p10_combine<true>(F, args, 1); }
}

extern "C" void kernel_launch(void* const* d_in, const int* in_sizes, int n_in, void* d_out, int out_size, void* d_ws, size_t ws_size, hipStream_t stream) {
    static int grid = 0;
    if (grid == 0) {
        if (n_in != 32 || out_size != ML * D || ws_size < WS_END) { fprintf(stderr, "kernel_launch: unexpected problem (n_in %d, out %d, ws %zu)\n", n_in, out_size, ws_size); grid = -1; return; }
        int dev = 0, cus = 0;
        if (hipGetDevice(&dev) != hipSuccess || hipDeviceGetAttribute(&cus, hipDeviceAttributeMultiprocessorCount, dev) != hipSuccess) { grid = -1; return; }
        if (hipFuncSetAttribute((const void*)fwd, hipFuncAttributeMaxDynamicSharedMemorySize, LDS_BYTES) != hipSuccess) { grid = -1; return; }
        int per_cu = 0;
        if (hipOccupancyMaxActiveBlocksPerMultiprocessor(&per_cu, (const void*)fwd, NTHREADS, LDS_BYTES) != hipSuccess || per_cu < 1) { fprintf(stderr, "kernel_launch: occupancy query says %d\n", per_cu); grid = -1; return; }
        grid = cus > 256 ? 256 : cus;
    }
    if (grid < 0) return;
    (void)in_sizes;
    hipMemsetAsync((char*)d_ws + WS_CTL, 0, CTL_ZERO_BYTES, stream);
    Args a{};
    for (int i = 0; i < 32; ++i) a.in[i] = (const float*)d_in[i];
    a.out = (float*)d_out; a.ws = (unsigned char*)d_ws;
#if MK_N_LAUNCHES == 1
    a.ph_lo = 0; a.ph_hi = N_PHASES;
    hipLaunchKernelGGL(fwd, dim3(grid), dim3(NTHREADS), LDS_BYTES, stream, a);
#else
    for (int k = 0; k < N_PHASES; ++k) { a.ph_lo = k; a.ph_hi = k + 1; hipLaunchKernelGGL(fwd, dim3(grid), dim3(NTHREADS), LDS_BYTES, stream, a); }
#endif
}
```

```cpp
#include <hip/hip_runtime.h>
#include <cstdio>
#include <cstdint>

#ifndef MK_N_LAUNCHES
#define MK_N_LAUNCHES 1
#endif

#define GAS __attribute__((address_space(1)))
#define LAS __attribute__((address_space(3)))
typedef unsigned short bf16_t;
typedef short bf16x8 __attribute__((ext_vector_type(8)));
typedef float f32x4 __attribute__((ext_vector_type(4)));
typedef float f32x2 __attribute__((ext_vector_type(2)));
typedef unsigned u32x4 __attribute__((ext_vector_type(4)));
typedef unsigned u32x2 __attribute__((ext_vector_type(2)));

constexpr int D = 1024, NBATCH = 8, TL = 4096, TCX = 256, ML = NBATCH * TL, MC = NBATCH * TCX, MA = ML + MC;
constexpr int NH = 16, HD = 64, NE = 16, ED = 512, GRIDW = 64;
constexpr int XM_LD = 5 * D;
constexpr int NWAVES = 8, NTHREADS = 512;
constexpr float RMS_EPS = 1e-6f, GN_EPS = 64e-5f;
constexpr int MAXTILES = 272;

constexpr size_t MiB = 1u << 20;
constexpr size_t WS_CTL = 0, CTL_ZERO_BYTES = 1 * MiB;
constexpr size_t WS_MOD = 1 * MiB;
constexpr size_t WS_EIDX = 2 * MiB;
constexpr size_t WS_GATE = WS_EIDX + 128 * 1024;
constexpr size_t WS_POS = WS_GATE + 256 * 1024;
constexpr size_t WS_CC = WS_POS + 256 * 1024;
constexpr size_t WS_TILE = WS_CC + 128 * 1024;
constexpr size_t WS_INV = WS_TILE + 4 * 1024;
static_assert(WS_INV + 69632 * 4 <= 4 * MiB, "ws map");
constexpr size_t WS_WRKV = 4 * MiB;
constexpr size_t WS_WL = 16 * MiB;
constexpr size_t WS_G2 = 18 * MiB;
constexpr size_t WS_WO = 19 * MiB;
constexpr size_t WS_WIN = 21 * MiB;
constexpr size_t WS_WOUT = 27 * MiB;
constexpr size_t WS_ACT = 32 * MiB;
constexpr size_t WS_XM = WS_ACT;
constexpr size_t WS_V = 372 * MiB;
constexpr size_t WS_KC = 440 * MiB;
constexpr size_t WS_LWA = 444 * MiB;
constexpr size_t WS_LG = 461 * MiB;
constexpr size_t WS_G = 32 * MiB;
constexpr size_t WS_Y0 = 96 * MiB, WS_Y1 = 160 * MiB;
constexpr size_t WS_ZO = 272 * MiB;
constexpr size_t WS_MOEW0 = 384 * MiB, WS_MOEW1 = 432 * MiB;
constexpr size_t WS_XN = 32 * MiB;
constexpr size_t WS_XP = 96 * MiB;
constexpr size_t WS_H = 232 * MiB;
constexpr size_t WS_BG = 232 * MiB, WS_U = 296 * MiB;
constexpr size_t WS_Z = 96 * MiB;
constexpr size_t WS_END = 480 * MiB;

constexpr int CW_BAR = 4096;

constexpr int RING_BYTES = 131072;
constexpr int LDS_BYTES = 147456;
constexpr int LDSCTL_OFF = LDS_BYTES - 512, MISC_OFF = LDSCTL_OFF + 64;
constexpr int LDS_X_OFF = RING_BYTES;

typedef __bf16 bf16x2v __attribute__((ext_vector_type(2)));
__device__ __forceinline__ unsigned pk2(float lo, float hi) { const f32x2 v = {lo, hi}; return __builtin_bit_cast(unsigned, __builtin_convertvector(v, bf16x2v)); }
__device__ __forceinline__ unsigned f2bf(float f) { return pk2(f, 0.f) & 0xffffu; }
__device__ __forceinline__ float bflo(unsigned u) { return __builtin_bit_cast(float, u << 16); }
__device__ __forceinline__ float bfhi(unsigned u) { return __builtin_bit_cast(float, u & 0xffff0000u); }
__device__ __forceinline__ float wave_sum(float v) {
#pragma unroll
    for (int o = 1; o < 64; o <<= 1) v += __shfl_xor(v, o);
    return v;
}
__device__ __forceinline__ float sigmoidf_(float x) { return 1.f / (1.f + __expf(-x)); }
#define LDS_WAIT() asm volatile("s_waitcnt lgkmcnt(0)" ::: "memory")

namespace pg8 {
constexpr int BM = 256, BK = 64, HALF = 128, HTB = HALF * BK * 2, STAGE_BYTES = 8 * HTB, NXCD = 8, WGM = 8;
__host__ __device__ __forceinline__ int lds_byte(int r, int c) { const int st = (r >> 4) * 2 + (c >> 5), rr = r & 15, cc = c & 31, ob = rr * 64 + cc * 2; return st * 1024 + (ob ^ (((ob >> 9) & 1) << 5)); }
__host__ __device__ __forceinline__ void stage_rc(int b, int& R, int& C) { const int st = b / 1024, sb = b % 1024, swz = sb ^ (((sb >> 9) & 1) << 5); R = (st >> 1) * 16 + swz / 64; C = (st & 1) * 32 + (swz % 64) / 2; }
__host__ __device__ __forceinline__ int perm32(int rho) { const int n = rho >> 4, i = rho & 15; return 8 * (i >> 2) + 4 * n + (i & 3); }

struct Unit { int pm, pn; const char* a; const char* b; int nt; const int* rows; };

__device__ __forceinline__ void swz_tile(int L, int nM, int nN, int& pm, int& pn) {
    const int nwg = nM * nN; int wgid = L;
    { const int q = nwg / NXCD, r = nwg % NXCD, xcd = wgid % NXCD, off = wgid / NXCD; wgid = (xcd < r ? xcd * (q + 1) : r * (q + 1) + (xcd - r) * q) + off; }
    const int nig = WGM * nN, gid = wgid / nig, fm = gid * WGM, gsz = (nM - fm) < WGM ? (nM - fm) : WGM;
    pm = fm + ((wgid % nig) % gsz); pn = (wgid % nig) / gsz;
}

__device__ __forceinline__ unsigned cvt_pk_bf16(float lo, float hi) { return pk2(lo, hi); }

template <class Epi, class Sched, bool GATHER = false, bool ALIGN_EPI = true, bool SP2 = true>
__device__ __forceinline__ void gemm_phase(LAS unsigned char* lds, const int lda, const int ldb, const Sched& S, const Epi& E) {
    const int tid = threadIdx.x, wid = __builtin_amdgcn_readfirstlane(tid >> 6), lane = tid & 63, wr = wid >> 2, wc = wid & 3, fr = lane & 15, fq = lane >> 4;
    unsigned vA[2][2], vN[2][2], voffB[2]; int gR[2], gC[2];
#pragma unroll
    for (int i = 0; i < 2; ++i) { int R, C; stage_rc(tid * 16 + i * 8192, R, C); const int Rb = Epi::PERM ? ((R & ~31) + perm32(R & 31)) : R;
        gR[i] = R; gC[i] = C * 2;
        vA[0][i] = (unsigned)(R * lda + C) * 2u; vA[1][i] = (unsigned)((R + HALF) * lda + C) * 2u; vN[0][i] = vA[0][i]; vN[1][i] = vA[1][i];
        voffB[i] = (unsigned)(Rb * ldb + C) * 2u; }
#define PG8_GATHER(dst, u) do { if constexpr (GATHER) { _Pragma("unroll") for (int _h = 0; _h < 2; ++_h) _Pragma("unroll") for (int _i = 0; _i < 2; ++_i) \
        dst[_h][_i] = (unsigned)(u).rows[gR[_i] + _h * HALF] * (unsigned)(lda * 2) + (unsigned)gC[_i]; } } while (0)
    const size_t kstep = (size_t)(BK * 2);
    const size_t hstepB = (size_t)HALF * ldb * 2;
    const unsigned ldsw = (unsigned)wid * 1024u;
    const int aoff = lds_byte(wr * 64 + fr, fq * 8), boff = lds_byte(wc * 32 + fr, fq * 8);
#define PG8_SA(b, h) (((b) * 2 + (h)) * HTB)
#define PG8_SB(b, h) ((4 + (b) * 2 + (h)) * HTB)
#define PG8_STAGE(bufoff, gbase, voff) do { _Pragma("unroll") for (int _i = 0; _i < 2; ++_i) \
        __builtin_amdgcn_global_load_lds((const unsigned*)((const char*)(gbase) + (voff)[_i]), (LAS unsigned*)(lds + (bufoff) + ldsw + _i * 8192), 16, 0, 0); } while (0)
#define PG8_LDA(dst, b, h) do { _Pragma("unroll") for (int m = 0; m < 4; ++m) _Pragma("unroll") for (int k = 0; k < 2; ++k) dst[m][k] = *(const LAS bf16x8*)(lds + PG8_SA(b, h) + aoff + m * 2048 + k * 1024); } while (0)
#define PG8_LDB(dst, b, h) do { _Pragma("unroll") for (int n = 0; n < 2; ++n) _Pragma("unroll") for (int k = 0; k < 2; ++k) dst[n][k] = *(const LAS bf16x8*)(lds + PG8_SB(b, h) + boff + n * 2048 + k * 1024); } while (0)
#define PG8_MMA(ai, bj, At, Bt) do { __builtin_amdgcn_s_setprio(1); _Pragma("unroll") for (int m = 0; m < 4; ++m) _Pragma("unroll") for (int n = 0; n < 2; ++n) _Pragma("unroll") for (int k = 0; k < 2; ++k) \
        acc[ai][bj][m][n] = __builtin_amdgcn_mfma_f32_16x16x32_bf16(Bt[n][k], At[m][k], acc[ai][bj][m][n], 0, 0, 0); __builtin_amdgcn_s_setprio(0); } while (0)
#define PG8_WAIT_V(n) asm volatile("s_waitcnt vmcnt(" #n ")" ::: "memory")
#define PG8_WAIT_L(n) asm volatile("s_waitcnt lgkmcnt(" #n ")" ::: "memory")
#define PG8_BAR __builtin_amdgcn_s_barrier()
#define PG8_SCHED __builtin_amdgcn_sched_barrier(0)
    Unit cur, nxt; int ui = 0;
    if (!S.next(0, cur)) return;
    f32x4 acc[2][2][4][2];
#pragma unroll
    for (int a = 0; a < 2; ++a)
#pragma unroll
        for (int b = 0; b < 2; ++b)
#pragma unroll
            for (int m = 0; m < 4; ++m)
#pragma unroll
                for (int n = 0; n < 2; ++n) acc[a][b][m][n] = (f32x4){0.f, 0.f, 0.f, 0.f};
    bf16x8 At[4][2], B0[2][2], B1[2][2];
    const char* cA = cur.a; const char* cB = cur.b;
    PG8_GATHER(vA, cur);
    if constexpr (SP2) {
        PG8_STAGE(PG8_SB(0, 0), cB, voffB); PG8_STAGE(PG8_SB(0, 1), cB + hstepB, voffB); PG8_STAGE(PG8_SA(0, 0), cA, vA[0]); PG8_STAGE(PG8_SA(0, 1), cA, vA[1]);
        if (wr == 1) PG8_BAR;
        PG8_WAIT_V(2); PG8_BAR;
        PG8_STAGE(PG8_SB(1, 0), cB + kstep, voffB); PG8_STAGE(PG8_SA(1, 0), cA + kstep, vA[0]); PG8_STAGE(PG8_SB(1, 1), cB + hstepB + kstep, voffB);
        PG8_WAIT_V(6); PG8_BAR;
    } else {
        PG8_STAGE(PG8_SB(0, 0), cB, voffB); PG8_STAGE(PG8_SA(0, 0), cA, vA[0]); PG8_STAGE(PG8_SB(0, 1), cB + hstepB, voffB); PG8_STAGE(PG8_SA(0, 1), cA, vA[1]);
        if (wr == 1) PG8_BAR;
        PG8_WAIT_V(4); PG8_BAR;
        PG8_STAGE(PG8_SB(1, 0), cB + kstep, voffB); PG8_STAGE(PG8_SA(1, 0), cA + kstep, vA[0]); PG8_STAGE(PG8_SB(1, 1), cB + hstepB + kstep, voffB);
        PG8_WAIT_V(6); PG8_BAR;
    }
    for (;;) {
        const bool has_next = S.next(ui + 1, nxt);
        const char* nA = has_next ? nxt.a : cA; const char* nB = has_next ? nxt.b : cB;
        if (has_next) PG8_GATHER(vN, nxt);
        const int nt = cur.nt;
        for (int t = 0; t < nt; t += 2) {
            const bool last = (t == nt - 2);
            const char* a1 = cA + (size_t)(t + 1) * kstep;
            const char* a2 = last ? nA : cA + (size_t)(t + 2) * kstep; const char* b2 = last ? nB : cB + (size_t)(t + 2) * kstep;
            const char* a3 = a2 + kstep; const char* b3 = b2 + kstep;
            unsigned vX[2][2];
#pragma unroll
            for (int _h = 0; _h < 2; ++_h)
#pragma unroll
                for (int _i = 0; _i < 2; ++_i) vX[_h][_i] = (GATHER && last) ? vN[_h][_i] : vA[_h][_i];
            if constexpr (SP2) {
            PG8_LDB(B0, 0, 0); PG8_LDB(B1, 0, 1); PG8_SCHED; PG8_LDA(At, 0, 0); PG8_STAGE(PG8_SA(1, 1), a1, vA[1]);
            PG8_WAIT_V(8); PG8_WAIT_L(0); PG8_BAR; PG8_MMA(0, 0, At, B0); PG8_MMA(0, 1, At, B1); PG8_BAR; PG8_SCHED;
            PG8_LDA(At, 0, 1); PG8_STAGE(PG8_SB(0, 0), b2, voffB); PG8_STAGE(PG8_SB(0, 1), b2 + hstepB, voffB); PG8_STAGE(PG8_SA(0, 0), a2, vX[0]);
            PG8_WAIT_V(8); PG8_WAIT_L(0); PG8_BAR; PG8_MMA(1, 0, At, B0); PG8_MMA(1, 1, At, B1); PG8_BAR; PG8_SCHED;
            PG8_LDB(B0, 1, 0); PG8_LDB(B1, 1, 1); PG8_SCHED; PG8_LDA(At, 1, 0); PG8_STAGE(PG8_SA(0, 1), a2, vX[1]);
            PG8_WAIT_V(8); PG8_WAIT_L(0); PG8_BAR; PG8_MMA(0, 0, At, B0); PG8_MMA(0, 1, At, B1); PG8_BAR; PG8_SCHED;
            PG8_LDA(At, 1, 1); PG8_STAGE(PG8_SB(1, 0), b3, voffB); PG8_STAGE(PG8_SB(1, 1), b3 + hstepB, voffB); PG8_STAGE(PG8_SA(1, 0), a3, vX[0]);
            PG8_WAIT_V(8); PG8_WAIT_L(0); PG8_BAR; PG8_MMA(1, 0, At, B0); PG8_MMA(1, 1, At, B1); PG8_BAR; PG8_SCHED;
            } else {
            PG8_LDB(B0, 0, 0); PG8_SCHED; PG8_LDA(At, 0, 0); PG8_STAGE(PG8_SA(1, 1), a1, vA[1]);
            PG8_WAIT_L(8); PG8_BAR; PG8_WAIT_L(0); PG8_MMA(0, 0, At, B0); PG8_BAR; PG8_SCHED;
            PG8_LDB(B1, 0, 1); PG8_STAGE(PG8_SB(0, 0), b2, voffB);
            PG8_BAR; PG8_WAIT_L(0); PG8_MMA(0, 1, At, B1); PG8_BAR;
            PG8_LDA(At, 0, 1); PG8_STAGE(PG8_SA(0, 0), a2, vX[0]);
            PG8_BAR; PG8_WAIT_L(0); PG8_MMA(1, 0, At, B0); PG8_BAR; PG8_SCHED;
            PG8_STAGE(PG8_SB(0, 1), b2 + hstepB, voffB);
            PG8_WAIT_V(6); PG8_BAR; PG8_MMA(1, 1, At, B1); PG8_BAR;
            PG8_LDB(B0, 1, 0); PG8_SCHED; PG8_LDA(At, 1, 0); PG8_STAGE(PG8_SA(0, 1), a2, vX[1]);
            PG8_WAIT_L(8); PG8_BAR; PG8_WAIT_L(0); PG8_MMA(0, 0, At, B0); PG8_BAR; PG8_SCHED;
            PG8_LDB(B1, 1, 1); PG8_STAGE(PG8_SB(1, 0), b3, voffB);
            PG8_BAR; PG8_WAIT_L(0); PG8_MMA(0, 1, At, B1); PG8_BAR;
            PG8_LDA(At, 1, 1); PG8_STAGE(PG8_SA(1, 0), a3, vX[0]);
            PG8_BAR; PG8_WAIT_L(0); PG8_MMA(1, 0, At, B0); PG8_BAR; PG8_SCHED;
            PG8_STAGE(PG8_SB(1, 1), b3 + hstepB, voffB);
            PG8_WAIT_V(6); PG8_BAR; PG8_MMA(1, 1, At, B1); PG8_BAR;
            }
        }
        if constexpr (ALIGN_EPI) { if (wr == 0) PG8_BAR; }
        E(acc, cur, wr, wc, fr, fq);
        if (!has_next) break;
#pragma unroll
        for (int a = 0; a < 2; ++a)
#pragma unroll
            for (int b = 0; b < 2; ++b)
#pragma unroll
                for (int m = 0; m < 4; ++m)
#pragma unroll
                    for (int n = 0; n < 2; ++n) acc[a][b][m][n] = (f32x4){0.f, 0.f, 0.f, 0.f};
        cur = nxt; cA = nA; cB = nB; ++ui;
        if constexpr (GATHER) {
#pragma unroll
            for (int _h = 0; _h < 2; ++_h)
#pragma unroll
                for (int _i = 0; _i < 2; ++_i) vA[_h][_i] = vN[_h][_i]; }
        if constexpr (ALIGN_EPI) { if (wr == 1) PG8_BAR; }
    }
    PG8_WAIT_V(0);
    if constexpr (!ALIGN_EPI) { if (wr == 0) PG8_BAR; }
    PG8_BAR;
#undef PG8_GATHER
#undef PG8_SA
#undef PG8_SB
#undef PG8_STAGE
#undef PG8_LDA
#undef PG8_LDB
#undef PG8_MMA
#undef PG8_WAIT_V
#undef PG8_WAIT_L
#undef PG8_BAR
#undef PG8_SCHED
}
}

#define XB_TMO      128
#define XB_XCNT(j)  (256  + 64 * (j))
#define XB_XSUB(j)  (1280 + 64 * (j))
#define XB_XGEN(j)  (2304 + 64 * (j))
#define XB_TOP      3328
#define XB_TOPGEN   3392
#define XCD_BAR_WORDS 3456
#define XB_SPIN_CAP (1u << 18)

__device__ __forceinline__ unsigned xb_ld(unsigned* p)              { return __hip_atomic_load(p, __ATOMIC_RELAXED, __HIP_MEMORY_SCOPE_AGENT); }
__device__ __forceinline__ unsigned xb_add(unsigned* p, unsigned v) { return __hip_atomic_fetch_add(p, v, __ATOMIC_RELAXED, __HIP_MEMORY_SCOPE_AGENT); }
__device__ __forceinline__ unsigned xb_xcc_id() { return (unsigned)__builtin_amdgcn_s_getreg((3 << 11) | 20) & 0xFu; }
#define XB_SPIN(cond, bar) do { unsigned _sp = 0; while (cond) { __builtin_amdgcn_s_sleep(1); \
    if ((++_sp & 255u) == 0u) { if (xb_ld(&(bar)[XB_TMO])) break; if (_sp > XB_SPIN_CAP) { atomicAdd(&(bar)[XB_TMO], 1u); break; } } } } while (0)

struct XcdBarrier { unsigned* bar; unsigned x; volatile LAS unsigned* st; };

__device__ __forceinline__ XcdBarrier xcd_barrier_post(unsigned* bar, volatile LAS unsigned* st) {
    XcdBarrier b; b.bar = bar; b.x = xb_xcc_id(); b.st = st;
    if (threadIdx.x == 0) (void)xb_add(&bar[XB_XCNT(b.x)], 1u);
    return b;
}
__device__ __forceinline__ void xcd_barrier_complete(unsigned* bar, unsigned x, unsigned& nloc, unsigned& nx) {
    const unsigned G = gridDim.x * gridDim.y * gridDim.z;
    unsigned sum, cnt, mine, sp = 0u;
    for (;;) {
        sum = 0u; cnt = 0u; mine = 0u;
#pragma unroll
        for (unsigned j = 0; j < 16; ++j) { const unsigned c = xb_ld(&bar[XB_XCNT(j)]); sum += c; cnt += (c > 0u) ? 1u : 0u; mine = (j == x) ? c : mine; }
        if (sum == G) break;
        __builtin_amdgcn_s_sleep(1);
        if ((++sp & 255u) == 0u) { if (xb_ld(&bar[XB_TMO])) break; if (sp > XB_SPIN_CAP) { atomicAdd(&bar[XB_TMO], 1u); break; } }
    }
    nloc = mine > 0u ? mine : 1u; nx = cnt > 0u ? cnt : 1u;
}
__device__ __forceinline__ void xcd_barrier(const XcdBarrier& b) {
    asm volatile("s_waitcnt vmcnt(0)" ::: "memory");
    __syncthreads();
    if (threadIdx.x == 0) {
        unsigned* bar = b.bar;
        __builtin_amdgcn_s_waitcnt(0);
        unsigned nloc = b.st[0], nx = b.st[1];
        if (nloc == 0u) { xcd_barrier_complete(bar, b.x, nloc, nx); b.st[0] = nloc; b.st[1] = nx; }
        const unsigned old = xb_add(&bar[XB_XSUB(b.x)], 1u);
        const unsigned gen = old / nloc;
        if (old + 1u == (gen + 1u) * nloc) {
            __builtin_amdgcn_fence(__ATOMIC_RELEASE, "agent");
            asm volatile("s_waitcnt vmcnt(0)" ::: "memory");
            const unsigned og = xb_add(&bar[XB_TOP], 1u);
            const unsigned tg = og / nx;
            if (og + 1u == (tg + 1u) * nx) xb_add(&bar[XB_TOPGEN], 1u);
            else XB_SPIN(xb_ld(&bar[XB_TOPGEN]) == tg, bar);
            __builtin_amdgcn_fence(__ATOMIC_ACQUIRE, "agent");
            xb_add(&bar[XB_XGEN(b.x)], 1u);
            asm volatile("s_waitcnt vmcnt(0)" ::: "memory");
        } else {
            XB_SPIN(xb_ld(&bar[XB_XGEN(b.x)]) == gen, bar);
            __builtin_amdgcn_fence(__ATOMIC_ACQUIRE, "agent");
            asm volatile("s_waitcnt vmcnt(0)" ::: "memory");
        }
    }
    __syncthreads();
}

struct Args { const float* in[32]; float* out; unsigned char* ws; int ph_lo, ph_hi; };
enum { I_X = 0, I_C, I_CTX, I_CCTX, I_ADAW, I_ADAB, I_NORMG, I_MU, I_WRKV, I_W0, I_W1, I_W2, I_A0, I_A1, I_A2, I_G1, I_G2, I_KK, I_KA, I_RK, I_GNW, I_GNB, I_WO,
       I_WIN, I_CONV, I_WOUT, I_ROUTW, I_ROUTB, I_MGATE, I_MUP, I_MDOWN, I_FINALG };

struct Frame {
    LAS unsigned char* lds;
    int tid, lane, wave, G, vcu, gw, NGW;
};


__device__ __forceinline__ void tr_item(const float* W, int ldw, int k0, int n0, bf16_t* dst, int ldd, int drow0, const float* mu, LAS float* scr, int lane) {
#pragma unroll 8
    for (int i = 0; i < 32; ++i) { const int kk = 2 * i + (lane >> 5); scr[kk * 33 + (lane & 31)] = W[(size_t)(k0 + kk) * ldw + n0 + (lane & 31)]; }
    LDS_WAIT(); asm volatile("" ::: "memory");
    const int c = lane & 7;
    float m[8];
#pragma unroll
    for (int q = 0; q < 8; ++q) m[q] = mu ? mu[k0 + 8 * c + q] : 0.f;
#pragma unroll
    for (int j = 0; j < 4; ++j) { const int n = (lane >> 3) + 8 * j; const LAS float* s = scr + (8 * c) * 33 + n;
        float v[8];
#pragma unroll
        for (int q = 0; q < 8; ++q) v[q] = s[q * 33];
        bf16_t* drow = dst + (size_t)(drow0 + n) * ldd + k0 + 8 * c;
        if (!mu) {
            u32x4 o; o.x = pk2(v[0], v[1]); o.y = pk2(v[2], v[3]); o.z = pk2(v[4], v[5]); o.w = pk2(v[6], v[7]);
            *(u32x4*)drow = o;
        } else {
            u32x4 o; o.x = pk2(v[0] * (1.f - m[0]), v[1] * (1.f - m[1])); o.y = pk2(v[2] * (1.f - m[2]), v[3] * (1.f - m[3]));
            o.z = pk2(v[4] * (1.f - m[4]), v[5] * (1.f - m[5])); o.w = pk2(v[6] * (1.f - m[6]), v[7] * (1.f - m[7]));
            *(u32x4*)drow = o;
            u32x4 p; p.x = pk2(v[0] * 0.5f * m[0], v[1] * 0.5f * m[1]); p.y = pk2(v[2] * 0.5f * m[2], v[3] * 0.5f * m[3]);
            p.z = pk2(v[4] * 0.5f * m[4], v[5] * 0.5f * m[5]); p.w = pk2(v[6] * 0.5f * m[6], v[7] * 0.5f * m[7]);
            *(u32x4*)(drow + 1024) = p;
        }
    }
    LDS_WAIT(); asm volatile("" ::: "memory");
}
__device__ __forceinline__ void tr_job_item(const float* W, int ldw, int N, bf16_t* dst, int ldd, int drow_base, bool il, const float* mu, int item, LAS float* scr, int lane) {
    const int nblk = N / 32, kb = item / nblk, nb = item % nblk, n0 = 32 * nb;
    const int dr = drow_base + (il ? ((n0 >> 7) * 256 + (n0 & 127)) : n0);
    tr_item(W, ldw, 64 * kb, n0, dst, ldd, dr, mu, scr, lane);
}

__device__ __forceinline__ void p0_prologue(const Frame& F, const Args& A) {
    unsigned char* ws = A.ws;
    LAS float* scr = (LAS float*)(F.lds + F.wave * 16384);
    bf16_t* WRKV = (bf16_t*)(ws + WS_WRKV); bf16_t* WL = (bf16_t*)(ws + WS_WL); bf16_t* G2 = (bf16_t*)(ws + WS_G2);
    bf16_t* WO = (bf16_t*)(ws + WS_WO); bf16_t* WIN = (bf16_t*)(ws + WS_WIN); bf16_t* WOUT = (bf16_t*)(ws + WS_WOUT);
    const float* mu = A.in[I_MU];
    constexpr int NIT = 3 * 512 + 4 * 32 + 64 + 64 + 512 + 3 * 512 + 512;
    for (int it = F.gw; it < NIT; it += F.NGW) {
        int r = it;
        if (r < 1536) { const int p = r / 512; tr_job_item(A.in[I_WRKV] + (size_t)p * D * D, D, D, WRKV, 2048, p * 1024, false, nullptr, r % 512, scr, F.lane); continue; } r -= 1536;
        if (r < 64) { const int dir = r / 32; tr_job_item(A.in[I_W1] + (size_t)dir * D * 64, 64, 64, WL, 2048, dir * 64, false, mu + 3 * D, r % 32, scr, F.lane); continue; } r -= 64;
        if (r < 64) { const int dir = r / 32; tr_job_item(A.in[I_A1] + (size_t)dir * D * 64, 64, 64, WL, 2048, 128 + dir * 64, false, mu + 4 * D, r % 32, scr, F.lane); continue; } r -= 64;
        if (r < 64) { tr_job_item(A.in[I_G1], 128, 128, WL, 2048, 256, false, mu + 5 * D, r, scr, F.lane); continue; } r -= 64;
        if (r < 64) { tr_job_item(A.in[I_G2], D, D, G2, 256, 0, false, nullptr, r, scr, F.lane); continue; } r -= 64;
        if (r < 512) { tr_job_item(A.in[I_WO], D, D, WO, D, 0, false, nullptr, r, scr, F.lane); continue; } r -= 512;
        if (r < 512) { tr_job_item(A.in[I_WIN], 3 * D, D, WIN, D, 0, false, nullptr, r, scr, F.lane); continue; } r -= 512;
        if (r < 512) { tr_job_item(A.in[I_WIN] + D, 3 * D, D, WIN, D, 1024, true, nullptr, r, scr, F.lane); continue; } r -= 512;
        if (r < 512) { tr_job_item(A.in[I_WIN] + 2 * D, 3 * D, D, WIN, D, 1024 + 128, true, nullptr, r, scr, F.lane); continue; } r -= 512;
        tr_job_item(A.in[I_WOUT], D, D, WOUT, D, 0, false, nullptr, r, scr, F.lane);
    }
    {
        const int gt = F.vcu * NTHREADS + F.tid, NGT = F.G * NTHREADS;
        u32x4 z = (u32x4){0u, 0u, 0u, 0u};
        for (int i = gt; i < 32768; i += NGT) ((u32x4*)(WL + (size_t)384 * 2048))[i] = z;
        for (int i = gt; i < 16384; i += NGT) { const int row = i >> 4, q = i & 15; *(u32x4*)(G2 + (size_t)row * 256 + 128 + q * 8) = z; }
    }
    __syncthreads();
    {
        LAS float* st = (LAS float*)F.lds;
        LAS float* red = st + 9 * 1024;
        for (int i = F.tid; i < 9 * 1024; i += NTHREADS) { const float v = (i < 8192) ? A.in[I_C][i] : A.in[I_CCTX][i - 8192]; st[i] = v / (1.f + __expf(-v)); }
        __syncthreads();
        float* MOD = (float*)(ws + WS_MOD);
        for (int u = blockIdx.x; u < 256; u += F.G) {
            const int l = u >> 7, e0 = (u & 127) * 48;
            if (F.tid < 384) {
                const int q = F.tid % 12, dg = F.tid / 12;
                f32x4 acc[9];
#pragma unroll
                for (int r = 0; r < 9; ++r) acc[r] = (f32x4){0.f, 0.f, 0.f, 0.f};
                const float* wb = A.in[I_ADAW] + (size_t)l * D * 6144 + e0 + 4 * q;
#pragma unroll 4
                for (int i = 0; i < 32; ++i) { const int d = dg + 32 * i; const f32x4 w = *(const f32x4*)(wb + (size_t)d * 6144);
#pragma unroll
                    for (int r = 0; r < 9; ++r) acc[r] += st[r * 1024 + d] * w; }
#pragma unroll
                for (int r = 0; r < 9; ++r) *(LAS f32x4*)(red + (dg * 9 + r) * 48 + 4 * q) = acc[r];
            }
            __syncthreads();
            if (F.tid < 432) { const int r = F.tid / 48, ci = F.tid % 48; float s = A.in[I_ADAB][l * 6144 + e0 + ci];
                for (int dg = 0; dg < 32; ++dg) s += red[(dg * 9 + r) * 48 + ci];
                MOD[((size_t)l * 9 + r) * 6144 + e0 + ci] = s; }
            __syncthreads();
        }
    }
}

__device__ __forceinline__ void p1_load_norm(const float* row, const f32x4 (&gsc)[4], const f32x4 (&sh)[4], f32x4 (&o)[4], int lane) {
    const f32x4* xr = (const f32x4*)row + lane; float s = 0.f;
#pragma unroll
    for (int j = 0; j < 4; ++j) { o[j] = xr[64 * j]; s += (o[j].x * o[j].x + o[j].y * o[j].y) + (o[j].z * o[j].z + o[j].w * o[j].w); }
    const float rstd = rsqrtf(wave_sum(s) * (1.f / D) + RMS_EPS);
#pragma unroll
    for (int j = 0; j < 4; ++j) o[j] = o[j] * rstd * gsc[j] + sh[j];
}
__device__ __forceinline__ void st_bf4(bf16_t* p, const f32x4 v) { u32x2 w; w.x = pk2(v.x, v.y); w.y = pk2(v.z, v.w); *(u32x2*)p = w; }

__device__ __forceinline__ void p1_mix(const Frame& F, const Args& A) {
    const float* MOD = (const float*)(A.ws + WS_MOD);
    bf16_t* XM = (bf16_t*)(A.ws + WS_XM);
    const float* mu = A.in[I_MU]; const float* ng = A.in[I_NORMG];
    for (int u = F.gw; u < 2176; u += F.NGW) {
        const bool isctx = u >= 2048; int t0, rowlen, modrow; const float* src; size_t orow0;
        if (!isctx) { t0 = u * 16; rowlen = GRIDW; modrow = t0 / TL; src = A.in[I_X] + (size_t)t0 * D; orow0 = t0; }
        else { t0 = (u - 2048) * 16; rowlen = TCX; modrow = 8; src = A.in[I_CTX] + (size_t)t0 * D; orow0 = (size_t)ML + t0; }
        const int pos0 = t0 % rowlen;
        const float* mrow = MOD + (size_t)modrow * 6144;
        f32x4 gsc[4], sh[4], m0[4], m1[4], m2[4];
#pragma unroll
        for (int j = 0; j < 4; ++j) { const int c = 4 * F.lane + 256 * j;
            const f32x4 g = *(const f32x4*)(ng + c), sc = *(const f32x4*)(mrow + 1024 + c);
            gsc[j] = g * (1.f + sc); sh[j] = *(const f32x4*)(mrow + c);
            m0[j] = *(const f32x4*)(mu + c); m1[j] = *(const f32x4*)(mu + D + c); m2[j] = *(const f32x4*)(mu + 2 * D + c); }
        f32x4 prev[4], cur[4], nxt[4];
        if (pos0 > 0) p1_load_norm(src - D, gsc, sh, prev, F.lane);
        else {
#pragma unroll
            for (int j = 0; j < 4; ++j) prev[j] = (f32x4){0.f, 0.f, 0.f, 0.f}; }
        p1_load_norm(src, gsc, sh, cur, F.lane);
        for (int i = 0; i < 16; ++i) {
            if (pos0 + i + 1 < rowlen) p1_load_norm(src + (size_t)(i + 1) * D, gsc, sh, nxt, F.lane);
            else {
#pragma unroll
                for (int j = 0; j < 4; ++j) nxt[j] = (f32x4){0.f, 0.f, 0.f, 0.f}; }
            bf16_t* orow = XM + (orow0 + i) * XM_LD + 4 * F.lane;
#pragma unroll
            for (int j = 0; j < 4; ++j) {
                const f32x4 s = prev[j] + nxt[j], xx = 0.5f * s - cur[j];
                st_bf4(orow + 256 * j, cur[j] + xx * m0[j]);
                st_bf4(orow + D + 256 * j, cur[j] + xx * m1[j]);
                st_bf4(orow + 2 * D + 256 * j, cur[j] + xx * m2[j]);
                st_bf4(orow + 3 * D + 256 * j, cur[j]);
                st_bf4(orow + 4 * D + 256 * j, s);
                prev[j] = cur[j]; cur[j] = nxt[j];
            }
        }
    }
}

struct SchedRKV {
    const char* xm; const char* w; int G, c;
    __device__ __forceinline__ bool next(int i, pg8::Unit& u) const {
        const int L = i * G + c; if (L >= 1600) return false;
        if (L < 1536) pg8::swz_tile(L, 128, 12, u.pm, u.pn); else { const int r = L - 1536; u.pm = 128 + (r >> 3); u.pn = 4 + (r & 7); }
        u.a = xm + (size_t)u.pm * 256 * XM_LD * 2 + (size_t)(u.pn >> 2) * D * 2; u.b = w + (size_t)u.pn * 256 * 2048 * 2; u.nt = 16; u.rows = nullptr; return true;
    }
};
struct EpiRKV {
    static constexpr bool PERM = true;
    bf16_t *R, *K, *KC, *V;
    __device__ __forceinline__ void operator()(const f32x4 (&acc)[2][2][4][2], const pg8::Unit& u, int wr, int wc, int fr, int fq) const {
        const int grp = u.pn >> 2; int prow = u.pm * 256; bf16_t* base;
        if (grp == 0) base = R; else if (grp == 1) { if (u.pm < 128) base = K; else { base = KC; prow -= ML; } } else base = V;
        const int row0 = prow + wr * 64 + fr, col0 = (u.pn & 3) * 256 + wc * 32 + 8 * fq;
#pragma unroll
        for (int ai = 0; ai < 2; ++ai)
#pragma unroll
            for (int m = 0; m < 4; ++m) { bf16_t* rowp = base + (size_t)(row0 + ai * 128 + m * 16) * D + col0;
#pragma unroll
                for (int bj = 0; bj < 2; ++bj) { const f32x4 v0 = acc[ai][bj][m][0], v1 = acc[ai][bj][m][1];
                    u32x4 w; w.x = pg8::cvt_pk_bf16(v0[0], v0[1]); w.y = pg8::cvt_pk_bf16(v0[2], v0[3]); w.z = pg8::cvt_pk_bf16(v1[0], v1[1]); w.w = pg8::cvt_pk_bf16(v1[2], v1[3]);
                    *(u32x4*)(rowp + bj * 128) = w; } }
    }
};
struct SchedLora {
    const char* xm; const char* w; int G, c;
    __device__ __forceinline__ bool next(int i, pg8::Unit& u) const {
        const int L = i * G + c; if (L >= 272) return false;
        u.pm = L >> 1; u.pn = L & 1;
        u.a = xm + (size_t)u.pm * 256 * XM_LD * 2 + (size_t)3 * D * 2; u.b = w + (size_t)u.pn * 256 * 2048 * 2; u.nt = 32; u.rows = nullptr; return true;
    }
};
struct EpiLora {
    static constexpr bool PERM = true;
    bf16_t *LWA, *LG;
    __device__ __forceinline__ void operator()(const f32x4 (&acc)[2][2][4][2], const pg8::Unit& u, int wr, int wc, int fr, int fq) const {
        bf16_t* base = u.pn ? LG : LWA;
        const int row0 = u.pm * 256 + wr * 64 + fr, col0 = wc * 32 + 8 * fq;
#pragma unroll
        for (int ai = 0; ai < 2; ++ai)
#pragma unroll
            for (int m = 0; m < 4; ++m) { bf16_t* rowp = base + (size_t)(row0 + ai * 128 + m * 16) * 256 + col0;
#pragma unroll
                for (int bj = 0; bj < 2; ++bj) { f32x4 v0 = acc[ai][bj][m][0], v1 = acc[ai][bj][m][1];
                    if (bj == 0) {
                        if (u.pn == 0) {
#pragma unroll
                            for (int q = 0; q < 4; ++q) { v0[q] = 1.f - 2.f / (__expf(2.f * v0[q]) + 1.f); v1[q] = 1.f - 2.f / (__expf(2.f * v1[q]) + 1.f); }
                        } else {
#pragma unroll
                            for (int q = 0; q < 4; ++q) { v0[q] = sigmoidf_(v0[q]); v1[q] = sigmoidf_(v1[q]); }
                        }
                    } else if (u.pn == 1) { v0 = (f32x4){0.f, 0.f, 0.f, 0.f}; v1 = v0; }
                    u32x4 w; w.x = pg8::cvt_pk_bf16(v0[0], v0[1]); w.y = pg8::cvt_pk_bf16(v0[2], v0[3]); w.z = pg8::cvt_pk_bf16(v1[0], v1[1]); w.w = pg8::cvt_pk_bf16(v1[2], v1[3]);
                    *(u32x4*)(rowp + bj * 128) = w; } }
    }
};
struct SchedPlain {
    const char* a; const char* b; int nM, nN, lda, ldb, nt, G, c;
    __device__ __forceinline__ bool next(int i, pg8::Unit& u) const {
        const int L = i * G + c; if (L >= nM * nN) return false;
        pg8::swz_tile(L, nM, nN, u.pm, u.pn);
        u.a = a + (size_t)u.pm * 256 * lda * 2; u.b = b + (size_t)u.pn * 256 * ldb * 2; u.nt = nt; u.rows = nullptr; return true;
    }
};
struct EpiBf16 {
    static constexpr bool PERM = true;
    bf16_t* O; int ldc;
    __device__ __forceinline__ void operator()(const f32x4 (&acc)[2][2][4][2], const pg8::Unit& u, int wr, int wc, int fr, int fq) const {
        const int row0 = u.pm * 256 + wr * 64 + fr, col0 = u.pn * 256 + wc * 32 + 8 * fq;
#pragma unroll
        for (int ai = 0; ai < 2; ++ai)
#pragma unroll
            for (int m = 0; m < 4; ++m) { bf16_t* rowp = O + (size_t)(row0 + ai * 128 + m * 16) * ldc + col0;
#pragma unroll
                for (int bj = 0; bj < 2; ++bj) { const f32x4 v0 = acc[ai][bj][m][0], v1 = acc[ai][bj][m][1];
                    u32x4 w; w.x = pg8::cvt_pk_bf16(v0[0], v0[1]); w.y = pg8::cvt_pk_bf16(v0[2], v0[3]); w.z = pg8::cvt_pk_bf16(v1[0], v1[1]); w.w = pg8::cvt_pk_bf16(v1[2], v1[3]);
                    *(u32x4*)(rowp + bj * 128) = w; } }
    }
};
struct EpiRes {
    static constexpr bool PERM = false;
    const float* base; float* out; const float* gate;
    __device__ __forceinline__ void operator()(const f32x4 (&acc)[2][2][4][2], const pg8::Unit& u, int wr, int wc, int fr, int fq) const {
        const int row0 = u.pm * 256 + wr * 64 + fr, col0 = u.pn * 256 + wc * 32 + 4 * fq;
        const float* gp = gate + (size_t)(u.pm >> 4) * 6144 + col0;
        f32x4 gv[2][2];
#pragma unroll
        for (int bj = 0; bj < 2; ++bj)
#pragma unroll
            for (int n = 0; n < 2; ++n) gv[bj][n] = *(const f32x4*)(gp + bj * 128 + n * 16);
#pragma unroll
        for (int ai = 0; ai < 2; ++ai)
#pragma unroll
            for (int m = 0; m < 4; ++m) { const size_t ro = (size_t)(row0 + ai * 128 + m * 16) * D + col0;
#pragma unroll
                for (int bj = 0; bj < 2; ++bj)
#pragma unroll
                    for (int n = 0; n < 2; ++n) { const f32x4 b = *(const f32x4*)(base + ro + bj * 128 + n * 16);
                        *(f32x4*)(out + ro + bj * 128 + n * 16) = b + gv[bj][n] * acc[ai][bj][m][n]; } }
    }
};
struct SchedMoe {
    const char* a; const char* b; const int* tile; int lda, ldb, nt, G, c; size_t estride;
    __device__ __forceinline__ bool next(int i, pg8::Unit& u) const {
        const int ntl = tile[0]; const int L = i * G + c; if (L >= ntl * 4) return false;
        u.pm = L >> 2; u.pn = L & 3; const int e = tile[16 + u.pm];
        u.a = a + (size_t)u.pm * 256 * lda * 2; u.b = b + (size_t)e * estride + (size_t)u.pn * 256 * ldb * 2; u.nt = nt; u.rows = nullptr; return true;
    }
};
struct SchedMoeG {
    const char* a; const char* b; const int* tile; const int* inv; int ldb, nt, G, c; size_t estride;
    __device__ __forceinline__ bool next(int i, pg8::Unit& u) const {
        const int ntl = tile[0]; const int L = i * G + c; if (L >= ntl * 4) return false;
        u.pm = L >> 2; u.pn = L & 3; const int e = tile[16 + u.pm];
        u.a = a; u.b = b + (size_t)e * estride + (size_t)u.pn * 256 * ldb * 2; u.nt = nt; u.rows = inv + u.pm * 256; return true;
    }
};
struct EpiGateUp {
    static constexpr bool PERM = true;
    bf16_t* H;
    __device__ __forceinline__ void operator()(const f32x4 (&acc)[2][2][4][2], const pg8::Unit& u, int wr, int wc, int fr, int fq) const {
        const int row0 = u.pm * 256 + wr * 64 + fr, col0 = u.pn * 128 + wc * 32 + 8 * fq;
#pragma unroll
        for (int ai = 0; ai < 2; ++ai)
#pragma unroll
            for (int m = 0; m < 4; ++m) { bf16_t* rowp = H + (size_t)(row0 + ai * 128 + m * 16) * ED + col0;
                f32x4 h0, h1;
#pragma unroll
                for (int q = 0; q < 4; ++q) { const float g0 = acc[ai][0][m][0][q], g1 = acc[ai][0][m][1][q];
                    h0[q] = g0 / (1.f + __expf(-g0)) * acc[ai][1][m][0][q]; h1[q] = g1 / (1.f + __expf(-g1)) * acc[ai][1][m][1][q]; }
                u32x4 w; w.x = pg8::cvt_pk_bf16(h0[0], h0[1]); w.y = pg8::cvt_pk_bf16(h0[2], h0[3]); w.z = pg8::cvt_pk_bf16(h1[0], h1[1]); w.w = pg8::cvt_pk_bf16(h1[2], h1[3]);
                *(u32x4*)rowp = w; }
    }
};
struct EpiWin {
    static constexpr bool PERM = true;
    bf16_t *BG, *U;
    __device__ __forceinline__ void operator()(const f32x4 (&acc)[2][2][4][2], const pg8::Unit& u, int wr, int wc, int fr, int fq) const {
        const int row0 = u.pm * 256 + wr * 64 + fr;
        if (u.pn < 4) {
            const int col0 = u.pn * 256 + wc * 32 + 8 * fq;
#pragma unroll
            for (int ai = 0; ai < 2; ++ai)
#pragma unroll
                for (int m = 0; m < 4; ++m) { bf16_t* rowp = BG + (size_t)(row0 + ai * 128 + m * 16) * D + col0;
#pragma unroll
                    for (int bj = 0; bj < 2; ++bj) { const f32x4 v0 = acc[ai][bj][m][0], v1 = acc[ai][bj][m][1];
                        u32x4 w; w.x = pg8::cvt_pk_bf16(v0[0], v0[1]); w.y = pg8::cvt_pk_bf16(v0[2], v0[3]); w.z = pg8::cvt_pk_bf16(v1[0], v1[1]); w.w = pg8::cvt_pk_bf16(v1[2], v1[3]);
                        *(u32x4*)(rowp + bj * 128) = w; } }
        } else {
            const int col0 = (u.pn - 4) * 128 + wc * 32 + 8 * fq;
#pragma unroll
            for (int ai = 0; ai < 2; ++ai)
#pragma unroll
                for (int m = 0; m < 4; ++m) { bf16_t* rowp = U + (size_t)(row0 + ai * 128 + m * 16) * D + col0;
                    const f32x4 v0 = acc[ai][0][m][0] * acc[ai][1][m][0], v1 = acc[ai][0][m][1] * acc[ai][1][m][1];
                    u32x4 w; w.x = pg8::cvt_pk_bf16(v0[0], v0[1]); w.y = pg8::cvt_pk_bf16(v0[2], v0[3]); w.z = pg8::cvt_pk_bf16(v1[0], v1[1]); w.w = pg8::cvt_pk_bf16(v1[2], v1[3]);
                    *(u32x4*)rowp = w; }
        }
    }
};

namespace sc {
constexpr int MPB = 144;
constexpr int MB = 64 * MPB;
constexpr int B_RAWK = 0, B_NAB = 0, B_RAWR = 1, B_NAK = 1, B_LW = 2, B_MRB = 2, B_LA = 3, B_MRK = 3, B_AT = 4, B_BT = 5, B_KT = 6,
              B_RT = 7, B_EL = 8, B_BBT = 9, B_KBT = 10, B_VTT = 11, B_T = 12, B_EH = 12, B_W2T = 13, B_A2T = 14;
constexpr int O_INVN = 15 * MB, O_BONP = O_INVN + 256, O_PV = O_BONP + 1024, O_KKS = O_PV + 256;
static_assert(O_KKS + 256 <= LDSCTL_OFF, "scan LDS");
__device__ __forceinline__ bf16x8 ldf(const LAS unsigned char* p) { return *(const LAS bf16x8*)p; }
__device__ __forceinline__ bf16x8 ldfp(const LAS unsigned char* p) {
    const u32x2 lo = *(const LAS u32x2*)p, hi = *(const LAS u32x2*)(p + 32);
    return __builtin_bit_cast(bf16x8, (u32x4){lo.x, lo.y, hi.x, hi.y});
}
__device__ __forceinline__ bf16x8 packfrag(const f32x4 x0, const f32x4 x1) {
    return __builtin_bit_cast(bf16x8, (u32x4){pg8::cvt_pk_bf16(x0[0], x0[1]), pg8::cvt_pk_bf16(x0[2], x0[3]), pg8::cvt_pk_bf16(x1[0], x1[1]), pg8::cvt_pk_bf16(x1[2], x1[3])});
}
__device__ __forceinline__ void st4(LAS unsigned char* p, const f32x4 d) { *(LAS u32x2*)p = (u32x2){pg8::cvt_pk_bf16(d[0], d[1]), pg8::cvt_pk_bf16(d[2], d[3])}; }
__device__ __forceinline__ f32x4 mma(const bf16x8 a, const bf16x8 b, const f32x4 c) { return __builtin_amdgcn_mfma_f32_16x16x32_bf16(a, b, c, 0, 0, 0); }
__device__ __forceinline__ float ld1(const LAS unsigned char* p) { return __builtin_bit_cast(float, (unsigned)(*(const LAS unsigned short*)p) << 16); }
__device__ __forceinline__ void st1(LAS unsigned char* p, float v) { *(LAS unsigned short*)p = (unsigned short)f2bf(v); }
__device__ __forceinline__ float fsig(float x) { return __builtin_amdgcn_rcpf(1.f + __expf(-x)); }
template <int CTRL> __device__ __forceinline__ float dppf(float v) { return __builtin_bit_cast(float, __builtin_amdgcn_update_dpp(0, __builtin_bit_cast(int, v), CTRL, 0xF, 0xF, true)); }
__device__ __forceinline__ float sum8(float v) { v += dppf<0xB1>(v); v += dppf<0x4E>(v); v += dppf<0x141>(v); return v; }
__device__ __forceinline__ float sum16(float v) { v = sum8(v); v += dppf<0x140>(v); return v; }
}

#ifndef SCAN_REP_E1
#define SCAN_REP_E1 1
#endif
#ifndef SCAN_REP_G
#define SCAN_REP_G 1
#endif
#ifndef SCAN_REP_V
#define SCAN_REP_V 1
#endif
#ifndef SCAN_REP_E0
#define SCAN_REP_E0 1
#endif
__device__ __forceinline__ void p3_scan(const Frame& F, const Args& A) {
    using namespace sc;
#define WGBAR() do { asm volatile("s_waitcnt lgkmcnt(0)" ::: "memory"); __builtin_amdgcn_s_barrier(); asm volatile("" ::: "memory"); } while (0)
    unsigned char* ws = A.ws;
    LAS unsigned char* L = F.lds;
    const bf16_t* Rg = (const bf16_t*)A.out; const bf16_t* Kg = Rg + (size_t)ML * D;
    const bf16_t* KCg = (const bf16_t*)(ws + WS_KC); const bf16_t* Vg = (const bf16_t*)(ws + WS_V); const bf16_t* LWAg = (const bf16_t*)(ws + WS_LWA);
    const int wv = F.wave;
    const f32x4 z4 = (f32x4){0.f, 0.f, 0.f, 0.f};
    for (int s = blockIdx.x; s < 256; s += F.G) {
        const int dir = s & 1, h = (s >> 1) & 15, b = s >> 5, c0 = h * HD;
        bf16_t* Yg = (bf16_t*)(ws + (dir ? WS_Y1 : WS_Y0));
        __syncthreads();
        for (int q = F.tid; q < 4096; q += NTHREADS) { const int j = q >> 6, c = q & 63;
            sc::st1(L + B_W2T * MB + c * MPB + j * 2, A.in[I_W2][((size_t)dir * 64 + j) * D + c0 + c]); sc::st1(L + B_A2T * MB + c * MPB + j * 2, A.in[I_A2][((size_t)dir * 64 + j) * D + c0 + c]); }
        if (F.tid < 64) *(LAS float*)(L + O_KKS + F.tid * 4) = A.in[I_KK][c0 + F.tid];
        const int ce = c0 + 16 * (wv & 3) + (F.lane & 15);
        const float w0c = A.in[I_W0][dir * D + ce], a0c = A.in[I_A0][dir * D + ce], kkc = A.in[I_KK][ce], kac = A.in[I_KA][ce], rkc = A.in[I_RK][ce];
        f32x4 S[4];
#pragma unroll
        for (int q = 0; q < 4; ++q) S[q] = z4;
        u32x4 pk_, pr_, pv_, plw_, pla_;
#define SCAN_PREFETCH(gc_, ti_, cg_) do { const int seg_ = (gc_) >= 4, ci_ = seg_ ? (gc_) - 4 : (gc_), Ts_ = seg_ ? TL : TCX; const int tl_ = ci_ * 64 + (ti_), t_ = dir ? (Ts_ - 1 - tl_) : tl_; \
            const size_t arow_ = seg_ ? ((size_t)b * TL + t_) : ((size_t)ML + (size_t)b * TCX + t_); \
            const bf16_t* krow_ = seg_ ? (Kg + ((size_t)b * TL + t_) * D) : (KCg + ((size_t)b * TCX + t_) * D); \
            pk_ = *(const u32x4*)(krow_ + c0 + 8 * (cg_)); pv_ = *(const u32x4*)(Vg + arow_ * D + c0 + 8 * (cg_)); \
            pr_ = (u32x4){0u, 0u, 0u, 0u}; if (seg_) pr_ = *(const u32x4*)(Rg + ((size_t)b * TL + t_) * D + c0 + 8 * (cg_)); \
            plw_ = *(const u32x4*)(LWAg + arow_ * 256 + dir * 64 + 8 * (cg_)); pla_ = *(const u32x4*)(LWAg + arow_ * 256 + 128 + dir * 64 + 8 * (cg_)); } while (0)
        SCAN_PREFETCH(0, (F.tid >> 3), (F.tid & 7));
        __syncthreads();
#pragma unroll 1
        for (int gc = 0; gc < 68; ++gc) {
            const int seg = gc >= 4, ci = seg ? gc - 4 : gc, Tseg = seg ? TL : TCX;
            int tz = F.tid; asm volatile("" : "+v"(tz));
            const int lane = tz & 63, r = lane & 15, g = lane >> 4, ti_ = tz >> 3, cg = tz & 7;
            const int o16 = r * MPB + g * 16;
            const int o8 = r * MPB + g * 8;
            const int oE = g * (4 * MPB) + r * 2;
#pragma unroll 1
            for (int rep_ = 0; rep_ < SCAN_REP_E0; ++rep_)
            {
                LAS unsigned char* st = L + ti_ * MPB + cg * 16;
                *(LAS u32x4*)(st + B_RAWK * MB) = pk_; *(LAS u32x4*)(st + B_RAWR * MB) = pr_; *(LAS u32x4*)(st + B_LW * MB) = plw_; *(LAS u32x4*)(st + B_LA * MB) = pla_;
                const unsigned vw[4] = {pv_.x, pv_.y, pv_.z, pv_.w}, kw[4] = {pk_.x, pk_.y, pk_.z, pk_.w};
                LAS unsigned char* vt = L + B_VTT * MB + cg * (8 * MPB) + ti_ * 2;
                const f32x4 kk0 = *(const LAS f32x4*)(L + O_KKS + cg * 32), kk1 = *(const LAS f32x4*)(L + O_KKS + cg * 32 + 16);
                const float kks[8] = {kk0[0], kk0[1], kk0[2], kk0[3], kk1[0], kk1[1], kk1[2], kk1[3]};
                float ss = 0.f;
#pragma unroll
                for (int q = 0; q < 4; ++q) {
                    *(LAS unsigned short*)(vt + (2 * q) * MPB) = (unsigned short)(vw[q] & 0xffffu);
                    *(LAS unsigned short*)(vt + (2 * q + 1) * MPB) = (unsigned short)(vw[q] >> 16);
                    const float k0 = bflo(kw[q]) * kks[2 * q], k1 = bfhi(kw[q]) * kks[2 * q + 1]; ss += k0 * k0 + k1 * k1; }
                ss = sum8(ss);
                if (cg == 0) *(LAS float*)(L + O_INVN + ti_ * 4) = rsqrtf(fmaxf(ss, 1e-24f));
            }
            WGBAR();
            if (gc + 1 < 68) SCAN_PREFETCH(gc + 1, ti_, cg);
            const int ct = wv & 3, th = wv >> 2;
#pragma unroll 1
            for (int rep_ = 0; rep_ < SCAN_REP_E1; ++rep_) {
            f32x4 aacc[2]; float ev[8];
            {
                f32x4 wacc[2];
                bf16x8 w2f[2], a2f[2];
#pragma unroll
                for (int ks = 0; ks < 2; ++ks) { w2f[ks] = ldf(L + B_W2T * MB + 16 * ct * MPB + 64 * ks + o16); a2f[ks] = ldf(L + B_A2T * MB + 16 * ct * MPB + 64 * ks + o16); }
                const LAS unsigned char* lwb = L + 32 * th * MPB + o16;
#pragma unroll
                for (int tt = 0; tt < 2; ++tt) { wacc[tt] = z4; aacc[tt] = z4;
#pragma unroll
                    for (int ks = 0; ks < 2; ++ks) { wacc[tt] = mma(ldf(lwb + B_LW * MB + 16 * tt * MPB + 64 * ks), w2f[ks], wacc[tt]); aacc[tt] = mma(ldf(lwb + B_LA * MB + 16 * tt * MPB + 64 * ks), a2f[ks], aacc[tt]); } }
                LAS unsigned char* eb2 = L + 16 * ct * MPB + 64 * th + o8;
#pragma unroll
                for (int tt = 0; tt < 2; ++tt) { f32x4 lo;
#pragma unroll
                    for (int q = 0; q < 4; ++q) { const float e = 0.60653066f * fsig(wacc[tt][q] + w0c); ev[4 * tt + q] = e; lo[q] = e - __builtin_bit_cast(float, f2bf(e) << 16); wacc[tt][q] = e; }
                    st4(eb2 + B_EH * MB + 32 * tt, wacc[tt]); st4(eb2 + B_EL * MB + 32 * tt, lo); }
            }
            WGBAR();
            {
                f32x4 Li4[2]; f32x4 tot4 = z4;
                const LAS unsigned char* ehb = L + B_EH * MB + 16 * ct * MPB + o16; const LAS unsigned char* elb = L + B_EL * MB + 16 * ct * MPB + o16;
                const bf16x8 eh0 = ldf(ehb), eh1 = ldf(ehb + 64), el0 = ldf(elb), el1 = ldf(elb + 64);
                const bf16x8 ones = __builtin_bit_cast(bf16x8, (u32x4){0x3F803F80u, 0x3F803F80u, 0x3F803F80u, 0x3F803F80u});
                tot4 = mma(ones, eh0, tot4); tot4 = mma(ones, el0, tot4); tot4 = mma(ones, eh1, tot4); tot4 = mma(ones, el1, tot4);
#pragma unroll
                for (int tt = 0; tt < 2; ++tt) {
                    const int irow = 16 * (2 * th + tt) + r;
                    unsigned tw[2][4];
#pragma unroll
                    for (int ks = 0; ks < 2; ++ks)
#pragma unroll
                        for (int p = 0; p < 4; ++p) { const int j0 = 32 * ks + 8 * g + 2 * p; tw[ks][p] = (j0 <= irow ? 0x3F80u : 0u) | (j0 + 1 <= irow ? 0x3F800000u : 0u); }
                    const bf16x8 t0 = __builtin_bit_cast(bf16x8, (u32x4){tw[0][0], tw[0][1], tw[0][2], tw[0][3]}), t1 = __builtin_bit_cast(bf16x8, (u32x4){tw[1][0], tw[1][1], tw[1][2], tw[1][3]});
                    f32x4 d = z4; d = mma(t0, eh0, d); d = mma(t0, el0, d);
                    if (th) { d = mma(t1, eh1, d); d = mma(t1, el1, d); }
                    Li4[tt] = d;
                }
                const float Pc = __expf(-tot4[0]);
                if (g == 0 && th == 0) *(LAS float*)(L + O_PV + (16 * ct + r) * 4) = Pc;
                LAS unsigned char* eb = L + oE + 32 * ct + 32 * th * MPB;
                LAS unsigned char* cb = L + o8 + 16 * ct * MPB + 64 * th;
#pragma unroll
                for (int tt = 0; tt < 2; ++tt) {
                    const f32x4 inv4 = *(const LAS f32x4*)(L + O_INVN + 128 * th + 64 * tt + g * 16);
                    f32x4 bbv, kbv;
#pragma unroll
                    for (int q = 0; q < 4; ++q) {
                        const int ro = (16 * tt + q) * MPB;
                        const float li = Li4[tt][q], e = ev[4 * tt + q];
                        const float kv = ld1(eb + B_RAWK * MB + ro), rv = ld1(eb + B_RAWR * MB + ro);
                        const float a = fsig(aacc[tt][q] + a0c);
                        const float kkn = kv * kkc * inv4[q];
                        const float beta = kkn * a, kd = kv * (1.f + (a - 1.f) * kac);
                        const float em = __expf(-li), ep = __builtin_amdgcn_rcpf(em), eex = __expf(e - li);
                        const float at = -kkn * eex, bt = beta * ep, kt = kd * ep, rt = rv * em;
                        bbv[q] = bt * Pc; kbv[q] = kt * Pc;
                        st1(eb + B_AT * MB + ro, at); st1(eb + B_BT * MB + ro, bt); st1(eb + B_KT * MB + ro, kt); st1(eb + B_RT * MB + ro, rt);
                        float bp = rv * kd * rkc;
                        bp = sum16(bp);
                        if (r == 0) *(LAS float*)(L + O_BONP + ct * 256 + 128 * th + (16 * tt + q) * 4 + g * 16) = bp;
                    }
                    st4(cb + B_BBT * MB + 32 * tt, bbv); st4(cb + B_KBT * MB + 32 * tt, kbv);
                    asm volatile("" ::: "memory");
                }
            }
            WGBAR();
            }
#pragma unroll 1
            for (int rep_ = 0; rep_ < SCAN_REP_G; ++rep_) {
            if (wv < 7) {
#pragma unroll 1
                for (int Lt = wv; Lt < 64; Lt += 7) {
                    const int m = Lt >> 4, ti = (Lt >> 2) & 3, ts = Lt & 3;
                    if (m == 0 && ti == ts) continue;
                    f32x4 d = z4;
                    if (ts <= ti) {
                        const LAS unsigned char* X = L + ((m & 1) ? B_KT : B_BT) * MB + 16 * ts * MPB + o16; const LAS unsigned char* Z = L + (m < 2 ? B_AT : B_RT) * MB + 16 * ti * MPB + o16;
                        d = mma(ldf(X), ldf(Z), d); d = mma(ldf(X + 64), ldf(Z + 64), d);
                        const int s0 = 16 * ts + 4 * g + (m < 2 ? 1 : 0), i = 16 * ti + r;
#pragma unroll
                        for (int q = 0; q < 4; ++q) d[q] = (s0 + q <= i) ? d[q] : 0.f;
                    }
                    st4(L + m * MB + 16 * ti * MPB + 32 * ts + o8, d);
                }
            } else {
#pragma unroll
                for (int q2 = 0; q2 < 4; ++q2) {
                    f32x4 d = z4;
                    d = mma(ldf(L + B_BT * MB + 16 * q2 * MPB + o16), ldf(L + B_AT * MB + 16 * q2 * MPB + o16), d); d = mma(ldf(L + B_BT * MB + 16 * q2 * MPB + 64 + o16), ldf(L + B_AT * MB + 16 * q2 * MPB + 64 + o16), d);
#pragma unroll
                    for (int q = 0; q < 4; ++q) d[q] = (4 * g + q < r) ? d[q] : 0.f;
                    st4(L + B_NAB * MB + 16 * q2 * MPB + 32 * q2 + o8, d);
                }
                LDS_WAIT(); asm volatile("" ::: "memory");
                const int oD = g * (16 * MPB + 32);
                float tc[16];
#pragma unroll
                for (int i = 0; i < 16; ++i) {
                    float acc = (i == r) ? 1.f : 0.f;
                    if (i > 0) {
                        const u32x4 n0 = *(const LAS u32x4*)(L + B_NAB * MB + oD + i * MPB), n1 = *(const LAS u32x4*)(L + B_NAB * MB + oD + i * MPB + 16);
                        const float nv[16] = {bflo(n0.x), bfhi(n0.x), bflo(n0.y), bfhi(n0.y), bflo(n0.z), bfhi(n0.z), bflo(n0.w), bfhi(n0.w),
                                              bflo(n1.x), bfhi(n1.x), bflo(n1.y), bfhi(n1.y), bflo(n1.z), bfhi(n1.z), bflo(n1.w), bfhi(n1.w)};
#pragma unroll
                        for (int s2 = 0; s2 < i; ++s2) acc += nv[s2] * tc[s2];
                    }
                    tc[i] = acc;
                    st1(L + B_T * MB + oD + i * MPB + r * 2, acc);
                }
            }
            LDS_WAIT(); asm volatile("" ::: "memory");
            }
            WGBAR();
            if (wv < 4) {
                f32x4 Ssv[4];
#pragma unroll
                for (int q = 0; q < 4; ++q) Ssv[q] = S[q];
#pragma unroll 1
              for (int rep_ = 0; rep_ < SCAN_REP_V; ++rep_) {
#pragma unroll
                for (int q = 0; q < 4; ++q) S[q] = Ssv[q];
                const int vs = wv;
                f32x4 W2[4], Y[4], U[4];
                const bf16x8 vb0 = ldf(L + B_VTT * MB + 16 * vs * MPB + o16), vb1 = ldf(L + B_VTT * MB + 16 * vs * MPB + 64 + o16);
                const bf16x8 Sb0 = packfrag(S[0], S[1]), Sb1 = packfrag(S[2], S[3]);
#pragma unroll
                for (int t = 0; t < 4; ++t) {
                    f32x4 d = z4;
                    d = mma(ldf(L + B_NAK * MB + 16 * t * MPB + o16), vb0, d); d = mma(ldf(L + B_NAK * MB + 16 * t * MPB + 64 + o16), vb1, d);
                    d = mma(ldfp(L + B_AT * MB + 16 * t * MPB + o8), Sb0, d); d = mma(ldfp(L + B_AT * MB + 16 * t * MPB + 64 + o8), Sb1, d); W2[t] = d;
                    const f32x4 p4 = *(const LAS f32x4*)(L + O_PV + 64 * t + g * 16);
                    f32x4 e2 = S[t] * p4;
                    e2 = mma(ldf(L + B_KBT * MB + 16 * t * MPB + o16), vb0, e2); e2 = mma(ldf(L + B_KBT * MB + 16 * t * MPB + 64 + o16), vb1, e2); S[t] = e2;
                    f32x4 y = z4;
                    if (seg) {
                        y = mma(ldf(L + B_MRK * MB + 16 * t * MPB + o16), vb0, y); y = mma(ldf(L + B_MRK * MB + 16 * t * MPB + 64 + o16), vb1, y);
                        y = mma(ldfp(L + B_RT * MB + 16 * t * MPB + o8), Sb0, y); y = mma(ldfp(L + B_RT * MB + 16 * t * MPB + 64 + o8), Sb1, y);
                    }
                    Y[t] = y;
                    asm volatile("" : "+v"(W2[t]), "+v"(S[t]), "+v"(Y[t]) :: "memory");
                }
#define DMUL(q_, x_) mma(__builtin_bit_cast(bf16x8, (u32x4){dq_[q_].x, dq_[q_].y, 0u, 0u}), packfrag((x_), z4), z4)
                u32x2 dq_[4];
#pragma unroll
                for (int q = 0; q < 4; ++q) dq_[q] = *(const LAS u32x2*)(L + B_T * MB + 16 * q * MPB + 32 * q + o8);
                U[0] = DMUL(0, W2[0]);
                { f32x4 x = mma(ldfp(L + B_NAB * MB + 16 * MPB + o8), packfrag(U[0], z4), W2[1]); U[1] = DMUL(1, x); }
                const bf16x8 u0 = packfrag(U[0], U[1]);
                { f32x4 x = mma(ldfp(L + B_NAB * MB + 32 * MPB + o8), u0, W2[2]); U[2] = DMUL(2, x); }
                { f32x4 x = mma(ldfp(L + B_NAB * MB + 48 * MPB + o8), u0, W2[3]); x = mma(ldfp(L + B_NAB * MB + 48 * MPB + 64 + o8), packfrag(U[2], z4), x); U[3] = DMUL(3, x); }
#undef DMUL
                const bf16x8 u1 = packfrag(U[2], U[3]);
#pragma unroll
                for (int t = 0; t < 4; ++t) {
                    S[t] = mma(ldfp(L + B_BBT * MB + 16 * t * MPB + o8), u0, S[t]); S[t] = mma(ldfp(L + B_BBT * MB + 16 * t * MPB + 64 + o8), u1, S[t]);
                    asm volatile("" : "+v"(S[t]) :: "memory");
                }
                if (seg) {
                    const int vcol = c0 + 16 * vs + r;
#pragma unroll
                    for (int t = 0; t < 4; ++t) {
                        f32x4 y = Y[t];
                        y = mma(ldfp(L + B_MRB * MB + 16 * t * MPB + o8), u0, y); y = mma(ldfp(L + B_MRB * MB + 16 * t * MPB + 64 + o8), u1, y);
                        const LAS float* bp = (const LAS float*)(L + O_BONP + 64 * t + g * 16);
                        const f32x4 bon = (*(const LAS f32x4*)bp + *(const LAS f32x4*)(bp + 64)) + (*(const LAS f32x4*)(bp + 128) + *(const LAS f32x4*)(bp + 192));
                        const u32x2 vv = *(const LAS u32x2*)(L + B_VTT * MB + 16 * vs * MPB + 32 * t + o8);
                        y[0] += bon[0] * bflo(vv.x); y[1] += bon[1] * bfhi(vv.x); y[2] += bon[2] * bflo(vv.y); y[3] += bon[3] * bfhi(vv.y);
#pragma unroll
                        for (int q = 0; q < 4; ++q) { const int tl = ci * 64 + 16 * t + 4 * g + q, tt = dir ? (Tseg - 1 - tl) : tl;
                            Yg[((size_t)b * TL + tt) * D + vcol] = (bf16_t)f2bf(y[q]); }
                        asm volatile("" ::: "memory");
                    }
                }
              }
            }
            WGBAR();
        }
#undef SCAN_PREFETCH
    }
#undef WGBAR
    __syncthreads();
}

__device__ __forceinline__ void p4_readout(const Frame& F, const Args& A) {
    unsigned char* ws = A.ws;
    {
        LAS float* scr = (LAS float*)(F.lds + F.wave * 16384);
        constexpr int NIT = 2 * 16 * 3 * 256;
        for (int it = F.gw; it < NIT; it += F.NGW) {
            const int mat = it >> 8, item = it & 255;
            const int kind = mat % 3, le = mat / 3, l = le >> 4, e = le & 15;
            unsigned char* mw = ws + (l ? WS_MOEW1 : WS_MOEW0);
            if (kind == 0) tr_job_item(A.in[I_MGATE] + (size_t)le * D * ED, ED, ED, (bf16_t*)mw, D, e * 1024, true, nullptr, item, scr, F.lane);
            else if (kind == 1) tr_job_item(A.in[I_MUP] + (size_t)le * D * ED, ED, ED, (bf16_t*)mw, D, e * 1024 + 128, true, nullptr, item, scr, F.lane);
            else tr_job_item(A.in[I_MDOWN] + (size_t)le * ED * D, D, D, (bf16_t*)(mw + 32 * MiB), ED, e * 1024, false, nullptr, item, scr, F.lane);
        }
    }
    const bf16_t* Y0 = (const bf16_t*)(ws + WS_Y0); const bf16_t* Y1 = (const bf16_t*)(ws + WS_Y1); const bf16_t* Gt = (const bf16_t*)(ws + WS_G);
    bf16_t* ZO = (bf16_t*)(ws + WS_ZO);
    float gw_[16], gb_[16];
#pragma unroll
    for (int j = 0; j < 2; ++j)
#pragma unroll
        for (int q = 0; q < 8; ++q) { const int c = 8 * F.lane + 512 * j + q; gw_[j * 8 + q] = A.in[I_GNW][c]; gb_[j * 8 + q] = A.in[I_GNB][c]; }
    for (int t = F.gw; t < ML; t += F.NGW) {
#pragma unroll
        for (int j = 0; j < 2; ++j) {
            const size_t off = (size_t)t * D + 8 * F.lane + 512 * j;
            const u32x4 a = *(const u32x4*)(Y0 + off), b = *(const u32x4*)(Y1 + off), g = *(const u32x4*)(Gt + off);
            float y[8] = {bflo(a.x) + bflo(b.x), bfhi(a.x) + bfhi(b.x), bflo(a.y) + bflo(b.y), bfhi(a.y) + bfhi(b.y), bflo(a.z) + bflo(b.z), bfhi(a.z) + bfhi(b.z), bflo(a.w) + bflo(b.w), bfhi(a.w) + bfhi(b.w)};
            float gg[8] = {bflo(g.x), bfhi(g.x), bflo(g.y), bfhi(g.y), bflo(g.z), bfhi(g.z), bflo(g.w), bfhi(g.w)};
            float s = 0.f;
#pragma unroll
            for (int q = 0; q < 8; ++q) s += y[q];
            s += __shfl_xor(s, 1); s += __shfl_xor(s, 2); s += __shfl_xor(s, 4);
            const float mean = s * (1.f / 64.f); float s2 = 0.f;
#pragma unroll
            for (int q = 0; q < 8; ++q) { y[q] -= mean; s2 += y[q] * y[q]; }
            s2 += __shfl_xor(s2, 1); s2 += __shfl_xor(s2, 2); s2 += __shfl_xor(s2, 4);
            const float rstd = rsqrtf(s2 * (1.f / 64.f) + GN_EPS);
            float z[8];
#pragma unroll
            for (int q = 0; q < 8; ++q) z[q] = (y[q] * rstd * gw_[j * 8 + q] + gb_[j * 8 + q]) * gg[q];
            u32x4 w; w.x = pk2(z[0], z[1]); w.y = pk2(z[2], z[3]); w.z = pk2(z[4], z[5]); w.w = pk2(z[6], z[7]);
            *(u32x4*)(ZO + off) = w;
        }
    }
}

__device__ __forceinline__ void p6_route(const Frame& F, const Args& A, const int layer) {
    unsigned char* ws = A.ws;
    LAS float* RW = (LAS float*)F.lds;
    __syncthreads();
    for (int i = F.tid; i < D * NE; i += NTHREADS) { const int d = i >> 4, e = i & 15; const int j = d >> 8, l = (d & 255) >> 2, jj = d & 3, dj = j * 4 + jj;
        RW[((dj * 4 + (e >> 2)) * 64 + l) * 4 + (e & 3)] = A.in[I_ROUTW][i]; }
    __syncthreads();
    const float* MOD = (const float*)(ws + WS_MOD) + (size_t)layer * 9 * 6144;
    const float* ng = A.in[I_NORMG] + (size_t)(layer * 2 + 1) * D;
    const float* h = A.out;
    bf16_t* XN = (bf16_t*)(ws + WS_XN);
    unsigned* EIDX = (unsigned*)(ws + WS_EIDX); float* GATE = (float*)(ws + WS_GATE); int* CC = (int*)(ws + WS_CC);
    float rb[16];
#pragma unroll
    for (int e = 0; e < 16; ++e) rb[e] = A.in[I_ROUTB][e];
    for (int ch = F.gw; ch < 2048; ch += F.NGW) {
        const int t0 = ch * 16, b = t0 / TL;
        const float* mrow = MOD + (size_t)b * 6144;
        f32x4 gsc[4], sh[4];
#pragma unroll
        for (int j = 0; j < 4; ++j) { const int c = 4 * F.lane + 256 * j; gsc[j] = *(const f32x4*)(ng + c) * (1.f + *(const f32x4*)(mrow + 4096 + c)); sh[j] = *(const f32x4*)(mrow + 3072 + c); }
        int cnt = 0;
        for (int i = 0; i < 16; ++i) {
            const int t = t0 + i;
            f32x4 v[4];
            p1_load_norm(h + (size_t)t * D, gsc, sh, v, F.lane);
            bf16_t* orow = XN + (size_t)t * D + 4 * F.lane;
#pragma unroll
            for (int j = 0; j < 4; ++j) st_bf4(orow + 256 * j, v[j]);
            float lg[16];
#pragma unroll
            for (int e = 0; e < 16; ++e) lg[e] = 0.f;
#pragma unroll
            for (int j = 0; j < 4; ++j)
#pragma unroll
                for (int jj = 0; jj < 4; ++jj) { const float xv = v[j][jj]; const int dj = j * 4 + jj;
#pragma unroll
                    for (int q = 0; q < 4; ++q) { const f32x4 w = *(const LAS f32x4*)(RW + ((dj * 4 + q) * 64 + F.lane) * 4);
                        lg[4 * q] += xv * w.x; lg[4 * q + 1] += xv * w.y; lg[4 * q + 2] += xv * w.z; lg[4 * q + 3] += xv * w.w; }
                    asm volatile("" : "+v"(lg[0]), "+v"(lg[1]), "+v"(lg[2]), "+v"(lg[3]), "+v"(lg[4]), "+v"(lg[5]), "+v"(lg[6]), "+v"(lg[7]),
                                      "+v"(lg[8]), "+v"(lg[9]), "+v"(lg[10]), "+v"(lg[11]), "+v"(lg[12]), "+v"(lg[13]), "+v"(lg[14]), "+v"(lg[15]) :: "memory"); }
#pragma unroll
            for (int e = 0; e < 16; ++e) lg[e] = wave_sum(lg[e]);
            float best = -3.0e38f; int be0 = 0, be1 = 1; float bs0 = 0.f, bs1 = 0.f;
#pragma unroll
            for (int g = 0; g < 4; ++g) {
                float s[4], sel[4];
#pragma unroll
                for (int q = 0; q < 4; ++q) { s[q] = 1.f / (1.f + expf(-lg[4 * g + q])); sel[q] = s[q] + rb[4 * g + q]; }
                int i1 = 0; float v1 = sel[0], s1 = s[0];
#pragma unroll
                for (int q = 1; q < 4; ++q) if (sel[q] > v1) { i1 = q; v1 = sel[q]; s1 = s[q]; }
                int i2 = -1; float v2 = -3.0e38f, s2 = 0.f;
#pragma unroll
                for (int q = 0; q < 4; ++q) if (q != i1 && sel[q] > v2) { i2 = q; v2 = sel[q]; s2 = s[q]; }
                const float gs = v1 + v2;
                if (gs > best) { best = gs; be0 = 4 * g + i1; be1 = 4 * g + i2; bs0 = s1; bs1 = s2; }
            }
            const float inv = 1.f / (bs0 + bs1);
            if (F.lane == 0) { EIDX[t] = (unsigned)be0 | ((unsigned)be1 << 8); GATE[2 * t] = bs0 * inv; GATE[2 * t + 1] = bs1 * inv; }
            cnt += (F.lane == be0) + (F.lane == be1);
        }
        if (F.lane < 16) CC[ch * 16 + F.lane] = cnt;
    }
    __syncthreads();
}

__device__ __forceinline__ void p7_permute(const Frame& F, const Args& A) {
    unsigned char* ws = A.ws;
    LAS int* cc = (LAS int*)F.lds;
    LAS int* ps = (LAS int*)(F.lds + LDS_X_OFF);
    LAS int* seg = ps + 512;
    LAS int* tot = seg + 16;
    const int* CC = (const int*)(ws + WS_CC);
    const unsigned* EIDX = (const unsigned*)(ws + WS_EIDX); int* POS = (int*)(ws + WS_POS); int* TILE = (int*)(ws + WS_TILE); int* INV = (int*)(ws + WS_INV);
    __syncthreads();
    for (int i = F.tid; i < 2048 * 16 / 4; i += NTHREADS) ((LAS u32x4*)cc)[i] = ((const u32x4*)CC)[i];
    __syncthreads();
    { const int e = F.tid & 15, part = F.tid >> 4; int s = 0; for (int q = 0; q < 64; ++q) s += cc[(part * 64 + q) * 16 + e]; ps[part * 16 + e] = s; }
    __syncthreads();
    if (F.tid < 16) { int run = 0; for (int p = 0; p < 32; ++p) { const int v = ps[p * 16 + F.tid]; ps[p * 16 + F.tid] = run; run += v; } tot[F.tid] = run; }
    __syncthreads();
    if (F.tid == 0) { int off = 0, nt = 0;
        for (int e = 0; e < 16; ++e) { const int tl = (tot[e] + 255) >> 8; seg[e] = off;
            if (blockIdx.x == 0) for (int q = 0; q < tl; ++q) TILE[16 + nt + q] = e;
            nt += tl; off += tl * 256; }
        if (blockIdx.x == 0) TILE[0] = nt; }
    __syncthreads();
    if (blockIdx.x == 0) {
        for (int e = 0; e < 16; ++e) { const int n0 = seg[e] + tot[e], n1 = seg[e] + (((tot[e] + 255) >> 8) << 8);
            for (int j = n0 + F.tid; j < n1; j += NTHREADS) INV[j] = 0; } }
    for (int ch = F.gw; ch < 2048; ch += F.NGW) {
        int base = 0;
        if (F.lane < 16) { base = seg[F.lane] + ps[(ch >> 6) * 16 + F.lane]; for (int q = (ch & ~63); q < ch; ++q) base += cc[q * 16 + F.lane]; }
        int myp = 0;
        for (int i = 0; i < 16; ++i) {
            const int t = ch * 16 + i; const unsigned ei = EIDX[t]; const int e0 = ei & 255, e1 = (ei >> 8) & 255;
            const int p0 = __shfl(base, e0); base += (F.lane == e0);
            const int p1 = __shfl(base, e1); base += (F.lane == e1);
            if (F.lane == 2 * i) myp = p0; if (F.lane == 2 * i + 1) myp = p1;
        }
        if (F.lane < 32) { POS[ch * 32 + F.lane] = myp; INV[myp] = ch * 16 + (F.lane >> 1); }
    }
    __syncthreads();
}

template <bool FINAL>
__device__ __forceinline__ void p10_combine(const Frame& F, const Args& A, const int layer) {
    unsigned char* ws = A.ws;
    const float* MOD = (const float*)(ws + WS_MOD);
    const bf16_t* O = (const bf16_t*)(ws + WS_XP); const int* POS = (const int*)(ws + WS_POS); const float* GATE = (const float*)(ws + WS_GATE);
    bf16_t* XN = (bf16_t*)(ws + WS_XN);
    float* h = A.out;
    for (int ch = F.gw; ch < 2048; ch += F.NGW) {
        const int t0 = ch * 16, b = t0 / TL;
        const float* mcur = MOD + ((size_t)layer * 9 + b) * 6144;
        f32x4 gt2[4], gsc[4], sh[4];
#pragma unroll
        for (int j = 0; j < 4; ++j) { const int c = 4 * F.lane + 256 * j; gt2[j] = *(const f32x4*)(mcur + 5120 + c);
            if (FINAL) { gsc[j] = *(const f32x4*)(A.in[I_FINALG] + c); sh[j] = (f32x4){0.f, 0.f, 0.f, 0.f}; }
            else { const float* mn = MOD + ((size_t)9 + b) * 6144; gsc[j] = *(const f32x4*)(A.in[I_NORMG] + 2 * D + c) * (1.f + *(const f32x4*)(mn + 1024 + c)); sh[j] = *(const f32x4*)(mn + c); } }
        for (int i = 0; i < 16; ++i) {
            const int t = t0 + i; const int p0 = POS[2 * t], p1 = POS[2 * t + 1]; const float w0 = GATE[2 * t], w1 = GATE[2 * t + 1];
            f32x4 v[4]; float s = 0.f;
#pragma unroll
            for (int j = 0; j < 4; ++j) { const int c = 4 * F.lane + 256 * j;
                const u32x2 oa = *(const u32x2*)(O + (size_t)p0 * D + c), ob = *(const u32x2*)(O + (size_t)p1 * D + c);
                const f32x4 m = w0 * (f32x4){bflo(oa.x), bfhi(oa.x), bflo(oa.y), bfhi(oa.y)} + w1 * (f32x4){bflo(ob.x), bfhi(ob.x), bflo(ob.y), bfhi(ob.y)};
                v[j] = *(const f32x4*)(h + (size_t)t * D + c) + gt2[j] * m;
                s += (v[j].x * v[j].x + v[j].y * v[j].y) + (v[j].z * v[j].z + v[j].w * v[j].w); }
            const float rstd = rsqrtf(wave_sum(s) * (1.f / D) + RMS_EPS);
            if (FINAL) {
#pragma unroll
                for (int j = 0; j < 4; ++j) *(f32x4*)(h + (size_t)t * D + 4 * F.lane + 256 * j) = v[j] * rstd * gsc[j];
            } else {
#pragma unroll
                for (int j = 0; j < 4; ++j) { *(f32x4*)(h + (size_t)t * D + 4 * F.lane + 256 * j) = v[j]; st_bf4(XN + (size_t)t * D + 4 * F.lane + 256 * j, v[j] * rstd * gsc[j] + sh[j]); }
            }
        }
    }
}

__device__ __forceinline__ void ld_bf16row(const bf16_t* row, float (&o)[16], int lane) {
#pragma unroll
    for (int j = 0; j < 2; ++j) { const u32x4 a = *(const u32x4*)(row + 8 * lane + 512 * j);
        o[8 * j] = bflo(a.x); o[8 * j + 1] = bfhi(a.x); o[8 * j + 2] = bflo(a.y); o[8 * j + 3] = bfhi(a.y); o[8 * j + 4] = bflo(a.z); o[8 * j + 5] = bfhi(a.z); o[8 * j + 6] = bflo(a.w); o[8 * j + 7] = bfhi(a.w); }
}
__device__ __forceinline__ void p12_conv(const Frame& F, const Args& A) {
    unsigned char* ws = A.ws;
    const bf16_t* BG = (const bf16_t*)(ws + WS_BG); const bf16_t* U = (const bf16_t*)(ws + WS_U); bf16_t* Z = (bf16_t*)(ws + WS_Z);
    float c0[16], c1[16], c2[16];
#pragma unroll
    for (int j = 0; j < 2; ++j)
#pragma unroll
        for (int q = 0; q < 8; ++q) { const int c = 8 * F.lane + 512 * j + q; c0[8 * j + q] = A.in[I_CONV][c]; c1[8 * j + q] = A.in[I_CONV][D + c]; c2[8 * j + q] = A.in[I_CONV][2 * D + c]; }
    for (int u = F.gw; u < 2048; u += F.NGW) {
        const int t0 = u * 16, pos0 = t0 % GRIDW;
        float prev[16], cur[16], nxt[16], bg[16];
        if (pos0 > 0) ld_bf16row(U + (size_t)(t0 - 1) * D, prev, F.lane);
        else {
#pragma unroll
            for (int q = 0; q < 16; ++q) prev[q] = 0.f; }
        ld_bf16row(U + (size_t)t0 * D, cur, F.lane);
        for (int i = 0; i < 16; ++i) {
            if (pos0 + i + 1 < GRIDW) ld_bf16row(U + (size_t)(t0 + i + 1) * D, nxt, F.lane);
            else {
#pragma unroll
                for (int q = 0; q < 16; ++q) nxt[q] = 0.f; }
            ld_bf16row(BG + (size_t)(t0 + i) * D, bg, F.lane);
            float z[16];
#pragma unroll
            for (int q = 0; q < 16; ++q) { z[q] = bg[q] * (c0[q] * prev[q] + c1[q] * cur[q] + c2[q] * nxt[q]); prev[q] = cur[q]; cur[q] = nxt[q]; }
#pragma unroll
            for (int j = 0; j < 2; ++j) { u32x4 w; w.x = pk2(z[8 * j], z[8 * j + 1]); w.y = pk2(z[8 * j + 2], z[8 * j + 3]); w.z = pk2(z[8 * j + 4], z[8 * j + 5]); w.w = pk2(z[8 * j + 6], z[8 * j + 7]);
                *(u32x4*)(Z + (size_t)(t0 + i) * D + 8 * F.lane + 512 * j) = w; }
        }
    }
}

constexpr int N_PHASES = 20;
__global__ void __launch_bounds__(NTHREADS, 2) fwd(Args args) {
    extern __shared__ __attribute__((aligned(16))) unsigned char lds_raw[];
    Frame F;
    F.lds = (LAS unsigned char*)lds_raw;
    F.tid = threadIdx.x; F.lane = F.tid & 63; F.wave = __builtin_amdgcn_readfirstlane(F.tid >> 6);
    F.G = gridDim.x; { const int bx = blockIdx.x; F.vcu = (F.G % 8 == 0) ? (bx % 8) * (F.G / 8) + bx / 8 : bx; }
    F.gw = F.vcu * NWAVES + F.wave; F.NGW = F.G * NWAVES;
    unsigned char* ws = args.ws;
    for (int u = F.tid; u < (LDS_BYTES - LDSCTL_OFF) / 4; u += NTHREADS) ((LAS unsigned*)(F.lds + LDSCTL_OFF))[u] = 0u;
    __syncthreads();
    volatile LAS unsigned* MISC = (volatile LAS unsigned*)(F.lds + MISC_OFF);
    XcdBarrier bar; bar.bar = (unsigned*)(ws + WS_CTL) + CW_BAR; bar.x = 0; bar.st = nullptr;
    const int lo = args.ph_lo, hi = args.ph_hi;
    if (hi - lo > 1) bar = xcd_barrier_post((unsigned*)(ws + WS_CTL) + CW_BAR, MISC + 8);
#ifndef PH_MASK
#define PH_MASK 0xFFFFFu
#endif
#define IN(k) (((PH_MASK >> (k)) & 1u) && lo <= (k) && (k) < hi)
#define SEAM(k) do { if (IN(k) && IN((k) + 1)) xcd_barrier(bar); } while (0)
#ifndef PROBE_MASK
#define PROBE_MASK 0u
#endif
#define RUNPH(k, ...) do { __VA_ARGS__ if constexpr (((PROBE_MASK >> (k)) & 1u) != 0u) { if (hi - lo > 1) xcd_barrier(bar); __VA_ARGS__ } } while (0)
    const float* MOD = (const float*)(ws + WS_MOD);
    const int bx = (int)blockIdx.x;

    if (IN(0)) { RUNPH(0, p0_prologue(F, args);); SEAM(0); }
    if (IN(1)) { RUNPH(1, p1_mix(F, args);); SEAM(1); }
    if (IN(2)) {
      RUNPH(2,
        { SchedRKV S{(const char*)(ws + WS_XM), (const char*)(ws + WS_WRKV), F.G, bx};
          EpiRKV E{(bf16_t*)args.out, (bf16_t*)args.out + (size_t)ML * D, (bf16_t*)(ws + WS_KC), (bf16_t*)(ws + WS_V)};
          pg8::gemm_phase<EpiRKV, SchedRKV>(F.lds, XM_LD, 2048, S, E); }
        { SchedLora S{(const char*)(ws + WS_XM), (const char*)(ws + WS_WL), F.G, (bx + F.G / 2) % F.G};
          EpiLora E{(bf16_t*)(ws + WS_LWA), (bf16_t*)(ws + WS_LG)};
          pg8::gemm_phase<EpiLora, SchedLora>(F.lds, XM_LD, 2048, S, E); }
      );
        SEAM(2);
    }
    if (IN(3)) {
      RUNPH(3,
        SchedPlain S{(const char*)(ws + WS_LG), (const char*)(ws + WS_G2), 128, 4, 256, 256, 4, F.G, bx};
        EpiBf16 E{(bf16_t*)(ws + WS_G), D};
        pg8::gemm_phase<EpiBf16, SchedPlain>(F.lds, 256, 256, S, E);
      );
        SEAM(3);
    }
    if (IN(4)) { RUNPH(4, p3_scan(F, args);); SEAM(4); }
    if (IN(5)) { RUNPH(5, p4_readout(F, args);); SEAM(5); }
    if (IN(6)) {
      RUNPH(6,
        SchedPlain S{(const char*)(ws + WS_ZO), (const char*)(ws + WS_WO), 128, 4, D, D, 16, F.G, bx};
        EpiRes E{args.in[I_X], args.out, MOD + 2048};
        pg8::gemm_phase<EpiRes, SchedPlain>(F.lds, D, D, S, E);
      );
        SEAM(6);
    }
    if (IN(7)) { RUNPH(7, p6_route(F, args, 0);); SEAM(7); }
    if (IN(8)) { RUNPH(8, p7_permute(F, args);); SEAM(8); }
    if (IN(9)) {
      RUNPH(9,
        SchedMoeG S{(const char*)(ws + WS_XN), (const char*)(ws + WS_MOEW0), (const int*)(ws + WS_TILE), (const int*)(ws + WS_INV), D, 16, F.G, bx, (size_t)2 * MiB};
        EpiGateUp E{(bf16_t*)(ws + WS_H)};
        pg8::gemm_phase<EpiGateUp, SchedMoeG, true>(F.lds, D, D, S, E);
      );
        SEAM(9);
    }
    if (IN(10)) {
      RUNPH(10,
        SchedMoe S{(const char*)(ws + WS_H), (const char*)(ws + WS_MOEW0 + 32 * MiB), (const int*)(ws + WS_TILE), ED, ED, 8, F.G, bx, (size_t)1 * MiB};
        EpiBf16 E{(bf16_t*)(ws + WS_XP), D};
        pg8::gemm_phase<EpiBf16, SchedMoe>(F.lds, ED, ED, S, E);
      );
        SEAM(10);
    }
    if (IN(11)) { p10_combine<false>(F, args, 0); SEAM(11); }
    if (IN(12)) {
      RUNPH(12,
        SchedPlain S{(const char*)(ws + WS_XN), (const char*)(ws + WS_WIN), 128, 12, D, D, 16, F.G, bx};
        EpiWin E{(bf16_t*)(ws + WS_BG), (bf16_t*)(ws + WS_U)};
        pg8::gemm_phase<EpiWin, SchedPlain>(F.lds, D, D, S, E);
      );
        SEAM(12);
    }
    if (IN(13)) { RUNPH(13, p12_conv(F, args);); SEAM(13); }
    if (IN(14)) {
        SchedPlain S{(const char*)(ws + WS_Z), (const char*)(ws + WS_WOUT), 128, 4, D, D, 16, F.G, bx};
        EpiRes E{args.out, args.out, MOD + 9 * 6144 + 2048};
        pg8::gemm_phase<EpiRes, SchedPlain>(F.lds, D, D, S, E);
        SEAM(14);
    }
    if (IN(15)) { RUNPH(15, p6_route(F, args, 1);); SEAM(15); }
    if (IN(16)) { RUNPH(16, p7_permute(F, args);); SEAM(16); }
    if (IN(17)) {
      RUNPH(17,
        SchedMoeG S{(const char*)(ws + WS_XN), (const char*)(ws + WS_MOEW1), (const int*)(ws + WS_TILE), (const int*)(ws + WS_INV), D, 16, F.G, bx, (size_t)2 * MiB};
        EpiGateUp E{(bf16_t*)(ws + WS_H)};
        pg8::gemm_phase<EpiGateUp, SchedMoeG, true>(F.lds, D, D, S, E);
      );
        SEAM(17);
    }
    if (IN(18)) {
      RUNPH(18,
        SchedMoe S{(const char*)(ws + WS_H), (const char*)(ws + WS_MOEW1 + 32 * MiB), (const int*)(ws + WS_TILE), ED, ED, 8, F.G, bx, (size_t)1 * MiB};
        EpiBf16 E{(bf16_t*)(ws + WS_XP), D};
        pg8::gemm_phase<EpiBf16, SchedMoe>(F.lds, ED, ED, S, E);
      );
        SEAM(18);
    }
    if (IN(19)) { p10_combine<true>(F, args, 1); }
}

extern "C" void kernel_launch(void* const* d_in, const int* in_sizes, int n_in, void* d_out, int out_size, void* d_ws, size_t ws_size, hipStream_t stream) {
    static int grid = 0;
    if (grid == 0) {
        if (n_in != 32 || out_size != ML * D || ws_size < WS_END) { fprintf(stderr, "kernel_launch: unexpected problem (n_in %d, out %d, ws %zu)\n", n_in, out_size, ws_size); grid = -1; return; }
        int dev = 0, cus = 0;
        if (hipGetDevice(&dev) != hipSuccess || hipDeviceGetAttribute(&cus, hipDeviceAttributeMultiprocessorCount, dev) != hipSuccess) { grid = -1; return; }
        if (hipFuncSetAttribute((const void*)fwd, hipFuncAttributeMaxDynamicSharedMemorySize, LDS_BYTES) != hipSuccess) { grid = -1; return; }
        int per_cu = 0;
        if (hipOccupancyMaxActiveBlocksPerMultiprocessor(&per_cu, (const void*)fwd, NTHREADS, LDS_BYTES) != hipSuccess || per_cu < 1) { fprintf(stderr, "kernel_launch: occupancy query says %d\n", per_cu); grid = -1; return; }
        grid = cus > 256 ? 256 : cus;
    }
    if (grid < 0) return;
    (void)in_sizes;
    hipMemsetAsync((char*)d_ws + WS_CTL, 0, CTL_ZERO_BYTES, stream);
    Args a{};
    for (int i = 0; i < 32; ++i) a.in[i] = (const float*)d_in[i];
    a.out = (float*)d_out; a.ws = (unsigned char*)d_ws;
#if MK_N_LAUNCHES == 1
    a.ph_lo = 0; a.ph_hi = N_PHASES;
    hipLaunchKernelGGL(fwd, dim3(grid), dim3(NTHREADS), LDS_BYTES, stream, a);
#else
    for (int k = 0; k < N_PHASES; ++k) { a.ph_lo = k; a.ph_hi = k + 1; hipLaunchKernelGGL(fwd, dim3(grid), dim3(NTHREADS), LDS_BYTES, stream, a); }
#endif
}
```

```cpp
#include <hip/hip_runtime.h>
#include <cstdio>
#include <cstdint>

#ifndef MK_N_LAUNCHES
#define MK_N_LAUNCHES 1
#endif

#define GAS __attribute__((address_space(1)))
#define LAS __attribute__((address_space(3)))
typedef unsigned short bf16_t;
typedef short bf16x8 __attribute__((ext_vector_type(8)));
typedef float f32x4 __attribute__((ext_vector_type(4)));
typedef float f32x2 __attribute__((ext_vector_type(2)));
typedef unsigned u32x4 __attribute__((ext_vector_type(4)));
typedef unsigned u32x2 __attribute__((ext_vector_type(2)));

constexpr int D = 1024, NBATCH = 8, TL = 4096, TCX = 256, ML = NBATCH * TL, MC = NBATCH * TCX, MA = ML + MC;
constexpr int NH = 16, HD = 64, NE = 16, ED = 512, GRIDW = 64;
constexpr int XM_LD = 5 * D;
constexpr int NWAVES = 8, NTHREADS = 512;
constexpr float RMS_EPS = 1e-6f, GN_EPS = 64e-5f;
constexpr int MAXTILES = 272;

constexpr size_t MiB = 1u << 20;
constexpr size_t WS_CTL = 0, CTL_ZERO_BYTES = 1 * MiB;
constexpr size_t WS_MOD = 1 * MiB;
constexpr size_t WS_EIDX = 2 * MiB;
constexpr size_t WS_GATE = WS_EIDX + 128 * 1024;
constexpr size_t WS_POS = WS_GATE + 256 * 1024;
constexpr size_t WS_CC = WS_POS + 256 * 1024;
constexpr size_t WS_TILE = WS_CC + 128 * 1024;
constexpr size_t WS_INV = WS_TILE + 4 * 1024;
static_assert(WS_INV + 69632 * 4 <= 4 * MiB, "ws map");
constexpr size_t WS_WRKV = 4 * MiB;
constexpr size_t WS_WL = 16 * MiB;
constexpr size_t WS_G2 = 18 * MiB;
constexpr size_t WS_WO = 19 * MiB;
constexpr size_t WS_WIN = 21 * MiB;
constexpr size_t WS_WOUT = 27 * MiB;
constexpr size_t WS_ACT = 32 * MiB;
constexpr size_t WS_XM = WS_ACT;
constexpr size_t WS_V = 372 * MiB;
constexpr size_t WS_KC = 440 * MiB;
constexpr size_t WS_LWA = 444 * MiB;
constexpr size_t WS_LG = 461 * MiB;
constexpr size_t WS_G = 32 * MiB;
constexpr size_t WS_Y0 = 96 * MiB, WS_Y1 = 160 * MiB;
constexpr size_t WS_ZO = 272 * MiB;
constexpr size_t WS_MOEW0 = 384 * MiB, WS_MOEW1 = 432 * MiB;
constexpr size_t WS_XN = 32 * MiB;
constexpr size_t WS_XP = 96 * MiB;
constexpr size_t WS_H = 232 * MiB;
constexpr size_t WS_BG = 232 * MiB, WS_U = 296 * MiB;
constexpr size_t WS_Z = 96 * MiB;
constexpr size_t WS_END = 480 * MiB;

constexpr int CW_BAR = 4096;
constexpr int CW_TMO2 = 16;
constexpr size_t CTL_RDY = 256 * 1024;

constexpr int RING_BYTES = 131072;
constexpr int LDS_BYTES = 147456;
constexpr int LDSCTL_OFF = LDS_BYTES - 512, MISC_OFF = LDSCTL_OFF + 64;
constexpr int LDS_X_OFF = RING_BYTES;

typedef __bf16 bf16x2v __attribute__((ext_vector_type(2)));
__device__ __forceinline__ unsigned pk2(float lo, float hi) { const f32x2 v = {lo, hi}; return __builtin_bit_cast(unsigned, __builtin_convertvector(v, bf16x2v)); }
__device__ __forceinline__ unsigned f2bf(float f) { return pk2(f, 0.f) & 0xffffu; }
__device__ __forceinline__ float bflo(unsigned u) { return __builtin_bit_cast(float, u << 16); }
__device__ __forceinline__ float bfhi(unsigned u) { return __builtin_bit_cast(float, u & 0xffff0000u); }
__device__ __forceinline__ float wave_sum(float v) {
#pragma unroll
    for (int o = 1; o < 64; o <<= 1) v += __shfl_xor(v, o);
    return v;
}
__device__ __forceinline__ float sigmoidf_(float x) { return 1.f / (1.f + __expf(-x)); }
#define LDS_WAIT() asm volatile("s_waitcnt lgkmcnt(0)" ::: "memory")

namespace pg8 {
constexpr int BM = 256, BK = 64, HALF = 128, HTB = HALF * BK * 2, STAGE_BYTES = 8 * HTB, NXCD = 8, WGM = 8;
__host__ __device__ __forceinline__ int lds_byte(int r, int c) { const int st = (r >> 4) * 2 + (c >> 5), rr = r & 15, cc = c & 31, ob = rr * 64 + cc * 2; return st * 1024 + (ob ^ (((ob >> 9) & 1) << 5)); }
__host__ __device__ __forceinline__ void stage_rc(int b, int& R, int& C) { const int st = b / 1024, sb = b % 1024, swz = sb ^ (((sb >> 9) & 1) << 5); R = (st >> 1) * 16 + swz / 64; C = (st & 1) * 32 + (swz % 64) / 2; }
__host__ __device__ __forceinline__ int perm32(int rho) { const int n = rho >> 4, i = rho & 15; return 8 * (i >> 2) + 4 * n + (i & 3); }

struct Unit { int pm, pn; const char* a; const char* b; int nt; const int* rows; int kind, pa, pb, row0; };

__device__ __forceinline__ void swz_tile(int L, int nM, int nN, int& pm, int& pn) {
    const int nwg = nM * nN; int wgid = L;
    { const int q = nwg / NXCD, r = nwg % NXCD, xcd = wgid % NXCD, off = wgid / NXCD; wgid = (xcd < r ? xcd * (q + 1) : r * (q + 1) + (xcd - r) * q) + off; }
    const int nig = WGM * nN, gid = wgid / nig, fm = gid * WGM, gsz = (nM - fm) < WGM ? (nM - fm) : WGM;
    pm = fm + ((wgid % nig) % gsz); pn = (wgid % nig) / gsz;
}

__device__ __forceinline__ unsigned cvt_pk_bf16(float lo, float hi) { return pk2(lo, hi); }

template <class Epi, class Sched, bool GATHER = false, int FUSED = 0  , bool ALIGN_EPI = true, bool SP2 = true>
__device__ __forceinline__ void gemm_phase(LAS unsigned char* lds, const int lda, const int ldb, const Sched& S, const Epi& E) {
    const int tid = threadIdx.x, wid = __builtin_amdgcn_readfirstlane(tid >> 6), lane = tid & 63, wr = wid >> 2, wc = wid & 3, fr = lane & 15, fq = lane >> 4;
    unsigned vA[2][2], vN[2][2], voffB[2], vBn[2]; int gR[2], gC[2], gRb[2]; size_t hsBc = 0, hsBn = 0;
#pragma unroll
    for (int i = 0; i < 2; ++i) { int R, C; stage_rc(tid * 16 + i * 8192, R, C); const int Rb = Epi::PERM ? ((R & ~31) + perm32(R & 31)) : R;
        gR[i] = R; gC[i] = C * 2; gRb[i] = Rb; vBn[i] = 0;
        vA[0][i] = (unsigned)(R * lda + C) * 2u; vA[1][i] = (unsigned)((R + HALF) * lda + C) * 2u; vN[0][i] = vA[0][i]; vN[1][i] = vA[1][i];
        voffB[i] = (unsigned)(Rb * ldb + C) * 2u; }
#define PG8_GATHER(dst, u) do { if constexpr (GATHER) { _Pragma("unroll") for (int _h = 0; _h < 2; ++_h) _Pragma("unroll") for (int _i = 0; _i < 2; ++_i) { \
        if constexpr (FUSED != 0) { const int ri_ = gR[_i] + _h * HALF; const unsigned rr_ = (u).rows ? (unsigned)(u).rows[ri_] : (unsigned)((u).row0 + ri_); dst[_h][_i] = rr_ * (unsigned)(u).pa + (unsigned)gC[_i]; } \
        else dst[_h][_i] = (unsigned)(u).rows[gR[_i] + _h * HALF] * (unsigned)(lda * 2) + (unsigned)gC[_i]; } } } while (0)
#define PG8_BOFF(dst, u) do { if constexpr (FUSED == 2) { _Pragma("unroll") for (int _i = 0; _i < 2; ++_i) dst[_i] = (unsigned)gRb[_i] * (unsigned)(u).pb + (unsigned)gC[_i]; } } while (0)
#define PG8_STAGE_B(bufoff, gbase, hh, nx) do { if constexpr (FUSED == 2) { if ((nx) && last) PG8_STAGE(bufoff, (gbase) + (hh) * hsBn, vBn); else PG8_STAGE(bufoff, (gbase) + (hh) * hsBc, voffB); } \
        else PG8_STAGE(bufoff, (gbase) + (hh) * hstepB, voffB); } while (0)
    const size_t kstep = (size_t)(BK * 2);
    const size_t hstepB = (size_t)HALF * ldb * 2;
    const unsigned ldsw = (unsigned)wid * 1024u;
    const int aoff = lds_byte(wr * 64 + fr, fq * 8), boff = lds_byte(wc * 32 + fr, fq * 8);
#define PG8_SA(b, h) (((b) * 2 + (h)) * HTB)
#define PG8_SB(b, h) ((4 + (b) * 2 + (h)) * HTB)
#define PG8_STAGE(bufoff, gbase, voff) do { _Pragma("unroll") for (int _i = 0; _i < 2; ++_i) \
        __builtin_amdgcn_global_load_lds((const unsigned*)((const char*)(gbase) + (voff)[_i]), (LAS unsigned*)(lds + (bufoff) + ldsw + _i * 8192), 16, 0, 0); } while (0)
#define PG8_LDA(dst, b, h) do { _Pragma("unroll") for (int m = 0; m < 4; ++m) _Pragma("unroll") for (int k = 0; k < 2; ++k) dst[m][k] = *(const LAS bf16x8*)(lds + PG8_SA(b, h) + aoff + m * 2048 + k * 1024); } while (0)
#define PG8_LDB(dst, b, h) do { _Pragma("unroll") for (int n = 0; n < 2; ++n) _Pragma("unroll") for (int k = 0; k < 2; ++k) dst[n][k] = *(const LAS bf16x8*)(lds + PG8_SB(b, h) + boff + n * 2048 + k * 1024); } while (0)
#define PG8_MMA(ai, bj, At, Bt) do { __builtin_amdgcn_s_setprio(1); _Pragma("unroll") for (int m = 0; m < 4; ++m) _Pragma("unroll") for (int n = 0; n < 2; ++n) _Pragma("unroll") for (int k = 0; k < 2; ++k) \
        acc[ai][bj][m][n] = __builtin_amdgcn_mfma_f32_16x16x32_bf16(Bt[n][k], At[m][k], acc[ai][bj][m][n], 0, 0, 0); __builtin_amdgcn_s_setprio(0); } while (0)
#define PG8_WAIT_V(n) asm volatile("s_waitcnt vmcnt(" #n ")" ::: "memory")
#define PG8_WAIT_L(n) asm volatile("s_waitcnt lgkmcnt(" #n ")" ::: "memory")
#define PG8_BAR __builtin_amdgcn_s_barrier()
#define PG8_SCHED __builtin_amdgcn_sched_barrier(0)
    Unit cur, nxt; int ui = 0;
    if (!S.next(0, cur)) return;
    f32x4 acc[2][2][4][2];
#pragma unroll
    for (int a = 0; a < 2; ++a)
#pragma unroll
        for (int b = 0; b < 2; ++b)
#pragma unroll
            for (int m = 0; m < 4; ++m)
#pragma unroll
                for (int n = 0; n < 2; ++n) acc[a][b][m][n] = (f32x4){0.f, 0.f, 0.f, 0.f};
    bf16x8 At[4][2], B0[2][2], B1[2][2];
    const char* cA = cur.a; const char* cB = cur.b;
    PG8_GATHER(vA, cur);
    if constexpr (FUSED == 2) { PG8_BOFF(voffB, cur); hsBc = (size_t)HALF * cur.pb; }
    if constexpr (FUSED != 0) S.a_ready(cur);
    { const bool last = false;
    if constexpr (SP2) {
        PG8_STAGE_B(PG8_SB(0, 0), cB, 0, false); PG8_STAGE_B(PG8_SB(0, 1), cB, 1, false); PG8_STAGE(PG8_SA(0, 0), cA, vA[0]); PG8_STAGE(PG8_SA(0, 1), cA, vA[1]);
        if (wr == 1) PG8_BAR;
        PG8_WAIT_V(2); PG8_BAR;
        PG8_STAGE_B(PG8_SB(1, 0), cB + kstep, 0, false); PG8_STAGE(PG8_SA(1, 0), cA + kstep, vA[0]); PG8_STAGE_B(PG8_SB(1, 1), cB + kstep, 1, false);
        PG8_WAIT_V(6); PG8_BAR;
    } else {
        PG8_STAGE_B(PG8_SB(0, 0), cB, 0, false); PG8_STAGE(PG8_SA(0, 0), cA, vA[0]); PG8_STAGE_B(PG8_SB(0, 1), cB, 1, false); PG8_STAGE(PG8_SA(0, 1), cA, vA[1]);
        if (wr == 1) PG8_BAR;
        PG8_WAIT_V(4); PG8_BAR;
        PG8_STAGE_B(PG8_SB(1, 0), cB + kstep, 0, false); PG8_STAGE(PG8_SA(1, 0), cA + kstep, vA[0]); PG8_STAGE_B(PG8_SB(1, 1), cB + kstep, 1, false);
        PG8_WAIT_V(6); PG8_BAR;
    }
    }
    for (;;) {
        const bool has_next = S.next(ui + 1, nxt);
        const char* nA = has_next ? nxt.a : cA; const char* nB = has_next ? nxt.b : cB;
        if (has_next) { PG8_GATHER(vN, nxt); if constexpr (FUSED == 2) { PG8_BOFF(vBn, nxt); hsBn = (size_t)HALF * nxt.pb; } }
        const int nt = cur.nt;
        for (int t = 0; t < nt; t += 2) {
            const bool last = (t == nt - 2);
            const char* a1 = cA + (size_t)(t + 1) * kstep;
            const char* a2 = last ? nA : cA + (size_t)(t + 2) * kstep; const char* b2 = last ? nB : cB + (size_t)(t + 2) * kstep;
            const char* a3 = a2 + kstep; const char* b3 = b2 + kstep;
            if constexpr (FUSED != 0) { if (last && has_next) S.a_ready(nxt); }
            unsigned vX[2][2];
#pragma unroll
            for (int _h = 0; _h < 2; ++_h)
#pragma unroll
                for (int _i = 0; _i < 2; ++_i) vX[_h][_i] = (GATHER && last) ? vN[_h][_i] : vA[_h][_i];
            if constexpr (SP2) {
            PG8_LDB(B0, 0, 0); PG8_LDB(B1, 0, 1); PG8_SCHED; PG8_LDA(At, 0, 0); PG8_STAGE(PG8_SA(1, 1), a1, vA[1]);
            PG8_WAIT_V(8); PG8_WAIT_L(0); PG8_BAR; PG8_MMA(0, 0, At, B0); PG8_MMA(0, 1, At, B1); PG8_BAR; PG8_SCHED;
            PG8_LDA(At, 0, 1); PG8_STAGE_B(PG8_SB(0, 0), b2, 0, true); PG8_STAGE_B(PG8_SB(0, 1), b2, 1, true); PG8_STAGE(PG8_SA(0, 0), a2, vX[0]);
            PG8_WAIT_V(8); PG8_WAIT_L(0); PG8_BAR; PG8_MMA(1, 0, At, B0); PG8_MMA(1, 1, At, B1); PG8_BAR; PG8_SCHED;
            PG8_LDB(B0, 1, 0); PG8_LDB(B1, 1, 1); PG8_SCHED; PG8_LDA(At, 1, 0); PG8_STAGE(PG8_SA(0, 1), a2, vX[1]);
            PG8_WAIT_V(8); PG8_WAIT_L(0); PG8_BAR; PG8_MMA(0, 0, At, B0); PG8_MMA(0, 1, At, B1); PG8_BAR; PG8_SCHED;
            PG8_LDA(At, 1, 1); PG8_STAGE_B(PG8_SB(1, 0), b3, 0, true); PG8_STAGE_B(PG8_SB(1, 1), b3, 1, true); PG8_STAGE(PG8_SA(1, 0), a3, vX[0]);
            PG8_WAIT_V(8); PG8_WAIT_L(0); PG8_BAR; PG8_MMA(1, 0, At, B0); PG8_MMA(1, 1, At, B1); PG8_BAR; PG8_SCHED;
            } else {
            PG8_LDB(B0, 0, 0); PG8_SCHED; PG8_LDA(At, 0, 0); PG8_STAGE(PG8_SA(1, 1), a1, vA[1]);
            PG8_WAIT_L(8); PG8_BAR; PG8_WAIT_L(0); PG8_MMA(0, 0, At, B0); PG8_BAR; PG8_SCHED;
            PG8_LDB(B1, 0, 1); PG8_STAGE_B(PG8_SB(0, 0), b2, 0, true);
            PG8_BAR; PG8_WAIT_L(0); PG8_MMA(0, 1, At, B1); PG8_BAR;
            PG8_LDA(At, 0, 1); PG8_STAGE(PG8_SA(0, 0), a2, vX[0]);
            PG8_BAR; PG8_WAIT_L(0); PG8_MMA(1, 0, At, B0); PG8_BAR; PG8_SCHED;
            PG8_STAGE_B(PG8_SB(0, 1), b2, 1, true);
            PG8_WAIT_V(6); PG8_BAR; PG8_MMA(1, 1, At, B1); PG8_BAR;
            PG8_LDB(B0, 1, 0); PG8_SCHED; PG8_LDA(At, 1, 0); PG8_STAGE(PG8_SA(0, 1), a2, vX[1]);
            PG8_WAIT_L(8); PG8_BAR; PG8_WAIT_L(0); PG8_MMA(0, 0, At, B0); PG8_BAR; PG8_SCHED;
            PG8_LDB(B1, 1, 1); PG8_STAGE_B(PG8_SB(1, 0), b3, 0, true);
            PG8_BAR; PG8_WAIT_L(0); PG8_MMA(0, 1, At, B1); PG8_BAR;
            PG8_LDA(At, 1, 1); PG8_STAGE(PG8_SA(1, 0), a3, vX[0]);
            PG8_BAR; PG8_WAIT_L(0); PG8_MMA(1, 0, At, B0); PG8_BAR; PG8_SCHED;
            PG8_STAGE_B(PG8_SB(1, 1), b3, 1, true);
            PG8_WAIT_V(6); PG8_BAR; PG8_MMA(1, 1, At, B1); PG8_BAR;
            }
        }
        if constexpr (ALIGN_EPI) { if (wr == 0) PG8_BAR; }
        E(acc, cur, wr, wc, fr, fq);
        if (!has_next) break;
#pragma unroll
        for (int a = 0; a < 2; ++a)
#pragma unroll
            for (int b = 0; b < 2; ++b)
#pragma unroll
                for (int m = 0; m < 4; ++m)
#pragma unroll
                    for (int n = 0; n < 2; ++n) acc[a][b][m][n] = (f32x4){0.f, 0.f, 0.f, 0.f};
        cur = nxt; cA = nA; cB = nB; ++ui;
        if constexpr (GATHER) {
#pragma unroll
            for (int _h = 0; _h < 2; ++_h)
#pragma unroll
                for (int _i = 0; _i < 2; ++_i) vA[_h][_i] = vN[_h][_i]; }
        if constexpr (FUSED == 2) { voffB[0] = vBn[0]; voffB[1] = vBn[1]; hsBc = hsBn; }
        if constexpr (ALIGN_EPI) { if (wr == 1) PG8_BAR; }
    }
    PG8_WAIT_V(0);
    if constexpr (!ALIGN_EPI) { if (wr == 0) PG8_BAR; }
    PG8_BAR;
#undef PG8_GATHER
#undef PG8_BOFF
#undef PG8_STAGE_B
#undef PG8_SA
#undef PG8_SB
#undef PG8_STAGE
#undef PG8_LDA
#undef PG8_LDB
#undef PG8_MMA
#undef PG8_WAIT_V
#undef PG8_WAIT_L
#undef PG8_BAR
#undef PG8_SCHED
}
}

#define XB_TMO      128
#define XB_XCNT(j)  (256  + 64 * (j))
#define XB_XSUB(j)  (1280 + 64 * (j))
#define XB_XGEN(j)  (2304 + 64 * (j))
#define XB_TOP      3328
#define XB_TOPGEN   3392
#define XCD_BAR_WORDS 3456
#define XB_SPIN_CAP (1u << 18)

__device__ __forceinline__ unsigned xb_ld(unsigned* p)              { return __hip_atomic_load(p, __ATOMIC_RELAXED, __HIP_MEMORY_SCOPE_AGENT); }
__device__ __forceinline__ unsigned xb_add(unsigned* p, unsigned v) { return __hip_atomic_fetch_add(p, v, __ATOMIC_RELAXED, __HIP_MEMORY_SCOPE_AGENT); }
__device__ __forceinline__ unsigned xb_xcc_id() { return (unsigned)__builtin_amdgcn_s_getreg((3 << 11) | 20) & 0xFu; }
#define XB_SPIN(cond, bar) do { unsigned _sp = 0; while (cond) { __builtin_amdgcn_s_sleep(1); \
    if ((++_sp & 255u) == 0u) { if (xb_ld(&(bar)[XB_TMO])) break; if (_sp > XB_SPIN_CAP) { atomicAdd(&(bar)[XB_TMO], 1u); break; } } } } while (0)

struct XcdBarrier { unsigned* bar; unsigned x; volatile LAS unsigned* st; };

__device__ __forceinline__ XcdBarrier xcd_barrier_post(unsigned* bar, volatile LAS unsigned* st) {
    XcdBarrier b; b.bar = bar; b.x = xb_xcc_id(); b.st = st;
    if (threadIdx.x == 0) (void)xb_add(&bar[XB_XCNT(b.x)], 1u);
    return b;
}
__device__ __forceinline__ void xcd_barrier_complete(unsigned* bar, unsigned x, unsigned& nloc, unsigned& nx) {
    const unsigned G = gridDim.x * gridDim.y * gridDim.z;
    unsigned sum, cnt, mine, sp = 0u;
    for (;;) {
        sum = 0u; cnt = 0u; mine = 0u;
#pragma unroll
        for (unsigned j = 0; j < 16; ++j) { const unsigned c = xb_ld(&bar[XB_XCNT(j)]); sum += c; cnt += (c > 0u) ? 1u : 0u; mine = (j == x) ? c : mine; }
        if (sum == G) break;
        __builtin_amdgcn_s_sleep(1);
        if ((++sp & 255u) == 0u) { if (xb_ld(&bar[XB_TMO])) break; if (sp > XB_SPIN_CAP) { atomicAdd(&bar[XB_TMO], 1u); break; } }
    }
    nloc = mine > 0u ? mine : 1u; nx = cnt > 0u ? cnt : 1u;
}
__device__ __forceinline__ void xcd_barrier(const XcdBarrier& b) {
    asm volatile("s_waitcnt vmcnt(0)" ::: "memory");
    __syncthreads();
    if (threadIdx.x == 0) {
        unsigned* bar = b.bar;
        __builtin_amdgcn_s_waitcnt(0);
        unsigned nloc = b.st[0], nx = b.st[1];
        if (nloc == 0u) { xcd_barrier_complete(bar, b.x, nloc, nx); b.st[0] = nloc; b.st[1] = nx; }
        const unsigned old = xb_add(&bar[XB_XSUB(b.x)], 1u);
        const unsigned gen = old / nloc;
        if (old + 1u == (gen + 1u) * nloc) {
            __builtin_amdgcn_fence(__ATOMIC_RELEASE, "agent");
            asm volatile("s_waitcnt vmcnt(0)" ::: "memory");
            const unsigned og = xb_add(&bar[XB_TOP], 1u);
            const unsigned tg = og / nx;
            if (og + 1u == (tg + 1u) * nx) xb_add(&bar[XB_TOPGEN], 1u);
            else XB_SPIN(xb_ld(&bar[XB_TOPGEN]) == tg, bar);
            __builtin_amdgcn_fence(__ATOMIC_ACQUIRE, "agent");
            xb_add(&bar[XB_XGEN(b.x)], 1u);
            asm volatile("s_waitcnt vmcnt(0)" ::: "memory");
        } else {
            XB_SPIN(xb_ld(&bar[XB_XGEN(b.x)]) == gen, bar);
            __builtin_amdgcn_fence(__ATOMIC_ACQUIRE, "agent");
            asm volatile("s_waitcnt vmcnt(0)" ::: "memory");
        }
    }
    __syncthreads();
}

struct Args { const float* in[32]; float* out; unsigned char* ws; int ph_lo, ph_hi; };
enum { I_X = 0, I_C, I_CTX, I_CCTX, I_ADAW, I_ADAB, I_NORMG, I_MU, I_WRKV, I_W0, I_W1, I_W2, I_A0, I_A1, I_A2, I_G1, I_G2, I_KK, I_KA, I_RK, I_GNW, I_GNB, I_WO,
       I_WIN, I_CONV, I_WOUT, I_ROUTW, I_ROUTB, I_MGATE, I_MUP, I_MDOWN, I_FINALG };

struct Frame {
    LAS unsigned char* lds;
    int tid, lane, wave, G, vcu, gw, NGW;
};


__device__ __forceinline__ void tr_item(const float* W, int ldw, int k0, int n0, bf16_t* dst, int ldd, int drow0, const float* mu, LAS float* scr, int lane) {
#pragma unroll 8
    for (int i = 0; i < 32; ++i) { const int kk = 2 * i + (lane >> 5); scr[kk * 33 + (lane & 31)] = W[(size_t)(k0 + kk) * ldw + n0 + (lane & 31)]; }
    LDS_WAIT(); asm volatile("" ::: "memory");
    const int c = lane & 7;
    float m[8];
#pragma unroll
    for (int q = 0; q < 8; ++q) m[q] = mu ? mu[k0 + 8 * c + q] : 0.f;
#pragma unroll
    for (int j = 0; j < 4; ++j) { const int n = (lane >> 3) + 8 * j; const LAS float* s = scr + (8 * c) * 33 + n;
        float v[8];
#pragma unroll
        for (int q = 0; q < 8; ++q) v[q] = s[q * 33];
        bf16_t* drow = dst + (size_t)(drow0 + n) * ldd + k0 + 8 * c;
        if (!mu) {
            u32x4 o; o.x = pk2(v[0], v[1]); o.y = pk2(v[2], v[3]); o.z = pk2(v[4], v[5]); o.w = pk2(v[6], v[7]);
            *(u32x4*)drow = o;
        } else {
            u32x4 o; o.x = pk2(v[0] * (1.f - m[0]), v[1] * (1.f - m[1])); o.y = pk2(v[2] * (1.f - m[2]), v[3] * (1.f - m[3]));
            o.z = pk2(v[4] * (1.f - m[4]), v[5] * (1.f - m[5])); o.w = pk2(v[6] * (1.f - m[6]), v[7] * (1.f - m[7]));
            *(u32x4*)drow = o;
            u32x4 p; p.x = pk2(v[0] * 0.5f * m[0], v[1] * 0.5f * m[1]); p.y = pk2(v[2] * 0.5f * m[2], v[3] * 0.5f * m[3]);
            p.z = pk2(v[4] * 0.5f * m[4], v[5] * 0.5f * m[5]); p.w = pk2(v[6] * 0.5f * m[6], v[7] * 0.5f * m[7]);
            *(u32x4*)(drow + 1024) = p;
        }
    }
    LDS_WAIT(); asm volatile("" ::: "memory");
}
__device__ __forceinline__ void tr_job_item(const float* W, int ldw, int N, bf16_t* dst, int ldd, int drow_base, bool il, const float* mu, int item, LAS float* scr, int lane) {
    const int nblk = N / 32, kb = item / nblk, nb = item % nblk, n0 = 32 * nb;
    const int dr = drow_base + (il ? ((n0 >> 7) * 256 + (n0 & 127)) : n0);
    tr_item(W, ldw, 64 * kb, n0, dst, ldd, dr, mu, scr, lane);
}

__device__ __forceinline__ void p0_prologue(const Frame& F, const Args& A) {
    unsigned char* ws = A.ws;
    LAS float* scr = (LAS float*)(F.lds + F.wave * 16384);
    bf16_t* WRKV = (bf16_t*)(ws + WS_WRKV); bf16_t* WL = (bf16_t*)(ws + WS_WL); bf16_t* G2 = (bf16_t*)(ws + WS_G2);
    bf16_t* WO = (bf16_t*)(ws + WS_WO); bf16_t* WIN = (bf16_t*)(ws + WS_WIN); bf16_t* WOUT = (bf16_t*)(ws + WS_WOUT);
    const float* mu = A.in[I_MU];
    constexpr int NIT = 3 * 512 + 4 * 32 + 64 + 64 + 512 + 3 * 512 + 512;
    for (int it = F.gw; it < NIT; it += F.NGW) {
        int r = it;
        if (r < 1536) { const int p = r / 512; tr_job_item(A.in[I_WRKV] + (size_t)p * D * D, D, D, WRKV, 2048, p * 1024, false, nullptr, r % 512, scr, F.lane); continue; } r -= 1536;
        if (r < 64) { const int dir = r / 32; tr_job_item(A.in[I_W1] + (size_t)dir * D * 64, 64, 64, WL, 2048, dir * 64, false, mu + 3 * D, r % 32, scr, F.lane); continue; } r -= 64;
        if (r < 64) { const int dir = r / 32; tr_job_item(A.in[I_A1] + (size_t)dir * D * 64, 64, 64, WL, 2048, 128 + dir * 64, false, mu + 4 * D, r % 32, scr, F.lane); continue; } r -= 64;
        if (r < 64) { tr_job_item(A.in[I_G1], 128, 128, WL, 2048, 256, false, mu + 5 * D, r, scr, F.lane); continue; } r -= 64;
        if (r < 64) { tr_job_item(A.in[I_G2], D, D, G2, 256, 0, false, nullptr, r, scr, F.lane); continue; } r -= 64;
        if (r < 512) { tr_job_item(A.in[I_WO], D, D, WO, D, 0, false, nullptr, r, scr, F.lane); continue; } r -= 512;
        if (r < 512) { tr_job_item(A.in[I_WIN], 3 * D, D, WIN, D, 0, false, nullptr, r, scr, F.lane); continue; } r -= 512;
        if (r < 512) { tr_job_item(A.in[I_WIN] + D, 3 * D, D, WIN, D, 1024, true, nullptr, r, scr, F.lane); continue; } r -= 512;
        if (r < 512) { tr_job_item(A.in[I_WIN] + 2 * D, 3 * D, D, WIN, D, 1024 + 128, true, nullptr, r, scr, F.lane); continue; } r -= 512;
        tr_job_item(A.in[I_WOUT], D, D, WOUT, D, 0, false, nullptr, r, scr, F.lane);
    }
    {
        const int gt = F.vcu * NTHREADS + F.tid, NGT = F.G * NTHREADS;
        u32x4 z = (u32x4){0u, 0u, 0u, 0u};
        for (int i = gt; i < 32768; i += NGT) ((u32x4*)(WL + (size_t)384 * 2048))[i] = z;
        for (int i = gt; i < 16384; i += NGT) { const int row = i >> 4, q = i & 15; *(u32x4*)(G2 + (size_t)row * 256 + 128 + q * 8) = z; }
    }
    __syncthreads();
    {
        LAS float* st = (LAS float*)F.lds;
        LAS float* red = st + 9 * 1024;
        for (int i = F.tid; i < 9 * 1024; i += NTHREADS) { const float v = (i < 8192) ? A.in[I_C][i] : A.in[I_CCTX][i - 8192]; st[i] = v / (1.f + __expf(-v)); }
        __syncthreads();
        float* MOD = (float*)(ws + WS_MOD);
        for (int u = blockIdx.x; u < 256; u += F.G) {
            const int l = u >> 7, e0 = (u & 127) * 48;
            if (F.tid < 384) {
                const int q = F.tid % 12, dg = F.tid / 12;
                f32x4 acc[9];
#pragma unroll
                for (int r = 0; r < 9; ++r) acc[r] = (f32x4){0.f, 0.f, 0.f, 0.f};
                const float* wb = A.in[I_ADAW] + (size_t)l * D * 6144 + e0 + 4 * q;
#pragma unroll 4
                for (int i = 0; i < 32; ++i) { const int d = dg + 32 * i; const f32x4 w = *(const f32x4*)(wb + (size_t)d * 6144);
#pragma unroll
                    for (int r = 0; r < 9; ++r) acc[r] += st[r * 1024 + d] * w; }
#pragma unroll
                for (int r = 0; r < 9; ++r) *(LAS f32x4*)(red + (dg * 9 + r) * 48 + 4 * q) = acc[r];
            }
            __syncthreads();
            if (F.tid < 432) { const int r = F.tid / 48, ci = F.tid % 48; float s = A.in[I_ADAB][l * 6144 + e0 + ci];
                for (int dg = 0; dg < 32; ++dg) s += red[(dg * 9 + r) * 48 + ci];
                MOD[((size_t)l * 9 + r) * 6144 + e0 + ci] = s; }
            __syncthreads();
        }
    }
}

__device__ __forceinline__ void p1_load_norm(const float* row, const f32x4 (&gsc)[4], const f32x4 (&sh)[4], f32x4 (&o)[4], int lane) {
    const f32x4* xr = (const f32x4*)row + lane; float s = 0.f;
#pragma unroll
    for (int j = 0; j < 4; ++j) { o[j] = xr[64 * j]; s += (o[j].x * o[j].x + o[j].y * o[j].y) + (o[j].z * o[j].z + o[j].w * o[j].w); }
    const float rstd = rsqrtf(wave_sum(s) * (1.f / D) + RMS_EPS);
#pragma unroll
    for (int j = 0; j < 4; ++j) o[j] = o[j] * rstd * gsc[j] + sh[j];
}
__device__ __forceinline__ void st_bf4(bf16_t* p, const f32x4 v) { u32x2 w; w.x = pk2(v.x, v.y); w.y = pk2(v.z, v.w); *(u32x2*)p = w; }

__device__ __forceinline__ void p1_mix(const Frame& F, const Args& A) {
    const float* MOD = (const float*)(A.ws + WS_MOD);
    bf16_t* XM = (bf16_t*)(A.ws + WS_XM);
    const float* mu = A.in[I_MU]; const float* ng = A.in[I_NORMG];
    for (int u = F.gw; u < 2176; u += F.NGW) {
        const bool isctx = u >= 2048; int t0, rowlen, modrow; const float* src; size_t orow0;
        if (!isctx) { t0 = u * 16; rowlen = GRIDW; modrow = t0 / TL; src = A.in[I_X] + (size_t)t0 * D; orow0 = t0; }
        else { t0 = (u - 2048) * 16; rowlen = TCX; modrow = 8; src = A.in[I_CTX] + (size_t)t0 * D; orow0 = (size_t)ML + t0; }
        const int pos0 = t0 % rowlen;
        const float* mrow = MOD + (size_t)modrow * 6144;
        f32x4 gsc[4], sh[4], m0[4], m1[4], m2[4];
#pragma unroll
        for (int j = 0; j < 4; ++j) { const int c = 4 * F.lane + 256 * j;
            const f32x4 g = *(const f32x4*)(ng + c), sc = *(const f32x4*)(mrow + 1024 + c);
            gsc[j] = g * (1.f + sc); sh[j] = *(const f32x4*)(mrow + c);
            m0[j] = *(const f32x4*)(mu + c); m1[j] = *(const f32x4*)(mu + D + c); m2[j] = *(const f32x4*)(mu + 2 * D + c); }
        f32x4 prev[4], cur[4], nxt[4];
        if (pos0 > 0) p1_load_norm(src - D, gsc, sh, prev, F.lane);
        else {
#pragma unroll
            for (int j = 0; j < 4; ++j) prev[j] = (f32x4){0.f, 0.f, 0.f, 0.f}; }
        p1_load_norm(src, gsc, sh, cur, F.lane);
        for (int i = 0; i < 16; ++i) {
            if (pos0 + i + 1 < rowlen) p1_load_norm(src + (size_t)(i + 1) * D, gsc, sh, nxt, F.lane);
            else {
#pragma unroll
                for (int j = 0; j < 4; ++j) nxt[j] = (f32x4){0.f, 0.f, 0.f, 0.f}; }
            bf16_t* orow = XM + (orow0 + i) * XM_LD + 4 * F.lane;
#pragma unroll
            for (int j = 0; j < 4; ++j) {
                const f32x4 s = prev[j] + nxt[j], xx = 0.5f * s - cur[j];
                st_bf4(orow + 256 * j, cur[j] + xx * m0[j]);
                st_bf4(orow + D + 256 * j, cur[j] + xx * m1[j]);
                st_bf4(orow + 2 * D + 256 * j, cur[j] + xx * m2[j]);
                st_bf4(orow + 3 * D + 256 * j, cur[j]);
                st_bf4(orow + 4 * D + 256 * j, s);
                prev[j] = cur[j]; cur[j] = nxt[j];
            }
        }
    }
}

struct SchedRKV {
    const char* xm; const char* w; int G, c;
    __device__ __forceinline__ bool next(int i, pg8::Unit& u) const {
        int L;
        if (G == 256) { const int n = c < 80 ? 7 : (c < 240 ? 6 : 5); if (i >= n) return false; L = i < 5 ? c + 256 * i : (i == 5 ? 1280 + c : 1520 + c); }
        else { L = i * G + c; if (L >= 1600) return false; }
        if (L < 1536) pg8::swz_tile(L, 128, 12, u.pm, u.pn); else { const int r = L - 1536; u.pm = 128 + (r >> 3); u.pn = 4 + (r & 7); }
        u.a = xm + (size_t)u.pm * 256 * XM_LD * 2 + (size_t)(u.pn >> 2) * D * 2; u.b = w + (size_t)u.pn * 256 * 2048 * 2; u.nt = 16; u.rows = nullptr; return true;
    }
};
struct EpiRKV {
    static constexpr bool PERM = true;
    bf16_t *R, *K, *KC, *V;
    __device__ __forceinline__ void operator()(const f32x4 (&acc)[2][2][4][2], const pg8::Unit& u, int wr, int wc, int fr, int fq) const {
        const int grp = u.pn >> 2; int prow = u.pm * 256; bf16_t* base;
        if (grp == 0) base = R; else if (grp == 1) { if (u.pm < 128) base = K; else { base = KC; prow -= ML; } } else base = V;
        const int row0 = prow + wr * 64 + fr, col0 = (u.pn & 3) * 256 + wc * 32 + 8 * fq;
#pragma unroll
        for (int ai = 0; ai < 2; ++ai)
#pragma unroll
            for (int m = 0; m < 4; ++m) { bf16_t* rowp = base + (size_t)(row0 + ai * 128 + m * 16) * D + col0;
#pragma unroll
                for (int bj = 0; bj < 2; ++bj) { const f32x4 v0 = acc[ai][bj][m][0], v1 = acc[ai][bj][m][1];
                    u32x4 w; w.x = pg8::cvt_pk_bf16(v0[0], v0[1]); w.y = pg8::cvt_pk_bf16(v0[2], v0[3]); w.z = pg8::cvt_pk_bf16(v1[0], v1[1]); w.w = pg8::cvt_pk_bf16(v1[2], v1[3]);
                    *(u32x4*)(rowp + bj * 128) = w; } }
    }
};
struct SchedLora {
    const char* xm; const char* w; int G, c;
    __device__ __forceinline__ bool next(int i, pg8::Unit& u) const {
        int L;
        if (G == 256) { if (i > 1 || (i == 1 && c < 240)) return false; L = i ? 256 + (c - 240) : c; }
        else { L = i * G + c; if (L >= 272) return false; }
        u.pm = L >> 1; u.pn = L & 1;
        u.a = xm + (size_t)u.pm * 256 * XM_LD * 2 + (size_t)3 * D * 2; u.b = w + (size_t)u.pn * 256 * 2048 * 2; u.nt = 32; u.rows = nullptr; return true;
    }
};
struct EpiLora {
    static constexpr bool PERM = true;
    bf16_t *LWA, *LG;
    __device__ __forceinline__ void operator()(const f32x4 (&acc)[2][2][4][2], const pg8::Unit& u, int wr, int wc, int fr, int fq) const {
        bf16_t* base = u.pn ? LG : LWA;
        const int row0 = u.pm * 256 + wr * 64 + fr, col0 = wc * 32 + 8 * fq;
#pragma unroll
        for (int ai = 0; ai < 2; ++ai)
#pragma unroll
            for (int m = 0; m < 4; ++m) { bf16_t* rowp = base + (size_t)(row0 + ai * 128 + m * 16) * 256 + col0;
#pragma unroll
                for (int bj = 0; bj < 2; ++bj) { f32x4 v0 = acc[ai][bj][m][0], v1 = acc[ai][bj][m][1];
                    if (bj == 0) {
                        if (u.pn == 0) {
#pragma unroll
                            for (int q = 0; q < 4; ++q) { v0[q] = 1.f - 2.f / (__expf(2.f * v0[q]) + 1.f); v1[q] = 1.f - 2.f / (__expf(2.f * v1[q]) + 1.f); }
                        } else {
#pragma unroll
                            for (int q = 0; q < 4; ++q) { v0[q] = sigmoidf_(v0[q]); v1[q] = sigmoidf_(v1[q]); }
                        }
                    } else if (u.pn == 1) { v0 = (f32x4){0.f, 0.f, 0.f, 0.f}; v1 = v0; }
                    u32x4 w; w.x = pg8::cvt_pk_bf16(v0[0], v0[1]); w.y = pg8::cvt_pk_bf16(v0[2], v0[3]); w.z = pg8::cvt_pk_bf16(v1[0], v1[1]); w.w = pg8::cvt_pk_bf16(v1[2], v1[3]);
                    *(u32x4*)(rowp + bj * 128) = w; } }
    }
};
struct SchedPlain {
    const char* a; const char* b; int nM, nN, lda, ldb, nt, G, c;
    __device__ __forceinline__ bool next(int i, pg8::Unit& u) const {
        const int L = i * G + c; if (L >= nM * nN) return false;
        pg8::swz_tile(L, nM, nN, u.pm, u.pn);
        u.a = a + (size_t)u.pm * 256 * lda * 2; u.b = b + (size_t)u.pn * 256 * ldb * 2; u.nt = nt; u.rows = nullptr; return true;
    }
};
struct EpiBf16 {
    static constexpr bool PERM = true;
    bf16_t* O; int ldc;
    __device__ __forceinline__ void operator()(const f32x4 (&acc)[2][2][4][2], const pg8::Unit& u, int wr, int wc, int fr, int fq) const {
        const int row0 = u.pm * 256 + wr * 64 + fr, col0 = u.pn * 256 + wc * 32 + 8 * fq;
#pragma unroll
        for (int ai = 0; ai < 2; ++ai)
#pragma unroll
            for (int m = 0; m < 4; ++m) { bf16_t* rowp = O + (size_t)(row0 + ai * 128 + m * 16) * ldc + col0;
#pragma unroll
                for (int bj = 0; bj < 2; ++bj) { const f32x4 v0 = acc[ai][bj][m][0], v1 = acc[ai][bj][m][1];
                    u32x4 w; w.x = pg8::cvt_pk_bf16(v0[0], v0[1]); w.y = pg8::cvt_pk_bf16(v0[2], v0[3]); w.z = pg8::cvt_pk_bf16(v1[0], v1[1]); w.w = pg8::cvt_pk_bf16(v1[2], v1[3]);
                    *(u32x4*)(rowp + bj * 128) = w; } }
    }
};
struct EpiRes {
    static constexpr bool PERM = false;
    const float* base; float* out; const float* gate;
    __device__ __forceinline__ void operator()(const f32x4 (&acc)[2][2][4][2], const pg8::Unit& u, int wr, int wc, int fr, int fq) const {
        const int row0 = u.pm * 256 + wr * 64 + fr, col0 = u.pn * 256 + wc * 32 + 4 * fq;
        const float* gp = gate + (size_t)(u.pm >> 4) * 6144 + col0;
        f32x4 gv[2][2];
#pragma unroll
        for (int bj = 0; bj < 2; ++bj)
#pragma unroll
            for (int n = 0; n < 2; ++n) gv[bj][n] = *(const f32x4*)(gp + bj * 128 + n * 16);
#pragma unroll
        for (int ai = 0; ai < 2; ++ai)
#pragma unroll
            for (int m = 0; m < 4; ++m) { const size_t ro = (size_t)(row0 + ai * 128 + m * 16) * D + col0;
#pragma unroll
                for (int bj = 0; bj < 2; ++bj)
#pragma unroll
                    for (int n = 0; n < 2; ++n) { const f32x4 b = *(const f32x4*)(base + ro + bj * 128 + n * 16);
                        *(f32x4*)(out + ro + bj * 128 + n * 16) = b + gv[bj][n] * acc[ai][bj][m][n]; } }
    }
};
struct SchedMoe {
    const char* a; const char* b; const int* tile; int lda, ldb, nt, G, c; size_t estride;
    __device__ __forceinline__ bool next(int i, pg8::Unit& u) const {
        const int ntl = tile[0]; const int L = i * G + c; if (L >= ntl * 4) return false;
        u.pm = L >> 2; u.pn = L & 3; const int e = tile[16 + u.pm];
        u.a = a + (size_t)u.pm * 256 * lda * 2; u.b = b + (size_t)e * estride + (size_t)u.pn * 256 * ldb * 2; u.nt = nt; u.rows = nullptr; return true;
    }
};
struct SchedMoeG {
    const char* a; const char* b; const int* tile; const int* inv; int ldb, nt, G, c; size_t estride;
    __device__ __forceinline__ bool next(int i, pg8::Unit& u) const {
        const int ntl = tile[0]; const int L = i * G + c; if (L >= ntl * 4) return false;
        u.pm = L >> 2; u.pn = L & 3; const int e = tile[16 + u.pm];
        u.a = a; u.b = b + (size_t)e * estride + (size_t)u.pn * 256 * ldb * 2; u.nt = nt; u.rows = inv + u.pm * 256; return true;
    }
};
struct EpiGateUp {
    static constexpr bool PERM = true;
    bf16_t* H;
    __device__ __forceinline__ void operator()(const f32x4 (&acc)[2][2][4][2], const pg8::Unit& u, int wr, int wc, int fr, int fq) const {
        const int row0 = u.pm * 256 + wr * 64 + fr, col0 = u.pn * 128 + wc * 32 + 8 * fq;
#pragma unroll
        for (int ai = 0; ai < 2; ++ai)
#pragma unroll
            for (int m = 0; m < 4; ++m) { bf16_t* rowp = H + (size_t)(row0 + ai * 128 + m * 16) * ED + col0;
                f32x4 h0, h1;
#pragma unroll
                for (int q = 0; q < 4; ++q) { const float g0 = acc[ai][0][m][0][q], g1 = acc[ai][0][m][1][q];
                    h0[q] = g0 / (1.f + __expf(-g0)) * acc[ai][1][m][0][q]; h1[q] = g1 / (1.f + __expf(-g1)) * acc[ai][1][m][1][q]; }
                u32x4 w; w.x = pg8::cvt_pk_bf16(h0[0], h0[1]); w.y = pg8::cvt_pk_bf16(h0[2], h0[3]); w.z = pg8::cvt_pk_bf16(h1[0], h1[1]); w.w = pg8::cvt_pk_bf16(h1[2], h1[3]);
                *(u32x4*)rowp = w; }
    }
};
struct EpiGateUpPub {
    static constexpr bool PERM = true;
    unsigned char* H; unsigned* rdy;
    __device__ __forceinline__ void operator()(const f32x4 (&acc)[2][2][4][2], const pg8::Unit& u, int wr, int wc, int fr, int fq) const {
        const int row0 = u.pm * 256 + wr * 64 + fr, col0 = u.pn * 128 + wc * 32 + 8 * fq;
        const __amdgpu_buffer_rsrc_t rsrc = __builtin_amdgcn_make_buffer_rsrc(H, 0, 69632 * ED * 2, 0x00020000);
#pragma unroll
        for (int ai = 0; ai < 2; ++ai)
#pragma unroll
            for (int m = 0; m < 4; ++m) {
                f32x4 h0, h1;
#pragma unroll
                for (int q = 0; q < 4; ++q) { const float g0 = acc[ai][0][m][0][q], g1 = acc[ai][0][m][1][q];
                    h0[q] = g0 / (1.f + __expf(-g0)) * acc[ai][1][m][0][q]; h1[q] = g1 / (1.f + __expf(-g1)) * acc[ai][1][m][1][q]; }
                u32x4 w; w.x = pg8::cvt_pk_bf16(h0[0], h0[1]); w.y = pg8::cvt_pk_bf16(h0[2], h0[3]); w.z = pg8::cvt_pk_bf16(h1[0], h1[1]); w.w = pg8::cvt_pk_bf16(h1[2], h1[3]);
                __builtin_amdgcn_raw_buffer_store_b128(w, rsrc, ((row0 + ai * 128 + m * 16) * ED + col0) * 2, 0, 16);
            }
        asm volatile("s_waitcnt vmcnt(0)" ::: "memory");
        if ((threadIdx.x & 63) == 0) __hip_atomic_fetch_add(rdy + 64 * u.pm, 1u, __ATOMIC_RELAXED, __HIP_MEMORY_SCOPE_AGENT);
    }
};
struct SchedMoeD {
    const char* hh; const char* wdn; const int* tile; unsigned* rdy; unsigned* tmo; int G, c;
    __device__ __forceinline__ bool next(int j, pg8::Unit& u) const {
        const int n1 = tile[0] * 4, q = n1 / G, x = n1 - q * G; int L;
        if (q >= 1 && 3 * x <= G) {
            int nd, base;
            if (c < x) { nd = q - 1; base = c * (q - 1); } else if (c < 3 * x) { nd = q + 1; base = x * (q - 1) + (c - x) * (q + 1); } else { nd = q; base = x * (q - 1) + 2 * x * (q + 1) + (c - 3 * x) * q; }
            if (j >= nd) return false; L = base + j;
        } else { L = j * G + (G - 1 - c); if (L >= n1) return false; }
        u.pm = L >> 2; u.pn = L & 3; u.kind = 1; const int e = tile[16 + u.pm];
        u.a = hh; u.rows = nullptr; u.row0 = u.pm * 256; u.pa = ED * 2; u.pb = ED * 2; u.b = wdn + (size_t)e * (1 * MiB) + (size_t)u.pn * 256 * ED * 2; u.nt = 8;
        return true;
    }
    __device__ __forceinline__ void a_ready(const pg8::Unit& u) const {
        if (threadIdx.x < 64) {
            unsigned* w = rdy + 64 * u.pm; unsigned polls = 0;
            while ((unsigned)__builtin_amdgcn_readfirstlane(__hip_atomic_load(w, __ATOMIC_RELAXED, __HIP_MEMORY_SCOPE_AGENT)) < 32u) {
                if ((++polls & 255u) == 0u) { if (__builtin_amdgcn_readfirstlane(__hip_atomic_load(tmo, __ATOMIC_RELAXED, __HIP_MEMORY_SCOPE_AGENT)) != 0u) break;
                    if (polls > (1u << 22)) { if (threadIdx.x == 0) __hip_atomic_store(tmo, 1u, __ATOMIC_RELAXED, __HIP_MEMORY_SCOPE_AGENT); break; } }
                __builtin_amdgcn_s_sleep(2); }
            __builtin_amdgcn_fence(__ATOMIC_ACQUIRE, "agent");
            asm volatile("s_waitcnt vmcnt(0)" ::: "memory");
        }
        asm volatile("" ::: "memory"); __builtin_amdgcn_s_barrier(); asm volatile("" ::: "memory");
    }
};
struct EpiWin {
    static constexpr bool PERM = true;
    bf16_t *BG, *U;
    __device__ __forceinline__ void operator()(const f32x4 (&acc)[2][2][4][2], const pg8::Unit& u, int wr, int wc, int fr, int fq) const {
        const int row0 = u.pm * 256 + wr * 64 + fr;
        if (u.pn < 4) {
            const int col0 = u.pn * 256 + wc * 32 + 8 * fq;
#pragma unroll
            for (int ai = 0; ai < 2; ++ai)
#pragma unroll
                for (int m = 0; m < 4; ++m) { bf16_t* rowp = BG + (size_t)(row0 + ai * 128 + m * 16) * D + col0;
#pragma unroll
                    for (int bj = 0; bj < 2; ++bj) { const f32x4 v0 = acc[ai][bj][m][0], v1 = acc[ai][bj][m][1];
                        u32x4 w; w.x = pg8::cvt_pk_bf16(v0[0], v0[1]); w.y = pg8::cvt_pk_bf16(v0[2], v0[3]); w.z = pg8::cvt_pk_bf16(v1[0], v1[1]); w.w = pg8::cvt_pk_bf16(v1[2], v1[3]);
                        *(u32x4*)(rowp + bj * 128) = w; } }
        } else {
            const int col0 = (u.pn - 4) * 128 + wc * 32 + 8 * fq;
#pragma unroll
            for (int ai = 0; ai < 2; ++ai)
#pragma unroll
                for (int m = 0; m < 4; ++m) { bf16_t* rowp = U + (size_t)(row0 + ai * 128 + m * 16) * D + col0;
                    const f32x4 v0 = acc[ai][0][m][0] * acc[ai][1][m][0], v1 = acc[ai][0][m][1] * acc[ai][1][m][1];
                    u32x4 w; w.x = pg8::cvt_pk_bf16(v0[0], v0[1]); w.y = pg8::cvt_pk_bf16(v0[2], v0[3]); w.z = pg8::cvt_pk_bf16(v1[0], v1[1]); w.w = pg8::cvt_pk_bf16(v1[2], v1[3]);
                    *(u32x4*)rowp = w; }
        }
    }
};

namespace sc {
constexpr int MPB = 144;
constexpr int MB = 64 * MPB;
constexpr int B_RAWK = 0, B_NAB = 0, B_RAWR = 1, B_NAK = 1, B_LW = 2, B_MRB = 2, B_LA = 3, B_MRK = 3, B_AT = 4, B_BT = 5, B_KT = 6,
              B_RT = 7, B_EL = 8, B_BBT = 9, B_KBT = 10, B_VTT = 11, B_T = 12, B_EH = 12, B_W2T = 13, B_A2T = 14;
constexpr int O_INVN = 15 * MB, O_BONP = O_INVN + 256, O_PV = O_BONP + 1024, O_KKS = O_PV + 256, O_NF = O_KKS + 256;
static_assert(O_NF + 4096 <= LDSCTL_OFF, "scan LDS");
__device__ __forceinline__ bf16x8 ldf(const LAS unsigned char* p) { return *(const LAS bf16x8*)p; }
__device__ __forceinline__ bf16x8 ldfp(const LAS unsigned char* p) {
    const u32x2 lo = *(const LAS u32x2*)p, hi = *(const LAS u32x2*)(p + 32);
    return __builtin_bit_cast(bf16x8, (u32x4){lo.x, lo.y, hi.x, hi.y});
}
__device__ __forceinline__ bf16x8 packfrag(const f32x4 x0, const f32x4 x1) {
    return __builtin_bit_cast(bf16x8, (u32x4){pg8::cvt_pk_bf16(x0[0], x0[1]), pg8::cvt_pk_bf16(x0[2], x0[3]), pg8::cvt_pk_bf16(x1[0], x1[1]), pg8::cvt_pk_bf16(x1[2], x1[3])});
}
__device__ __forceinline__ void st4(LAS unsigned char* p, const f32x4 d) { *(LAS u32x2*)p = (u32x2){pg8::cvt_pk_bf16(d[0], d[1]), pg8::cvt_pk_bf16(d[2], d[3])}; }
__device__ __forceinline__ f32x4 mma(const bf16x8 a, const bf16x8 b, const f32x4 c) { return __builtin_amdgcn_mfma_f32_16x16x32_bf16(a, b, c, 0, 0, 0); }
__device__ __forceinline__ float ld1(const LAS unsigned char* p) { return __builtin_bit_cast(float, (unsigned)(*(const LAS unsigned short*)p) << 16); }
__device__ __forceinline__ void st1(LAS unsigned char* p, float v) { *(LAS unsigned short*)p = (unsigned short)f2bf(v); }
__device__ __forceinline__ float fsig(float x) { return __builtin_amdgcn_rcpf(1.f + __expf(-x)); }
template <int CTRL> __device__ __forceinline__ float dppf(float v) { return __builtin_bit_cast(float, __builtin_amdgcn_update_dpp(0, __builtin_bit_cast(int, v), CTRL, 0xF, 0xF, true)); }
__device__ __forceinline__ float sum8(float v) { v += dppf<0xB1>(v); v += dppf<0x4E>(v); v += dppf<0x141>(v); return v; }
__device__ __forceinline__ float sum16(float v) { v = sum8(v); v += dppf<0x140>(v); return v; }
}

#ifndef SCAN_REP_E1
#define SCAN_REP_E1 1
#endif
#ifndef SCAN_REP_G
#define SCAN_REP_G 1
#endif
#ifndef SCAN_REP_V
#define SCAN_REP_V 1
#endif
#ifndef SCAN_REP_E0
#define SCAN_REP_E0 1
#endif
__device__ __forceinline__ void p3_scan(const Frame& F, const Args& A) {
    using namespace sc;
#define WGBAR() do { asm volatile("s_waitcnt lgkmcnt(0)" ::: "memory"); __builtin_amdgcn_s_barrier(); asm volatile("" ::: "memory"); } while (0)
    unsigned char* ws = A.ws;
    LAS unsigned char* L = F.lds;
    const bf16_t* Rg = (const bf16_t*)A.out; const bf16_t* Kg = Rg + (size_t)ML * D;
    const bf16_t* KCg = (const bf16_t*)(ws + WS_KC); const bf16_t* Vg = (const bf16_t*)(ws + WS_V); const bf16_t* LWAg = (const bf16_t*)(ws + WS_LWA);
    const int wv = F.wave;
    const f32x4 z4 = (f32x4){0.f, 0.f, 0.f, 0.f};
    for (int s = blockIdx.x; s < 256; s += F.G) {
        const int dir = s & 1, h = (s >> 1) & 15, b = s >> 5, c0 = h * HD;
        bf16_t* Yg = (bf16_t*)(ws + (dir ? WS_Y1 : WS_Y0));
        __syncthreads();
        for (int q = F.tid; q < 4096; q += NTHREADS) { const int j = q >> 6, c = q & 63;
            sc::st1(L + B_W2T * MB + c * MPB + j * 2, A.in[I_W2][((size_t)dir * 64 + j) * D + c0 + c]); sc::st1(L + B_A2T * MB + c * MPB + j * 2, A.in[I_A2][((size_t)dir * 64 + j) * D + c0 + c]); }
        if (F.tid < 64) *(LAS float*)(L + O_KKS + F.tid * 4) = A.in[I_KK][c0 + F.tid];
        const int ce = c0 + 16 * (wv & 3) + (F.lane & 15);
        const float w0c = A.in[I_W0][dir * D + ce], a0c = A.in[I_A0][dir * D + ce], kkc = A.in[I_KK][ce], kac = A.in[I_KA][ce], rkc = A.in[I_RK][ce];
        f32x4 S[4];
#pragma unroll
        for (int q = 0; q < 4; ++q) S[q] = z4;
        u32x4 pk_, pr_, pv_, plw_, pla_;
#define SCAN_PREFETCH(gc_, ti_, cg_) do { const int seg_ = (gc_) >= 4, ci_ = seg_ ? (gc_) - 4 : (gc_), Ts_ = seg_ ? TL : TCX; const int tl_ = ci_ * 64 + (ti_), t_ = dir ? (Ts_ - 1 - tl_) : tl_; \
            const size_t arow_ = seg_ ? ((size_t)b * TL + t_) : ((size_t)ML + (size_t)b * TCX + t_); \
            const bf16_t* krow_ = seg_ ? (Kg + ((size_t)b * TL + t_) * D) : (KCg + ((size_t)b * TCX + t_) * D); \
            pk_ = *(const u32x4*)(krow_ + c0 + 8 * (cg_)); pv_ = *(const u32x4*)(Vg + arow_ * D + c0 + 8 * (cg_)); \
            pr_ = (u32x4){0u, 0u, 0u, 0u}; if (seg_) pr_ = *(const u32x4*)(Rg + ((size_t)b * TL + t_) * D + c0 + 8 * (cg_)); \
            plw_ = *(const u32x4*)(LWAg + arow_ * 256 + dir * 64 + 8 * (cg_)); pla_ = *(const u32x4*)(LWAg + arow_ * 256 + 128 + dir * 64 + 8 * (cg_)); } while (0)
        SCAN_PREFETCH(0, (F.tid >> 3), (F.tid & 7));
        __syncthreads();
#pragma unroll 1
        for (int gc = 0; gc < 68; ++gc) {
            const int seg = gc >= 4, ci = seg ? gc - 4 : gc, Tseg = seg ? TL : TCX;
            int tz = F.tid; asm volatile("" : "+v"(tz));
            const int lane = tz & 63, r = lane & 15, g = lane >> 4, ti_ = tz >> 3, cg = tz & 7;
            const int o16 = r * MPB + g * 16;
            const int o8 = r * MPB + g * 8;
            const int oE = g * (4 * MPB) + r * 2;
#pragma unroll 1
            for (int rep_ = 0; rep_ < SCAN_REP_E0; ++rep_)
            {
                LAS unsigned char* st = L + ti_ * MPB + cg * 16;
                *(LAS u32x4*)(st + B_RAWK * MB) = pk_; *(LAS u32x4*)(st + B_RAWR * MB) = pr_; *(LAS u32x4*)(st + B_LW * MB) = plw_; *(LAS u32x4*)(st + B_LA * MB) = pla_;
                const unsigned vw[4] = {pv_.x, pv_.y, pv_.z, pv_.w}, kw[4] = {pk_.x, pk_.y, pk_.z, pk_.w};
                LAS unsigned char* vt = L + B_VTT * MB + cg * (8 * MPB) + ti_ * 2;
                const f32x4 kk0 = *(const LAS f32x4*)(L + O_KKS + cg * 32), kk1 = *(const LAS f32x4*)(L + O_KKS + cg * 32 + 16);
                const float kks[8] = {kk0[0], kk0[1], kk0[2], kk0[3], kk1[0], kk1[1], kk1[2], kk1[3]};
                float ss = 0.f;
#pragma unroll
                for (int q = 0; q < 4; ++q) {
                    *(LAS unsigned short*)(vt + (2 * q) * MPB) = (unsigned short)(vw[q] & 0xffffu);
                    *(LAS unsigned short*)(vt + (2 * q + 1) * MPB) = (unsigned short)(vw[q] >> 16);
                    const float k0 = bflo(kw[q]) * kks[2 * q], k1 = bfhi(kw[q]) * kks[2 * q + 1]; ss += k0 * k0 + k1 * k1; }
                ss = sum8(ss);
                if (cg == 0) *(LAS float*)(L + O_INVN + ti_ * 4) = rsqrtf(fmaxf(ss, 1e-24f));
            }
            WGBAR();
            if (gc + 1 < 68) SCAN_PREFETCH(gc + 1, ti_, cg);
            const int ct = wv & 3, th = wv >> 2;
#pragma unroll 1
            for (int rep_ = 0; rep_ < SCAN_REP_E1; ++rep_) {
            f32x4 aacc[2]; float ev[8];
            {
                f32x4 wacc[2];
                bf16x8 w2f[2], a2f[2];
#pragma unroll
                for (int ks = 0; ks < 2; ++ks) { w2f[ks] = ldf(L + B_W2T * MB + 16 * ct * MPB + 64 * ks + o16); a2f[ks] = ldf(L + B_A2T * MB + 16 * ct * MPB + 64 * ks + o16); }
                const LAS unsigned char* lwb = L + 32 * th * MPB + o16;
#pragma unroll
                for (int tt = 0; tt < 2; ++tt) { wacc[tt] = z4; aacc[tt] = z4;
#pragma unroll
                    for (int ks = 0; ks < 2; ++ks) { wacc[tt] = mma(ldf(lwb + B_LW * MB + 16 * tt * MPB + 64 * ks), w2f[ks], wacc[tt]); aacc[tt] = mma(ldf(lwb + B_LA * MB + 16 * tt * MPB + 64 * ks), a2f[ks], aacc[tt]); } }
                LAS unsigned char* eb2 = L + 16 * ct * MPB + 64 * th + o8;
#pragma unroll
                for (int tt = 0; tt < 2; ++tt) { f32x4 lo;
#pragma unroll
                    for (int q = 0; q < 4; ++q) { const float e = 0.60653066f * fsig(wacc[tt][q] + w0c); ev[4 * tt + q] = e; lo[q] = e - __builtin_bit_cast(float, f2bf(e) << 16); wacc[tt][q] = e; }
                    st4(eb2 + B_EH * MB + 32 * tt, wacc[tt]); st4(eb2 + B_EL * MB + 32 * tt, lo); }
            }
            WGBAR();
            {
                f32x4 Li4[2]; f32x4 tot4 = z4;
                const LAS unsigned char* ehb = L + B_EH * MB + 16 * ct * MPB + o16; const LAS unsigned char* elb = L + B_EL * MB + 16 * ct * MPB + o16;
                const bf16x8 eh0 = ldf(ehb), eh1 = ldf(ehb + 64), el0 = ldf(elb), el1 = ldf(elb + 64);
                const bf16x8 ones = __builtin_bit_cast(bf16x8, (u32x4){0x3F803F80u, 0x3F803F80u, 0x3F803F80u, 0x3F803F80u});
                tot4 = mma(ones, eh0, tot4); tot4 = mma(ones, el0, tot4); tot4 = mma(ones, eh1, tot4); tot4 = mma(ones, el1, tot4);
#pragma unroll
                for (int tt = 0; tt < 2; ++tt) {
                    const int irow = 16 * (2 * th + tt) + r;
                    unsigned tw[2][4];
#pragma unroll
                    for (int ks = 0; ks < 2; ++ks)
#pragma unroll
                        for (int p = 0; p < 4; ++p) { const int j0 = 32 * ks + 8 * g + 2 * p; tw[ks][p] = (j0 <= irow ? 0x3F80u : 0u) | (j0 + 1 <= irow ? 0x3F800000u : 0u); }
                    const bf16x8 t0 = __builtin_bit_cast(bf16x8, (u32x4){tw[0][0], tw[0][1], tw[0][2], tw[0][3]}), t1 = __builtin_bit_cast(bf16x8, (u32x4){tw[1][0], tw[1][1], tw[1][2], tw[1][3]});
                    f32x4 d = z4; d = mma(t0, eh0, d); d = mma(t0, el0, d);
                    if (th) { d = mma(t1, eh1, d); d = mma(t1, el1, d); }
                    Li4[tt] = d;
                }
                const float Pc = __expf(-tot4[0]);
                if (g == 0 && th == 0) *(LAS float*)(L + O_PV + (16 * ct + r) * 4) = Pc;
                LAS unsigned char* eb = L + oE + 32 * ct + 32 * th * MPB;
                LAS unsigned char* cb = L + o8 + 16 * ct * MPB + 64 * th;
#pragma unroll
                for (int tt = 0; tt < 2; ++tt) {
                    const f32x4 inv4 = *(const LAS f32x4*)(L + O_INVN + 128 * th + 64 * tt + g * 16);
                    f32x4 bbv, kbv;
#pragma unroll
                    for (int q = 0; q < 4; ++q) {
                        const int ro = (16 * tt + q) * MPB;
                        const float li = Li4[tt][q], e = ev[4 * tt + q];
                        const float kv = ld1(eb + B_RAWK * MB + ro), rv = ld1(eb + B_RAWR * MB + ro);
                        const float a = fsig(aacc[tt][q] + a0c);
                        const float kkn = kv * kkc * inv4[q];
                        const float beta = kkn * a, kd = kv * (1.f + (a - 1.f) * kac);
                        const float em = __expf(-li), ep = __builtin_amdgcn_rcpf(em), eex = __expf(e - li);
                        const float at = -kkn * eex, bt = beta * ep, kt = kd * ep, rt = rv * em;
                        bbv[q] = bt * Pc; kbv[q] = kt * Pc;
                        st1(eb + B_AT * MB + ro, at); st1(eb + B_BT * MB + ro, bt); st1(eb + B_KT * MB + ro, kt); st1(eb + B_RT * MB + ro, rt);
                        float bp = rv * kd * rkc;
                        bp = sum16(bp);
                        if (r == 0) *(LAS float*)(L + O_BONP + ct * 256 + 128 * th + (16 * tt + q) * 4 + g * 16) = bp;
                    }
                    st4(cb + B_BBT * MB + 32 * tt, bbv); st4(cb + B_KBT * MB + 32 * tt, kbv);
                    asm volatile("" ::: "memory");
                }
            }
            WGBAR();
            }
#pragma unroll 1
            for (int rep_ = 0; rep_ < SCAN_REP_G; ++rep_) {
#define GRAM_ROW(m_, ti_) do { const int mm_ = (m_); \
                const LAS unsigned char* Xb_ = L + ((mm_ & 1) ? B_KT : B_BT) * MB + o16; const LAS unsigned char* Zb_ = L + (mm_ < 2 ? B_AT : B_RT) * MB + 16 * (ti_) * MPB + o16; \
                const bf16x8 zf0_ = ldf(Zb_), zf1_ = ldf(Zb_ + 64); const int i_ = 16 * (ti_) + r, st_ = (mm_ < 2) ? 1 : 0; \
                _Pragma("unroll") for (int ts_ = 0; ts_ < 4; ++ts_) { f32x4 d_ = z4; \
                    if (ts_ <= (ti_)) { d_ = mma(ldf(Xb_ + 16 * ts_ * MPB), zf0_, d_); d_ = mma(ldf(Xb_ + 16 * ts_ * MPB + 64), zf1_, d_); \
                        _Pragma("unroll") for (int q_ = 0; q_ < 4; ++q_) d_[q_] = (16 * ts_ + 4 * g + st_ + q_ <= i_) ? d_[q_] : 0.f; } \
                    st4(L + mm_ * MB + 16 * (ti_) * MPB + 32 * ts_ + o8, d_); } } while (0)
            if (wv < 6) {
                const int m = wv >> 1;
                if (wv & 1) { GRAM_ROW(m, 1); GRAM_ROW(m, 2); } else { GRAM_ROW(m, 0); GRAM_ROW(m, 3); }
                if (wv == 0) GRAM_ROW(3, 0);
                if (wv == 1) GRAM_ROW(3, 1);
            } else if (wv == 6) {
                GRAM_ROW(3, 2); GRAM_ROW(3, 3);
            } else {
#pragma unroll
                for (int q2 = 0; q2 < 4; ++q2) {
                    f32x4 d = z4;
                    d = mma(ldf(L + B_BT * MB + 16 * q2 * MPB + o16), ldf(L + B_AT * MB + 16 * q2 * MPB + o16), d); d = mma(ldf(L + B_BT * MB + 16 * q2 * MPB + 64 + o16), ldf(L + B_AT * MB + 16 * q2 * MPB + 64 + o16), d);
#pragma unroll
                    for (int q = 0; q < 4; ++q) d[q] = (4 * g + q < r) ? d[q] : 0.f;
                    st4(L + B_NAB * MB + 16 * q2 * MPB + 32 * q2 + o8, d);
                    *(LAS f32x4*)(L + O_NF + q2 * 1024 + r * 64 + g * 16) = d;
                }
            }
            LDS_WAIT(); asm volatile("" ::: "memory");
            }
            WGBAR();
            f32x4 W2[4], Y[4], U[4]; bf16x8 Sb0, Sb1, vb0, vb1, u0, u1;
            const int vs = wv & 3;
            if (wv == 7) {
                const int oD = g * (16 * MPB + 32);
                const LAS unsigned char* nf = L + O_NF + g * 1024;
                float tc[16];
                tc[0] = (r == 0) ? 1.f : 0.f;
#pragma unroll
                for (int half = 0; half < 2; ++half) {
                    f32x4 rw[8][4];
#pragma unroll
                    for (int ii = 0; ii < 8; ++ii) { const int i = 8 * half + ii;
#pragma unroll
                        for (int c4 = 0; c4 < 4; ++c4) if (i > 0 && 4 * c4 < i) rw[ii][c4] = *(const LAS f32x4*)(nf + i * 64 + c4 * 16); }
#pragma unroll
                    for (int ii = 0; ii < 8; ++ii) { const int i = 8 * half + ii;
                        if (i > 0) {
                            float a0 = (i == r) ? 1.f : 0.f, a1 = 0.f, a2 = 0.f, a3 = 0.f;
#pragma unroll
                            for (int s2 = 0; s2 < i; ++s2) { const float nvv = rw[ii][s2 >> 2][s2 & 3];
                                if ((s2 & 3) == 0) a0 += nvv * tc[s2]; else if ((s2 & 3) == 1) a1 += nvv * tc[s2]; else if ((s2 & 3) == 2) a2 += nvv * tc[s2]; else a3 += nvv * tc[s2]; }
                            tc[i] = (a0 + a1) + (a2 + a3);
                        }
                    }
                }
#pragma unroll
                for (int i = 0; i < 16; ++i) st1(L + B_T * MB + oD + i * MPB + r * 2, tc[i]);
            }
            vb0 = ldf(L + B_VTT * MB + 16 * vs * MPB + o16); vb1 = ldf(L + B_VTT * MB + 16 * vs * MPB + 64 + o16);
            if (wv < 4) {
                Sb0 = packfrag(S[0], S[1]); Sb1 = packfrag(S[2], S[3]);
                *(LAS bf16x8*)(L + B_BT * MB + vs * 2048 + lane * 16) = Sb0; *(LAS bf16x8*)(L + B_BT * MB + vs * 2048 + 1024 + lane * 16) = Sb1;
#pragma unroll
                for (int t = 0; t < 4; ++t) {
                    f32x4 d = z4;
                    d = mma(ldf(L + B_NAK * MB + 16 * t * MPB + o16), vb0, d); d = mma(ldf(L + B_NAK * MB + 16 * t * MPB + 64 + o16), vb1, d);
                    d = mma(ldfp(L + B_AT * MB + 16 * t * MPB + o8), Sb0, d); d = mma(ldfp(L + B_AT * MB + 16 * t * MPB + 64 + o8), Sb1, d); W2[t] = d;
                    const f32x4 p4 = *(const LAS f32x4*)(L + O_PV + 64 * t + g * 16);
                    f32x4 e2 = S[t] * p4;
                    e2 = mma(ldf(L + B_KBT * MB + 16 * t * MPB + o16), vb0, e2); e2 = mma(ldf(L + B_KBT * MB + 16 * t * MPB + 64 + o16), vb1, e2); S[t] = e2;
                    asm volatile("" : "+v"(W2[t]), "+v"(S[t]) :: "memory");
                }
            } else if (seg) {
#pragma unroll
                for (int t = 0; t < 4; ++t) { f32x4 y = z4;
                    y = mma(ldf(L + B_MRK * MB + 16 * t * MPB + o16), vb0, y); y = mma(ldf(L + B_MRK * MB + 16 * t * MPB + 64 + o16), vb1, y); Y[t] = y; }
            }
            WGBAR();
            if (wv < 4) {
#define DMUL(q_, x_) mma(__builtin_bit_cast(bf16x8, (u32x4){dq_[q_].x, dq_[q_].y, 0u, 0u}), packfrag((x_), z4), z4)
                u32x2 dq_[4];
#pragma unroll
                for (int q = 0; q < 4; ++q) dq_[q] = *(const LAS u32x2*)(L + B_T * MB + 16 * q * MPB + 32 * q + o8);
                U[0] = DMUL(0, W2[0]);
                { f32x4 x = mma(ldfp(L + B_NAB * MB + 16 * MPB + o8), packfrag(U[0], z4), W2[1]); U[1] = DMUL(1, x); }
                u0 = packfrag(U[0], U[1]);
                { f32x4 x = mma(ldfp(L + B_NAB * MB + 32 * MPB + o8), u0, W2[2]); U[2] = DMUL(2, x); }
                { f32x4 x = mma(ldfp(L + B_NAB * MB + 48 * MPB + o8), u0, W2[3]); x = mma(ldfp(L + B_NAB * MB + 48 * MPB + 64 + o8), packfrag(U[2], z4), x); U[3] = DMUL(3, x); }
#undef DMUL
                u1 = packfrag(U[2], U[3]);
                *(LAS bf16x8*)(L + B_KT * MB + vs * 2048 + lane * 16) = u0; *(LAS bf16x8*)(L + B_KT * MB + vs * 2048 + 1024 + lane * 16) = u1;
            } else if (seg) {
                Sb0 = *(const LAS bf16x8*)(L + B_BT * MB + vs * 2048 + lane * 16); Sb1 = *(const LAS bf16x8*)(L + B_BT * MB + vs * 2048 + 1024 + lane * 16);
#pragma unroll
                for (int t = 0; t < 4; ++t) { Y[t] = mma(ldfp(L + B_RT * MB + 16 * t * MPB + o8), Sb0, Y[t]); Y[t] = mma(ldfp(L + B_RT * MB + 16 * t * MPB + 64 + o8), Sb1, Y[t]); }
            }
            WGBAR();
            if (wv < 4) {
#pragma unroll
                for (int t = 0; t < 4; ++t) {
                    S[t] = mma(ldfp(L + B_BBT * MB + 16 * t * MPB + o8), u0, S[t]); S[t] = mma(ldfp(L + B_BBT * MB + 16 * t * MPB + 64 + o8), u1, S[t]);
                    asm volatile("" : "+v"(S[t]) :: "memory");
                }
            } else if (seg) {
                u0 = *(const LAS bf16x8*)(L + B_KT * MB + vs * 2048 + lane * 16); u1 = *(const LAS bf16x8*)(L + B_KT * MB + vs * 2048 + 1024 + lane * 16);
                const int vcol = c0 + 16 * vs + r;
#pragma unroll
                for (int t = 0; t < 4; ++t) {
                    f32x4 y = Y[t];
                    y = mma(ldfp(L + B_MRB * MB + 16 * t * MPB + o8), u0, y); y = mma(ldfp(L + B_MRB * MB + 16 * t * MPB + 64 + o8), u1, y);
                    const LAS float* bp = (const LAS float*)(L + O_BONP + 64 * t + g * 16);
                    const f32x4 bon = (*(const LAS f32x4*)bp + *(const LAS f32x4*)(bp + 64)) + (*(const LAS f32x4*)(bp + 128) + *(const LAS f32x4*)(bp + 192));
                    const u32x2 vv = *(const LAS u32x2*)(L + B_VTT * MB + 16 * vs * MPB + 32 * t + o8);
                    y[0] += bon[0] * bflo(vv.x); y[1] += bon[1] * bfhi(vv.x); y[2] += bon[2] * bflo(vv.y); y[3] += bon[3] * bfhi(vv.y);
#pragma unroll
                    for (int q = 0; q < 4; ++q) { const int tl = ci * 64 + 16 * t + 4 * g + q, tt = dir ? (Tseg - 1 - tl) : tl;
                        Yg[((size_t)b * TL + tt) * D + vcol] = (bf16_t)f2bf(y[q]); }
                    asm volatile("" ::: "memory");
                }
            }
            WGBAR();
        }
#undef SCAN_PREFETCH
#undef GRAM_ROW
    }
#undef WGBAR
    __syncthreads();
}

__device__ __forceinline__ void p4_readout(const Frame& F, const Args& A) {
    unsigned char* ws = A.ws;
    {
        LAS float* scr = (LAS float*)(F.lds + F.wave * 16384);
        constexpr int NIT = 2 * 16 * 3 * 256;
        for (int it = F.gw; it < NIT; it += F.NGW) {
            const int mat = it >> 8, item = it & 255;
            const int kind = mat % 3, le = mat / 3, l = le >> 4, e = le & 15;
            unsigned char* mw = ws + (l ? WS_MOEW1 : WS_MOEW0);
            if (kind == 0) tr_job_item(A.in[I_MGATE] + (size_t)le * D * ED, ED, ED, (bf16_t*)mw, D, e * 1024, true, nullptr, item, scr, F.lane);
            else if (kind == 1) tr_job_item(A.in[I_MUP] + (size_t)le * D * ED, ED, ED, (bf16_t*)mw, D, e * 1024 + 128, true, nullptr, item, scr, F.lane);
            else tr_job_item(A.in[I_MDOWN] + (size_t)le * ED * D, D, D, (bf16_t*)(mw + 32 * MiB), ED, e * 1024, false, nullptr, item, scr, F.lane);
        }
    }
    const bf16_t* Y0 = (const bf16_t*)(ws + WS_Y0); const bf16_t* Y1 = (const bf16_t*)(ws + WS_Y1); const bf16_t* Gt = (const bf16_t*)(ws + WS_G);
    bf16_t* ZO = (bf16_t*)(ws + WS_ZO);
    float gw_[16], gb_[16];
#pragma unroll
    for (int j = 0; j < 2; ++j)
#pragma unroll
        for (int q = 0; q < 8; ++q) { const int c = 8 * F.lane + 512 * j + q; gw_[j * 8 + q] = A.in[I_GNW][c]; gb_[j * 8 + q] = A.in[I_GNB][c]; }
    for (int t = F.gw; t < ML; t += F.NGW) {
#pragma unroll
        for (int j = 0; j < 2; ++j) {
            const size_t off = (size_t)t * D + 8 * F.lane + 512 * j;
            const u32x4 a = *(const u32x4*)(Y0 + off), b = *(const u32x4*)(Y1 + off), g = *(const u32x4*)(Gt + off);
            float y[8] = {bflo(a.x) + bflo(b.x), bfhi(a.x) + bfhi(b.x), bflo(a.y) + bflo(b.y), bfhi(a.y) + bfhi(b.y), bflo(a.z) + bflo(b.z), bfhi(a.z) + bfhi(b.z), bflo(a.w) + bflo(b.w), bfhi(a.w) + bfhi(b.w)};
            float gg[8] = {bflo(g.x), bfhi(g.x), bflo(g.y), bfhi(g.y), bflo(g.z), bfhi(g.z), bflo(g.w), bfhi(g.w)};
            float s = 0.f;
#pragma unroll
            for (int q = 0; q < 8; ++q) s += y[q];
            s += __shfl_xor(s, 1); s += __shfl_xor(s, 2); s += __shfl_xor(s, 4);
            const float mean = s * (1.f / 64.f); float s2 = 0.f;
#pragma unroll
            for (int q = 0; q < 8; ++q) { y[q] -= mean; s2 += y[q] * y[q]; }
            s2 += __shfl_xor(s2, 1); s2 += __shfl_xor(s2, 2); s2 += __shfl_xor(s2, 4);
            const float rstd = rsqrtf(s2 * (1.f / 64.f) + GN_EPS);
            float z[8];
#pragma unroll
            for (int q = 0; q < 8; ++q) z[q] = (y[q] * rstd * gw_[j * 8 + q] + gb_[j * 8 + q]) * gg[q];
            u32x4 w; w.x = pk2(z[0], z[1]); w.y = pk2(z[2], z[3]); w.z = pk2(z[4], z[5]); w.w = pk2(z[6], z[7]);
            *(u32x4*)(ZO + off) = w;
        }
    }
}

__device__ __forceinline__ void p6_route(const Frame& F, const Args& A, const int layer) {
    unsigned char* ws = A.ws;
    LAS float* RW = (LAS float*)F.lds;
    __syncthreads();
    for (int i = F.tid; i < D * NE; i += NTHREADS) { const int d = i >> 4, e = i & 15; const int j = d >> 8, l = (d & 255) >> 2, jj = d & 3, dj = j * 4 + jj;
        RW[((dj * 4 + (e >> 2)) * 64 + l) * 4 + (e & 3)] = A.in[I_ROUTW][i]; }
    __syncthreads();
    const float* MOD = (const float*)(ws + WS_MOD) + (size_t)layer * 9 * 6144;
    const float* ng = A.in[I_NORMG] + (size_t)(layer * 2 + 1) * D;
    const float* h = A.out;
    bf16_t* XN = (bf16_t*)(ws + WS_XN);
    unsigned* EIDX = (unsigned*)(ws + WS_EIDX); float* GATE = (float*)(ws + WS_GATE); int* CC = (int*)(ws + WS_CC);
    float rb[16];
#pragma unroll
    for (int e = 0; e < 16; ++e) rb[e] = A.in[I_ROUTB][e];
    for (int ch = F.gw; ch < 2048; ch += F.NGW) {
        const int t0 = ch * 16, b = t0 / TL;
        const float* mrow = MOD + (size_t)b * 6144;
        f32x4 gsc[4], sh[4];
#pragma unroll
        for (int j = 0; j < 4; ++j) { const int c = 4 * F.lane + 256 * j; gsc[j] = *(const f32x4*)(ng + c) * (1.f + *(const f32x4*)(mrow + 4096 + c)); sh[j] = *(const f32x4*)(mrow + 3072 + c); }
        int cnt = 0;
        for (int i = 0; i < 16; ++i) {
            const int t = t0 + i;
            f32x4 v[4];
            p1_load_norm(h + (size_t)t * D, gsc, sh, v, F.lane);
            bf16_t* orow = XN + (size_t)t * D + 4 * F.lane;
#pragma unroll
            for (int j = 0; j < 4; ++j) st_bf4(orow + 256 * j, v[j]);
            float lg[16];
#pragma unroll
            for (int e = 0; e < 16; ++e) lg[e] = 0.f;
#pragma unroll
            for (int j = 0; j < 4; ++j)
#pragma unroll
                for (int jj = 0; jj < 4; ++jj) { const float xv = v[j][jj]; const int dj = j * 4 + jj;
#pragma unroll
                    for (int q = 0; q < 4; ++q) { const f32x4 w = *(const LAS f32x4*)(RW + ((dj * 4 + q) * 64 + F.lane) * 4);
                        lg[4 * q] += xv * w.x; lg[4 * q + 1] += xv * w.y; lg[4 * q + 2] += xv * w.z; lg[4 * q + 3] += xv * w.w; }
                    asm volatile("" : "+v"(lg[0]), "+v"(lg[1]), "+v"(lg[2]), "+v"(lg[3]), "+v"(lg[4]), "+v"(lg[5]), "+v"(lg[6]), "+v"(lg[7]),
                                      "+v"(lg[8]), "+v"(lg[9]), "+v"(lg[10]), "+v"(lg[11]), "+v"(lg[12]), "+v"(lg[13]), "+v"(lg[14]), "+v"(lg[15]) :: "memory"); }
#pragma unroll
            for (int e = 0; e < 16; ++e) lg[e] = wave_sum(lg[e]);
            float best = -3.0e38f; int be0 = 0, be1 = 1; float bs0 = 0.f, bs1 = 0.f;
#pragma unroll
            for (int g = 0; g < 4; ++g) {
                float s[4], sel[4];
#pragma unroll
                for (int q = 0; q < 4; ++q) { s[q] = 1.f / (1.f + expf(-lg[4 * g + q])); sel[q] = s[q] + rb[4 * g + q]; }
                int i1 = 0; float v1 = sel[0], s1 = s[0];
#pragma unroll
                for (int q = 1; q < 4; ++q) if (sel[q] > v1) { i1 = q; v1 = sel[q]; s1 = s[q]; }
                int i2 = -1; float v2 = -3.0e38f, s2 = 0.f;
#pragma unroll
                for (int q = 0; q < 4; ++q) if (q != i1 && sel[q] > v2) { i2 = q; v2 = sel[q]; s2 = s[q]; }
                const float gs = v1 + v2;
                if (gs > best) { best = gs; be0 = 4 * g + i1; be1 = 4 * g + i2; bs0 = s1; bs1 = s2; }
            }
            const float inv = 1.f / (bs0 + bs1);
            if (F.lane == 0) { EIDX[t] = (unsigned)be0 | ((unsigned)be1 << 8); GATE[2 * t] = bs0 * inv; GATE[2 * t + 1] = bs1 * inv; }
            cnt += (F.lane == be0) + (F.lane == be1);
        }
        if (F.lane < 16) CC[ch * 16 + F.lane] = cnt;
    }
    __syncthreads();
}

__device__ __forceinline__ void p7_permute(const Frame& F, const Args& A) {
    unsigned char* ws = A.ws;
    LAS int* cc = (LAS int*)F.lds;
    LAS int* ps = (LAS int*)(F.lds + LDS_X_OFF);
    LAS int* seg = ps + 512;
    LAS int* tot = seg + 16;
    const int* CC = (const int*)(ws + WS_CC);
    const unsigned* EIDX = (const unsigned*)(ws + WS_EIDX); int* POS = (int*)(ws + WS_POS); int* TILE = (int*)(ws + WS_TILE); int* INV = (int*)(ws + WS_INV);
    __syncthreads();
    for (int i = F.tid; i < 2048 * 16 / 4; i += NTHREADS) ((LAS u32x4*)cc)[i] = ((const u32x4*)CC)[i];
    __syncthreads();
    { const int e = F.tid & 15, part = F.tid >> 4; int s = 0; for (int q = 0; q < 64; ++q) s += cc[(part * 64 + q) * 16 + e]; ps[part * 16 + e] = s; }
    __syncthreads();
    if (F.tid < 16) { int run = 0; for (int p = 0; p < 32; ++p) { const int v = ps[p * 16 + F.tid]; ps[p * 16 + F.tid] = run; run += v; } tot[F.tid] = run; }
    __syncthreads();
    if (F.tid == 0) { int off = 0, nt = 0;
        for (int e = 0; e < 16; ++e) { const int tl = (tot[e] + 255) >> 8; seg[e] = off;
            if (blockIdx.x == 0) for (int q = 0; q < tl; ++q) TILE[16 + nt + q] = e;
            nt += tl; off += tl * 256; }
        if (blockIdx.x == 0) TILE[0] = nt; }
    __syncthreads();
    if (blockIdx.x == 0) {
        for (int e = 0; e < 16; ++e) { const int n0 = seg[e] + tot[e], n1 = seg[e] + (((tot[e] + 255) >> 8) << 8);
            for (int j = n0 + F.tid; j < n1; j += NTHREADS) INV[j] = 0; } }
    for (int ch = F.gw; ch < 2048; ch += F.NGW) {
        int base = 0;
        if (F.lane < 16) { base = seg[F.lane] + ps[(ch >> 6) * 16 + F.lane]; for (int q = (ch & ~63); q < ch; ++q) base += cc[q * 16 + F.lane]; }
        int myp = 0;
        for (int i = 0; i < 16; ++i) {
            const int t = ch * 16 + i; const unsigned ei = EIDX[t]; const int e0 = ei & 255, e1 = (ei >> 8) & 255;
            const int p0 = __shfl(base, e0); base += (F.lane == e0);
            const int p1 = __shfl(base, e1); base += (F.lane == e1);
            if (F.lane == 2 * i) myp = p0; if (F.lane == 2 * i + 1) myp = p1;
        }
        if (F.lane < 32) { POS[ch * 32 + F.lane] = myp; INV[myp] = ch * 16 + (F.lane >> 1); }
    }
    __syncthreads();
}

template <bool FINAL>
__device__ __forceinline__ void p10_combine(const Frame& F, const Args& A, const int layer) {
    unsigned char* ws = A.ws;
    const float* MOD = (const float*)(ws + WS_MOD);
    const bf16_t* O = (const bf16_t*)(ws + WS_XP); const int* POS = (const int*)(ws + WS_POS); const float* GATE = (const float*)(ws + WS_GATE);
    bf16_t* XN = (bf16_t*)(ws + WS_XN);
    float* h = A.out;
    for (int ch = F.gw; ch < 2048; ch += F.NGW) {
        const int t0 = ch * 16, b = t0 / TL;
        const float* mcur = MOD + ((size_t)layer * 9 + b) * 6144;
        f32x4 gt2[4], gsc[4], sh[4];
#pragma unroll
        for (int j = 0; j < 4; ++j) { const int c = 4 * F.lane + 256 * j; gt2[j] = *(const f32x4*)(mcur + 5120 + c);
            if (FINAL) { gsc[j] = *(const f32x4*)(A.in[I_FINALG] + c); sh[j] = (f32x4){0.f, 0.f, 0.f, 0.f}; }
            else { const float* mn = MOD + ((size_t)9 + b) * 6144; gsc[j] = *(const f32x4*)(A.in[I_NORMG] + 2 * D + c) * (1.f + *(const f32x4*)(mn + 1024 + c)); sh[j] = *(const f32x4*)(mn + c); } }
        for (int i = 0; i < 16; ++i) {
            const int t = t0 + i; const int p0 = POS[2 * t], p1 = POS[2 * t + 1]; const float w0 = GATE[2 * t], w1 = GATE[2 * t + 1];
            f32x4 v[4]; float s = 0.f;
#pragma unroll
            for (int j = 0; j < 4; ++j) { const int c = 4 * F.lane + 256 * j;
                const u32x2 oa = *(const u32x2*)(O + (size_t)p0 * D + c), ob = *(const u32x2*)(O + (size_t)p1 * D + c);
                const f32x4 m = w0 * (f32x4){bflo(oa.x), bfhi(oa.x), bflo(oa.y), bfhi(oa.y)} + w1 * (f32x4){bflo(ob.x), bfhi(ob.x), bflo(ob.y), bfhi(ob.y)};
                v[j] = *(const f32x4*)(h + (size_t)t * D + c) + gt2[j] * m;
                s += (v[j].x * v[j].x + v[j].y * v[j].y) + (v[j].z * v[j].z + v[j].w * v[j].w); }
            const float rstd = rsqrtf(wave_sum(s) * (1.f / D) + RMS_EPS);
            if (FINAL) {
#pragma unroll
                for (int j = 0; j < 4; ++j) *(f32x4*)(h + (size_t)t * D + 4 * F.lane + 256 * j) = v[j] * rstd * gsc[j];
            } else {
#pragma unroll
                for (int j = 0; j < 4; ++j) { *(f32x4*)(h + (size_t)t * D + 4 * F.lane + 256 * j) = v[j]; st_bf4(XN + (size_t)t * D + 4 * F.lane + 256 * j, v[j] * rstd * gsc[j] + sh[j]); }
            }
        }
    }
}

__device__ __forceinline__ void ld_bf16row(const bf16_t* row, float (&o)[16], int lane) {
#pragma unroll
    for (int j = 0; j < 2; ++j) { const u32x4 a = *(const u32x4*)(row + 8 * lane + 512 * j);
        o[8 * j] = bflo(a.x); o[8 * j + 1] = bfhi(a.x); o[8 * j + 2] = bflo(a.y); o[8 * j + 3] = bfhi(a.y); o[8 * j + 4] = bflo(a.z); o[8 * j + 5] = bfhi(a.z); o[8 * j + 6] = bflo(a.w); o[8 * j + 7] = bfhi(a.w); }
}
__device__ __forceinline__ void p12_conv(const Frame& F, const Args& A) {
    unsigned char* ws = A.ws;
    const bf16_t* BG = (const bf16_t*)(ws + WS_BG); const bf16_t* U = (const bf16_t*)(ws + WS_U); bf16_t* Z = (bf16_t*)(ws + WS_Z);
    float c0[16], c1[16], c2[16];
#pragma unroll
    for (int j = 0; j < 2; ++j)
#pragma unroll
        for (int q = 0; q < 8; ++q) { const int c = 8 * F.lane + 512 * j + q; c0[8 * j + q] = A.in[I_CONV][c]; c1[8 * j + q] = A.in[I_CONV][D + c]; c2[8 * j + q] = A.in[I_CONV][2 * D + c]; }
    for (int u = F.gw; u < 2048; u += F.NGW) {
        const int t0 = u * 16, pos0 = t0 % GRIDW;
        float prev[16], cur[16], nxt[16], bg[16];
        if (pos0 > 0) ld_bf16row(U + (size_t)(t0 - 1) * D, prev, F.lane);
        else {
#pragma unroll
            for (int q = 0; q < 16; ++q) prev[q] = 0.f; }
        ld_bf16row(U + (size_t)t0 * D, cur, F.lane);
        for (int i = 0; i < 16; ++i) {
            if (pos0 + i + 1 < GRIDW) ld_bf16row(U + (size_t)(t0 + i + 1) * D, nxt, F.lane);
            else {
#pragma unroll
                for (int q = 0; q < 16; ++q) nxt[q] = 0.f; }
            ld_bf16row(BG + (size_t)(t0 + i) * D, bg, F.lane);
            float z[16];
#pragma unroll
            for (int q = 0; q < 16; ++q) { z[q] = bg[q] * (c0[q] * prev[q] + c1[q] * cur[q] + c2[q] * nxt[q]); prev[q] = cur[q]; cur[q] = nxt[q]; }
#pragma unroll
            for (int j = 0; j < 2; ++j) { u32x4 w; w.x = pk2(z[8 * j], z[8 * j + 1]); w.y = pk2(z[8 * j + 2], z[8 * j + 3]); w.z = pk2(z[8 * j + 4], z[8 * j + 5]); w.w = pk2(z[8 * j + 6], z[8 * j + 7]);
                *(u32x4*)(Z + (size_t)(t0 + i) * D + 8 * F.lane + 512 * j) = w; }
        }
    }
}

constexpr int N_PHASES = 20;
__global__ void __launch_bounds__(NTHREADS, 2) fwd(Args args) {
    extern __shared__ __attribute__((aligned(16))) unsigned char lds_raw[];
    Frame F;
    F.lds = (LAS unsigned char*)lds_raw;
    F.tid = threadIdx.x; F.lane = F.tid & 63; F.wave = __builtin_amdgcn_readfirstlane(F.tid >> 6);
    F.G = gridDim.x; { const int bx = blockIdx.x; F.vcu = (F.G % 8 == 0) ? (bx % 8) * (F.G / 8) + bx / 8 : bx; }
    F.gw = F.vcu * NWAVES + F.wave; F.NGW = F.G * NWAVES;
    unsigned char* ws = args.ws;
    for (int u = F.tid; u < (LDS_BYTES - LDSCTL_OFF) / 4; u += NTHREADS) ((LAS unsigned*)(F.lds + LDSCTL_OFF))[u] = 0u;
    __syncthreads();
    volatile LAS unsigned* MISC = (volatile LAS unsigned*)(F.lds + MISC_OFF);
    XcdBarrier bar; bar.bar = (unsigned*)(ws + WS_CTL) + CW_BAR; bar.x = 0; bar.st = nullptr;
    const int lo = args.ph_lo, hi = args.ph_hi;
    if (hi - lo > 1) bar = xcd_barrier_post((unsigned*)(ws + WS_CTL) + CW_BAR, MISC + 8);
#ifndef PH_MASK
#define PH_MASK 0xFFFFFu
#endif
#define IN(k) (((PH_MASK >> (k)) & 1u) && lo <= (k) && (k) < hi)
#define SEAM(k) do { if (IN(k) && IN((k) + 1)) xcd_barrier(bar); } while (0)
#ifndef PROBE_MASK
#define PROBE_MASK 0u
#endif
#define RUNPH(k, ...) do { __VA_ARGS__ if constexpr (((PROBE_MASK >> (k)) & 1u) != 0u) { if (hi - lo > 1) xcd_barrier(bar); __VA_ARGS__ } } while (0)
    const float* MOD = (const float*)(ws + WS_MOD);
    const int bx = (int)blockIdx.x;

    if (IN(0)) { RUNPH(0, p0_prologue(F, args);); SEAM(0); }
    if (IN(1)) { RUNPH(1, p1_mix(F, args);); SEAM(1); }
    if (IN(2)) {
      RUNPH(2,
        { SchedRKV S{(const char*)(ws + WS_XM), (const char*)(ws + WS_WRKV), F.G, bx};
          EpiRKV E{(bf16_t*)args.out, (bf16_t*)args.out + (size_t)ML * D, (bf16_t*)(ws + WS_KC), (bf16_t*)(ws + WS_V)};
          pg8::gemm_phase<EpiRKV, SchedRKV>(F.lds, XM_LD, 2048, S, E); }
        { SchedLora S{(const char*)(ws + WS_XM), (const char*)(ws + WS_WL), F.G, F.G == 256 ? bx : (bx + F.G / 2) % F.G};
          EpiLora E{(bf16_t*)(ws + WS_LWA), (bf16_t*)(ws + WS_LG)};
          pg8::gemm_phase<EpiLora, SchedLora>(F.lds, XM_LD, 2048, S, E); }
      );
        SEAM(2);
    }
    if (IN(3)) {
      RUNPH(3,
        SchedPlain S{(const char*)(ws + WS_LG), (const char*)(ws + WS_G2), 128, 4, 256, 256, 4, F.G, bx};
        EpiBf16 E{(bf16_t*)(ws + WS_G), D};
        pg8::gemm_phase<EpiBf16, SchedPlain>(F.lds, 256, 256, S, E);
      );
        SEAM(3);
    }
    if (IN(4)) { RUNPH(4, p3_scan(F, args);); SEAM(4); }
    if (IN(5)) { RUNPH(5, p4_readout(F, args);); SEAM(5); }
    if (IN(6)) {
      RUNPH(6,
        SchedPlain S{(const char*)(ws + WS_ZO), (const char*)(ws + WS_WO), 128, 4, D, D, 16, F.G, bx};
        EpiRes E{args.in[I_X], args.out, MOD + 2048};
        pg8::gemm_phase<EpiRes, SchedPlain>(F.lds, D, D, S, E);
      );
        SEAM(6);
    }
    if (IN(7)) { RUNPH(7, p6_route(F, args, 0);); SEAM(7); }
    if (IN(8)) { RUNPH(8, p7_permute(F, args);); SEAM(8); }
    if (IN(9)) {
        unsigned* const rdy = (unsigned*)(ws + WS_CTL + CTL_RDY + 0 * 128 * 1024);
        { const SchedMoeG S{(const char*)(ws + WS_XN), (const char*)(ws + WS_MOEW0), (const int*)(ws + WS_TILE), (const int*)(ws + WS_INV), D, 16, F.G, bx, (size_t)2 * MiB};
          const EpiGateUpPub E{(unsigned char*)(ws + WS_H), rdy};
          pg8::gemm_phase<EpiGateUpPub, SchedMoeG, true>(F.lds, D, D, S, E); }
        { const SchedMoeD S{(const char*)(ws + WS_H), (const char*)(ws + WS_MOEW0 + 32 * MiB), (const int*)(ws + WS_TILE), rdy, (unsigned*)(ws + WS_CTL) + CW_TMO2, F.G, bx};
          const EpiBf16 E{(bf16_t*)(ws + WS_XP), D};
          pg8::gemm_phase<EpiBf16, SchedMoeD, true, 1>(F.lds, ED, ED, S, E); }
        if (IN(9) && IN(10 + 1)) xcd_barrier(bar);
    }
    if (IN(11)) { p10_combine<false>(F, args, 0); SEAM(11); }
    if (IN(12)) {
      RUNPH(12,
        SchedPlain S{(const char*)(ws + WS_XN), (const char*)(ws + WS_WIN), 128, 12, D, D, 16, F.G, bx};
        EpiWin E{(bf16_t*)(ws + WS_BG), (bf16_t*)(ws + WS_U)};
        pg8::gemm_phase<EpiWin, SchedPlain>(F.lds, D, D, S, E);
      );
        SEAM(12);
    }
    if (IN(13)) { RUNPH(13, p12_conv(F, args);); SEAM(13); }
    if (IN(14)) {
        SchedPlain S{(const char*)(ws + WS_Z), (const char*)(ws + WS_WOUT), 128, 4, D, D, 16, F.G, bx};
        EpiRes E{args.out, args.out, MOD + 9 * 6144 + 2048};
        pg8::gemm_phase<EpiRes, SchedPlain>(F.lds, D, D, S, E);
        SEAM(14);
    }
    if (IN(15)) { RUNPH(15, p6_route(F, args, 1);); SEAM(15); }
    if (IN(16)) { RUNPH(16, p7_permute(F, args);); SEAM(16); }
    if (IN(17)) {
        unsigned* const rdy = (unsigned*)(ws + WS_CTL + CTL_RDY + 1 * 128 * 1024);
        { const SchedMoeG S{(const char*)(ws + WS_XN), (const char*)(ws + WS_MOEW1), (const int*)(ws + WS_TILE), (const int*)(ws + WS_INV), D, 16, F.G, bx, (size_t)2 * MiB};
          const EpiGateUpPub E{(unsigned char*)(ws + WS_H), rdy};
          pg8::gemm_phase<EpiGateUpPub, SchedMoeG, true>(F.lds, D, D, S, E); }
        { const SchedMoeD S{(const char*)(ws + WS_H), (const char*)(ws + WS_MOEW1 + 32 * MiB), (const int*)(ws + WS_TILE), rdy, (unsigned*)(ws + WS_CTL) + CW_TMO2, F.G, bx};
          const EpiBf16 E{(bf16_t*)(ws + WS_XP), D};
          pg8::gemm_phase<EpiBf16, SchedMoeD, true, 1>(F.lds, ED, ED, S, E); }
        if (IN(17) && IN(18 + 1)) xcd_barrier(bar);
    }
    if (IN(19)) { p10_combine<true>(F, args, 1); }
}

extern "C" void kernel_launch(void* const* d_in, const int* in_sizes, int n_in, void* d_out, int out_size, void* d_ws, size_t ws_size, hipStream_t stream) {
    static int grid = 0;
    if (grid == 0) {
        if (n_in != 32 || out_size != ML * D || ws_size < WS_END) { fprintf(stderr, "kernel_launch: unexpected problem (n_in %d, out %d, ws %zu)\n", n_in, out_size, ws_size); grid = -1; return; }
        int dev = 0, cus = 0;
        if (hipGetDevice(&dev) != hipSuccess || hipDeviceGetAttribute(&cus, hipDeviceAttributeMultiprocessorCount, dev) != hipSuccess) { grid = -1; return; }
        if (hipFuncSetAttribute((const void*)fwd, hipFuncAttributeMaxDynamicSharedMemorySize, LDS_BYTES) != hipSuccess) { grid = -1; return; }
        int per_cu = 0;
        if (hipOccupancyMaxActiveBlocksPerMultiprocessor(&per_cu, (const void*)fwd, NTHREADS, LDS_BYTES) != hipSuccess || per_cu < 1) { fprintf(stderr, "kernel_launch: occupancy query says %d\n", per_cu); grid = -1; return; }
        grid = cus > 256 ? 256 : cus;
    }
    if (grid < 0) return;
    (void)in_sizes;
    hipMemsetAsync((char*)d_ws + WS_CTL, 0, CTL_ZERO_BYTES, stream);
    Args a{};
    for (int i = 0; i < 32; ++i) a.in[i] = (const float*)d_in[i];
    a.out = (float*)d_out; a.ws = (unsigned char*)d_ws;
#if MK_N_LAUNCHES == 1
    a.ph_lo = 0; a.ph_hi = N_PHASES;
    hipLaunchKernelGGL(fwd, dim3(grid), dim3(NTHREADS), LDS_BYTES, stream, a);
#else
    for (int k = 0; k < N_PHASES; ++k) { a.ph_lo = k; a.ph_hi = k + 1; hipLaunchKernelGGL(fwd, dim3(grid), dim3(NTHREADS), LDS_BYTES, stream, a); }
#endif
}
```

```cpp
#include <hip/hip_runtime.h>
#include <cstdio>
#include <cstdint>

#ifndef MK_N_LAUNCHES
#define MK_N_LAUNCHES 1
#endif

#define GAS __attribute__((address_space(1)))
#define LAS __attribute__((address_space(3)))
typedef unsigned short bf16_t;
typedef short bf16x8 __attribute__((ext_vector_type(8)));
typedef float f32x4 __attribute__((ext_vector_type(4)));
typedef float f32x2 __attribute__((ext_vector_type(2)));
typedef unsigned u32x4 __attribute__((ext_vector_type(4)));
typedef unsigned u32x2 __attribute__((ext_vector_type(2)));

constexpr int D = 1024, NBATCH = 8, TL = 4096, TCX = 256, ML = NBATCH * TL, MC = NBATCH * TCX, MA = ML + MC;
constexpr int NH = 16, HD = 64, NE = 16, ED = 512, GRIDW = 64;
constexpr int XM_LD = 5 * D;
constexpr int NWAVES = 8, NTHREADS = 512;
constexpr float RMS_EPS = 1e-6f, GN_EPS = 64e-5f;
constexpr int MAXTILES = 272;

constexpr size_t MiB = 1u << 20;
constexpr size_t WS_CTL = 0, CTL_ZERO_BYTES = 1 * MiB;
constexpr size_t WS_MOD = 1 * MiB;
constexpr size_t WS_EIDX = 2 * MiB;
constexpr size_t WS_GATE = WS_EIDX + 128 * 1024;
constexpr size_t WS_POS = WS_GATE + 256 * 1024;
constexpr size_t WS_CC = WS_POS + 256 * 1024;
constexpr size_t WS_TILE = WS_CC + 128 * 1024;
constexpr size_t WS_INV = WS_TILE + 4 * 1024;
static_assert(WS_INV + 69632 * 4 <= 4 * MiB, "ws map");
constexpr size_t WS_WRKV = 4 * MiB;
constexpr size_t WS_WL = 16 * MiB;
constexpr size_t WS_G2 = 18 * MiB;
constexpr size_t WS_WO = 19 * MiB;
constexpr size_t WS_WIN = 21 * MiB;
constexpr size_t WS_WOUT = 27 * MiB;
constexpr size_t WS_ACT = 32 * MiB;
constexpr size_t WS_XM = WS_ACT;
constexpr size_t WS_V = 372 * MiB;
constexpr size_t WS_KC = 440 * MiB;
constexpr size_t WS_LWA = 444 * MiB;
constexpr size_t WS_LG = 461 * MiB;
constexpr size_t WS_G = 32 * MiB;
constexpr size_t WS_Y0 = 96 * MiB, WS_Y1 = 160 * MiB;
constexpr size_t WS_ZO = 272 * MiB;
constexpr size_t WS_MOEW0 = 416 * MiB, WS_MOEW1 = 464 * MiB;
constexpr size_t WS_XN = 32 * MiB;
constexpr size_t WS_XP = 96 * MiB;
constexpr size_t WS_H = 232 * MiB;
constexpr size_t WS_BG = 232 * MiB, WS_U = 160 * MiB;
constexpr size_t WS_HB = 336 * MiB;
constexpr size_t WS_Z = 96 * MiB;
constexpr size_t WS_END = 512 * MiB;

constexpr int CW_BAR = 4096;
constexpr int CW_TMO2 = 16;
constexpr size_t CTL_RDY = 256 * 1024;

constexpr int RING_BYTES = 131072;
constexpr int LDS_BYTES = 163840;
constexpr int LDSCTL_OFF = LDS_BYTES - 512, MISC_OFF = LDSCTL_OFF + 64;
constexpr int LDS_X_OFF = RING_BYTES;

typedef __bf16 bf16x2v __attribute__((ext_vector_type(2)));
__device__ __forceinline__ unsigned pk2(float lo, float hi) { const f32x2 v = {lo, hi}; return __builtin_bit_cast(unsigned, __builtin_convertvector(v, bf16x2v)); }
__device__ __forceinline__ unsigned f2bf(float f) { return pk2(f, 0.f) & 0xffffu; }
__device__ __forceinline__ float bflo(unsigned u) { return __builtin_bit_cast(float, u << 16); }
__device__ __forceinline__ float bfhi(unsigned u) { return __builtin_bit_cast(float, u & 0xffff0000u); }
__device__ __forceinline__ float wave_sum(float v) {
#pragma unroll
    for (int o = 1; o < 64; o <<= 1) v += __shfl_xor(v, o);
    return v;
}
__device__ __forceinline__ float sigmoidf_(float x) { return 1.f / (1.f + __expf(-x)); }
#define LDS_WAIT() asm volatile("s_waitcnt lgkmcnt(0)" ::: "memory")

namespace pg8 {
constexpr int BM = 256, BK = 64, HALF = 128, HTB = HALF * BK * 2, STAGE_BYTES = 8 * HTB, NXCD = 8, WGM = 8;
__host__ __device__ __forceinline__ int lds_byte(int r, int c) { const int st = (r >> 4) * 2 + (c >> 5), rr = r & 15, cc = c & 31, ob = rr * 64 + cc * 2; return st * 1024 + (ob ^ (((ob >> 9) & 1) << 5)); }
__host__ __device__ __forceinline__ void stage_rc(int b, int& R, int& C) { const int st = b / 1024, sb = b % 1024, swz = sb ^ (((sb >> 9) & 1) << 5); R = (st >> 1) * 16 + swz / 64; C = (st & 1) * 32 + (swz % 64) / 2; }
__host__ __device__ __forceinline__ int perm32(int rho) { const int n = rho >> 4, i = rho & 15; return 8 * (i >> 2) + 4 * n + (i & 3); }

struct Unit { int pm, pn; const char* a; const char* b; int nt; const int* rows; int kind, pa, pb, row0; };

__device__ __forceinline__ void swz_tile(int L, int nM, int nN, int& pm, int& pn) {
    const int nwg = nM * nN; int wgid = L;
    { const int q = nwg / NXCD, r = nwg % NXCD, xcd = wgid % NXCD, off = wgid / NXCD; wgid = (xcd < r ? xcd * (q + 1) : r * (q + 1) + (xcd - r) * q) + off; }
    const int nig = WGM * nN, gid = wgid / nig, fm = gid * WGM, gsz = (nM - fm) < WGM ? (nM - fm) : WGM;
    pm = fm + ((wgid % nig) % gsz); pn = (wgid % nig) / gsz;
}

__device__ __forceinline__ unsigned cvt_pk_bf16(float lo, float hi) { return pk2(lo, hi); }

template <class Epi, class Sched, bool GATHER = false, int FUSED = 0  , bool ALIGN_EPI = true, bool SP2 = true>
__device__ __forceinline__ void gemm_phase(LAS unsigned char* lds, const int lda, const int ldb, const Sched& S, const Epi& E) {
    const int tid = threadIdx.x, wid = __builtin_amdgcn_readfirstlane(tid >> 6), lane = tid & 63, wr = wid >> 2, wc = wid & 3, fr = lane & 15, fq = lane >> 4;
    unsigned vA[2][2], vN[2][2], voffB[2], vBn[2]; int gR[2], gC[2], gRb[2]; size_t hsBc = 0, hsBn = 0;
#pragma unroll
    for (int i = 0; i < 2; ++i) { int R, C; stage_rc(tid * 16 + i * 8192, R, C); const int Rb = Epi::PERM ? ((R & ~31) + perm32(R & 31)) : R;
        gR[i] = R; gC[i] = C * 2; gRb[i] = Rb; vBn[i] = 0;
        vA[0][i] = (unsigned)(R * lda + C) * 2u; vA[1][i] = (unsigned)((R + HALF) * lda + C) * 2u; vN[0][i] = vA[0][i]; vN[1][i] = vA[1][i];
        voffB[i] = (unsigned)(Rb * ldb + C) * 2u; }
#define PG8_GATHER(dst, u) do { if constexpr (GATHER) { _Pragma("unroll") for (int _h = 0; _h < 2; ++_h) _Pragma("unroll") for (int _i = 0; _i < 2; ++_i) { \
        if constexpr (FUSED != 0) { const int ri_ = gR[_i] + _h * HALF; const unsigned rr_ = (u).rows ? (unsigned)(u).rows[ri_] : (unsigned)((u).row0 + ri_); dst[_h][_i] = rr_ * (unsigned)(u).pa + (unsigned)gC[_i]; } \
        else dst[_h][_i] = (unsigned)(u).rows[gR[_i] + _h * HALF] * (unsigned)(lda * 2) + (unsigned)gC[_i]; } } } while (0)
#define PG8_BOFF(dst, u) do { if constexpr (FUSED == 2) { _Pragma("unroll") for (int _i = 0; _i < 2; ++_i) dst[_i] = (unsigned)gRb[_i] * (unsigned)(u).pb + (unsigned)gC[_i]; } } while (0)
#define PG8_STAGE_B(bufoff, gbase, hh, nx) do { if constexpr (FUSED == 2) { if ((nx) && last) PG8_STAGE(bufoff, (gbase) + (hh) * hsBn, vBn); else PG8_STAGE(bufoff, (gbase) + (hh) * hsBc, voffB); } \
        else PG8_STAGE(bufoff, (gbase) + (hh) * hstepB, voffB); } while (0)
    const size_t kstep = (size_t)(BK * 2);
    const size_t hstepB = (size_t)HALF * ldb * 2;
    const unsigned ldsw = (unsigned)wid * 1024u;
    const int aoff = lds_byte(wr * 64 + fr, fq * 8), boff = lds_byte(wc * 32 + fr, fq * 8);
#define PG8_SA(b, h) (((b) * 2 + (h)) * HTB)
#define PG8_SB(b, h) ((4 + (b) * 2 + (h)) * HTB)
#define PG8_STAGE(bufoff, gbase, voff) do { _Pragma("unroll") for (int _i = 0; _i < 2; ++_i) \
        __builtin_amdgcn_global_load_lds((const unsigned*)((const char*)(gbase) + (voff)[_i]), (LAS unsigned*)(lds + (bufoff) + ldsw + _i * 8192), 16, 0, 0); } while (0)
#define PG8_LDA(dst, b, h) do { _Pragma("unroll") for (int m = 0; m < 4; ++m) _Pragma("unroll") for (int k = 0; k < 2; ++k) dst[m][k] = *(const LAS bf16x8*)(lds + PG8_SA(b, h) + aoff + m * 2048 + k * 1024); } while (0)
#define PG8_LDB(dst, b, h) do { _Pragma("unroll") for (int n = 0; n < 2; ++n) _Pragma("unroll") for (int k = 0; k < 2; ++k) dst[n][k] = *(const LAS bf16x8*)(lds + PG8_SB(b, h) + boff + n * 2048 + k * 1024); } while (0)
#define PG8_MMA(ai, bj, At, Bt) do { __builtin_amdgcn_s_setprio(1); _Pragma("unroll") for (int m = 0; m < 4; ++m) _Pragma("unroll") for (int n = 0; n < 2; ++n) _Pragma("unroll") for (int k = 0; k < 2; ++k) \
        acc[ai][bj][m][n] = __builtin_amdgcn_mfma_f32_16x16x32_bf16(Bt[n][k], At[m][k], acc[ai][bj][m][n], 0, 0, 0); __builtin_amdgcn_s_setprio(0); } while (0)
#define PG8_WAIT_V(n) asm volatile("s_waitcnt vmcnt(" #n ")" ::: "memory")
#define PG8_WAIT_L(n) asm volatile("s_waitcnt lgkmcnt(" #n ")" ::: "memory")
#define PG8_BAR __builtin_amdgcn_s_barrier()
#define PG8_SCHED __builtin_amdgcn_sched_barrier(0)
    Unit cur, nxt; int ui = 0;
    if (!S.next(0, cur)) return;
    f32x4 acc[2][2][4][2];
#pragma unroll
    for (int a = 0; a < 2; ++a)
#pragma unroll
        for (int b = 0; b < 2; ++b)
#pragma unroll
            for (int m = 0; m < 4; ++m)
#pragma unroll
                for (int n = 0; n < 2; ++n) acc[a][b][m][n] = (f32x4){0.f, 0.f, 0.f, 0.f};
    bf16x8 At[4][2], B0[2][2], B1[2][2];
    const char* cA = cur.a; const char* cB = cur.b;
    PG8_GATHER(vA, cur);
    if constexpr (FUSED == 2) { PG8_BOFF(voffB, cur); hsBc = (size_t)HALF * cur.pb; }
    if constexpr (FUSED != 0) S.a_ready(cur);
    { const bool last = false;
    if constexpr (SP2) {
        PG8_STAGE_B(PG8_SB(0, 0), cB, 0, false); PG8_STAGE_B(PG8_SB(0, 1), cB, 1, false); PG8_STAGE(PG8_SA(0, 0), cA, vA[0]); PG8_STAGE(PG8_SA(0, 1), cA, vA[1]);
        if (wr == 1) PG8_BAR;
        PG8_WAIT_V(2); PG8_BAR;
        PG8_STAGE_B(PG8_SB(1, 0), cB + kstep, 0, false); PG8_STAGE(PG8_SA(1, 0), cA + kstep, vA[0]); PG8_STAGE_B(PG8_SB(1, 1), cB + kstep, 1, false);
        PG8_WAIT_V(6); PG8_BAR;
    } else {
        PG8_STAGE_B(PG8_SB(0, 0), cB, 0, false); PG8_STAGE(PG8_SA(0, 0), cA, vA[0]); PG8_STAGE_B(PG8_SB(0, 1), cB, 1, false); PG8_STAGE(PG8_SA(0, 1), cA, vA[1]);
        if (wr == 1) PG8_BAR;
        PG8_WAIT_V(4); PG8_BAR;
        PG8_STAGE_B(PG8_SB(1, 0), cB + kstep, 0, false); PG8_STAGE(PG8_SA(1, 0), cA + kstep, vA[0]); PG8_STAGE_B(PG8_SB(1, 1), cB + kstep, 1, false);
        PG8_WAIT_V(6); PG8_BAR;
    }
    }
    for (;;) {
        const bool has_next = S.next(ui + 1, nxt);
        const char* nA = has_next ? nxt.a : cA; const char* nB = has_next ? nxt.b : cB;
        if (has_next) { PG8_GATHER(vN, nxt); if constexpr (FUSED == 2) { PG8_BOFF(vBn, nxt); hsBn = (size_t)HALF * nxt.pb; } }
        const int nt = cur.nt;
        for (int t = 0; t < nt; t += 2) {
            const bool last = (t == nt - 2);
            const char* a1 = cA + (size_t)(t + 1) * kstep;
            const char* a2 = last ? nA : cA + (size_t)(t + 2) * kstep; const char* b2 = last ? nB : cB + (size_t)(t + 2) * kstep;
            const char* a3 = a2 + kstep; const char* b3 = b2 + kstep;
            if constexpr (FUSED != 0) { if (last && has_next) S.a_ready(nxt); }
            unsigned vX[2][2];
#pragma unroll
            for (int _h = 0; _h < 2; ++_h)
#pragma unroll
                for (int _i = 0; _i < 2; ++_i) vX[_h][_i] = (GATHER && last) ? vN[_h][_i] : vA[_h][_i];
            if constexpr (SP2) {
            PG8_LDB(B0, 0, 0); PG8_LDB(B1, 0, 1); PG8_SCHED; PG8_LDA(At, 0, 0); PG8_STAGE(PG8_SA(1, 1), a1, vA[1]);
            PG8_WAIT_V(8); PG8_WAIT_L(0); PG8_BAR; PG8_MMA(0, 0, At, B0); PG8_MMA(0, 1, At, B1); PG8_BAR; PG8_SCHED;
            PG8_LDA(At, 0, 1); PG8_STAGE_B(PG8_SB(0, 0), b2, 0, true); PG8_STAGE_B(PG8_SB(0, 1), b2, 1, true); PG8_STAGE(PG8_SA(0, 0), a2, vX[0]);
            PG8_WAIT_V(8); PG8_WAIT_L(0); PG8_BAR; PG8_MMA(1, 0, At, B0); PG8_MMA(1, 1, At, B1); PG8_BAR; PG8_SCHED;
            PG8_LDB(B0, 1, 0); PG8_LDB(B1, 1, 1); PG8_SCHED; PG8_LDA(At, 1, 0); PG8_STAGE(PG8_SA(0, 1), a2, vX[1]);
            PG8_WAIT_V(8); PG8_WAIT_L(0); PG8_BAR; PG8_MMA(0, 0, At, B0); PG8_MMA(0, 1, At, B1); PG8_BAR; PG8_SCHED;
            PG8_LDA(At, 1, 1); PG8_STAGE_B(PG8_SB(1, 0), b3, 0, true); PG8_STAGE_B(PG8_SB(1, 1), b3, 1, true); PG8_STAGE(PG8_SA(1, 0), a3, vX[0]);
            PG8_WAIT_V(8); PG8_WAIT_L(0); PG8_BAR; PG8_MMA(1, 0, At, B0); PG8_MMA(1, 1, At, B1); PG8_BAR; PG8_SCHED;
            } else {
            PG8_LDB(B0, 0, 0); PG8_SCHED; PG8_LDA(At, 0, 0); PG8_STAGE(PG8_SA(1, 1), a1, vA[1]);
            PG8_WAIT_L(8); PG8_BAR; PG8_WAIT_L(0); PG8_MMA(0, 0, At, B0); PG8_BAR; PG8_SCHED;
            PG8_LDB(B1, 0, 1); PG8_STAGE_B(PG8_SB(0, 0), b2, 0, true);
            PG8_BAR; PG8_WAIT_L(0); PG8_MMA(0, 1, At, B1); PG8_BAR;
            PG8_LDA(At, 0, 1); PG8_STAGE(PG8_SA(0, 0), a2, vX[0]);
            PG8_BAR; PG8_WAIT_L(0); PG8_MMA(1, 0, At, B0); PG8_BAR; PG8_SCHED;
            PG8_STAGE_B(PG8_SB(0, 1), b2, 1, true);
            PG8_WAIT_V(6); PG8_BAR; PG8_MMA(1, 1, At, B1); PG8_BAR;
            PG8_LDB(B0, 1, 0); PG8_SCHED; PG8_LDA(At, 1, 0); PG8_STAGE(PG8_SA(0, 1), a2, vX[1]);
            PG8_WAIT_L(8); PG8_BAR; PG8_WAIT_L(0); PG8_MMA(0, 0, At, B0); PG8_BAR; PG8_SCHED;
            PG8_LDB(B1, 1, 1); PG8_STAGE_B(PG8_SB(1, 0), b3, 0, true);
            PG8_BAR; PG8_WAIT_L(0); PG8_MMA(0, 1, At, B1); PG8_BAR;
            PG8_LDA(At, 1, 1); PG8_STAGE(PG8_SA(1, 0), a3, vX[0]);
            PG8_BAR; PG8_WAIT_L(0); PG8_MMA(1, 0, At, B0); PG8_BAR; PG8_SCHED;
            PG8_STAGE_B(PG8_SB(1, 1), b3, 1, true);
            PG8_WAIT_V(6); PG8_BAR; PG8_MMA(1, 1, At, B1); PG8_BAR;
            }
        }
        if constexpr (ALIGN_EPI) { if (wr == 0) PG8_BAR; }
        E(acc, cur, wr, wc, fr, fq);
        if (!has_next) break;
#pragma unroll
        for (int a = 0; a < 2; ++a)
#pragma unroll
            for (int b = 0; b < 2; ++b)
#pragma unroll
                for (int m = 0; m < 4; ++m)
#pragma unroll
                    for (int n = 0; n < 2; ++n) acc[a][b][m][n] = (f32x4){0.f, 0.f, 0.f, 0.f};
        cur = nxt; cA = nA; cB = nB; ++ui;
        if constexpr (GATHER) {
#pragma unroll
            for (int _h = 0; _h < 2; ++_h)
#pragma unroll
                for (int _i = 0; _i < 2; ++_i) vA[_h][_i] = vN[_h][_i]; }
        if constexpr (FUSED == 2) { voffB[0] = vBn[0]; voffB[1] = vBn[1]; hsBc = hsBn; }
        if constexpr (ALIGN_EPI) { if (wr == 1) PG8_BAR; }
    }
    PG8_WAIT_V(0);
    if constexpr (!ALIGN_EPI) { if (wr == 0) PG8_BAR; }
    PG8_BAR;
#undef PG8_GATHER
#undef PG8_BOFF
#undef PG8_STAGE_B
#undef PG8_SA
#undef PG8_SB
#undef PG8_STAGE
#undef PG8_LDA
#undef PG8_LDB
#undef PG8_MMA
#undef PG8_WAIT_V
#undef PG8_WAIT_L
#undef PG8_BAR
#undef PG8_SCHED
}
}

#define XB_TMO      128
#define XB_XCNT(j)  (256  + 64 * (j))
#define XB_XSUB(j)  (1280 + 64 * (j))
#define XB_XGEN(j)  (2304 + 64 * (j))
#define XB_TOP      3328
#define XB_TOPGEN   3392
#define XCD_BAR_WORDS 3456
#define XB_SPIN_CAP (1u << 18)

__device__ __forceinline__ unsigned xb_ld(unsigned* p)              { return __hip_atomic_load(p, __ATOMIC_RELAXED, __HIP_MEMORY_SCOPE_AGENT); }
__device__ __forceinline__ unsigned xb_add(unsigned* p, unsigned v) { return __hip_atomic_fetch_add(p, v, __ATOMIC_RELAXED, __HIP_MEMORY_SCOPE_AGENT); }
__device__ __forceinline__ unsigned xb_xcc_id() { return (unsigned)__builtin_amdgcn_s_getreg((3 << 11) | 20) & 0xFu; }
#define XB_SPIN(cond, bar) do { unsigned _sp = 0; while (cond) { __builtin_amdgcn_s_sleep(1); \
    if ((++_sp & 255u) == 0u) { if (xb_ld(&(bar)[XB_TMO])) break; if (_sp > XB_SPIN_CAP) { atomicAdd(&(bar)[XB_TMO], 1u); break; } } } } while (0)

struct XcdBarrier { unsigned* bar; unsigned x; volatile LAS unsigned* st; };

__device__ __forceinline__ XcdBarrier xcd_barrier_post(unsigned* bar, volatile LAS unsigned* st) {
    XcdBarrier b; b.bar = bar; b.x = xb_xcc_id(); b.st = st;
    if (threadIdx.x == 0) (void)xb_add(&bar[XB_XCNT(b.x)], 1u);
    return b;
}
__device__ __forceinline__ void xcd_barrier_complete(unsigned* bar, unsigned x, unsigned& nloc, unsigned& nx) {
    const unsigned G = gridDim.x * gridDim.y * gridDim.z;
    unsigned sum, cnt, mine, sp = 0u;
    for (;;) {
        sum = 0u; cnt = 0u; mine = 0u;
#pragma unroll
        for (unsigned j = 0; j < 16; ++j) { const unsigned c = xb_ld(&bar[XB_XCNT(j)]); sum += c; cnt += (c > 0u) ? 1u : 0u; mine = (j == x) ? c : mine; }
        if (sum == G) break;
        __builtin_amdgcn_s_sleep(1);
        if ((++sp & 255u) == 0u) { if (xb_ld(&bar[XB_TMO])) break; if (sp > XB_SPIN_CAP) { atomicAdd(&bar[XB_TMO], 1u); break; } }
    }
    nloc = mine > 0u ? mine : 1u; nx = cnt > 0u ? cnt : 1u;
}
__device__ __forceinline__ void xcd_barrier(const XcdBarrier& b) {
    asm volatile("s_waitcnt vmcnt(0)" ::: "memory");
    __syncthreads();
    if (threadIdx.x == 0) {
        unsigned* bar = b.bar;
        __builtin_amdgcn_s_waitcnt(0);
        unsigned nloc = b.st[0], nx = b.st[1];
        if (nloc == 0u) { xcd_barrier_complete(bar, b.x, nloc, nx); b.st[0] = nloc; b.st[1] = nx; }
        const unsigned old = xb_add(&bar[XB_XSUB(b.x)], 1u);
        const unsigned gen = old / nloc;
        if (old + 1u == (gen + 1u) * nloc) {
            __builtin_amdgcn_fence(__ATOMIC_RELEASE, "agent");
            asm volatile("s_waitcnt vmcnt(0)" ::: "memory");
            const unsigned og = xb_add(&bar[XB_TOP], 1u);
            const unsigned tg = og / nx;
            if (og + 1u == (tg + 1u) * nx) xb_add(&bar[XB_TOPGEN], 1u);
            else XB_SPIN(xb_ld(&bar[XB_TOPGEN]) == tg, bar);
            __builtin_amdgcn_fence(__ATOMIC_ACQUIRE, "agent");
            xb_add(&bar[XB_XGEN(b.x)], 1u);
            asm volatile("s_waitcnt vmcnt(0)" ::: "memory");
        } else {
            XB_SPIN(xb_ld(&bar[XB_XGEN(b.x)]) == gen, bar);
            __builtin_amdgcn_fence(__ATOMIC_ACQUIRE, "agent");
            asm volatile("s_waitcnt vmcnt(0)" ::: "memory");
        }
    }
    __syncthreads();
}

struct Args { const float* in[32]; float* out; unsigned char* ws; int ph_lo, ph_hi; };
enum { I_X = 0, I_C, I_CTX, I_CCTX, I_ADAW, I_ADAB, I_NORMG, I_MU, I_WRKV, I_W0, I_W1, I_W2, I_A0, I_A1, I_A2, I_G1, I_G2, I_KK, I_KA, I_RK, I_GNW, I_GNB, I_WO,
       I_WIN, I_CONV, I_WOUT, I_ROUTW, I_ROUTB, I_MGATE, I_MUP, I_MDOWN, I_FINALG };

struct Frame {
    LAS unsigned char* lds;
    int tid, lane, wave, G, vcu, gw, NGW;
};


__device__ __forceinline__ void tr_item(const float* W, int ldw, int k0, int n0, bf16_t* dst, int ldd, int drow0, const float* mu, LAS float* scr, int lane) {
#pragma unroll 8
    for (int i = 0; i < 32; ++i) { const int kk = 2 * i + (lane >> 5); scr[kk * 33 + (lane & 31)] = W[(size_t)(k0 + kk) * ldw + n0 + (lane & 31)]; }
    LDS_WAIT(); asm volatile("" ::: "memory");
    const int c = lane & 7;
    float m[8];
#pragma unroll
    for (int q = 0; q < 8; ++q) m[q] = mu ? mu[k0 + 8 * c + q] : 0.f;
#pragma unroll
    for (int j = 0; j < 4; ++j) { const int n = (lane >> 3) + 8 * j; const LAS float* s = scr + (8 * c) * 33 + n;
        float v[8];
#pragma unroll
        for (int q = 0; q < 8; ++q) v[q] = s[q * 33];
        bf16_t* drow = dst + (size_t)(drow0 + n) * ldd + k0 + 8 * c;
        if (!mu) {
            u32x4 o; o.x = pk2(v[0], v[1]); o.y = pk2(v[2], v[3]); o.z = pk2(v[4], v[5]); o.w = pk2(v[6], v[7]);
            *(u32x4*)drow = o;
        } else {
            u32x4 o; o.x = pk2(v[0] * (1.f - m[0]), v[1] * (1.f - m[1])); o.y = pk2(v[2] * (1.f - m[2]), v[3] * (1.f - m[3]));
            o.z = pk2(v[4] * (1.f - m[4]), v[5] * (1.f - m[5])); o.w = pk2(v[6] * (1.f - m[6]), v[7] * (1.f - m[7]));
            *(u32x4*)drow = o;
            u32x4 p; p.x = pk2(v[0] * 0.5f * m[0], v[1] * 0.5f * m[1]); p.y = pk2(v[2] * 0.5f * m[2], v[3] * 0.5f * m[3]);
            p.z = pk2(v[4] * 0.5f * m[4], v[5] * 0.5f * m[5]); p.w = pk2(v[6] * 0.5f * m[6], v[7] * 0.5f * m[7]);
            *(u32x4*)(drow + 1024) = p;
        }
    }
    LDS_WAIT(); asm volatile("" ::: "memory");
}
__device__ __forceinline__ void tr_job_item(const float* W, int ldw, int N, bf16_t* dst, int ldd, int drow_base, bool il, const float* mu, int item, LAS float* scr, int lane) {
    const int nblk = N / 32, kb = item / nblk, nb = item % nblk, n0 = 32 * nb;
    const int dr = drow_base + (il ? ((n0 >> 7) * 256 + (n0 & 127)) : n0);
    tr_item(W, ldw, 64 * kb, n0, dst, ldd, dr, mu, scr, lane);
}

__device__ __forceinline__ void p0_prologue(const Frame& F, const Args& A) {
    unsigned char* ws = A.ws;
    LAS float* scr = (LAS float*)(F.lds + F.wave * 16384);
    bf16_t* WRKV = (bf16_t*)(ws + WS_WRKV); bf16_t* WL = (bf16_t*)(ws + WS_WL); bf16_t* G2 = (bf16_t*)(ws + WS_G2);
    bf16_t* WO = (bf16_t*)(ws + WS_WO); bf16_t* WIN = (bf16_t*)(ws + WS_WIN); bf16_t* WOUT = (bf16_t*)(ws + WS_WOUT);
    const float* mu = A.in[I_MU];
    constexpr int NIT = 3 * 512 + 4 * 32 + 64 + 64 + 512 + 3 * 512 + 512;
    for (int it = F.gw; it < NIT; it += F.NGW) {
        int r = it;
        if (r < 1536) { const int p = r / 512; tr_job_item(A.in[I_WRKV] + (size_t)p * D * D, D, D, WRKV, 2048, p * 1024, false, nullptr, r % 512, scr, F.lane); continue; } r -= 1536;
        if (r < 64) { const int dir = r / 32; tr_job_item(A.in[I_W1] + (size_t)dir * D * 64, 64, 64, WL, 2048, dir * 64, false, mu + 3 * D, r % 32, scr, F.lane); continue; } r -= 64;
        if (r < 64) { const int dir = r / 32; tr_job_item(A.in[I_A1] + (size_t)dir * D * 64, 64, 64, WL, 2048, 128 + dir * 64, false, mu + 4 * D, r % 32, scr, F.lane); continue; } r -= 64;
        if (r < 64) { tr_job_item(A.in[I_G1], 128, 128, WL, 2048, 256, false, mu + 5 * D, r, scr, F.lane); continue; } r -= 64;
        if (r < 64) { tr_job_item(A.in[I_G2], D, D, G2, 256, 0, false, nullptr, r, scr, F.lane); continue; } r -= 64;
        if (r < 512) { tr_job_item(A.in[I_WO], D, D, WO, D, 0, false, nullptr, r, scr, F.lane); continue; } r -= 512;
        if (r < 512) { tr_job_item(A.in[I_WIN], 3 * D, D, WIN, D, 0, false, nullptr, r, scr, F.lane); continue; } r -= 512;
        if (r < 512) { tr_job_item(A.in[I_WIN] + D, 3 * D, D, WIN, D, 1024, true, nullptr, r, scr, F.lane); continue; } r -= 512;
        if (r < 512) { tr_job_item(A.in[I_WIN] + 2 * D, 3 * D, D, WIN, D, 1024 + 128, true, nullptr, r, scr, F.lane); continue; } r -= 512;
        tr_job_item(A.in[I_WOUT], D, D, WOUT, D, 0, false, nullptr, r, scr, F.lane);
    }
    {
        const int gt = F.vcu * NTHREADS + F.tid, NGT = F.G * NTHREADS;
        u32x4 z = (u32x4){0u, 0u, 0u, 0u};
        for (int i = gt; i < 32768; i += NGT) ((u32x4*)(WL + (size_t)384 * 2048))[i] = z;
        for (int i = gt; i < 16384; i += NGT) { const int row = i >> 4, q = i & 15; *(u32x4*)(G2 + (size_t)row * 256 + 128 + q * 8) = z; }
    }
    __syncthreads();
    {
        LAS float* st = (LAS float*)F.lds;
        LAS float* red = st + 9 * 1024;
        for (int i = F.tid; i < 9 * 1024; i += NTHREADS) { const float v = (i < 8192) ? A.in[I_C][i] : A.in[I_CCTX][i - 8192]; st[i] = v / (1.f + __expf(-v)); }
        __syncthreads();
        float* MOD = (float*)(ws + WS_MOD);
        for (int u = blockIdx.x; u < 256; u += F.G) {
            const int l = u >> 7, e0 = (u & 127) * 48;
            if (F.tid < 384) {
                const int q = F.tid % 12, dg = F.tid / 12;
                f32x4 acc[9];
#pragma unroll
                for (int r = 0; r < 9; ++r) acc[r] = (f32x4){0.f, 0.f, 0.f, 0.f};
                const float* wb = A.in[I_ADAW] + (size_t)l * D * 6144 + e0 + 4 * q;
#pragma unroll 4
                for (int i = 0; i < 32; ++i) { const int d = dg + 32 * i; const f32x4 w = *(const f32x4*)(wb + (size_t)d * 6144);
#pragma unroll
                    for (int r = 0; r < 9; ++r) acc[r] += st[r * 1024 + d] * w; }
#pragma unroll
                for (int r = 0; r < 9; ++r) *(LAS f32x4*)(red + (dg * 9 + r) * 48 + 4 * q) = acc[r];
            }
            __syncthreads();
            if (F.tid < 432) { const int r = F.tid / 48, ci = F.tid % 48; float s = A.in[I_ADAB][l * 6144 + e0 + ci];
                for (int dg = 0; dg < 32; ++dg) s += red[(dg * 9 + r) * 48 + ci];
                MOD[((size_t)l * 9 + r) * 6144 + e0 + ci] = s; }
            __syncthreads();
        }
    }
}

__device__ __forceinline__ void p1_load_norm(const float* row, const f32x4 (&gsc)[4], const f32x4 (&sh)[4], f32x4 (&o)[4], int lane) {
    const f32x4* xr = (const f32x4*)row + lane; float s = 0.f;
#pragma unroll
    for (int j = 0; j < 4; ++j) { o[j] = xr[64 * j]; s += (o[j].x * o[j].x + o[j].y * o[j].y) + (o[j].z * o[j].z + o[j].w * o[j].w); }
    const float rstd = rsqrtf(wave_sum(s) * (1.f / D) + RMS_EPS);
#pragma unroll
    for (int j = 0; j < 4; ++j) o[j] = o[j] * rstd * gsc[j] + sh[j];
}
__device__ __forceinline__ void ld_row_bf16(const bf16_t* row, f32x4 (&o)[4], int lane) {
#pragma unroll
    for (int j = 0; j < 4; ++j) { const u32x2 q = *(const u32x2*)(row + 4 * lane + 256 * j); o[j] = (f32x4){bflo(q.x), bfhi(q.x), bflo(q.y), bfhi(q.y)}; }
}
__device__ __forceinline__ void norm_rows(f32x4 (&o)[4], const f32x4 (&gsc)[4], const f32x4 (&sh)[4]) {
    float s = 0.f;
#pragma unroll
    for (int j = 0; j < 4; ++j) s += (o[j].x * o[j].x + o[j].y * o[j].y) + (o[j].z * o[j].z + o[j].w * o[j].w);
    const float rstd = rsqrtf(wave_sum(s) * (1.f / D) + RMS_EPS);
#pragma unroll
    for (int j = 0; j < 4; ++j) o[j] = o[j] * rstd * gsc[j] + sh[j];
}
__device__ __forceinline__ void st_bf4(bf16_t* p, const f32x4 v) { u32x2 w; w.x = pk2(v.x, v.y); w.y = pk2(v.z, v.w); *(u32x2*)p = w; }

__device__ __forceinline__ void p1_mix(const Frame& F, const Args& A) {
    const float* MOD = (const float*)(A.ws + WS_MOD);
    bf16_t* XM = (bf16_t*)(A.ws + WS_XM);
    const float* mu = A.in[I_MU]; const float* ng = A.in[I_NORMG];
    for (int u = F.gw; u < 2176; u += F.NGW) {
        const bool isctx = u >= 2048; int t0, rowlen, modrow; const float* src; size_t orow0;
        if (!isctx) { t0 = u * 16; rowlen = GRIDW; modrow = t0 / TL; src = A.in[I_X] + (size_t)t0 * D; orow0 = t0; }
        else { t0 = (u - 2048) * 16; rowlen = TCX; modrow = 8; src = A.in[I_CTX] + (size_t)t0 * D; orow0 = (size_t)ML + t0; }
        const int pos0 = t0 % rowlen;
        const float* mrow = MOD + (size_t)modrow * 6144;
        f32x4 gsc[4], sh[4], m0[4], m1[4], m2[4];
#pragma unroll
        for (int j = 0; j < 4; ++j) { const int c = 4 * F.lane + 256 * j;
            const f32x4 g = *(const f32x4*)(ng + c), sc = *(const f32x4*)(mrow + 1024 + c);
            gsc[j] = g * (1.f + sc); sh[j] = *(const f32x4*)(mrow + c);
            m0[j] = *(const f32x4*)(mu + c); m1[j] = *(const f32x4*)(mu + D + c); m2[j] = *(const f32x4*)(mu + 2 * D + c); }
        f32x4 prev[4], cur[4], nxt[4];
        if (pos0 > 0) p1_load_norm(src - D, gsc, sh, prev, F.lane);
        else {
#pragma unroll
            for (int j = 0; j < 4; ++j) prev[j] = (f32x4){0.f, 0.f, 0.f, 0.f}; }
        p1_load_norm(src, gsc, sh, cur, F.lane);
        for (int i = 0; i < 16; ++i) {
            if (pos0 + i + 1 < rowlen) p1_load_norm(src + (size_t)(i + 1) * D, gsc, sh, nxt, F.lane);
            else {
#pragma unroll
                for (int j = 0; j < 4; ++j) nxt[j] = (f32x4){0.f, 0.f, 0.f, 0.f}; }
            bf16_t* orow = XM + (orow0 + i) * XM_LD + 4 * F.lane;
#pragma unroll
            for (int j = 0; j < 4; ++j) {
                const f32x4 s = prev[j] + nxt[j], xx = 0.5f * s - cur[j];
                st_bf4(orow + 256 * j, cur[j] + xx * m0[j]);
                st_bf4(orow + D + 256 * j, cur[j] + xx * m1[j]);
                st_bf4(orow + 2 * D + 256 * j, cur[j] + xx * m2[j]);
                st_bf4(orow + 3 * D + 256 * j, cur[j]);
                st_bf4(orow + 4 * D + 256 * j, s);
                prev[j] = cur[j]; cur[j] = nxt[j];
            }
        }
    }
}

struct SchedRKV {
    const char* xm; const char* w; int G, c;
    __device__ __forceinline__ bool next(int i, pg8::Unit& u) const {
        int L;
        if (G == 256) { const int n = c < 80 ? 7 : (c < 240 ? 6 : 5); if (i >= n) return false; L = i < 5 ? c + 256 * i : (i == 5 ? 1280 + c : 1520 + c); }
        else { L = i * G + c; if (L >= 1600) return false; }
        if (L < 1536) pg8::swz_tile(L, 128, 12, u.pm, u.pn); else { const int r = L - 1536; u.pm = 128 + (r >> 3); u.pn = 4 + (r & 7); }
        u.a = xm + (size_t)u.pm * 256 * XM_LD * 2 + (size_t)(u.pn >> 2) * D * 2; u.b = w + (size_t)u.pn * 256 * 2048 * 2; u.nt = 16; u.rows = nullptr; return true;
    }
};
struct EpiRKV {
    static constexpr bool PERM = true;
    bf16_t *R, *K, *KC, *V;
    __device__ __forceinline__ void operator()(const f32x4 (&acc)[2][2][4][2], const pg8::Unit& u, int wr, int wc, int fr, int fq) const {
        const int grp = u.pn >> 2; int prow = u.pm * 256; bf16_t* base;
        if (grp == 0) base = R; else if (grp == 1) { if (u.pm < 128) base = K; else { base = KC; prow -= ML; } } else base = V;
        const int row0 = prow + wr * 64 + fr, col0 = (u.pn & 3) * 256 + wc * 32 + 8 * fq;
#pragma unroll
        for (int ai = 0; ai < 2; ++ai)
#pragma unroll
            for (int m = 0; m < 4; ++m) { bf16_t* rowp = base + (size_t)(row0 + ai * 128 + m * 16) * D + col0;
#pragma unroll
                for (int bj = 0; bj < 2; ++bj) { const f32x4 v0 = acc[ai][bj][m][0], v1 = acc[ai][bj][m][1];
                    u32x4 w; w.x = pg8::cvt_pk_bf16(v0[0], v0[1]); w.y = pg8::cvt_pk_bf16(v0[2], v0[3]); w.z = pg8::cvt_pk_bf16(v1[0], v1[1]); w.w = pg8::cvt_pk_bf16(v1[2], v1[3]);
                    *(u32x4*)(rowp + bj * 128) = w; } }
    }
};
struct SchedLora {
    const char* xm; const char* w; int G, c;
    __device__ __forceinline__ bool next(int i, pg8::Unit& u) const {
        int L;
        if (G == 256) { if (i > 1 || (i == 1 && c < 240)) return false; L = i ? 256 + (c - 240) : c; }
        else { L = i * G + c; if (L >= 272) return false; }
        u.pm = L >> 1; u.pn = L & 1;
        u.a = xm + (size_t)u.pm * 256 * XM_LD * 2 + (size_t)3 * D * 2; u.b = w + (size_t)u.pn * 256 * 2048 * 2; u.nt = 32; u.rows = nullptr; return true;
    }
};
struct EpiLora {
    static constexpr bool PERM = true;
    bf16_t *LWA, *LG;
    __device__ __forceinline__ void operator()(const f32x4 (&acc)[2][2][4][2], const pg8::Unit& u, int wr, int wc, int fr, int fq) const {
        bf16_t* base = u.pn ? LG : LWA;
        const int row0 = u.pm * 256 + wr * 64 + fr, col0 = wc * 32 + 8 * fq;
#pragma unroll
        for (int ai = 0; ai < 2; ++ai)
#pragma unroll
            for (int m = 0; m < 4; ++m) { bf16_t* rowp = base + (size_t)(row0 + ai * 128 + m * 16) * 256 + col0;
#pragma unroll
                for (int bj = 0; bj < 2; ++bj) { f32x4 v0 = acc[ai][bj][m][0], v1 = acc[ai][bj][m][1];
                    if (bj == 0) {
                        if (u.pn == 0) {
#pragma unroll
                            for (int q = 0; q < 4; ++q) { v0[q] = 1.f - 2.f / (__expf(2.f * v0[q]) + 1.f); v1[q] = 1.f - 2.f / (__expf(2.f * v1[q]) + 1.f); }
                        } else {
#pragma unroll
                            for (int q = 0; q < 4; ++q) { v0[q] = sigmoidf_(v0[q]); v1[q] = sigmoidf_(v1[q]); }
                        }
                    } else if (u.pn == 1) { v0 = (f32x4){0.f, 0.f, 0.f, 0.f}; v1 = v0; }
                    u32x4 w; w.x = pg8::cvt_pk_bf16(v0[0], v0[1]); w.y = pg8::cvt_pk_bf16(v0[2], v0[3]); w.z = pg8::cvt_pk_bf16(v1[0], v1[1]); w.w = pg8::cvt_pk_bf16(v1[2], v1[3]);
                    *(u32x4*)(rowp + bj * 128) = w; } }
    }
};
struct SchedPlain {
    const char* a; const char* b; int nM, nN, lda, ldb, nt, G, c;
    __device__ __forceinline__ bool next(int i, pg8::Unit& u) const {
        const int L = i * G + c; if (L >= nM * nN) return false;
        pg8::swz_tile(L, nM, nN, u.pm, u.pn);
        u.a = a + (size_t)u.pm * 256 * lda * 2; u.b = b + (size_t)u.pn * 256 * ldb * 2; u.nt = nt; u.rows = nullptr; return true;
    }
};
struct EpiBf16 {
    static constexpr bool PERM = true;
    bf16_t* O; int ldc;
    __device__ __forceinline__ void operator()(const f32x4 (&acc)[2][2][4][2], const pg8::Unit& u, int wr, int wc, int fr, int fq) const {
        const int row0 = u.pm * 256 + wr * 64 + fr, col0 = u.pn * 256 + wc * 32 + 8 * fq;
#pragma unroll
        for (int ai = 0; ai < 2; ++ai)
#pragma unroll
            for (int m = 0; m < 4; ++m) { bf16_t* rowp = O + (size_t)(row0 + ai * 128 + m * 16) * ldc + col0;
#pragma unroll
                for (int bj = 0; bj < 2; ++bj) { const f32x4 v0 = acc[ai][bj][m][0], v1 = acc[ai][bj][m][1];
                    u32x4 w; w.x = pg8::cvt_pk_bf16(v0[0], v0[1]); w.y = pg8::cvt_pk_bf16(v0[2], v0[3]); w.z = pg8::cvt_pk_bf16(v1[0], v1[1]); w.w = pg8::cvt_pk_bf16(v1[2], v1[3]);
                    *(u32x4*)(rowp + bj * 128) = w; } }
    }
};
struct EpiRes {
    static constexpr bool PERM = true;
    const float* basef; bf16_t* hb; const float* gate;
    __device__ __forceinline__ void operator()(const f32x4 (&acc)[2][2][4][2], const pg8::Unit& u, int wr, int wc, int fr, int fq) const {
        const int row0 = u.pm * 256 + wr * 64 + fr, col0 = u.pn * 256 + wc * 32 + 8 * fq;
        const float* gp = gate + (size_t)(u.pm >> 4) * 6144 + col0;
        f32x4 gv[2][2];
#pragma unroll
        for (int bj = 0; bj < 2; ++bj)
#pragma unroll
            for (int n = 0; n < 2; ++n) gv[bj][n] = *(const f32x4*)(gp + bj * 128 + n * 4);
#pragma unroll
        for (int ai = 0; ai < 2; ++ai)
#pragma unroll
            for (int m = 0; m < 4; ++m) { const size_t ro = (size_t)(row0 + ai * 128 + m * 16) * D + col0;
#pragma unroll
                for (int bj = 0; bj < 2; ++bj) {
                    f32x4 b0, b1;
                    if (basef) { b0 = *(const f32x4*)(basef + ro + bj * 128); b1 = *(const f32x4*)(basef + ro + bj * 128 + 4); }
                    else { const u32x4 q = *(const u32x4*)(hb + ro + bj * 128); b0 = (f32x4){bflo(q.x), bfhi(q.x), bflo(q.y), bfhi(q.y)}; b1 = (f32x4){bflo(q.z), bfhi(q.z), bflo(q.w), bfhi(q.w)}; }
                    const f32x4 v0 = b0 + gv[bj][0] * acc[ai][bj][m][0], v1 = b1 + gv[bj][1] * acc[ai][bj][m][1];
                    u32x4 w; w.x = pg8::cvt_pk_bf16(v0[0], v0[1]); w.y = pg8::cvt_pk_bf16(v0[2], v0[3]); w.z = pg8::cvt_pk_bf16(v1[0], v1[1]); w.w = pg8::cvt_pk_bf16(v1[2], v1[3]);
                    *(u32x4*)(hb + ro + bj * 128) = w; } }
    }
};
struct SchedMoe {
    const char* a; const char* b; const int* tile; int lda, ldb, nt, G, c; size_t estride;
    __device__ __forceinline__ bool next(int i, pg8::Unit& u) const {
        const int ntl = tile[0]; const int L = i * G + c; if (L >= ntl * 4) return false;
        u.pm = L >> 2; u.pn = L & 3; const int e = tile[16 + u.pm];
        u.a = a + (size_t)u.pm * 256 * lda * 2; u.b = b + (size_t)e * estride + (size_t)u.pn * 256 * ldb * 2; u.nt = nt; u.rows = nullptr; return true;
    }
};
struct SchedMoeG {
    const char* a; const char* b; const int* tile; const int* inv; int ldb, nt, G, c; size_t estride;
    __device__ __forceinline__ bool next(int i, pg8::Unit& u) const {
        const int ntl = tile[0]; const int L = i * G + c; if (L >= ntl * 4) return false;
        u.pm = L >> 2; u.pn = L & 3; const int e = tile[16 + u.pm];
        u.a = a; u.b = b + (size_t)e * estride + (size_t)u.pn * 256 * ldb * 2; u.nt = nt; u.rows = inv + u.pm * 256; return true;
    }
};
struct EpiGateUp {
    static constexpr bool PERM = true;
    bf16_t* H;
    __device__ __forceinline__ void operator()(const f32x4 (&acc)[2][2][4][2], const pg8::Unit& u, int wr, int wc, int fr, int fq) const {
        const int row0 = u.pm * 256 + wr * 64 + fr, col0 = u.pn * 128 + wc * 32 + 8 * fq;
#pragma unroll
        for (int ai = 0; ai < 2; ++ai)
#pragma unroll
            for (int m = 0; m < 4; ++m) { bf16_t* rowp = H + (size_t)(row0 + ai * 128 + m * 16) * ED + col0;
                f32x4 h0, h1;
#pragma unroll
                for (int q = 0; q < 4; ++q) { const float g0 = acc[ai][0][m][0][q], g1 = acc[ai][0][m][1][q];
                    h0[q] = g0 / (1.f + __expf(-g0)) * acc[ai][1][m][0][q]; h1[q] = g1 / (1.f + __expf(-g1)) * acc[ai][1][m][1][q]; }
                u32x4 w; w.x = pg8::cvt_pk_bf16(h0[0], h0[1]); w.y = pg8::cvt_pk_bf16(h0[2], h0[3]); w.z = pg8::cvt_pk_bf16(h1[0], h1[1]); w.w = pg8::cvt_pk_bf16(h1[2], h1[3]);
                *(u32x4*)rowp = w; }
    }
};
struct EpiGateUpPub {
    static constexpr bool PERM = true;
    unsigned char* H; unsigned* rdy;
    __device__ __forceinline__ void operator()(const f32x4 (&acc)[2][2][4][2], const pg8::Unit& u, int wr, int wc, int fr, int fq) const {
        const int row0 = u.pm * 256 + wr * 64 + fr, col0 = u.pn * 128 + wc * 32 + 8 * fq;
        const __amdgpu_buffer_rsrc_t rsrc = __builtin_amdgcn_make_buffer_rsrc(H, 0, 69632 * ED * 2, 0x00020000);
#pragma unroll
        for (int ai = 0; ai < 2; ++ai)
#pragma unroll
            for (int m = 0; m < 4; ++m) {
                f32x4 h0, h1;
#pragma unroll
                for (int q = 0; q < 4; ++q) { const float g0 = acc[ai][0][m][0][q], g1 = acc[ai][0][m][1][q];
                    h0[q] = g0 / (1.f + __expf(-g0)) * acc[ai][1][m][0][q]; h1[q] = g1 / (1.f + __expf(-g1)) * acc[ai][1][m][1][q]; }
                u32x4 w; w.x = pg8::cvt_pk_bf16(h0[0], h0[1]); w.y = pg8::cvt_pk_bf16(h0[2], h0[3]); w.z = pg8::cvt_pk_bf16(h1[0], h1[1]); w.w = pg8::cvt_pk_bf16(h1[2], h1[3]);
                __builtin_amdgcn_raw_buffer_store_b128(w, rsrc, ((row0 + ai * 128 + m * 16) * ED + col0) * 2, 0, 16);
            }
        asm volatile("s_waitcnt vmcnt(0)" ::: "memory");
        if ((threadIdx.x & 63) == 0) __hip_atomic_fetch_add(rdy + 64 * u.pm, 1u, __ATOMIC_RELAXED, __HIP_MEMORY_SCOPE_AGENT);
    }
};
struct SchedMoeD {
    const char* hh; const char* wdn; const int* tile; unsigned* rdy; unsigned* tmo; int G, c;
    __device__ __forceinline__ bool next(int j, pg8::Unit& u) const {
        const int n1 = tile[0] * 4, q = n1 / G, x = n1 - q * G; int L;
        if (q >= 1 && 3 * x <= G) {
            int nd, base;
            if (c < x) { nd = q - 1; base = c * (q - 1); } else if (c < 3 * x) { nd = q + 1; base = x * (q - 1) + (c - x) * (q + 1); } else { nd = q; base = x * (q - 1) + 2 * x * (q + 1) + (c - 3 * x) * q; }
            if (j >= nd) return false; L = base + j;
        } else { L = j * G + (G - 1 - c); if (L >= n1) return false; }
        u.pm = L >> 2; u.pn = L & 3; u.kind = 1; const int e = tile[16 + u.pm];
        u.a = hh; u.rows = nullptr; u.row0 = u.pm * 256; u.pa = ED * 2; u.pb = ED * 2; u.b = wdn + (size_t)e * (1 * MiB) + (size_t)u.pn * 256 * ED * 2; u.nt = 8;
        return true;
    }
    __device__ __forceinline__ void a_ready(const pg8::Unit& u) const {
        if (threadIdx.x < 64) {
            unsigned* w = rdy + 64 * u.pm; unsigned polls = 0;
            while ((unsigned)__builtin_amdgcn_readfirstlane(__hip_atomic_load(w, __ATOMIC_RELAXED, __HIP_MEMORY_SCOPE_AGENT)) < 32u) {
                if ((++polls & 255u) == 0u) { if (__builtin_amdgcn_readfirstlane(__hip_atomic_load(tmo, __ATOMIC_RELAXED, __HIP_MEMORY_SCOPE_AGENT)) != 0u) break;
                    if (polls > (1u << 22)) { if (threadIdx.x == 0) __hip_atomic_store(tmo, 1u, __ATOMIC_RELAXED, __HIP_MEMORY_SCOPE_AGENT); break; } }
                __builtin_amdgcn_s_sleep(2); }
            __builtin_amdgcn_fence(__ATOMIC_ACQUIRE, "agent");
            asm volatile("s_waitcnt vmcnt(0)" ::: "memory");
        }
        asm volatile("" ::: "memory"); __builtin_amdgcn_s_barrier(); asm volatile("" ::: "memory");
    }
};
struct EpiWin {
    static constexpr bool PERM = true;
    bf16_t *BG, *U;
    __device__ __forceinline__ void operator()(const f32x4 (&acc)[2][2][4][2], const pg8::Unit& u, int wr, int wc, int fr, int fq) const {
        const int row0 = u.pm * 256 + wr * 64 + fr;
        if (u.pn < 4) {
            const int col0 = u.pn * 256 + wc * 32 + 8 * fq;
#pragma unroll
            for (int ai = 0; ai < 2; ++ai)
#pragma unroll
                for (int m = 0; m < 4; ++m) { bf16_t* rowp = BG + (size_t)(row0 + ai * 128 + m * 16) * D + col0;
#pragma unroll
                    for (int bj = 0; bj < 2; ++bj) { const f32x4 v0 = acc[ai][bj][m][0], v1 = acc[ai][bj][m][1];
                        u32x4 w; w.x = pg8::cvt_pk_bf16(v0[0], v0[1]); w.y = pg8::cvt_pk_bf16(v0[2], v0[3]); w.z = pg8::cvt_pk_bf16(v1[0], v1[1]); w.w = pg8::cvt_pk_bf16(v1[2], v1[3]);
                        *(u32x4*)(rowp + bj * 128) = w; } }
        } else {
            const int col0 = (u.pn - 4) * 128 + wc * 32 + 8 * fq;
#pragma unroll
            for (int ai = 0; ai < 2; ++ai)
#pragma unroll
                for (int m = 0; m < 4; ++m) { bf16_t* rowp = U + (size_t)(row0 + ai * 128 + m * 16) * D + col0;
                    const f32x4 v0 = acc[ai][0][m][0] * acc[ai][1][m][0], v1 = acc[ai][0][m][1] * acc[ai][1][m][1];
                    u32x4 w; w.x = pg8::cvt_pk_bf16(v0[0], v0[1]); w.y = pg8::cvt_pk_bf16(v0[2], v0[3]); w.z = pg8::cvt_pk_bf16(v1[0], v1[1]); w.w = pg8::cvt_pk_bf16(v1[2], v1[3]);
                    *(u32x4*)rowp = w; }
        }
    }
};

namespace sc {
constexpr int MPB = 144;
constexpr int MB = 64 * MPB;
constexpr int B_RAWK = 0, B_NAB = 0, B_RAWR = 1, B_NAK = 1, B_LW = 2, B_MRB = 2, B_LA = 3, B_MRK = 3, B_AT = 4, B_BT = 5, B_KT = 6,
              B_RT = 7, B_EL = 8, B_BTT = 9, B_KTT = 10, B_VTT = 11, B_T = 12, B_EH = 12, B_W2T = 13, B_A2T = 14, B_RK = 15;
constexpr int O_INVN = 16 * MB, O_BON = O_INVN + 256, O_PV = O_BON + 1024, O_KKS = O_PV + 256, O_NF = O_KKS + 256;
static_assert(O_NF + 4096 <= LDSCTL_OFF, "scan LDS");
__device__ __forceinline__ bf16x8 ldf(const LAS unsigned char* p) { return *(const LAS bf16x8*)p; }
__device__ __forceinline__ bf16x8 ldfp(const LAS unsigned char* p) {
    const u32x2 lo = *(const LAS u32x2*)p, hi = *(const LAS u32x2*)(p + 32);
    return __builtin_bit_cast(bf16x8, (u32x4){lo.x, lo.y, hi.x, hi.y});
}
__device__ __forceinline__ bf16x8 packfrag(const f32x4 x0, const f32x4 x1) {
    return __builtin_bit_cast(bf16x8, (u32x4){pg8::cvt_pk_bf16(x0[0], x0[1]), pg8::cvt_pk_bf16(x0[2], x0[3]), pg8::cvt_pk_bf16(x1[0], x1[1]), pg8::cvt_pk_bf16(x1[2], x1[3])});
}
__device__ __forceinline__ void st4(LAS unsigned char* p, const f32x4 d) { *(LAS u32x2*)p = (u32x2){pg8::cvt_pk_bf16(d[0], d[1]), pg8::cvt_pk_bf16(d[2], d[3])}; }
__device__ __forceinline__ f32x4 mma(const bf16x8 a, const bf16x8 b, const f32x4 c) { return __builtin_amdgcn_mfma_f32_16x16x32_bf16(a, b, c, 0, 0, 0); }
__device__ __forceinline__ float ld1(const LAS unsigned char* p) { return __builtin_bit_cast(float, (unsigned)(*(const LAS unsigned short*)p) << 16); }
__device__ __forceinline__ void st1(LAS unsigned char* p, float v) { *(LAS unsigned short*)p = (unsigned short)f2bf(v); }
__device__ __forceinline__ float fsig(float x) { return __builtin_amdgcn_rcpf(1.f + __expf(-x)); }
template <int CTRL> __device__ __forceinline__ float dppf(float v) { return __builtin_bit_cast(float, __builtin_amdgcn_update_dpp(0, __builtin_bit_cast(int, v), CTRL, 0xF, 0xF, true)); }
__device__ __forceinline__ float sum8(float v) { v += dppf<0xB1>(v); v += dppf<0x4E>(v); v += dppf<0x141>(v); return v; }
__device__ __forceinline__ float sum16(float v) { v = sum8(v); v += dppf<0x140>(v); return v; }
}

#ifndef SCAN_REP_E1
#define SCAN_REP_E1 1
#endif
#ifndef SCAN_REP_G
#define SCAN_REP_G 1
#endif
#ifndef SCAN_REP_V
#define SCAN_REP_V 1
#endif
#ifndef SCAN_REP_E0
#define SCAN_REP_E0 1
#endif
__device__ __forceinline__ void p3_scan(const Frame& F, const Args& A) {
    using namespace sc;
#define WGBAR() do { asm volatile("s_waitcnt lgkmcnt(0)" ::: "memory"); __builtin_amdgcn_s_barrier(); asm volatile("" ::: "memory"); } while (0)
    unsigned char* ws = A.ws;
    LAS unsigned char* L = F.lds;
    const bf16_t* Rg = (const bf16_t*)A.out; const bf16_t* Kg = Rg + (size_t)ML * D;
    const bf16_t* KCg = (const bf16_t*)(ws + WS_KC); const bf16_t* Vg = (const bf16_t*)(ws + WS_V); const bf16_t* LWAg = (const bf16_t*)(ws + WS_LWA);
    const int wv = F.wave;
    const f32x4 z4 = (f32x4){0.f, 0.f, 0.f, 0.f};
    for (int s = blockIdx.x; s < 256; s += F.G) {
        const int dir = s & 1, h = (s >> 1) & 15, b = s >> 5, c0 = h * HD;
        bf16_t* Yg = (bf16_t*)(ws + (dir ? WS_Y1 : WS_Y0));
        __syncthreads();
        for (int q = F.tid; q < 4096; q += NTHREADS) { const int j = q >> 6, c = q & 63;
            sc::st1(L + B_W2T * MB + c * MPB + j * 2, A.in[I_W2][((size_t)dir * 64 + j) * D + c0 + c]); sc::st1(L + B_A2T * MB + c * MPB + j * 2, A.in[I_A2][((size_t)dir * 64 + j) * D + c0 + c]); }
        if (F.tid < 64) *(LAS float*)(L + O_KKS + F.tid * 4) = A.in[I_KK][c0 + F.tid];
        const int ce = c0 + 16 * (wv & 3) + (F.lane & 15);
        const float w0c = A.in[I_W0][dir * D + ce], a0c = A.in[I_A0][dir * D + ce], kkc = A.in[I_KK][ce], kac = A.in[I_KA][ce], rkc = A.in[I_RK][ce];
        f32x4 S[4];
#pragma unroll
        for (int q = 0; q < 4; ++q) S[q] = z4;
        u32x4 pk_, pr_, pv_, plw_, pla_;
#define SCAN_PREFETCH(gc_, ti_, cg_) do { const int seg_ = (gc_) >= 4, ci_ = seg_ ? (gc_) - 4 : (gc_), Ts_ = seg_ ? TL : TCX; const int tl_ = ci_ * 64 + (ti_), t_ = dir ? (Ts_ - 1 - tl_) : tl_; \
            const size_t arow_ = seg_ ? ((size_t)b * TL + t_) : ((size_t)ML + (size_t)b * TCX + t_); \
            const bf16_t* krow_ = seg_ ? (Kg + ((size_t)b * TL + t_) * D) : (KCg + ((size_t)b * TCX + t_) * D); \
            pk_ = *(const u32x4*)(krow_ + c0 + 8 * (cg_)); pv_ = *(const u32x4*)(Vg + arow_ * D + c0 + 8 * (cg_)); \
            pr_ = (u32x4){0u, 0u, 0u, 0u}; if (seg_) pr_ = *(const u32x4*)(Rg + ((size_t)b * TL + t_) * D + c0 + 8 * (cg_)); \
            plw_ = *(const u32x4*)(LWAg + arow_ * 256 + dir * 64 + 8 * (cg_)); pla_ = *(const u32x4*)(LWAg + arow_ * 256 + 128 + dir * 64 + 8 * (cg_)); } while (0)
        SCAN_PREFETCH(0, (F.tid >> 3), (F.tid & 7));
        __syncthreads();
#pragma unroll 1
        for (int gc = 0; gc < 68; ++gc) {
            const int seg = gc >= 4, ci = seg ? gc - 4 : gc, Tseg = seg ? TL : TCX;
            int tz = F.tid; asm volatile("" : "+v"(tz));
            const int lane = tz & 63, r = lane & 15, g = lane >> 4, ti_ = tz >> 3, cg = tz & 7;
            const int o16 = r * MPB + g * 16;
            const int o8 = r * MPB + g * 8;
            const int oE = g * (4 * MPB) + r * 2;
#pragma unroll 1
            for (int rep_ = 0; rep_ < SCAN_REP_E0; ++rep_)
            {
                LAS unsigned char* st = L + ti_ * MPB + cg * 16;
                *(LAS u32x4*)(st + B_RAWK * MB) = pk_; *(LAS u32x4*)(st + B_RAWR * MB) = pr_; *(LAS u32x4*)(st + B_LW * MB) = plw_; *(LAS u32x4*)(st + B_LA * MB) = pla_;
                const unsigned vw[4] = {pv_.x, pv_.y, pv_.z, pv_.w}, kw[4] = {pk_.x, pk_.y, pk_.z, pk_.w};
                LAS unsigned char* vt = L + B_VTT * MB + cg * (8 * MPB) + ti_ * 2;
                const f32x4 kk0 = *(const LAS f32x4*)(L + O_KKS + cg * 32), kk1 = *(const LAS f32x4*)(L + O_KKS + cg * 32 + 16);
                const float kks[8] = {kk0[0], kk0[1], kk0[2], kk0[3], kk1[0], kk1[1], kk1[2], kk1[3]};
                float ss = 0.f;
#pragma unroll
                for (int q = 0; q < 4; ++q) {
                    *(LAS unsigned short*)(vt + (2 * q) * MPB) = (unsigned short)(vw[q] & 0xffffu);
                    *(LAS unsigned short*)(vt + (2 * q + 1) * MPB) = (unsigned short)(vw[q] >> 16);
                    const float k0 = bflo(kw[q]) * kks[2 * q], k1 = bfhi(kw[q]) * kks[2 * q + 1]; ss += k0 * k0 + k1 * k1; }
                ss = sum8(ss);
                if (cg == 0) *(LAS float*)(L + O_INVN + ti_ * 4) = rsqrtf(fmaxf(ss, 1e-24f));
            }
            WGBAR();
            if (gc + 1 < 68) SCAN_PREFETCH(gc + 1, ti_, cg);
            const int ct = wv & 3, th = wv >> 2;
#pragma unroll 1
            for (int rep_ = 0; rep_ < SCAN_REP_E1; ++rep_) {
            f32x4 aacc[2]; float ev[8];
            {
                f32x4 wacc[2];
                bf16x8 w2f[2], a2f[2];
#pragma unroll
                for (int ks = 0; ks < 2; ++ks) { w2f[ks] = ldf(L + B_W2T * MB + 16 * ct * MPB + 64 * ks + o16); a2f[ks] = ldf(L + B_A2T * MB + 16 * ct * MPB + 64 * ks + o16); }
                const LAS unsigned char* lwb = L + 32 * th * MPB + o16;
#pragma unroll
                for (int tt = 0; tt < 2; ++tt) { wacc[tt] = z4; aacc[tt] = z4;
#pragma unroll
                    for (int ks = 0; ks < 2; ++ks) { wacc[tt] = mma(ldf(lwb + B_LW * MB + 16 * tt * MPB + 64 * ks), w2f[ks], wacc[tt]); aacc[tt] = mma(ldf(lwb + B_LA * MB + 16 * tt * MPB + 64 * ks), a2f[ks], aacc[tt]); } }
                LAS unsigned char* eb2 = L + 16 * ct * MPB + 64 * th + o8;
#pragma unroll
                for (int tt = 0; tt < 2; ++tt) { f32x4 lo;
#pragma unroll
                    for (int q = 0; q < 4; ++q) { const float e = 0.60653066f * fsig(wacc[tt][q] + w0c); ev[4 * tt + q] = e; lo[q] = e - __builtin_bit_cast(float, f2bf(e) << 16); wacc[tt][q] = e; }
                    st4(eb2 + B_EH * MB + 32 * tt, wacc[tt]); st4(eb2 + B_EL * MB + 32 * tt, lo); }
            }
            WGBAR();
            {
                f32x4 Li4[2]; f32x4 tot4 = z4;
                const LAS unsigned char* ehb = L + B_EH * MB + 16 * ct * MPB + o16; const LAS unsigned char* elb = L + B_EL * MB + 16 * ct * MPB + o16;
                const bf16x8 eh0 = ldf(ehb), eh1 = ldf(ehb + 64), el0 = ldf(elb), el1 = ldf(elb + 64);
                const bf16x8 ones = __builtin_bit_cast(bf16x8, (u32x4){0x3F803F80u, 0x3F803F80u, 0x3F803F80u, 0x3F803F80u});
                tot4 = mma(ones, eh0, tot4); tot4 = mma(ones, el0, tot4); tot4 = mma(ones, eh1, tot4); tot4 = mma(ones, el1, tot4);
#pragma unroll
                for (int tt = 0; tt < 2; ++tt) {
                    const int irow = 16 * (2 * th + tt) + r;
                    unsigned tw[2][4];
#pragma unroll
                    for (int ks = 0; ks < 2; ++ks)
#pragma unroll
                        for (int p = 0; p < 4; ++p) { const int j0 = 32 * ks + 8 * g + 2 * p; tw[ks][p] = (j0 <= irow ? 0x3F80u : 0u) | (j0 + 1 <= irow ? 0x3F800000u : 0u); }
                    const bf16x8 t0 = __builtin_bit_cast(bf16x8, (u32x4){tw[0][0], tw[0][1], tw[0][2], tw[0][3]}), t1 = __builtin_bit_cast(bf16x8, (u32x4){tw[1][0], tw[1][1], tw[1][2], tw[1][3]});
                    f32x4 d = z4; d = mma(t0, eh0, d); d = mma(t0, el0, d);
                    if (th) { d = mma(t1, eh1, d); d = mma(t1, el1, d); }
                    Li4[tt] = d;
                }
                const float Pc = __expf(-tot4[0]);
                if (g == 0 && th == 0) *(LAS float*)(L + O_PV + (16 * ct + r) * 4) = Pc;
                LAS unsigned char* eb = L + oE + 32 * ct + 32 * th * MPB;
                LAS unsigned char* cb = L + o8 + 16 * ct * MPB + 64 * th;
#pragma unroll
                for (int tt = 0; tt < 2; ++tt) {
                    const f32x4 inv4 = *(const LAS f32x4*)(L + O_INVN + 128 * th + 64 * tt + g * 16);
                    f32x4 btv, ktv;
                    const float em0 = __expf(-Li4[tt][0]), em1 = __expf(-Li4[tt][1]), em2 = __expf(-Li4[tt][2]), em3 = __expf(-Li4[tt][3]);
                    const float emv[4] = {em0, em1, em2, em3}, exv[4] = {__expf(ev[4 * tt] - Li4[tt][0]), em0, em1, em2};
#pragma unroll
                    for (int q = 0; q < 4; ++q) {
                        const int ro = (16 * tt + q) * MPB;
                        const float kv = ld1(eb + B_RAWK * MB + ro), rv = ld1(eb + B_RAWR * MB + ro);
                        const float a = fsig(aacc[tt][q] + a0c);
                        const float kkn = kv * kkc * inv4[q];
                        const float beta = kkn * a, kd = kv * (1.f + (a - 1.f) * kac);
                        const float em = emv[q], ep = __builtin_amdgcn_rcpf(em);
                        const float at = -kkn * exv[q], bt = beta * ep, kt = kd * ep, rt = rv * em;
                        btv[q] = bt; ktv[q] = kt;
                        st1(eb + B_AT * MB + ro, at); st1(eb + B_BT * MB + ro, bt); st1(eb + B_KT * MB + ro, kt); st1(eb + B_RT * MB + ro, rt); st1(eb + B_RK * MB + ro, rt * rkc);
                    }
                    st4(cb + B_BTT * MB + 32 * tt, btv); st4(cb + B_KTT * MB + 32 * tt, ktv);
                    asm volatile("" ::: "memory");
                }
            }
            WGBAR();
            }
#pragma unroll 1
            for (int rep_ = 0; rep_ < SCAN_REP_G; ++rep_) {
#define GRAM_ROW(m_, ti_) do { const int mm_ = (m_); \
                const LAS unsigned char* Xb_ = L + ((mm_ & 1) ? B_KT : B_BT) * MB + o16; const LAS unsigned char* Zb_ = L + (mm_ < 2 ? B_AT : B_RT) * MB + 16 * (ti_) * MPB + o16; \
                const bf16x8 zf0_ = ldf(Zb_), zf1_ = ldf(Zb_ + 64); const int i_ = 16 * (ti_) + r, st_ = (mm_ < 2) ? 1 : 0; \
                _Pragma("unroll") for (int ts_ = 0; ts_ < 4; ++ts_) { f32x4 d_ = z4; \
                    if (ts_ <= (ti_)) { d_ = mma(ldf(Xb_ + 16 * ts_ * MPB), zf0_, d_); d_ = mma(ldf(Xb_ + 16 * ts_ * MPB + 64), zf1_, d_); \
                        _Pragma("unroll") for (int q_ = 0; q_ < 4; ++q_) d_[q_] = (16 * ts_ + 4 * g + st_ + q_ <= i_) ? d_[q_] : 0.f; } \
                    st4(L + mm_ * MB + 16 * (ti_) * MPB + 32 * ts_ + o8, d_); } } while (0)
            if (wv < 6) {
                const int m = wv >> 1;
                if (wv & 1) { GRAM_ROW(m, 1); GRAM_ROW(m, 2); } else { GRAM_ROW(m, 0); GRAM_ROW(m, 3); }
                if (wv == 0) GRAM_ROW(3, 0);
                if (wv == 1) GRAM_ROW(3, 1);
            } else if (wv == 6) {
                GRAM_ROW(3, 2); GRAM_ROW(3, 3);
            } else {
#pragma unroll
                for (int q2 = 0; q2 < 4; ++q2) {
                    f32x4 d = z4;
                    d = mma(ldf(L + B_BT * MB + 16 * q2 * MPB + o16), ldf(L + B_AT * MB + 16 * q2 * MPB + o16), d); d = mma(ldf(L + B_BT * MB + 16 * q2 * MPB + 64 + o16), ldf(L + B_AT * MB + 16 * q2 * MPB + 64 + o16), d);
#pragma unroll
                    for (int q = 0; q < 4; ++q) d[q] = (4 * g + q < r) ? d[q] : 0.f;
                    st4(L + B_NAB * MB + 16 * q2 * MPB + 32 * q2 + o8, d);
                    *(LAS f32x4*)(L + O_NF + q2 * 1024 + r * 64 + g * 16) = d;
                    f32x4 bd = z4;
                    bd = mma(ldf(L + B_KT * MB + 16 * q2 * MPB + o16), ldf(L + B_RK * MB + 16 * q2 * MPB + o16), bd); bd = mma(ldf(L + B_KT * MB + 16 * q2 * MPB + 64 + o16), ldf(L + B_RK * MB + 16 * q2 * MPB + 64 + o16), bd);
                    const int rq = r & 3; const float bv = rq == 0 ? bd[0] : (rq == 1 ? bd[1] : (rq == 2 ? bd[2] : bd[3]));
                    if (g == (r >> 2)) *(LAS float*)(L + O_BON + (16 * q2 + r) * 4) = bv;
                }
            }
            LDS_WAIT(); asm volatile("" ::: "memory");
            }
            WGBAR();
            f32x4 W2[4], Y[4], U[4]; bf16x8 Sb0, Sb1, vb0, vb1, u0, u1;
            const int vs = wv & 3;
            if (wv == 7) {
                const int oD = g * (16 * MPB + 32);
                const LAS unsigned char* nf = L + O_NF + g * 1024;
                float tc[16];
                tc[0] = (r == 0) ? 1.f : 0.f;
#pragma unroll
                for (int half = 0; half < 2; ++half) {
                    f32x4 rw[8][4];
#pragma unroll
                    for (int ii = 0; ii < 8; ++ii) { const int i = 8 * half + ii;
#pragma unroll
                        for (int c4 = 0; c4 < 4; ++c4) if (i > 0 && 4 * c4 < i) rw[ii][c4] = *(const LAS f32x4*)(nf + i * 64 + c4 * 16); }
#pragma unroll
                    for (int ii = 0; ii < 8; ++ii) { const int i = 8 * half + ii;
                        if (i > 0) {
                            float a0 = (i == r) ? 1.f : 0.f, a1 = 0.f, a2 = 0.f, a3 = 0.f;
#pragma unroll
                            for (int s2 = 0; s2 < i; ++s2) { const float nvv = rw[ii][s2 >> 2][s2 & 3];
                                if ((s2 & 3) == 0) a0 += nvv * tc[s2]; else if ((s2 & 3) == 1) a1 += nvv * tc[s2]; else if ((s2 & 3) == 2) a2 += nvv * tc[s2]; else a3 += nvv * tc[s2]; }
                            tc[i] = (a0 + a1) + (a2 + a3);
                        }
                    }
                }
#pragma unroll
                for (int i = 0; i < 16; ++i) st1(L + B_T * MB + oD + i * MPB + r * 2, tc[i]);
            }
            vb0 = ldf(L + B_VTT * MB + 16 * vs * MPB + o16); vb1 = ldf(L + B_VTT * MB + 16 * vs * MPB + 64 + o16);
            if (wv < 4) {
                Sb0 = packfrag(S[0], S[1]); Sb1 = packfrag(S[2], S[3]);
                *(LAS bf16x8*)(L + B_BT * MB + vs * 2048 + lane * 16) = Sb0; *(LAS bf16x8*)(L + B_BT * MB + vs * 2048 + 1024 + lane * 16) = Sb1;
#pragma unroll
                for (int t = 0; t < 4; ++t) {
                    f32x4 d = z4;
                    d = mma(ldf(L + B_NAK * MB + 16 * t * MPB + o16), vb0, d); d = mma(ldf(L + B_NAK * MB + 16 * t * MPB + 64 + o16), vb1, d);
                    d = mma(ldfp(L + B_AT * MB + 16 * t * MPB + o8), Sb0, d); d = mma(ldfp(L + B_AT * MB + 16 * t * MPB + 64 + o8), Sb1, d); W2[t] = d;
                    f32x4 e2 = S[t];
                    e2 = mma(ldf(L + B_KTT * MB + 16 * t * MPB + o16), vb0, e2); e2 = mma(ldf(L + B_KTT * MB + 16 * t * MPB + 64 + o16), vb1, e2); S[t] = e2;
                    asm volatile("" : "+v"(W2[t]), "+v"(S[t]) :: "memory");
                }
            } else if (seg) {
#pragma unroll
                for (int t = 0; t < 4; ++t) { f32x4 y = z4;
                    y = mma(ldf(L + B_MRK * MB + 16 * t * MPB + o16), vb0, y); y = mma(ldf(L + B_MRK * MB + 16 * t * MPB + 64 + o16), vb1, y); Y[t] = y; }
            }
            WGBAR();
            if (wv < 4) {
#define DMUL(q_, x_) mma(__builtin_bit_cast(bf16x8, (u32x4){dq_[q_].x, dq_[q_].y, 0u, 0u}), packfrag((x_), z4), z4)
                u32x2 dq_[4];
#pragma unroll
                for (int q = 0; q < 4; ++q) dq_[q] = *(const LAS u32x2*)(L + B_T * MB + 16 * q * MPB + 32 * q + o8);
                U[0] = DMUL(0, W2[0]);
                { f32x4 x = mma(ldfp(L + B_NAB * MB + 16 * MPB + o8), packfrag(U[0], z4), W2[1]); U[1] = DMUL(1, x); }
                u0 = packfrag(U[0], U[1]);
                { f32x4 x = mma(ldfp(L + B_NAB * MB + 32 * MPB + o8), u0, W2[2]); U[2] = DMUL(2, x); }
                { f32x4 x = mma(ldfp(L + B_NAB * MB + 48 * MPB + o8), u0, W2[3]); x = mma(ldfp(L + B_NAB * MB + 48 * MPB + 64 + o8), packfrag(U[2], z4), x); U[3] = DMUL(3, x); }
#undef DMUL
                u1 = packfrag(U[2], U[3]);
                *(LAS bf16x8*)(L + B_KT * MB + vs * 2048 + lane * 16) = u0; *(LAS bf16x8*)(L + B_KT * MB + vs * 2048 + 1024 + lane * 16) = u1;
            } else if (seg) {
                Sb0 = *(const LAS bf16x8*)(L + B_BT * MB + vs * 2048 + lane * 16); Sb1 = *(const LAS bf16x8*)(L + B_BT * MB + vs * 2048 + 1024 + lane * 16);
#pragma unroll
                for (int t = 0; t < 4; ++t) { Y[t] = mma(ldfp(L + B_RT * MB + 16 * t * MPB + o8), Sb0, Y[t]); Y[t] = mma(ldfp(L + B_RT * MB + 16 * t * MPB + 64 + o8), Sb1, Y[t]); }
            }
            WGBAR();
            if (wv < 4) {
#pragma unroll
                for (int t = 0; t < 4; ++t) {
                    f32x4 e2 = mma(ldfp(L + B_BTT * MB + 16 * t * MPB + o8), u0, S[t]); e2 = mma(ldfp(L + B_BTT * MB + 16 * t * MPB + 64 + o8), u1, e2);
                    S[t] = e2 * *(const LAS f32x4*)(L + O_PV + 64 * t + g * 16);
                }
            } else if (seg) {
                u0 = *(const LAS bf16x8*)(L + B_KT * MB + vs * 2048 + lane * 16); u1 = *(const LAS bf16x8*)(L + B_KT * MB + vs * 2048 + 1024 + lane * 16);
                const int vcol = c0 + 16 * vs + r;
#pragma unroll
                for (int t = 0; t < 4; ++t) {
                    f32x4 y = Y[t];
                    y = mma(ldfp(L + B_MRB * MB + 16 * t * MPB + o8), u0, y); y = mma(ldfp(L + B_MRB * MB + 16 * t * MPB + 64 + o8), u1, y);
                    const f32x4 bon = *(const LAS f32x4*)(L + O_BON + 64 * t + g * 16);
                    const u32x2 vv = *(const LAS u32x2*)(L + B_VTT * MB + 16 * vs * MPB + 32 * t + o8);
                    y[0] += bon[0] * bflo(vv.x); y[1] += bon[1] * bfhi(vv.x); y[2] += bon[2] * bflo(vv.y); y[3] += bon[3] * bfhi(vv.y);
#pragma unroll
                    for (int q = 0; q < 4; ++q) { const int tl = ci * 64 + 16 * t + 4 * g + q, tt = dir ? (Tseg - 1 - tl) : tl;
                        Yg[((size_t)b * TL + tt) * D + vcol] = (bf16_t)f2bf(y[q]); }
                    asm volatile("" ::: "memory");
                }
            }
            WGBAR();
        }
#undef SCAN_PREFETCH
#undef GRAM_ROW
    }
#undef WGBAR
    __syncthreads();
}

__device__ __forceinline__ void p4_readout(const Frame& F, const Args& A) {
    unsigned char* ws = A.ws;
    {
        LAS float* scr = (LAS float*)(F.lds + F.wave * 16384);
        constexpr int NIT = 2 * 16 * 3 * 256;
        for (int it = F.gw; it < NIT; it += F.NGW) {
            const int mat = it >> 8, item = it & 255;
            const int kind = mat % 3, le = mat / 3, l = le >> 4, e = le & 15;
            unsigned char* mw = ws + (l ? WS_MOEW1 : WS_MOEW0);
            if (kind == 0) tr_job_item(A.in[I_MGATE] + (size_t)le * D * ED, ED, ED, (bf16_t*)mw, D, e * 1024, true, nullptr, item, scr, F.lane);
            else if (kind == 1) tr_job_item(A.in[I_MUP] + (size_t)le * D * ED, ED, ED, (bf16_t*)mw, D, e * 1024 + 128, true, nullptr, item, scr, F.lane);
            else tr_job_item(A.in[I_MDOWN] + (size_t)le * ED * D, D, D, (bf16_t*)(mw + 32 * MiB), ED, e * 1024, false, nullptr, item, scr, F.lane);
        }
    }
    const bf16_t* Y0 = (const bf16_t*)(ws + WS_Y0); const bf16_t* Y1 = (const bf16_t*)(ws + WS_Y1); const bf16_t* Gt = (const bf16_t*)(ws + WS_G);
    bf16_t* ZO = (bf16_t*)(ws + WS_ZO);
    float gw_[16], gb_[16];
#pragma unroll
    for (int j = 0; j < 2; ++j)
#pragma unroll
        for (int q = 0; q < 8; ++q) { const int c = 8 * F.lane + 512 * j + q; gw_[j * 8 + q] = A.in[I_GNW][c]; gb_[j * 8 + q] = A.in[I_GNB][c]; }
    for (int t = F.gw; t < ML; t += F.NGW) {
#pragma unroll
        for (int j = 0; j < 2; ++j) {
            const size_t off = (size_t)t * D + 8 * F.lane + 512 * j;
            const u32x4 a = *(const u32x4*)(Y0 + off), b = *(const u32x4*)(Y1 + off), g = *(const u32x4*)(Gt + off);
            float y[8] = {bflo(a.x) + bflo(b.x), bfhi(a.x) + bfhi(b.x), bflo(a.y) + bflo(b.y), bfhi(a.y) + bfhi(b.y), bflo(a.z) + bflo(b.z), bfhi(a.z) + bfhi(b.z), bflo(a.w) + bflo(b.w), bfhi(a.w) + bfhi(b.w)};
            float gg[8] = {bflo(g.x), bfhi(g.x), bflo(g.y), bfhi(g.y), bflo(g.z), bfhi(g.z), bflo(g.w), bfhi(g.w)};
            float s = 0.f;
#pragma unroll
            for (int q = 0; q < 8; ++q) s += y[q];
            s += __shfl_xor(s, 1); s += __shfl_xor(s, 2); s += __shfl_xor(s, 4);
            const float mean = s * (1.f / 64.f); float s2 = 0.f;
#pragma unroll
            for (int q = 0; q < 8; ++q) { y[q] -= mean; s2 += y[q] * y[q]; }
            s2 += __shfl_xor(s2, 1); s2 += __shfl_xor(s2, 2); s2 += __shfl_xor(s2, 4);
            const float rstd = rsqrtf(s2 * (1.f / 64.f) + GN_EPS);
            float z[8];
#pragma unroll
            for (int q = 0; q < 8; ++q) z[q] = (y[q] * rstd * gw_[j * 8 + q] + gb_[j * 8 + q]) * gg[q];
            u32x4 w; w.x = pk2(z[0], z[1]); w.y = pk2(z[2], z[3]); w.z = pk2(z[4], z[5]); w.w = pk2(z[6], z[7]);
            *(u32x4*)(ZO + off) = w;
        }
    }
}

__device__ __forceinline__ void p6_route(const Frame& F, const Args& A, const int layer) {
    unsigned char* ws = A.ws;
    LAS float* RW = (LAS float*)F.lds;
    __syncthreads();
    for (int i = F.tid; i < D * NE; i += NTHREADS) { const int d = i >> 4, e = i & 15; const int j = d >> 8, l = (d & 255) >> 2, jj = d & 3, dj = j * 4 + jj;
        RW[((dj * 4 + (e >> 2)) * 64 + l) * 4 + (e & 3)] = A.in[I_ROUTW][i]; }
    __syncthreads();
    const float* MOD = (const float*)(ws + WS_MOD) + (size_t)layer * 9 * 6144;
    const float* ng = A.in[I_NORMG] + (size_t)(layer * 2 + 1) * D;
    const bf16_t* h = (const bf16_t*)(ws + WS_HB);
    bf16_t* XN = (bf16_t*)(ws + WS_XN);
    unsigned* EIDX = (unsigned*)(ws + WS_EIDX); float* GATE = (float*)(ws + WS_GATE); int* CC = (int*)(ws + WS_CC);
    float rb[16];
#pragma unroll
    for (int e = 0; e < 16; ++e) rb[e] = A.in[I_ROUTB][e];
    for (int ch = F.gw; ch < 2048; ch += F.NGW) {
        const int t0 = ch * 16, b = t0 / TL;
        const float* mrow = MOD + (size_t)b * 6144;
        f32x4 gsc[4], sh[4];
#pragma unroll
        for (int j = 0; j < 4; ++j) { const int c = 4 * F.lane + 256 * j; gsc[j] = *(const f32x4*)(ng + c) * (1.f + *(const f32x4*)(mrow + 4096 + c)); sh[j] = *(const f32x4*)(mrow + 3072 + c); }
        int cnt = 0;
        for (int i = 0; i < 16; ++i) {
            const int t = t0 + i;
            f32x4 v[4];
            ld_row_bf16(h + (size_t)t * D, v, F.lane); norm_rows(v, gsc, sh);
            bf16_t* orow = XN + (size_t)t * D + 4 * F.lane;
#pragma unroll
            for (int j = 0; j < 4; ++j) st_bf4(orow + 256 * j, v[j]);
            float lg[16];
#pragma unroll
            for (int e = 0; e < 16; ++e) lg[e] = 0.f;
#pragma unroll
            for (int j = 0; j < 4; ++j)
#pragma unroll
                for (int jj = 0; jj < 4; ++jj) { const float xv = v[j][jj]; const int dj = j * 4 + jj;
#pragma unroll
                    for (int q = 0; q < 4; ++q) { const f32x4 w = *(const LAS f32x4*)(RW + ((dj * 4 + q) * 64 + F.lane) * 4);
                        lg[4 * q] += xv * w.x; lg[4 * q + 1] += xv * w.y; lg[4 * q + 2] += xv * w.z; lg[4 * q + 3] += xv * w.w; }
                    asm volatile("" : "+v"(lg[0]), "+v"(lg[1]), "+v"(lg[2]), "+v"(lg[3]), "+v"(lg[4]), "+v"(lg[5]), "+v"(lg[6]), "+v"(lg[7]),
                                      "+v"(lg[8]), "+v"(lg[9]), "+v"(lg[10]), "+v"(lg[11]), "+v"(lg[12]), "+v"(lg[13]), "+v"(lg[14]), "+v"(lg[15]) :: "memory"); }
#pragma unroll
            for (int e = 0; e < 16; ++e) lg[e] = wave_sum(lg[e]);
            float best = -3.0e38f; int be0 = 0, be1 = 1; float bs0 = 0.f, bs1 = 0.f;
#pragma unroll
            for (int g = 0; g < 4; ++g) {
                float s[4], sel[4];
#pragma unroll
                for (int q = 0; q < 4; ++q) { s[q] = 1.f / (1.f + expf(-lg[4 * g + q])); sel[q] = s[q] + rb[4 * g + q]; }
                int i1 = 0; float v1 = sel[0], s1 = s[0];
#pragma unroll
                for (int q = 1; q < 4; ++q) if (sel[q] > v1) { i1 = q; v1 = sel[q]; s1 = s[q]; }
                int i2 = -1; float v2 = -3.0e38f, s2 = 0.f;
#pragma unroll
                for (int q = 0; q < 4; ++q) if (q != i1 && sel[q] > v2) { i2 = q; v2 = sel[q]; s2 = s[q]; }
                const float gs = v1 + v2;
                if (gs > best) { best = gs; be0 = 4 * g + i1; be1 = 4 * g + i2; bs0 = s1; bs1 = s2; }
            }
            const float inv = 1.f / (bs0 + bs1);
            if (F.lane == 0) { EIDX[t] = (unsigned)be0 | ((unsigned)be1 << 8); GATE[2 * t] = bs0 * inv; GATE[2 * t + 1] = bs1 * inv; }
            cnt += (F.lane == be0) + (F.lane == be1);
        }
        if (F.lane < 16) CC[ch * 16 + F.lane] = cnt;
    }
    __syncthreads();
}

__device__ __forceinline__ void p7_permute(const Frame& F, const Args& A) {
    unsigned char* ws = A.ws;
    LAS int* cc = (LAS int*)F.lds;
    LAS int* ps = (LAS int*)(F.lds + LDS_X_OFF);
    LAS int* seg = ps + 512;
    LAS int* tot = seg + 16;
    const int* CC = (const int*)(ws + WS_CC);
    const unsigned* EIDX = (const unsigned*)(ws + WS_EIDX); int* POS = (int*)(ws + WS_POS); int* TILE = (int*)(ws + WS_TILE); int* INV = (int*)(ws + WS_INV);
    __syncthreads();
    for (int i = F.tid; i < 2048 * 16 / 4; i += NTHREADS) ((LAS u32x4*)cc)[i] = ((const u32x4*)CC)[i];
    __syncthreads();
    { const int e = F.tid & 15, part = F.tid >> 4; int s = 0; for (int q = 0; q < 64; ++q) s += cc[(part * 64 + q) * 16 + e]; ps[part * 16 + e] = s; }
    __syncthreads();
    if (F.tid < 16) { int run = 0; for (int p = 0; p < 32; ++p) { const int v = ps[p * 16 + F.tid]; ps[p * 16 + F.tid] = run; run += v; } tot[F.tid] = run; }
    __syncthreads();
    if (F.tid == 0) { int off = 0, nt = 0;
        for (int e = 0; e < 16; ++e) { const int tl = (tot[e] + 255) >> 8; seg[e] = off;
            if (blockIdx.x == 0) for (int q = 0; q < tl; ++q) TILE[16 + nt + q] = e;
            nt += tl; off += tl * 256; }
        if (blockIdx.x == 0) TILE[0] = nt; }
    __syncthreads();
    if (blockIdx.x == 0) {
        for (int e = 0; e < 16; ++e) { const int n0 = seg[e] + tot[e], n1 = seg[e] + (((tot[e] + 255) >> 8) << 8);
            for (int j = n0 + F.tid; j < n1; j += NTHREADS) INV[j] = 0; } }
    for (int ch = F.gw; ch < 2048; ch += F.NGW) {
        int base = 0;
        if (F.lane < 16) { base = seg[F.lane] + ps[(ch >> 6) * 16 + F.lane]; for (int q = (ch & ~63); q < ch; ++q) base += cc[q * 16 + F.lane]; }
        int myp = 0;
        for (int i = 0; i < 16; ++i) {
            const int t = ch * 16 + i; const unsigned ei = EIDX[t]; const int e0 = ei & 255, e1 = (ei >> 8) & 255;
            const int p0 = __shfl(base, e0); base += (F.lane == e0);
            const int p1 = __shfl(base, e1); base += (F.lane == e1);
            if (F.lane == 2 * i) myp = p0; if (F.lane == 2 * i + 1) myp = p1;
        }
        if (F.lane < 32) { POS[ch * 32 + F.lane] = myp; INV[myp] = ch * 16 + (F.lane >> 1); }
    }
    __syncthreads();
}

template <bool FINAL>
__device__ __forceinline__ void p10_combine(const Frame& F, const Args& A, const int layer) {
    unsigned char* ws = A.ws;
    const float* MOD = (const float*)(ws + WS_MOD);
    const bf16_t* O = (const bf16_t*)(ws + WS_XP); const int* POS = (const int*)(ws + WS_POS); const float* GATE = (const float*)(ws + WS_GATE);
    bf16_t* XN = (bf16_t*)(ws + WS_XN);
    bf16_t* h = (bf16_t*)(ws + WS_HB); float* outp = A.out;
    for (int ch = F.gw; ch < 2048; ch += F.NGW) {
        const int t0 = ch * 16, b = t0 / TL;
        const float* mcur = MOD + ((size_t)layer * 9 + b) * 6144;
        f32x4 gt2[4], gsc[4], sh[4];
#pragma unroll
        for (int j = 0; j < 4; ++j) { const int c = 4 * F.lane + 256 * j; gt2[j] = *(const f32x4*)(mcur + 5120 + c);
            if (FINAL) { gsc[j] = *(const f32x4*)(A.in[I_FINALG] + c); sh[j] = (f32x4){0.f, 0.f, 0.f, 0.f}; }
            else { const float* mn = MOD + ((size_t)9 + b) * 6144; gsc[j] = *(const f32x4*)(A.in[I_NORMG] + 2 * D + c) * (1.f + *(const f32x4*)(mn + 1024 + c)); sh[j] = *(const f32x4*)(mn + c); } }
        for (int i = 0; i < 16; ++i) {
            const int t = t0 + i; const int p0 = POS[2 * t], p1 = POS[2 * t + 1]; const float w0 = GATE[2 * t], w1 = GATE[2 * t + 1];
            f32x4 v[4]; float s = 0.f;
#pragma unroll
            for (int j = 0; j < 4; ++j) { const int c = 4 * F.lane + 256 * j;
                const u32x2 oa = *(const u32x2*)(O + (size_t)p0 * D + c), ob = *(const u32x2*)(O + (size_t)p1 * D + c);
                const f32x4 m = w0 * (f32x4){bflo(oa.x), bfhi(oa.x), bflo(oa.y), bfhi(oa.y)} + w1 * (f32x4){bflo(ob.x), bfhi(ob.x), bflo(ob.y), bfhi(ob.y)};
                const u32x2 hq = *(const u32x2*)(h + (size_t)t * D + c);
                v[j] = (f32x4){bflo(hq.x), bfhi(hq.x), bflo(hq.y), bfhi(hq.y)} + gt2[j] * m;
                s += (v[j].x * v[j].x + v[j].y * v[j].y) + (v[j].z * v[j].z + v[j].w * v[j].w); }
            const float rstd = rsqrtf(wave_sum(s) * (1.f / D) + RMS_EPS);
            if (FINAL) {
#pragma unroll
                for (int j = 0; j < 4; ++j) *(f32x4*)(outp + (size_t)t * D + 4 * F.lane + 256 * j) = v[j] * rstd * gsc[j];
            } else {
#pragma unroll
                for (int j = 0; j < 4; ++j) { st_bf4(h + (size_t)t * D + 4 * F.lane + 256 * j, v[j]); st_bf4(XN + (size_t)t * D + 4 * F.lane + 256 * j, v[j] * rstd * gsc[j] + sh[j]); }
            }
        }
    }
}

__device__ __forceinline__ void ld_bf16row(const bf16_t* row, float (&o)[16], int lane) {
#pragma unroll
    for (int j = 0; j < 2; ++j) { const u32x4 a = *(const u32x4*)(row + 8 * lane + 512 * j);
        o[8 * j] = bflo(a.x); o[8 * j + 1] = bfhi(a.x); o[8 * j + 2] = bflo(a.y); o[8 * j + 3] = bfhi(a.y); o[8 * j + 4] = bflo(a.z); o[8 * j + 5] = bfhi(a.z); o[8 * j + 6] = bflo(a.w); o[8 * j + 7] = bfhi(a.w); }
}
__device__ __forceinline__ void p12_conv(const Frame& F, const Args& A) {
    unsigned char* ws = A.ws;
    const bf16_t* BG = (const bf16_t*)(ws + WS_BG); const bf16_t* U = (const bf16_t*)(ws + WS_U); bf16_t* Z = (bf16_t*)(ws + WS_Z);
    float c0[16], c1[16], c2[16];
#pragma unroll
    for (int j = 0; j < 2; ++j)
#pragma unroll
        for (int q = 0; q < 8; ++q) { const int c = 8 * F.lane + 512 * j + q; c0[8 * j + q] = A.in[I_CONV][c]; c1[8 * j + q] = A.in[I_CONV][D + c]; c2[8 * j + q] = A.in[I_CONV][2 * D + c]; }
    for (int u = F.gw; u < 2048; u += F.NGW) {
        const int t0 = u * 16, pos0 = t0 % GRIDW;
        float prev[16], cur[16], nxt[16], bg[16];
        if (pos0 > 0) ld_bf16row(U + (size_t)(t0 - 1) * D, prev, F.lane);
        else {
#pragma unroll
            for (int q = 0; q < 16; ++q) prev[q] = 0.f; }
        ld_bf16row(U + (size_t)t0 * D, cur, F.lane);
        for (int i = 0; i < 16; ++i) {
            if (pos0 + i + 1 < GRIDW) ld_bf16row(U + (size_t)(t0 + i + 1) * D, nxt, F.lane);
            else {
#pragma unroll
                for (int q = 0; q < 16; ++q) nxt[q] = 0.f; }
            ld_bf16row(BG + (size_t)(t0 + i) * D, bg, F.lane);
            float z[16];
#pragma unroll
            for (int q = 0; q < 16; ++q) { z[q] = bg[q] * (c0[q] * prev[q] + c1[q] * cur[q] + c2[q] * nxt[q]); prev[q] = cur[q]; cur[q] = nxt[q]; }
#pragma unroll
            for (int j = 0; j < 2; ++j) { u32x4 w; w.x = pk2(z[8 * j], z[8 * j + 1]); w.y = pk2(z[8 * j + 2], z[8 * j + 3]); w.z = pk2(z[8 * j + 4], z[8 * j + 5]); w.w = pk2(z[8 * j + 6], z[8 * j + 7]);
                *(u32x4*)(Z + (size_t)(t0 + i) * D + 8 * F.lane + 512 * j) = w; }
        }
    }
}

constexpr int N_PHASES = 20;
__global__ void __launch_bounds__(NTHREADS, 2) fwd(Args args) {
    extern __shared__ __attribute__((aligned(16))) unsigned char lds_raw[];
    Frame F;
    F.lds = (LAS unsigned char*)lds_raw;
    F.tid = threadIdx.x; F.lane = F.tid & 63; F.wave = __builtin_amdgcn_readfirstlane(F.tid >> 6);
    F.G = gridDim.x; { const int bx = blockIdx.x; F.vcu = (F.G % 8 == 0) ? (bx % 8) * (F.G / 8) + bx / 8 : bx; }
    F.gw = F.vcu * NWAVES + F.wave; F.NGW = F.G * NWAVES;
    unsigned char* ws = args.ws;
    for (int u = F.tid; u < (LDS_BYTES - LDSCTL_OFF) / 4; u += NTHREADS) ((LAS unsigned*)(F.lds + LDSCTL_OFF))[u] = 0u;
    __syncthreads();
    volatile LAS unsigned* MISC = (volatile LAS unsigned*)(F.lds + MISC_OFF);
    XcdBarrier bar; bar.bar = (unsigned*)(ws + WS_CTL) + CW_BAR; bar.x = 0; bar.st = nullptr;
    const int lo = args.ph_lo, hi = args.ph_hi;
    if (hi - lo > 1) bar = xcd_barrier_post((unsigned*)(ws + WS_CTL) + CW_BAR, MISC + 8);
#ifndef PH_MASK
#define PH_MASK 0xFFFFFu
#endif
#define IN(k) (((PH_MASK >> (k)) & 1u) && lo <= (k) && (k) < hi)
#define SEAM(k) do { if (IN(k) && IN((k) + 1)) xcd_barrier(bar); } while (0)
#ifndef PROBE_MASK
#define PROBE_MASK 0u
#endif
#define RUNPH(k, ...) do { __VA_ARGS__ if constexpr (((PROBE_MASK >> (k)) & 1u) != 0u) { if (hi - lo > 1) xcd_barrier(bar); __VA_ARGS__ } } while (0)
    const float* MOD = (const float*)(ws + WS_MOD);
    const int bx = (int)blockIdx.x;

    if (IN(0)) { RUNPH(0, p0_prologue(F, args);); SEAM(0); }
    if (IN(1)) { RUNPH(1, p1_mix(F, args);); SEAM(1); }
    if (IN(2)) {
      RUNPH(2,
        { SchedRKV S{(const char*)(ws + WS_XM), (const char*)(ws + WS_WRKV), F.G, bx};
          EpiRKV E{(bf16_t*)args.out, (bf16_t*)args.out + (size_t)ML * D, (bf16_t*)(ws + WS_KC), (bf16_t*)(ws + WS_V)};
          pg8::gemm_phase<EpiRKV, SchedRKV>(F.lds, XM_LD, 2048, S, E); }
        { SchedLora S{(const char*)(ws + WS_XM), (const char*)(ws + WS_WL), F.G, F.G == 256 ? bx : (bx + F.G / 2) % F.G};
          EpiLora E{(bf16_t*)(ws + WS_LWA), (bf16_t*)(ws + WS_LG)};
          pg8::gemm_phase<EpiLora, SchedLora>(F.lds, XM_LD, 2048, S, E); }
      );
        SEAM(2);
    }
    if (IN(3)) {
      RUNPH(3,
        SchedPlain S{(const char*)(ws + WS_LG), (const char*)(ws + WS_G2), 128, 4, 256, 256, 4, F.G, bx};
        EpiBf16 E{(bf16_t*)(ws + WS_G), D};
        pg8::gemm_phase<EpiBf16, SchedPlain>(F.lds, 256, 256, S, E);
      );
        SEAM(3);
    }
    if (IN(4)) { RUNPH(4, p3_scan(F, args);); SEAM(4); }
    if (IN(5)) { RUNPH(5, p4_readout(F, args);); SEAM(5); }
    if (IN(6)) {
      RUNPH(6,
        SchedPlain S{(const char*)(ws + WS_ZO), (const char*)(ws + WS_WO), 128, 4, D, D, 16, F.G, bx};
        EpiRes E{args.in[I_X], (bf16_t*)(ws + WS_HB), MOD + 2048};
        pg8::gemm_phase<EpiRes, SchedPlain>(F.lds, D, D, S, E);
      );
        SEAM(6);
    }
    if (IN(7)) { RUNPH(7, p6_route(F, args, 0);); SEAM(7); }
    if (IN(8)) { RUNPH(8, p7_permute(F, args);); SEAM(8); }
    if (IN(9)) {
        unsigned* const rdy = (unsigned*)(ws + WS_CTL + CTL_RDY + 0 * 128 * 1024);
        { const SchedMoeG S{(const char*)(ws + WS_XN), (const char*)(ws + WS_MOEW0), (const int*)(ws + WS_TILE), (const int*)(ws + WS_INV), D, 16, F.G, bx, (size_t)2 * MiB};
          const EpiGateUpPub E{(unsigned char*)(ws + WS_H), rdy};
          pg8::gemm_phase<EpiGateUpPub, SchedMoeG, true>(F.lds, D, D, S, E); }
        { const SchedMoeD S{(const char*)(ws + WS_H), (const char*)(ws + WS_MOEW0 + 32 * MiB), (const int*)(ws + WS_TILE), rdy, (unsigned*)(ws + WS_CTL) + CW_TMO2, F.G, bx};
          const EpiBf16 E{(bf16_t*)(ws + WS_XP), D};
          pg8::gemm_phase<EpiBf16, SchedMoeD, true, 1>(F.lds, ED, ED, S, E); }
        if (IN(9) && IN(10 + 1)) xcd_barrier(bar);
    }
    if (IN(11)) { p10_combine<false>(F, args, 0); SEAM(11); }
    if (IN(12)) {
      RUNPH(12,
        SchedPlain S{(const char*)(ws + WS_XN), (const char*)(ws + WS_WIN), 128, 12, D, D, 16, F.G, bx};
        EpiWin E{(bf16_t*)(ws + WS_BG), (bf16_t*)(ws + WS_U)};
        pg8::gemm_phase<EpiWin, SchedPlain>(F.lds, D, D, S, E);
      );
        SEAM(12);
    }
    if (IN(13)) { RUNPH(13, p12_conv(F, args);); SEAM(13); }
    if (IN(14)) {
        SchedPlain S{(const char*)(ws + WS_Z), (const char*)(ws + WS_WOUT), 128, 4, D, D, 16, F.G, bx};
        EpiRes E{nullptr, (bf16_t*)(ws + WS_HB), MOD + 9 * 6144 + 2048};
        pg8::gemm_phase<EpiRes, SchedPlain>(F.lds, D, D, S, E);
        SEAM(14);
    }
    if (IN(15)) { RUNPH(15, p6_route(F, args, 1);); SEAM(15); }
    if (IN(16)) { RUNPH(16, p7_permute(F, args);); SEAM(16); }
    if (IN(17)) {
        unsigned* const rdy = (unsigned*)(ws + WS_CTL + CTL_RDY + 1 * 128 * 1024);
        { const SchedMoeG S{(const char*)(ws + WS_XN), (const char*)(ws + WS_MOEW1), (const int*)(ws + WS_TILE), (const int*)(ws + WS_INV), D, 16, F.G, bx, (size_t)2 * MiB};
          const EpiGateUpPub E{(unsigned char*)(ws + WS_H), rdy};
          pg8::gemm_phase<EpiGateUpPub, SchedMoeG, true>(F.lds, D, D, S, E); }
        { const SchedMoeD S{(const char*)(ws + WS_H), (const char*)(ws + WS_MOEW1 + 32 * MiB), (const int*)(ws + WS_TILE), rdy, (unsigned*)(ws + WS_CTL) + CW_TMO2, F.G, bx};
          const EpiBf16 E{(bf16_t*)(ws + WS_XP), D};
          pg8::gemm_phase<EpiBf16, SchedMoeD, true, 1>(F.lds, ED, ED, S, E); }
        if (IN(17) && IN(18 + 1)) xcd_barrier(bar);
    }
    if (IN(19)) { p10_combine<true>(F, args, 1); }
}

extern "C" void kernel_launch(void* const* d_in, const int* in_sizes, int n_in, void* d_out, int out_size, void* d_ws, size_t ws_size, hipStream_t stream) {
    static int grid = 0;
    if (grid == 0) {
        if (n_in != 32 || out_size != ML * D || ws_size < WS_END) { fprintf(stderr, "kernel_launch: unexpected problem (n_in %d, out %d, ws %zu)\n", n_in, out_size, ws_size); grid = -1; return; }
        int dev = 0, cus = 0;
        if (hipGetDevice(&dev) != hipSuccess || hipDeviceGetAttribute(&cus, hipDeviceAttributeMultiprocessorCount, dev) != hipSuccess) { grid = -1; return; }
        if (hipFuncSetAttribute((const void*)fwd, hipFuncAttributeMaxDynamicSharedMemorySize, LDS_BYTES) != hipSuccess) { grid = -1; return; }
        int per_cu = 0;
        if (hipOccupancyMaxActiveBlocksPerMultiprocessor(&per_cu, (const void*)fwd, NTHREADS, LDS_BYTES) != hipSuccess || per_cu < 1) { fprintf(stderr, "kernel_launch: occupancy query says %d\n", per_cu); grid = -1; return; }
        grid = cus > 256 ? 256 : cus;
    }
    if (grid < 0) return;
    (void)in_sizes;
    hipMemsetAsync((char*)d_ws + WS_CTL, 0, CTL_ZERO_BYTES, stream);
    Args a{};
    for (int i = 0; i < 32; ++i) a.in[i] = (const float*)d_in[i];
    a.out = (float*)d_out; a.ws = (unsigned char*)d_ws;
#if MK_N_LAUNCHES == 1
    a.ph_lo = 0; a.ph_hi = N_PHASES;
    hipLaunchKernelGGL(fwd, dim3(grid), dim3(NTHREADS), LDS_BYTES, stream, a);
#else
    for (int k = 0; k < N_PHASES; ++k) { a.ph_lo = k; a.ph_hi = k + 1; hipLaunchKernelGGL(fwd, dim3(grid), dim3(NTHREADS), LDS_BYTES, stream, a); }
#endif
}
```

```cpp
#include <hip/hip_runtime.h>
#include <cstdio>
#include <cstdint>

#ifndef MK_N_LAUNCHES
#define MK_N_LAUNCHES 1
#endif

#define GAS __attribute__((address_space(1)))
#define LAS __attribute__((address_space(3)))
typedef unsigned short bf16_t;
typedef short bf16x8 __attribute__((ext_vector_type(8)));
typedef float f32x4 __attribute__((ext_vector_type(4)));
typedef float f32x2 __attribute__((ext_vector_type(2)));
typedef unsigned u32x4 __attribute__((ext_vector_type(4)));
typedef unsigned u32x2 __attribute__((ext_vector_type(2)));

constexpr int D = 1024, NBATCH = 8, TL = 4096, TCX = 256, ML = NBATCH * TL, MC = NBATCH * TCX, MA = ML + MC;
constexpr int NH = 16, HD = 64, NE = 16, ED = 512, GRIDW = 64;
constexpr int XM_LD = 5 * D;
constexpr int NWAVES = 8, NTHREADS = 512;
constexpr float RMS_EPS = 1e-6f, GN_EPS = 64e-5f;
constexpr int MAXTILES = 272;

constexpr size_t MiB = 1u << 20;
constexpr size_t WS_CTL = 0, CTL_ZERO_BYTES = 1 * MiB;
constexpr size_t WS_MOD = 1 * MiB;
constexpr size_t WS_EIDX = 2 * MiB;
constexpr size_t WS_GATE = WS_EIDX + 128 * 1024;
constexpr size_t WS_POS = WS_GATE + 256 * 1024;
constexpr size_t WS_CC = WS_POS + 256 * 1024;
constexpr size_t WS_TILE = WS_CC + 128 * 1024;
constexpr size_t WS_INV = WS_TILE + 4 * 1024;
static_assert(WS_INV + 69632 * 4 <= 4 * MiB, "ws map");
constexpr size_t WS_WRKV = 4 * MiB;
constexpr size_t WS_WL = 16 * MiB;
constexpr size_t WS_G2 = 18 * MiB;
constexpr size_t WS_WO = 19 * MiB;
constexpr size_t WS_WIN = 21 * MiB;
constexpr size_t WS_WOUT = 27 * MiB;
constexpr size_t WS_ACT = 32 * MiB;
constexpr size_t WS_XM = WS_ACT;
constexpr size_t WS_V = 372 * MiB;
constexpr size_t WS_KC = 440 * MiB;
constexpr size_t WS_LWA = 444 * MiB;
constexpr size_t WS_LG = 461 * MiB;
constexpr size_t WS_G = 32 * MiB;
constexpr size_t WS_Y0 = 96 * MiB, WS_Y1 = 160 * MiB;
constexpr size_t WS_ZO = 272 * MiB;
constexpr size_t WS_MOEW0 = 416 * MiB, WS_MOEW1 = 464 * MiB;
constexpr size_t WS_XN = 32 * MiB;
constexpr size_t WS_XP = 96 * MiB;
constexpr size_t WS_H = 232 * MiB;
constexpr size_t WS_BG = 232 * MiB, WS_U = 160 * MiB;
constexpr size_t WS_HB = 336 * MiB;
constexpr size_t WS_Z = 96 * MiB;
constexpr size_t WS_END = 512 * MiB;

constexpr int CW_BAR = 4096;
constexpr int CW_TMO2 = 16;
constexpr size_t CTL_RDY = 256 * 1024;

constexpr int RING_BYTES = 131072;
constexpr int LDS_BYTES = 163840;
constexpr int LDSCTL_OFF = LDS_BYTES - 512, MISC_OFF = LDSCTL_OFF + 64;
constexpr int LDS_X_OFF = RING_BYTES;

typedef __bf16 bf16x2v __attribute__((ext_vector_type(2)));
__device__ __forceinline__ unsigned pk2(float lo, float hi) { const f32x2 v = {lo, hi}; return __builtin_bit_cast(unsigned, __builtin_convertvector(v, bf16x2v)); }
__device__ __forceinline__ unsigned f2bf(float f) { return pk2(f, 0.f) & 0xffffu; }
__device__ __forceinline__ float bflo(unsigned u) { return __builtin_bit_cast(float, u << 16); }
__device__ __forceinline__ float bfhi(unsigned u) { return __builtin_bit_cast(float, u & 0xffff0000u); }
__device__ __forceinline__ float wave_sum(float v) {
#pragma unroll
    for (int o = 1; o < 64; o <<= 1) v += __shfl_xor(v, o);
    return v;
}
__device__ __forceinline__ float sigmoidf_(float x) { return 1.f / (1.f + __expf(-x)); }
#define LDS_WAIT() asm volatile("s_waitcnt lgkmcnt(0)" ::: "memory")

namespace pg8 {
constexpr int BM = 256, BK = 64, HALF = 128, HTB = HALF * BK * 2, STAGE_BYTES = 8 * HTB, NXCD = 8, WGM = 8;
__host__ __device__ __forceinline__ int lds_byte(int r, int c) { const int st = (r >> 4) * 2 + (c >> 5), rr = r & 15, cc = c & 31, ob = rr * 64 + cc * 2; return st * 1024 + (ob ^ (((ob >> 9) & 1) << 5)); }
__host__ __device__ __forceinline__ void stage_rc(int b, int& R, int& C) { const int st = b / 1024, sb = b % 1024, swz = sb ^ (((sb >> 9) & 1) << 5); R = (st >> 1) * 16 + swz / 64; C = (st & 1) * 32 + (swz % 64) / 2; }
__host__ __device__ __forceinline__ int perm32(int rho) { const int n = rho >> 4, i = rho & 15; return 8 * (i >> 2) + 4 * n + (i & 3); }

struct Unit { int pm, pn; const char* a; const char* b; int nt; const int* rows; int kind, pa, pb, row0; };

__device__ __forceinline__ void swz_tile(int L, int nM, int nN, int& pm, int& pn) {
    const int nwg = nM * nN; int wgid = L;
    { const int q = nwg / NXCD, r = nwg % NXCD, xcd = wgid % NXCD, off = wgid / NXCD; wgid = (xcd < r ? xcd * (q + 1) : r * (q + 1) + (xcd - r) * q) + off; }
    const int nig = WGM * nN, gid = wgid / nig, fm = gid * WGM, gsz = (nM - fm) < WGM ? (nM - fm) : WGM;
    pm = fm + ((wgid % nig) % gsz); pn = (wgid % nig) / gsz;
}

__device__ __forceinline__ unsigned cvt_pk_bf16(float lo, float hi) { return pk2(lo, hi); }

template <class Epi, class Sched, bool GATHER = false, int FUSED = 0  , bool ALIGN_EPI = true, bool SP2 = true>
__device__ __forceinline__ void gemm_phase(LAS unsigned char* lds, const int lda, const int ldb, const Sched& S, const Epi& E) {
    const int tid = threadIdx.x, wid = __builtin_amdgcn_readfirstlane(tid >> 6), lane = tid & 63, wr = wid >> 2, wc = wid & 3, fr = lane & 15, fq = lane >> 4;
    unsigned vA[2][2], vN[2][2], voffB[2], vBn[2]; int gR[2], gC[2], gRb[2]; size_t hsBc = 0, hsBn = 0;
#pragma unroll
    for (int i = 0; i < 2; ++i) { int R, C; stage_rc(tid * 16 + i * 8192, R, C); const int Rb = Epi::PERM ? ((R & ~31) + perm32(R & 31)) : R;
        gR[i] = R; gC[i] = C * 2; gRb[i] = Rb; vBn[i] = 0;
        vA[0][i] = (unsigned)(R * lda + C) * 2u; vA[1][i] = (unsigned)((R + HALF) * lda + C) * 2u; vN[0][i] = vA[0][i]; vN[1][i] = vA[1][i];
        voffB[i] = (unsigned)(Rb * ldb + C) * 2u; }
#define PG8_GATHER(dst, u) do { if constexpr (GATHER) { _Pragma("unroll") for (int _h = 0; _h < 2; ++_h) _Pragma("unroll") for (int _i = 0; _i < 2; ++_i) { \
        if constexpr (FUSED != 0) { const int ri_ = gR[_i] + _h * HALF; const unsigned rr_ = (u).rows ? (unsigned)(u).rows[ri_] : (unsigned)((u).row0 + ri_); dst[_h][_i] = rr_ * (unsigned)(u).pa + (unsigned)gC[_i]; } \
        else dst[_h][_i] = (unsigned)(u).rows[gR[_i] + _h * HALF] * (unsigned)(lda * 2) + (unsigned)gC[_i]; } } } while (0)
#define PG8_BOFF(dst, u) do { if constexpr (FUSED == 2) { _Pragma("unroll") for (int _i = 0; _i < 2; ++_i) dst[_i] = (unsigned)gRb[_i] * (unsigned)(u).pb + (unsigned)gC[_i]; } } while (0)
#define PG8_STAGE_B(bufoff, gbase, hh, nx) do { if constexpr (FUSED == 2) { if ((nx) && last) PG8_STAGE(bufoff, (gbase) + (hh) * hsBn, vBn); else PG8_STAGE(bufoff, (gbase) + (hh) * hsBc, voffB); } \
        else PG8_STAGE(bufoff, (gbase) + (hh) * hstepB, voffB); } while (0)
    const size_t kstep = (size_t)(BK * 2);
    const size_t hstepB = (size_t)HALF * ldb * 2;
    const unsigned ldsw = (unsigned)wid * 1024u;
    const int aoff = lds_byte(wr * 64 + fr, fq * 8), boff = lds_byte(wc * 32 + fr, fq * 8);
#define PG8_SA(b, h) (((b) * 2 + (h)) * HTB)
#define PG8_SB(b, h) ((4 + (b) * 2 + (h)) * HTB)
#define PG8_STAGE(bufoff, gbase, voff) do { _Pragma("unroll") for (int _i = 0; _i < 2; ++_i) \
        __builtin_amdgcn_global_load_lds((const unsigned*)((const char*)(gbase) + (voff)[_i]), (LAS unsigned*)(lds + (bufoff) + ldsw + _i * 8192), 16, 0, 0); } while (0)
#define PG8_LDA(dst, b, h) do { _Pragma("unroll") for (int m = 0; m < 4; ++m) _Pragma("unroll") for (int k = 0; k < 2; ++k) dst[m][k] = *(const LAS bf16x8*)(lds + PG8_SA(b, h) + aoff + m * 2048 + k * 1024); } while (0)
#define PG8_LDB(dst, b, h) do { _Pragma("unroll") for (int n = 0; n < 2; ++n) _Pragma("unroll") for (int k = 0; k < 2; ++k) dst[n][k] = *(const LAS bf16x8*)(lds + PG8_SB(b, h) + boff + n * 2048 + k * 1024); } while (0)
#define PG8_MMA(ai, bj, At, Bt) do { __builtin_amdgcn_s_setprio(1); _Pragma("unroll") for (int m = 0; m < 4; ++m) _Pragma("unroll") for (int n = 0; n < 2; ++n) _Pragma("unroll") for (int k = 0; k < 2; ++k) \
        acc[ai][bj][m][n] = __builtin_amdgcn_mfma_f32_16x16x32_bf16(Bt[n][k], At[m][k], acc[ai][bj][m][n], 0, 0, 0); __builtin_amdgcn_s_setprio(0); } while (0)
#define PG8_WAIT_V(n) asm volatile("s_waitcnt vmcnt(" #n ")" ::: "memory")
#define PG8_WAIT_L(n) asm volatile("s_waitcnt lgkmcnt(" #n ")" ::: "memory")
#define PG8_BAR __builtin_amdgcn_s_barrier()
#define PG8_SCHED __builtin_amdgcn_sched_barrier(0)
    Unit cur, nxt; int ui = 0;
    if (!S.next(0, cur)) return;
    f32x4 acc[2][2][4][2];
#pragma unroll
    for (int a = 0; a < 2; ++a)
#pragma unroll
        for (int b = 0; b < 2; ++b)
#pragma unroll
            for (int m = 0; m < 4; ++m)
#pragma unroll
                for (int n = 0; n < 2; ++n) acc[a][b][m][n] = (f32x4){0.f, 0.f, 0.f, 0.f};
    bf16x8 At[4][2], B0[2][2], B1[2][2];
    const char* cA = cur.a; const char* cB = cur.b;
    PG8_GATHER(vA, cur);
    if constexpr (FUSED == 2) { PG8_BOFF(voffB, cur); hsBc = (size_t)HALF * cur.pb; }
    if constexpr (FUSED != 0) S.a_ready(cur);
    { const bool last = false;
    if constexpr (SP2) {
        PG8_STAGE_B(PG8_SB(0, 0), cB, 0, false); PG8_STAGE_B(PG8_SB(0, 1), cB, 1, false); PG8_STAGE(PG8_SA(0, 0), cA, vA[0]); PG8_STAGE(PG8_SA(0, 1), cA, vA[1]);
        if (wr == 1) PG8_BAR;
        PG8_WAIT_V(2); PG8_BAR;
        PG8_STAGE_B(PG8_SB(1, 0), cB + kstep, 0, false); PG8_STAGE(PG8_SA(1, 0), cA + kstep, vA[0]); PG8_STAGE_B(PG8_SB(1, 1), cB + kstep, 1, false);
        PG8_WAIT_V(6); PG8_BAR;
    } else {
        PG8_STAGE_B(PG8_SB(0, 0), cB, 0, false); PG8_STAGE(PG8_SA(0, 0), cA, vA[0]); PG8_STAGE_B(PG8_SB(0, 1), cB, 1, false); PG8_STAGE(PG8_SA(0, 1), cA, vA[1]);
        if (wr == 1) PG8_BAR;
        PG8_WAIT_V(4); PG8_BAR;
        PG8_STAGE_B(PG8_SB(1, 0), cB + kstep, 0, false); PG8_STAGE(PG8_SA(1, 0), cA + kstep, vA[0]); PG8_STAGE_B(PG8_SB(1, 1), cB + kstep, 1, false);
        PG8_WAIT_V(6); PG8_BAR;
    }
    }
    for (;;) {
        const bool has_next = S.next(ui + 1, nxt);
        const char* nA = has_next ? nxt.a : cA; const char* nB = has_next ? nxt.b : cB;
        if (has_next) { PG8_GATHER(vN, nxt); if constexpr (FUSED == 2) { PG8_BOFF(vBn, nxt); hsBn = (size_t)HALF * nxt.pb; } }
        const int nt = cur.nt;
        for (int t = 0; t < nt; t += 2) {
            const bool last = (t == nt - 2);
            const char* a1 = cA + (size_t)(t + 1) * kstep;
            const char* a2 = last ? nA : cA + (size_t)(t + 2) * kstep; const char* b2 = last ? nB : cB + (size_t)(t + 2) * kstep;
            const char* a3 = a2 + kstep; const char* b3 = b2 + kstep;
            if constexpr (FUSED != 0) { if (last && has_next) S.a_ready(nxt); }
            unsigned vX[2][2];
#pragma unroll
            for (int _h = 0; _h < 2; ++_h)
#pragma unroll
                for (int _i = 0; _i < 2; ++_i) vX[_h][_i] = (GATHER && last) ? vN[_h][_i] : vA[_h][_i];
            if constexpr (SP2) {
            PG8_LDB(B0, 0, 0); PG8_LDB(B1, 0, 1); PG8_SCHED; PG8_LDA(At, 0, 0); PG8_STAGE(PG8_SA(1, 1), a1, vA[1]);
            PG8_WAIT_V(8); PG8_WAIT_L(0); PG8_BAR; PG8_MMA(0, 0, At, B0); PG8_MMA(0, 1, At, B1); PG8_BAR; PG8_SCHED;
            PG8_LDA(At, 0, 1); PG8_STAGE_B(PG8_SB(0, 0), b2, 0, true); PG8_STAGE_B(PG8_SB(0, 1), b2, 1, true); PG8_STAGE(PG8_SA(0, 0), a2, vX[0]);
            PG8_WAIT_V(8); PG8_WAIT_L(0); PG8_BAR; PG8_MMA(1, 0, At, B0); PG8_MMA(1, 1, At, B1); PG8_BAR; PG8_SCHED;
            PG8_LDB(B0, 1, 0); PG8_LDB(B1, 1, 1); PG8_SCHED; PG8_LDA(At, 1, 0); PG8_STAGE(PG8_SA(0, 1), a2, vX[1]);
            PG8_WAIT_V(8); PG8_WAIT_L(0); PG8_BAR; PG8_MMA(0, 0, At, B0); PG8_MMA(0, 1, At, B1); PG8_BAR; PG8_SCHED;
            PG8_LDA(At, 1, 1); PG8_STAGE_B(PG8_SB(1, 0), b3, 0, true); PG8_STAGE_B(PG8_SB(1, 1), b3, 1, true); PG8_STAGE(PG8_SA(1, 0), a3, vX[0]);
            PG8_WAIT_V(8); PG8_WAIT_L(0); PG8_BAR; PG8_MMA(1, 0, At, B0); PG8_MMA(1, 1, At, B1); PG8_BAR; PG8_SCHED;
            } else {
            PG8_LDB(B0, 0, 0); PG8_SCHED; PG8_LDA(At, 0, 0); PG8_STAGE(PG8_SA(1, 1), a1, vA[1]);
            PG8_WAIT_L(8); PG8_BAR; PG8_WAIT_L(0); PG8_MMA(0, 0, At, B0); PG8_BAR; PG8_SCHED;
            PG8_LDB(B1, 0, 1); PG8_STAGE_B(PG8_SB(0, 0), b2, 0, true);
            PG8_BAR; PG8_WAIT_L(0); PG8_MMA(0, 1, At, B1); PG8_BAR;
            PG8_LDA(At, 0, 1); PG8_STAGE(PG8_SA(0, 0), a2, vX[0]);
            PG8_BAR; PG8_WAIT_L(0); PG8_MMA(1, 0, At, B0); PG8_BAR; PG8_SCHED;
            PG8_STAGE_B(PG8_SB(0, 1), b2, 1, true);
            PG8_WAIT_V(6); PG8_BAR; PG8_MMA(1, 1, At, B1); PG8_BAR;
            PG8_LDB(B0, 1, 0); PG8_SCHED; PG8_LDA(At, 1, 0); PG8_STAGE(PG8_SA(0, 1), a2, vX[1]);
            PG8_WAIT_L(8); PG8_BAR; PG8_WAIT_L(0); PG8_MMA(0, 0, At, B0); PG8_BAR; PG8_SCHED;
            PG8_LDB(B1, 1, 1); PG8_STAGE_B(PG8_SB(1, 0), b3, 0, true);
            PG8_BAR; PG8_WAIT_L(0); PG8_MMA(0, 1, At, B1); PG8_BAR;
            PG8_LDA(At, 1, 1); PG8_STAGE(PG8_SA(1, 0), a3, vX[0]);
            PG8_BAR; PG8_WAIT_L(0); PG8_MMA(1, 0, At, B0); PG8_BAR; PG8_SCHED;
            PG8_STAGE_B(PG8_SB(1, 1), b3, 1, true);
            PG8_WAIT_V(6); PG8_BAR; PG8_MMA(1, 1, At, B1); PG8_BAR;
            }
        }
        if constexpr (ALIGN_EPI) { if (wr == 0) PG8_BAR; }
        E(acc, cur, wr, wc, fr, fq);
        if (!has_next) break;
#pragma unroll
        for (int a = 0; a < 2; ++a)
#pragma unroll
            for (int b = 0; b < 2; ++b)
#pragma unroll
                for (int m = 0; m < 4; ++m)
#pragma unroll
                    for (int n = 0; n < 2; ++n) acc[a][b][m][n] = (f32x4){0.f, 0.f, 0.f, 0.f};
        cur = nxt; cA = nA; cB = nB; ++ui;
        if constexpr (GATHER) {
#pragma unroll
            for (int _h = 0; _h < 2; ++_h)
#pragma unroll
                for (int _i = 0; _i < 2; ++_i) vA[_h][_i] = vN[_h][_i]; }
        if constexpr (FUSED == 2) { voffB[0] = vBn[0]; voffB[1] = vBn[1]; hsBc = hsBn; }
        if constexpr (ALIGN_EPI) { if (wr == 1) PG8_BAR; }
    }
    PG8_WAIT_V(0);
    if constexpr (!ALIGN_EPI) { if (wr == 0) PG8_BAR; }
    PG8_BAR;
#undef PG8_GATHER
#undef PG8_BOFF
#undef PG8_STAGE_B
#undef PG8_SA
#undef PG8_SB
#undef PG8_STAGE
#undef PG8_LDA
#undef PG8_LDB
#undef PG8_MMA
#undef PG8_WAIT_V
#undef PG8_WAIT_L
#undef PG8_BAR
#undef PG8_SCHED
}
}

#define XB_TMO      128
#define XB_XCNT(j)  (256  + 64 * (j))
#define XB_XSUB(j)  (1280 + 64 * (j))
#define XB_XGEN(j)  (2304 + 64 * (j))
#define XB_TOP      3328
#define XB_TOPGEN   3392
#define XCD_BAR_WORDS 3456
#define XB_SPIN_CAP (1u << 18)

__device__ __forceinline__ unsigned xb_ld(unsigned* p)              { return __hip_atomic_load(p, __ATOMIC_RELAXED, __HIP_MEMORY_SCOPE_AGENT); }
__device__ __forceinline__ unsigned xb_add(unsigned* p, unsigned v) { return __hip_atomic_fetch_add(p, v, __ATOMIC_RELAXED, __HIP_MEMORY_SCOPE_AGENT); }
__device__ __forceinline__ unsigned xb_xcc_id() { return (unsigned)__builtin_amdgcn_s_getreg((3 << 11) | 20) & 0xFu; }
#define XB_SPIN(cond, bar) do { unsigned _sp = 0; while (cond) { __builtin_amdgcn_s_sleep(1); \
    if ((++_sp & 255u) == 0u) { if (xb_ld(&(bar)[XB_TMO])) break; if (_sp > XB_SPIN_CAP) { atomicAdd(&(bar)[XB_TMO], 1u); break; } } } } while (0)

struct XcdBarrier { unsigned* bar; unsigned x; volatile LAS unsigned* st; };

__device__ __forceinline__ XcdBarrier xcd_barrier_post(unsigned* bar, volatile LAS unsigned* st) {
    XcdBarrier b; b.bar = bar; b.x = xb_xcc_id(); b.st = st;
    if (threadIdx.x == 0) (void)xb_add(&bar[XB_XCNT(b.x)], 1u);
    return b;
}
__device__ __forceinline__ void xcd_barrier_complete(unsigned* bar, unsigned x, unsigned& nloc, unsigned& nx) {
    const unsigned G = gridDim.x * gridDim.y * gridDim.z;
    unsigned sum, cnt, mine, sp = 0u;
    for (;;) {
        sum = 0u; cnt = 0u; mine = 0u;
#pragma unroll
        for (unsigned j = 0; j < 16; ++j) { const unsigned c = xb_ld(&bar[XB_XCNT(j)]); sum += c; cnt += (c > 0u) ? 1u : 0u; mine = (j == x) ? c : mine; }
        if (sum == G) break;
        __builtin_amdgcn_s_sleep(1);
        if ((++sp & 255u) == 0u) { if (xb_ld(&bar[XB_TMO])) break; if (sp > XB_SPIN_CAP) { atomicAdd(&bar[XB_TMO], 1u); break; } }
    }
    nloc = mine > 0u ? mine : 1u; nx = cnt > 0u ? cnt : 1u;
}
__device__ __forceinline__ void xcd_barrier(const XcdBarrier& b) {
    asm volatile("s_waitcnt vmcnt(0)" ::: "memory");
    __syncthreads();
    if (threadIdx.x == 0) {
        unsigned* bar = b.bar;
        __builtin_amdgcn_s_waitcnt(0);
        unsigned nloc = b.st[0], nx = b.st[1];
        if (nloc == 0u) { xcd_barrier_complete(bar, b.x, nloc, nx); b.st[0] = nloc; b.st[1] = nx; }
        const unsigned old = xb_add(&bar[XB_XSUB(b.x)], 1u);
        const unsigned gen = old / nloc;
        if (old + 1u == (gen + 1u) * nloc) {
            __builtin_amdgcn_fence(__ATOMIC_RELEASE, "agent");
            asm volatile("s_waitcnt vmcnt(0)" ::: "memory");
            const unsigned og = xb_add(&bar[XB_TOP], 1u);
            const unsigned tg = og / nx;
            if (og + 1u == (tg + 1u) * nx) xb_add(&bar[XB_TOPGEN], 1u);
            else XB_SPIN(xb_ld(&bar[XB_TOPGEN]) == tg, bar);
            __builtin_amdgcn_fence(__ATOMIC_ACQUIRE, "agent");
            xb_add(&bar[XB_XGEN(b.x)], 1u);
            asm volatile("s_waitcnt vmcnt(0)" ::: "memory");
        } else {
            XB_SPIN(xb_ld(&bar[XB_XGEN(b.x)]) == gen, bar);
            __builtin_amdgcn_fence(__ATOMIC_ACQUIRE, "agent");
            asm volatile("s_waitcnt vmcnt(0)" ::: "memory");
        }
    }
    __syncthreads();
}

struct Args { const float* in[32]; float* out; unsigned char* ws; int ph_lo, ph_hi; };
enum { I_X = 0, I_C, I_CTX, I_CCTX, I_ADAW, I_ADAB, I_NORMG, I_MU, I_WRKV, I_W0, I_W1, I_W2, I_A0, I_A1, I_A2, I_G1, I_G2, I_KK, I_KA, I_RK, I_GNW, I_GNB, I_WO,
       I_WIN, I_CONV, I_WOUT, I_ROUTW, I_ROUTB, I_MGATE, I_MUP, I_MDOWN, I_FINALG };

struct Frame {
    LAS unsigned char* lds;
    int tid, lane, wave, G, vcu, gw, NGW;
};


__device__ __forceinline__ void tr_item(const float* W, int ldw, int k0, int n0, bf16_t* dst, int ldd, int drow0, const float* mu, LAS float* scr, int lane) {
#pragma unroll 8
    for (int i = 0; i < 32; ++i) { const int kk = 2 * i + (lane >> 5); scr[kk * 33 + (lane & 31)] = W[(size_t)(k0 + kk) * ldw + n0 + (lane & 31)]; }
    LDS_WAIT(); asm volatile("" ::: "memory");
    const int c = lane & 7;
    float m[8];
#pragma unroll
    for (int q = 0; q < 8; ++q) m[q] = mu ? mu[k0 + 8 * c + q] : 0.f;
#pragma unroll
    for (int j = 0; j < 4; ++j) { const int n = (lane >> 3) + 8 * j; const LAS float* s = scr + (8 * c) * 33 + n;
        float v[8];
#pragma unroll
        for (int q = 0; q < 8; ++q) v[q] = s[q * 33];
        bf16_t* drow = dst + (size_t)(drow0 + n) * ldd + k0 + 8 * c;
        if (!mu) {
            u32x4 o; o.x = pk2(v[0], v[1]); o.y = pk2(v[2], v[3]); o.z = pk2(v[4], v[5]); o.w = pk2(v[6], v[7]);
            *(u32x4*)drow = o;
        } else {
            u32x4 o; o.x = pk2(v[0] * (1.f - m[0]), v[1] * (1.f - m[1])); o.y = pk2(v[2] * (1.f - m[2]), v[3] * (1.f - m[3]));
            o.z = pk2(v[4] * (1.f - m[4]), v[5] * (1.f - m[5])); o.w = pk2(v[6] * (1.f - m[6]), v[7] * (1.f - m[7]));
            *(u32x4*)drow = o;
            u32x4 p; p.x = pk2(v[0] * 0.5f * m[0], v[1] * 0.5f * m[1]); p.y = pk2(v[2] * 0.5f * m[2], v[3] * 0.5f * m[3]);
            p.z = pk2(v[4] * 0.5f * m[4], v[5] * 0.5f * m[5]); p.w = pk2(v[6] * 0.5f * m[6], v[7] * 0.5f * m[7]);
            *(u32x4*)(drow + 1024) = p;
        }
    }
    LDS_WAIT(); asm volatile("" ::: "memory");
}
__device__ __forceinline__ void tr_job_item(const float* W, int ldw, int N, bf16_t* dst, int ldd, int drow_base, bool il, const float* mu, int item, LAS float* scr, int lane) {
    const int nblk = N / 32, kb = item / nblk, nb = item % nblk, n0 = 32 * nb;
    const int dr = drow_base + (il ? ((n0 >> 7) * 256 + (n0 & 127)) : n0);
    tr_item(W, ldw, 64 * kb, n0, dst, ldd, dr, mu, scr, lane);
}

__device__ __forceinline__ void p0_prologue(const Frame& F, const Args& A) {
    unsigned char* ws = A.ws;
    LAS float* scr = (LAS float*)(F.lds + F.wave * 16384);
    bf16_t* WRKV = (bf16_t*)(ws + WS_WRKV); bf16_t* WL = (bf16_t*)(ws + WS_WL); bf16_t* G2 = (bf16_t*)(ws + WS_G2);
    bf16_t* WO = (bf16_t*)(ws + WS_WO); bf16_t* WIN = (bf16_t*)(ws + WS_WIN); bf16_t* WOUT = (bf16_t*)(ws + WS_WOUT);
    const float* mu = A.in[I_MU];
    constexpr int NIT = 3 * 512 + 4 * 32 + 64 + 64 + 512 + 3 * 512 + 512;
    for (int it = F.gw; it < NIT; it += F.NGW) {
        int r = it;
        if (r < 1536) { const int p = r / 512; tr_job_item(A.in[I_WRKV] + (size_t)p * D * D, D, D, WRKV, D, p * 1024, false, nullptr, r % 512, scr, F.lane); continue; } r -= 1536;
        if (r < 64) { const int dir = r / 32; tr_job_item(A.in[I_W1] + (size_t)dir * D * 64, 64, 64, WL, 2048, dir * 64, false, mu + 3 * D, r % 32, scr, F.lane); continue; } r -= 64;
        if (r < 64) { const int dir = r / 32; tr_job_item(A.in[I_A1] + (size_t)dir * D * 64, 64, 64, WL, 2048, 128 + dir * 64, false, mu + 4 * D, r % 32, scr, F.lane); continue; } r -= 64;
        if (r < 64) { tr_job_item(A.in[I_G1], 128, 128, WL, 2048, 256, false, mu + 5 * D, r, scr, F.lane); continue; } r -= 64;
        if (r < 64) { tr_job_item(A.in[I_G2], D, D, G2, 256, 0, false, nullptr, r, scr, F.lane); continue; } r -= 64;
        if (r < 512) { tr_job_item(A.in[I_WO], D, D, WO, D, 0, false, nullptr, r, scr, F.lane); continue; } r -= 512;
        if (r < 512) { tr_job_item(A.in[I_WIN], 3 * D, D, WIN, D, 0, false, nullptr, r, scr, F.lane); continue; } r -= 512;
        if (r < 512) { tr_job_item(A.in[I_WIN] + D, 3 * D, D, WIN, D, 1024, true, nullptr, r, scr, F.lane); continue; } r -= 512;
        if (r < 512) { tr_job_item(A.in[I_WIN] + 2 * D, 3 * D, D, WIN, D, 1024 + 128, true, nullptr, r, scr, F.lane); continue; } r -= 512;
        tr_job_item(A.in[I_WOUT], D, D, WOUT, D, 0, false, nullptr, r, scr, F.lane);
    }
    {
        const int gt = F.vcu * NTHREADS + F.tid, NGT = F.G * NTHREADS;
        u32x4 z = (u32x4){0u, 0u, 0u, 0u};
        for (int i = gt; i < 32768; i += NGT) ((u32x4*)(WL + (size_t)384 * 2048))[i] = z;
        for (int i = gt; i < 16384; i += NGT) { const int row = i >> 4, q = i & 15; *(u32x4*)(G2 + (size_t)row * 256 + 128 + q * 8) = z; }
    }
    __syncthreads();
    {
        LAS float* st = (LAS float*)F.lds;
        LAS float* red = st + 9 * 1024;
        for (int i = F.tid; i < 9 * 1024; i += NTHREADS) { const float v = (i < 8192) ? A.in[I_C][i] : A.in[I_CCTX][i - 8192]; st[i] = v / (1.f + __expf(-v)); }
        __syncthreads();
        float* MOD = (float*)(ws + WS_MOD);
        for (int u = blockIdx.x; u < 256; u += F.G) {
            const int l = u >> 7, e0 = (u & 127) * 48;
            if (F.tid < 384) {
                const int q = F.tid % 12, dg = F.tid / 12;
                f32x4 acc[9];
#pragma unroll
                for (int r = 0; r < 9; ++r) acc[r] = (f32x4){0.f, 0.f, 0.f, 0.f};
                const float* wb = A.in[I_ADAW] + (size_t)l * D * 6144 + e0 + 4 * q;
#pragma unroll 4
                for (int i = 0; i < 32; ++i) { const int d = dg + 32 * i; const f32x4 w = *(const f32x4*)(wb + (size_t)d * 6144);
#pragma unroll
                    for (int r = 0; r < 9; ++r) acc[r] += st[r * 1024 + d] * w; }
#pragma unroll
                for (int r = 0; r < 9; ++r) *(LAS f32x4*)(red + (dg * 9 + r) * 48 + 4 * q) = acc[r];
            }
            __syncthreads();
            if (F.tid < 432) { const int r = F.tid / 48, ci = F.tid % 48; float s = A.in[I_ADAB][l * 6144 + e0 + ci];
                for (int dg = 0; dg < 32; ++dg) s += red[(dg * 9 + r) * 48 + ci];
                MOD[((size_t)l * 9 + r) * 6144 + e0 + ci] = s; }
            __syncthreads();
        }
    }
}

__device__ __forceinline__ void p1_load_norm(const float* row, const f32x4 (&gsc)[4], const f32x4 (&sh)[4], f32x4 (&o)[4], int lane) {
    const f32x4* xr = (const f32x4*)row + lane; float s = 0.f;
#pragma unroll
    for (int j = 0; j < 4; ++j) { o[j] = xr[64 * j]; s += (o[j].x * o[j].x + o[j].y * o[j].y) + (o[j].z * o[j].z + o[j].w * o[j].w); }
    const float rstd = rsqrtf(wave_sum(s) * (1.f / D) + RMS_EPS);
#pragma unroll
    for (int j = 0; j < 4; ++j) o[j] = o[j] * rstd * gsc[j] + sh[j];
}
__device__ __forceinline__ void ld_row_bf16(const bf16_t* row, f32x4 (&o)[4], int lane) {
#pragma unroll
    for (int j = 0; j < 4; ++j) { const u32x2 q = *(const u32x2*)(row + 4 * lane + 256 * j); o[j] = (f32x4){bflo(q.x), bfhi(q.x), bflo(q.y), bfhi(q.y)}; }
}
__device__ __forceinline__ void norm_rows(f32x4 (&o)[4], const f32x4 (&gsc)[4], const f32x4 (&sh)[4]) {
    float s = 0.f;
#pragma unroll
    for (int j = 0; j < 4; ++j) s += (o[j].x * o[j].x + o[j].y * o[j].y) + (o[j].z * o[j].z + o[j].w * o[j].w);
    const float rstd = rsqrtf(wave_sum(s) * (1.f / D) + RMS_EPS);
#pragma unroll
    for (int j = 0; j < 4; ++j) o[j] = o[j] * rstd * gsc[j] + sh[j];
}
__device__ __forceinline__ void st_bf4(bf16_t* p, const f32x4 v) { u32x2 w; w.x = pk2(v.x, v.y); w.y = pk2(v.z, v.w); *(u32x2*)p = w; }

__device__ __forceinline__ void p1_mix(const Frame& F, const Args& A) {
    const float* MOD = (const float*)(A.ws + WS_MOD);
    bf16_t* XM = (bf16_t*)(A.ws + WS_XM);
    const float* mu = A.in[I_MU]; const float* ng = A.in[I_NORMG];
    for (int u = F.gw; u < 2176; u += F.NGW) {
        const bool isctx = u >= 2048; int t0, rowlen, modrow; const float* src; size_t orow0;
        if (!isctx) { t0 = u * 16; rowlen = GRIDW; modrow = t0 / TL; src = A.in[I_X] + (size_t)t0 * D; orow0 = t0; }
        else { t0 = (u - 2048) * 16; rowlen = TCX; modrow = 8; src = A.in[I_CTX] + (size_t)t0 * D; orow0 = (size_t)ML + t0; }
        const int pos0 = t0 % rowlen;
        const float* mrow = MOD + (size_t)modrow * 6144;
        f32x4 gsc[4], sh[4], m0[4], m1[4], m2[4];
#pragma unroll
        for (int j = 0; j < 4; ++j) { const int c = 4 * F.lane + 256 * j;
            const f32x4 g = *(const f32x4*)(ng + c), sc = *(const f32x4*)(mrow + 1024 + c);
            gsc[j] = g * (1.f + sc); sh[j] = *(const f32x4*)(mrow + c);
            m0[j] = *(const f32x4*)(mu + c); m1[j] = *(const f32x4*)(mu + D + c); m2[j] = *(const f32x4*)(mu + 2 * D + c); }
        f32x4 prev[4], cur[4], nxt[4];
        if (pos0 > 0) p1_load_norm(src - D, gsc, sh, prev, F.lane);
        else {
#pragma unroll
            for (int j = 0; j < 4; ++j) prev[j] = (f32x4){0.f, 0.f, 0.f, 0.f}; }
        p1_load_norm(src, gsc, sh, cur, F.lane);
        for (int i = 0; i < 16; ++i) {
            if (pos0 + i + 1 < rowlen) p1_load_norm(src + (size_t)(i + 1) * D, gsc, sh, nxt, F.lane);
            else {
#pragma unroll
                for (int j = 0; j < 4; ++j) nxt[j] = (f32x4){0.f, 0.f, 0.f, 0.f}; }
            bf16_t* orow = XM + (orow0 + i) * D + 4 * F.lane; bf16_t* orow2 = XM + (size_t)3 * MA * D + (orow0 + i) * (2 * D) + 4 * F.lane;
#pragma unroll
            for (int j = 0; j < 4; ++j) {
                const f32x4 s = prev[j] + nxt[j], xx = 0.5f * s - cur[j];
                st_bf4(orow + 256 * j, cur[j] + xx * m0[j]);
                st_bf4(orow + (size_t)MA * D + 256 * j, cur[j] + xx * m1[j]);
                st_bf4(orow + (size_t)2 * MA * D + 256 * j, cur[j] + xx * m2[j]);
                st_bf4(orow2 + 256 * j, cur[j]);
                st_bf4(orow2 + D + 256 * j, s);
                prev[j] = cur[j]; cur[j] = nxt[j];
            }
        }
    }
}

struct SchedRKV {
    const char* xm; const char* w; int G, c;
    __device__ __forceinline__ bool next(int i, pg8::Unit& u) const {
        int L;
        if (G == 256) { const int n = c < 80 ? 7 : (c < 240 ? 6 : 5); if (i >= n) return false; L = i < 5 ? c + 256 * i : (i == 5 ? 1280 + c : 1520 + c); }
        else { L = i * G + c; if (L >= 1600) return false; }
        if (L < 1536) pg8::swz_tile(L, 128, 12, u.pm, u.pn); else { const int r = L - 1536; u.pm = 128 + (r >> 3); u.pn = 4 + (r & 7); }
        u.a = xm + (size_t)(u.pn >> 2) * MA * D * 2 + (size_t)u.pm * 256 * D * 2; u.b = w + (size_t)u.pn * 256 * D * 2; u.nt = 16; u.rows = nullptr; return true;
    }
};
struct EpiRKV {
    static constexpr bool PERM = true;
    bf16_t *R, *K, *KC, *V;
    __device__ __forceinline__ void operator()(const f32x4 (&acc)[2][2][4][2], const pg8::Unit& u, int wr, int wc, int fr, int fq) const {
        const int grp = u.pn >> 2; int prow = u.pm * 256; bf16_t* base;
        if (grp == 0) base = R; else if (grp == 1) { if (u.pm < 128) base = K; else { base = KC; prow -= ML; } } else base = V;
        const int row0 = prow + wr * 64 + fr, col0 = (u.pn & 3) * 256 + wc * 32 + 8 * fq;
#pragma unroll
        for (int ai = 0; ai < 2; ++ai)
#pragma unroll
            for (int m = 0; m < 4; ++m) { bf16_t* rowp = base + (size_t)(row0 + ai * 128 + m * 16) * D + col0;
#pragma unroll
                for (int bj = 0; bj < 2; ++bj) { const f32x4 v0 = acc[ai][bj][m][0], v1 = acc[ai][bj][m][1];
                    u32x4 w; w.x = pg8::cvt_pk_bf16(v0[0], v0[1]); w.y = pg8::cvt_pk_bf16(v0[2], v0[3]); w.z = pg8::cvt_pk_bf16(v1[0], v1[1]); w.w = pg8::cvt_pk_bf16(v1[2], v1[3]);
                    *(u32x4*)(rowp + bj * 128) = w; } }
    }
};
struct SchedLora {
    const char* xm; const char* w; int G, c;
    __device__ __forceinline__ bool next(int i, pg8::Unit& u) const {
        int L;
        if (G == 256) { if (i > 1 || (i == 1 && c < 240)) return false; L = i ? 256 + (c - 240) : c; }
        else { L = i * G + c; if (L >= 272) return false; }
        u.pm = L >> 1; u.pn = L & 1;
        u.a = xm + (size_t)3 * MA * D * 2 + (size_t)u.pm * 256 * 2 * D * 2; u.b = w + (size_t)u.pn * 256 * 2048 * 2; u.nt = 32; u.rows = nullptr; return true;
    }
};
struct EpiLora {
    static constexpr bool PERM = true;
    bf16_t *LWA, *LG;
    __device__ __forceinline__ void operator()(const f32x4 (&acc)[2][2][4][2], const pg8::Unit& u, int wr, int wc, int fr, int fq) const {
        bf16_t* base = u.pn ? LG : LWA;
        const int row0 = u.pm * 256 + wr * 64 + fr, col0 = wc * 32 + 8 * fq;
#pragma unroll
        for (int ai = 0; ai < 2; ++ai)
#pragma unroll
            for (int m = 0; m < 4; ++m) { bf16_t* rowp = base + (size_t)(row0 + ai * 128 + m * 16) * 256 + col0;
#pragma unroll
                for (int bj = 0; bj < 2; ++bj) { f32x4 v0 = acc[ai][bj][m][0], v1 = acc[ai][bj][m][1];
                    if (bj == 0) {
                        if (u.pn == 0) {
#pragma unroll
                            for (int q = 0; q < 4; ++q) { v0[q] = 1.f - 2.f / (__expf(2.f * v0[q]) + 1.f); v1[q] = 1.f - 2.f / (__expf(2.f * v1[q]) + 1.f); }
                        } else {
#pragma unroll
                            for (int q = 0; q < 4; ++q) { v0[q] = sigmoidf_(v0[q]); v1[q] = sigmoidf_(v1[q]); }
                        }
                    } else if (u.pn == 1) { v0 = (f32x4){0.f, 0.f, 0.f, 0.f}; v1 = v0; }
                    u32x4 w; w.x = pg8::cvt_pk_bf16(v0[0], v0[1]); w.y = pg8::cvt_pk_bf16(v0[2], v0[3]); w.z = pg8::cvt_pk_bf16(v1[0], v1[1]); w.w = pg8::cvt_pk_bf16(v1[2], v1[3]);
                    *(u32x4*)(rowp + bj * 128) = w; } }
    }
};
struct SchedPlain {
    const char* a; const char* b; int nM, nN, lda, ldb, nt, G, c;
    __device__ __forceinline__ bool next(int i, pg8::Unit& u) const {
        const int L = i * G + c; if (L >= nM * nN) return false;
        pg8::swz_tile(L, nM, nN, u.pm, u.pn);
        u.a = a + (size_t)u.pm * 256 * lda * 2; u.b = b + (size_t)u.pn * 256 * ldb * 2; u.nt = nt; u.rows = nullptr; return true;
    }
};
struct EpiBf16 {
    static constexpr bool PERM = true;
    bf16_t* O; int ldc;
    __device__ __forceinline__ void operator()(const f32x4 (&acc)[2][2][4][2], const pg8::Unit& u, int wr, int wc, int fr, int fq) const {
        const int row0 = u.pm * 256 + wr * 64 + fr, col0 = u.pn * 256 + wc * 32 + 8 * fq;
#pragma unroll
        for (int ai = 0; ai < 2; ++ai)
#pragma unroll
            for (int m = 0; m < 4; ++m) { bf16_t* rowp = O + (size_t)(row0 + ai * 128 + m * 16) * ldc + col0;
#pragma unroll
                for (int bj = 0; bj < 2; ++bj) { const f32x4 v0 = acc[ai][bj][m][0], v1 = acc[ai][bj][m][1];
                    u32x4 w; w.x = pg8::cvt_pk_bf16(v0[0], v0[1]); w.y = pg8::cvt_pk_bf16(v0[2], v0[3]); w.z = pg8::cvt_pk_bf16(v1[0], v1[1]); w.w = pg8::cvt_pk_bf16(v1[2], v1[3]);
                    *(u32x4*)(rowp + bj * 128) = w; } }
    }
};
struct EpiRes {
    static constexpr bool PERM = true;
    const float* basef; bf16_t* hb; const float* gate;
    __device__ __forceinline__ void operator()(const f32x4 (&acc)[2][2][4][2], const pg8::Unit& u, int wr, int wc, int fr, int fq) const {
        const int row0 = u.pm * 256 + wr * 64 + fr, col0 = u.pn * 256 + wc * 32 + 8 * fq;
        const float* gp = gate + (size_t)(u.pm >> 4) * 6144 + col0;
        f32x4 gv[2][2];
#pragma unroll
        for (int bj = 0; bj < 2; ++bj)
#pragma unroll
            for (int n = 0; n < 2; ++n) gv[bj][n] = *(const f32x4*)(gp + bj * 128 + n * 4);
#pragma unroll
        for (int ai = 0; ai < 2; ++ai)
#pragma unroll
            for (int m = 0; m < 4; ++m) { const size_t ro = (size_t)(row0 + ai * 128 + m * 16) * D + col0;
#pragma unroll
                for (int bj = 0; bj < 2; ++bj) {
                    f32x4 b0, b1;
                    if (basef) { b0 = *(const f32x4*)(basef + ro + bj * 128); b1 = *(const f32x4*)(basef + ro + bj * 128 + 4); }
                    else { const u32x4 q = *(const u32x4*)(hb + ro + bj * 128); b0 = (f32x4){bflo(q.x), bfhi(q.x), bflo(q.y), bfhi(q.y)}; b1 = (f32x4){bflo(q.z), bfhi(q.z), bflo(q.w), bfhi(q.w)}; }
                    const f32x4 v0 = b0 + gv[bj][0] * acc[ai][bj][m][0], v1 = b1 + gv[bj][1] * acc[ai][bj][m][1];
                    u32x4 w; w.x = pg8::cvt_pk_bf16(v0[0], v0[1]); w.y = pg8::cvt_pk_bf16(v0[2], v0[3]); w.z = pg8::cvt_pk_bf16(v1[0], v1[1]); w.w = pg8::cvt_pk_bf16(v1[2], v1[3]);
                    *(u32x4*)(hb + ro + bj * 128) = w; } }
    }
};
struct SchedMoe {
    const char* a; const char* b; const int* tile; int lda, ldb, nt, G, c; size_t estride;
    __device__ __forceinline__ bool next(int i, pg8::Unit& u) const {
        const int ntl = tile[0]; const int L = i * G + c; if (L >= ntl * 4) return false;
        u.pm = L >> 2; u.pn = L & 3; const int e = tile[16 + u.pm];
        u.a = a + (size_t)u.pm * 256 * lda * 2; u.b = b + (size_t)e * estride + (size_t)u.pn * 256 * ldb * 2; u.nt = nt; u.rows = nullptr; return true;
    }
};
struct SchedMoeG {
    const char* a; const char* b; const int* tile; const int* inv; int ldb, nt, G, c; size_t estride;
    __device__ __forceinline__ bool next(int i, pg8::Unit& u) const {
        const int ntl = tile[0]; const int L = i * G + c; if (L >= ntl * 4) return false;
        const int ng = ntl >> 3;
        if ((L >> 5) < ng) { u.pm = (L >> 5) * 8 + (L & 7); u.pn = (L >> 3) & 3; } else { const int r_ = L - ng * 32; u.pm = ng * 8 + (r_ >> 2); u.pn = r_ & 3; }
        const int e = tile[16 + u.pm];
        u.a = a; u.b = b + (size_t)e * estride + (size_t)u.pn * 256 * ldb * 2; u.nt = nt; u.rows = inv + u.pm * 256; return true;
    }
};
struct EpiGateUp {
    static constexpr bool PERM = true;
    bf16_t* H;
    __device__ __forceinline__ void operator()(const f32x4 (&acc)[2][2][4][2], const pg8::Unit& u, int wr, int wc, int fr, int fq) const {
        const int row0 = u.pm * 256 + wr * 64 + fr, col0 = u.pn * 128 + wc * 32 + 8 * fq;
#pragma unroll
        for (int ai = 0; ai < 2; ++ai)
#pragma unroll
            for (int m = 0; m < 4; ++m) { bf16_t* rowp = H + (size_t)(row0 + ai * 128 + m * 16) * ED + col0;
                f32x4 h0, h1;
#pragma unroll
                for (int q = 0; q < 4; ++q) { const float g0 = acc[ai][0][m][0][q], g1 = acc[ai][0][m][1][q];
                    h0[q] = g0 / (1.f + __expf(-g0)) * acc[ai][1][m][0][q]; h1[q] = g1 / (1.f + __expf(-g1)) * acc[ai][1][m][1][q]; }
                u32x4 w; w.x = pg8::cvt_pk_bf16(h0[0], h0[1]); w.y = pg8::cvt_pk_bf16(h0[2], h0[3]); w.z = pg8::cvt_pk_bf16(h1[0], h1[1]); w.w = pg8::cvt_pk_bf16(h1[2], h1[3]);
                *(u32x4*)rowp = w; }
    }
};
struct EpiGateUpPub {
    static constexpr bool PERM = true;
    unsigned char* H; unsigned* rdy;
    __device__ __forceinline__ void operator()(const f32x4 (&acc)[2][2][4][2], const pg8::Unit& u, int wr, int wc, int fr, int fq) const {
        const int row0 = u.pm * 256 + wr * 64 + fr, col0 = u.pn * 128 + wc * 32 + 8 * fq;
        const __amdgpu_buffer_rsrc_t rsrc = __builtin_amdgcn_make_buffer_rsrc(H, 0, 69632 * ED * 2, 0x00020000);
#pragma unroll
        for (int ai = 0; ai < 2; ++ai)
#pragma unroll
            for (int m = 0; m < 4; ++m) {
                f32x4 h0, h1;
#pragma unroll
                for (int q = 0; q < 4; ++q) { const float g0 = acc[ai][0][m][0][q], g1 = acc[ai][0][m][1][q];
                    h0[q] = g0 / (1.f + __expf(-g0)) * acc[ai][1][m][0][q]; h1[q] = g1 / (1.f + __expf(-g1)) * acc[ai][1][m][1][q]; }
                u32x4 w; w.x = pg8::cvt_pk_bf16(h0[0], h0[1]); w.y = pg8::cvt_pk_bf16(h0[2], h0[3]); w.z = pg8::cvt_pk_bf16(h1[0], h1[1]); w.w = pg8::cvt_pk_bf16(h1[2], h1[3]);
                __builtin_amdgcn_raw_buffer_store_b128(w, rsrc, ((row0 + ai * 128 + m * 16) * ED + col0) * 2, 0, 16);
            }
        asm volatile("s_waitcnt vmcnt(0)" ::: "memory");
        if ((threadIdx.x & 63) == 0) __hip_atomic_fetch_add(rdy + 64 * u.pm, 1u, __ATOMIC_RELAXED, __HIP_MEMORY_SCOPE_AGENT);
    }
};
struct SchedMoeD {
    const char* hh; const char* wdn; const int* tile; unsigned* rdy; unsigned* tmo; int G, c;
    __device__ __forceinline__ bool next(int j, pg8::Unit& u) const {
        const int n1 = tile[0] * 4, q = n1 / G, x = n1 - q * G; int L;
        if (q >= 1 && 3 * x <= G) {
            int nd, base;
            if (c < x) { nd = q - 1; base = c * (q - 1); } else if (c < 3 * x) { nd = q + 1; base = x * (q - 1) + (c - x) * (q + 1); } else { nd = q; base = x * (q - 1) + 2 * x * (q + 1) + (c - 3 * x) * q; }
            if (j >= nd) return false; L = base + j;
        } else { L = j * G + (G - 1 - c); if (L >= n1) return false; }
        u.pm = L >> 2; u.pn = L & 3; u.kind = 1; const int e = tile[16 + u.pm];
        u.a = hh; u.rows = nullptr; u.row0 = u.pm * 256; u.pa = ED * 2; u.pb = ED * 2; u.b = wdn + (size_t)e * (1 * MiB) + (size_t)u.pn * 256 * ED * 2; u.nt = 8;
        return true;
    }
    __device__ __forceinline__ void a_ready(const pg8::Unit& u) const {
        if (threadIdx.x < 64) {
            unsigned* w = rdy + 64 * u.pm; unsigned polls = 0;
            while ((unsigned)__builtin_amdgcn_readfirstlane(__hip_atomic_load(w, __ATOMIC_RELAXED, __HIP_MEMORY_SCOPE_AGENT)) < 32u) {
                if ((++polls & 255u) == 0u) { if (__builtin_amdgcn_readfirstlane(__hip_atomic_load(tmo, __ATOMIC_RELAXED, __HIP_MEMORY_SCOPE_AGENT)) != 0u) break;
                    if (polls > (1u << 22)) { if (threadIdx.x == 0) __hip_atomic_store(tmo, 1u, __ATOMIC_RELAXED, __HIP_MEMORY_SCOPE_AGENT); break; } }
                __builtin_amdgcn_s_sleep(2); }
            __builtin_amdgcn_fence(__ATOMIC_ACQUIRE, "agent");
            asm volatile("s_waitcnt vmcnt(0)" ::: "memory");
        }
        asm volatile("" ::: "memory"); __builtin_amdgcn_s_barrier(); asm volatile("" ::: "memory");
    }
};
struct EpiWin {
    static constexpr bool PERM = true;
    bf16_t *BG, *U;
    __device__ __forceinline__ void operator()(const f32x4 (&acc)[2][2][4][2], const pg8::Unit& u, int wr, int wc, int fr, int fq) const {
        const int row0 = u.pm * 256 + wr * 64 + fr;
        if (u.pn < 4) {
            const int col0 = u.pn * 256 + wc * 32 + 8 * fq;
#pragma unroll
            for (int ai = 0; ai < 2; ++ai)
#pragma unroll
                for (int m = 0; m < 4; ++m) { bf16_t* rowp = BG + (size_t)(row0 + ai * 128 + m * 16) * D + col0;
#pragma unroll
                    for (int bj = 0; bj < 2; ++bj) { const f32x4 v0 = acc[ai][bj][m][0], v1 = acc[ai][bj][m][1];
                        u32x4 w; w.x = pg8::cvt_pk_bf16(v0[0], v0[1]); w.y = pg8::cvt_pk_bf16(v0[2], v0[3]); w.z = pg8::cvt_pk_bf16(v1[0], v1[1]); w.w = pg8::cvt_pk_bf16(v1[2], v1[3]);
                        *(u32x4*)(rowp + bj * 128) = w; } }
        } else {
            const int col0 = (u.pn - 4) * 128 + wc * 32 + 8 * fq;
#pragma unroll
            for (int ai = 0; ai < 2; ++ai)
#pragma unroll
                for (int m = 0; m < 4; ++m) { bf16_t* rowp = U + (size_t)(row0 + ai * 128 + m * 16) * D + col0;
                    const f32x4 v0 = acc[ai][0][m][0] * acc[ai][1][m][0], v1 = acc[ai][0][m][1] * acc[ai][1][m][1];
                    u32x4 w; w.x = pg8::cvt_pk_bf16(v0[0], v0[1]); w.y = pg8::cvt_pk_bf16(v0[2], v0[3]); w.z = pg8::cvt_pk_bf16(v1[0], v1[1]); w.w = pg8::cvt_pk_bf16(v1[2], v1[3]);
                    *(u32x4*)rowp = w; }
        }
    }
};

namespace sc {
constexpr int MPB = 144;
constexpr int MB = 64 * MPB;
constexpr int B_RAWK = 0, B_NAB = 0, B_RAWR = 1, B_NAK = 1, B_LW = 2, B_MRB = 2, B_LA = 3, B_MRK = 3, B_AT = 4, B_BT = 5, B_KT = 6,
              B_RT = 7, B_EL = 8, B_BTT = 9, B_KTT = 10, B_VTT = 11, B_T = 12, B_EH = 12, B_W2T = 13, B_A2T = 14, B_RK = 15;
constexpr int O_INVN = 16 * MB, O_BON = O_INVN + 256, O_PV = O_BON + 1024, O_KKS = O_PV + 256, O_NF = O_KKS + 256;
static_assert(O_NF + 4096 <= LDSCTL_OFF, "scan LDS");
__device__ __forceinline__ bf16x8 ldf(const LAS unsigned char* p) { return *(const LAS bf16x8*)p; }
__device__ __forceinline__ bf16x8 ldfp(const LAS unsigned char* p) {
    const u32x2 lo = *(const LAS u32x2*)p, hi = *(const LAS u32x2*)(p + 32);
    return __builtin_bit_cast(bf16x8, (u32x4){lo.x, lo.y, hi.x, hi.y});
}
__device__ __forceinline__ bf16x8 packfrag(const f32x4 x0, const f32x4 x1) {
    return __builtin_bit_cast(bf16x8, (u32x4){pg8::cvt_pk_bf16(x0[0], x0[1]), pg8::cvt_pk_bf16(x0[2], x0[3]), pg8::cvt_pk_bf16(x1[0], x1[1]), pg8::cvt_pk_bf16(x1[2], x1[3])});
}
__device__ __forceinline__ void st4(LAS unsigned char* p, const f32x4 d) { *(LAS u32x2*)p = (u32x2){pg8::cvt_pk_bf16(d[0], d[1]), pg8::cvt_pk_bf16(d[2], d[3])}; }
__device__ __forceinline__ f32x4 mma(const bf16x8 a, const bf16x8 b, const f32x4 c) { return __builtin_amdgcn_mfma_f32_16x16x32_bf16(a, b, c, 0, 0, 0); }
__device__ __forceinline__ float ld1(const LAS unsigned char* p) { return __builtin_bit_cast(float, (unsigned)(*(const LAS unsigned short*)p) << 16); }
__device__ __forceinline__ void st1(LAS unsigned char* p, float v) { *(LAS unsigned short*)p = (unsigned short)f2bf(v); }
__device__ __forceinline__ float fsig(float x) { return __builtin_amdgcn_rcpf(1.f + __expf(-x)); }
template <int CTRL> __device__ __forceinline__ float dppf(float v) { return __builtin_bit_cast(float, __builtin_amdgcn_update_dpp(0, __builtin_bit_cast(int, v), CTRL, 0xF, 0xF, true)); }
__device__ __forceinline__ float sum8(float v) { v += dppf<0xB1>(v); v += dppf<0x4E>(v); v += dppf<0x141>(v); return v; }
__device__ __forceinline__ float sum16(float v) { v = sum8(v); v += dppf<0x140>(v); return v; }
}

#ifndef SCAN_REP_E1
#define SCAN_REP_E1 1
#endif
#ifndef SCAN_REP_G
#define SCAN_REP_G 1
#endif
#ifndef SCAN_REP_V
#define SCAN_REP_V 1
#endif
#ifndef SCAN_REP_E0
#define SCAN_REP_E0 1
#endif
__device__ __forceinline__ void p3_scan(const Frame& F, const Args& A) {
    using namespace sc;
#define WGBAR() do { asm volatile("s_waitcnt lgkmcnt(0)" ::: "memory"); __builtin_amdgcn_s_barrier(); asm volatile("" ::: "memory"); } while (0)
    unsigned char* ws = A.ws;
    LAS unsigned char* L = F.lds;
    const bf16_t* Rg = (const bf16_t*)A.out; const bf16_t* Kg = Rg + (size_t)ML * D;
    const bf16_t* KCg = (const bf16_t*)(ws + WS_KC); const bf16_t* Vg = (const bf16_t*)(ws + WS_V); const bf16_t* LWAg = (const bf16_t*)(ws + WS_LWA);
    const int wv = F.wave;
    const f32x4 z4 = (f32x4){0.f, 0.f, 0.f, 0.f};
    for (int s = blockIdx.x; s < 256; s += F.G) {
        const int dir = s & 1, h = (s >> 1) & 15, b = s >> 5, c0 = h * HD;
        bf16_t* Yg = (bf16_t*)(ws + (dir ? WS_Y1 : WS_Y0));
        __syncthreads();
        for (int q = F.tid; q < 4096; q += NTHREADS) { const int j = q >> 6, c = q & 63;
            sc::st1(L + B_W2T * MB + c * MPB + j * 2, A.in[I_W2][((size_t)dir * 64 + j) * D + c0 + c]); sc::st1(L + B_A2T * MB + c * MPB + j * 2, A.in[I_A2][((size_t)dir * 64 + j) * D + c0 + c]); }
        if (F.tid < 64) *(LAS float*)(L + O_KKS + F.tid * 4) = A.in[I_KK][c0 + F.tid];
        const int ce = c0 + 16 * (wv & 3) + (F.lane & 15);
        const float w0c = A.in[I_W0][dir * D + ce], a0c = A.in[I_A0][dir * D + ce], kkc = A.in[I_KK][ce], kac = A.in[I_KA][ce], rkc = A.in[I_RK][ce];
        f32x4 S[4];
#pragma unroll
        for (int q = 0; q < 4; ++q) S[q] = z4;
        u32x4 pk_, pr_, pv_, plw_, pla_;
#define SCAN_PREFETCH(gc_, ti_, cg_) do { const int seg_ = (gc_) >= 4, ci_ = seg_ ? (gc_) - 4 : (gc_), Ts_ = seg_ ? TL : TCX; \
            const int t0_ = dir ? (Ts_ - 1 - ci_ * 64) : ci_ * 64;                                     \
            const size_t rl_ = (size_t)b * TL + t0_, ra_ = seg_ ? rl_ : ((size_t)ML + (size_t)b * TCX + t0_);    \
            const int lt_ = dir ? -(ti_) : (ti_);                                                          \
            const int lo_ = lt_ * D + c0 + 8 * (cg_), ll_ = lt_ * 256 + dir * 64 + 8 * (cg_); \
            const bf16_t* kb_ = seg_ ? (Kg + rl_ * D) : (KCg + ((size_t)b * TCX + t0_) * D); \
            pk_ = *(const u32x4*)(kb_ + lo_); pv_ = *(const u32x4*)(Vg + ra_ * D + lo_); \
            pr_ = (u32x4){0u, 0u, 0u, 0u}; if (seg_) pr_ = *(const u32x4*)(Rg + rl_ * D + lo_); \
            plw_ = *(const u32x4*)(LWAg + ra_ * 256 + ll_); pla_ = *(const u32x4*)(LWAg + ra_ * 256 + 128 + ll_); } while (0)
        SCAN_PREFETCH(0, (F.tid >> 3), (F.tid & 7));
        __syncthreads();
#pragma unroll 1
        for (int gc = 0; gc < 68; ++gc) {
            const int seg = gc >= 4, ci = seg ? gc - 4 : gc, Tseg = seg ? TL : TCX;
            int tz = F.tid; asm volatile("" : "+v"(tz));
            const int lane = tz & 63, r = lane & 15, g = lane >> 4, ti_ = tz >> 3, cg = tz & 7;
            const int o16 = r * MPB + g * 16;
            const int o8 = r * MPB + g * 8;
            const int oE = g * (4 * MPB) + r * 2;
#pragma unroll 1
            for (int rep_ = 0; rep_ < SCAN_REP_E0; ++rep_)
            {
                LAS unsigned char* st = L + ti_ * MPB + cg * 16;
                *(LAS u32x4*)(st + B_RAWK * MB) = pk_; *(LAS u32x4*)(st + B_RAWR * MB) = pr_; *(LAS u32x4*)(st + B_LW * MB) = plw_; *(LAS u32x4*)(st + B_LA * MB) = pla_;
                const unsigned vw[4] = {pv_.x, pv_.y, pv_.z, pv_.w}, kw[4] = {pk_.x, pk_.y, pk_.z, pk_.w};
                LAS unsigned char* vt = L + B_VTT * MB + cg * (8 * MPB) + ti_ * 2;
                const f32x4 kk0 = *(const LAS f32x4*)(L + O_KKS + cg * 32), kk1 = *(const LAS f32x4*)(L + O_KKS + cg * 32 + 16);
                const float kks[8] = {kk0[0], kk0[1], kk0[2], kk0[3], kk1[0], kk1[1], kk1[2], kk1[3]};
                float ss = 0.f;
#pragma unroll
                for (int q = 0; q < 4; ++q) {
                    *(LAS unsigned short*)(vt + (2 * q) * MPB) = (unsigned short)(vw[q] & 0xffffu);
                    *(LAS unsigned short*)(vt + (2 * q + 1) * MPB) = (unsigned short)(vw[q] >> 16);
                    const float k0 = bflo(kw[q]) * kks[2 * q], k1 = bfhi(kw[q]) * kks[2 * q + 1]; ss += k0 * k0 + k1 * k1; }
                ss = sum8(ss);
                if (cg == 0) *(LAS float*)(L + O_INVN + ti_ * 4) = rsqrtf(fmaxf(ss, 1e-24f));
            }
            WGBAR();
            if (gc + 1 < 68) SCAN_PREFETCH(gc + 1, ti_, cg);
            const int ct = wv & 3, th = wv >> 2;
#pragma unroll 1
            for (int rep_ = 0; rep_ < SCAN_REP_E1; ++rep_) {
            f32x4 aacc[2]; float ev[8];
            {
                f32x4 wacc[2];
                bf16x8 w2f[2], a2f[2];
#pragma unroll
                for (int ks = 0; ks < 2; ++ks) { w2f[ks] = ldf(L + B_W2T * MB + 16 * ct * MPB + 64 * ks + o16); a2f[ks] = ldf(L + B_A2T * MB + 16 * ct * MPB + 64 * ks + o16); }
                const LAS unsigned char* lwb = L + 32 * th * MPB + o16;
#pragma unroll
                for (int tt = 0; tt < 2; ++tt) { wacc[tt] = z4; aacc[tt] = z4;
#pragma unroll
                    for (int ks = 0; ks < 2; ++ks) { wacc[tt] = mma(ldf(lwb + B_LW * MB + 16 * tt * MPB + 64 * ks), w2f[ks], wacc[tt]); aacc[tt] = mma(ldf(lwb + B_LA * MB + 16 * tt * MPB + 64 * ks), a2f[ks], aacc[tt]); } }
                LAS unsigned char* eb2 = L + 16 * ct * MPB + 64 * th + o8;
#pragma unroll
                for (int tt = 0; tt < 2; ++tt) { f32x4 lo;
#pragma unroll
                    for (int q = 0; q < 4; ++q) { const float e = 0.60653066f * fsig(wacc[tt][q] + w0c); ev[4 * tt + q] = e; lo[q] = e - __builtin_bit_cast(float, f2bf(e) << 16); wacc[tt][q] = e; }
                    st4(eb2 + B_EH * MB + 32 * tt, wacc[tt]); st4(eb2 + B_EL * MB + 32 * tt, lo); }
            }
            WGBAR();
            {
                f32x4 Li4[2]; f32x4 tot4 = z4;
                const LAS unsigned char* ehb = L + B_EH * MB + 16 * ct * MPB + o16; const LAS unsigned char* elb = L + B_EL * MB + 16 * ct * MPB + o16;
                const bf16x8 eh0 = ldf(ehb), eh1 = ldf(ehb + 64), el0 = ldf(elb), el1 = ldf(elb + 64);
                const bf16x8 ones = __builtin_bit_cast(bf16x8, (u32x4){0x3F803F80u, 0x3F803F80u, 0x3F803F80u, 0x3F803F80u});
                tot4 = mma(ones, eh0, tot4); tot4 = mma(ones, el0, tot4); tot4 = mma(ones, eh1, tot4); tot4 = mma(ones, el1, tot4);
#pragma unroll
                for (int tt = 0; tt < 2; ++tt) {
                    const int irow = 16 * (2 * th + tt) + r;
                    unsigned tw[2][4];
#pragma unroll
                    for (int ks = 0; ks < 2; ++ks)
#pragma unroll
                        for (int p = 0; p < 4; ++p) { const int j0 = 32 * ks + 8 * g + 2 * p; tw[ks][p] = (j0 <= irow ? 0x3F80u : 0u) | (j0 + 1 <= irow ? 0x3F800000u : 0u); }
                    const bf16x8 t0 = __builtin_bit_cast(bf16x8, (u32x4){tw[0][0], tw[0][1], tw[0][2], tw[0][3]}), t1 = __builtin_bit_cast(bf16x8, (u32x4){tw[1][0], tw[1][1], tw[1][2], tw[1][3]});
                    f32x4 d = z4; d = mma(t0, eh0, d); d = mma(t0, el0, d);
                    if (th) { d = mma(t1, eh1, d); d = mma(t1, el1, d); }
                    Li4[tt] = d;
                }
                const float Pc = __expf(-tot4[0]);
                if (g == 0 && th == 0) *(LAS float*)(L + O_PV + (16 * ct + r) * 4) = Pc;
                LAS unsigned char* eb = L + oE + 32 * ct + 32 * th * MPB;
                LAS unsigned char* cb = L + o8 + 16 * ct * MPB + 64 * th;
#pragma unroll
                for (int tt = 0; tt < 2; ++tt) {
                    const f32x4 inv4 = *(const LAS f32x4*)(L + O_INVN + 128 * th + 64 * tt + g * 16);
                    f32x4 btv, ktv;
                    const float em0 = __expf(-Li4[tt][0]), em1 = __expf(-Li4[tt][1]), em2 = __expf(-Li4[tt][2]), em3 = __expf(-Li4[tt][3]);
                    const float emv[4] = {em0, em1, em2, em3}, exv[4] = {__expf(ev[4 * tt] - Li4[tt][0]), em0, em1, em2};
#pragma unroll
                    for (int q = 0; q < 4; ++q) {
                        const int ro = (16 * tt + q) * MPB;
                        const float kv = ld1(eb + B_RAWK * MB + ro), rv = ld1(eb + B_RAWR * MB + ro);
                        const float a = fsig(aacc[tt][q] + a0c);
                        const float kkn = kv * kkc * inv4[q];
                        const float beta = kkn * a, kd = kv * (1.f + (a - 1.f) * kac);
                        const float em = emv[q], ep = __builtin_amdgcn_rcpf(em);
                        const float at = -kkn * exv[q], bt = beta * ep, kt = kd * ep, rt = rv * em;
                        btv[q] = bt; ktv[q] = kt;
                        st1(eb + B_AT * MB + ro, at); st1(eb + B_BT * MB + ro, bt); st1(eb + B_KT * MB + ro, kt); st1(eb + B_RT * MB + ro, rt); st1(eb + B_RK * MB + ro, rt * rkc);
                    }
                    st4(cb + B_BTT * MB + 32 * tt, btv); st4(cb + B_KTT * MB + 32 * tt, ktv);
                    asm volatile("" ::: "memory");
                }
            }
            WGBAR();
            }
#pragma unroll 1
            for (int rep_ = 0; rep_ < SCAN_REP_G; ++rep_) {
#define GRAM_ROW(m_, ti_) do { const int mm_ = (m_); \
                const LAS unsigned char* Xb_ = L + ((mm_ & 1) ? B_KT : B_BT) * MB + o16; const LAS unsigned char* Zb_ = L + (mm_ < 2 ? B_AT : B_RT) * MB + 16 * (ti_) * MPB + o16; \
                const bf16x8 zf0_ = ldf(Zb_), zf1_ = ldf(Zb_ + 64); const int i_ = 16 * (ti_) + r, st_ = (mm_ < 2) ? 1 : 0; \
                _Pragma("unroll") for (int ts_ = 0; ts_ < 4; ++ts_) { f32x4 d_ = z4; \
                    if (ts_ <= (ti_)) { d_ = mma(ldf(Xb_ + 16 * ts_ * MPB), zf0_, d_); d_ = mma(ldf(Xb_ + 16 * ts_ * MPB + 64), zf1_, d_); \
                        _Pragma("unroll") for (int q_ = 0; q_ < 4; ++q_) d_[q_] = (16 * ts_ + 4 * g + st_ + q_ <= i_) ? d_[q_] : 0.f; } \
                    st4(L + mm_ * MB + 16 * (ti_) * MPB + 32 * ts_ + o8, d_); } } while (0)
            if (wv < 6) {
                const int m = wv >> 1;
                if (wv & 1) { GRAM_ROW(m, 1); GRAM_ROW(m, 2); } else { GRAM_ROW(m, 0); GRAM_ROW(m, 3); }
                if (wv == 0) GRAM_ROW(3, 0);
                if (wv == 1) GRAM_ROW(3, 1);
            } else if (wv == 6) {
                GRAM_ROW(3, 2); GRAM_ROW(3, 3);
            } else {
#pragma unroll
                for (int q2 = 0; q2 < 4; ++q2) {
                    f32x4 d = z4;
                    d = mma(ldf(L + B_BT * MB + 16 * q2 * MPB + o16), ldf(L + B_AT * MB + 16 * q2 * MPB + o16), d); d = mma(ldf(L + B_BT * MB + 16 * q2 * MPB + 64 + o16), ldf(L + B_AT * MB + 16 * q2 * MPB + 64 + o16), d);
#pragma unroll
                    for (int q = 0; q < 4; ++q) d[q] = (4 * g + q < r) ? d[q] : 0.f;
                    st4(L + B_NAB * MB + 16 * q2 * MPB + 32 * q2 + o8, d);
                    *(LAS f32x4*)(L + O_NF + q2 * 1024 + r * 64 + g * 16) = d;
                    f32x4 bd = z4;
                    bd = mma(ldf(L + B_KT * MB + 16 * q2 * MPB + o16), ldf(L + B_RK * MB + 16 * q2 * MPB + o16), bd); bd = mma(ldf(L + B_KT * MB + 16 * q2 * MPB + 64 + o16), ldf(L + B_RK * MB + 16 * q2 * MPB + 64 + o16), bd);
                    const int rq = r & 3; const float bv = rq == 0 ? bd[0] : (rq == 1 ? bd[1] : (rq == 2 ? bd[2] : bd[3]));
                    if (g == (r >> 2)) *(LAS float*)(L + O_BON + (16 * q2 + r) * 4) = bv;
                }
            }
            LDS_WAIT(); asm volatile("" ::: "memory");
            }
            WGBAR();
            f32x4 W2[4], Y[4], U[4]; bf16x8 Sb0, Sb1, vb0, vb1, u0, u1;
            const int vs = wv & 3;
            if (wv == 7) {
                const int oD = g * (16 * MPB + 32);
                const LAS unsigned char* nf = L + O_NF + g * 1024;
                float tc[16];
                tc[0] = (r == 0) ? 1.f : 0.f;
#pragma unroll
                for (int half = 0; half < 2; ++half) {
                    f32x4 rw[8][4];
#pragma unroll
                    for (int ii = 0; ii < 8; ++ii) { const int i = 8 * half + ii;
#pragma unroll
                        for (int c4 = 0; c4 < 4; ++c4) if (i > 0 && 4 * c4 < i) rw[ii][c4] = *(const LAS f32x4*)(nf + i * 64 + c4 * 16); }
#pragma unroll
                    for (int ii = 0; ii < 8; ++ii) { const int i = 8 * half + ii;
                        if (i > 0) {
                            float a0 = (i == r) ? 1.f : 0.f, a1 = 0.f, a2 = 0.f, a3 = 0.f;
#pragma unroll
                            for (int s2 = 0; s2 < i; ++s2) { const float nvv = rw[ii][s2 >> 2][s2 & 3];
                                if ((s2 & 3) == 0) a0 += nvv * tc[s2]; else if ((s2 & 3) == 1) a1 += nvv * tc[s2]; else if ((s2 & 3) == 2) a2 += nvv * tc[s2]; else a3 += nvv * tc[s2]; }
                            tc[i] = (a0 + a1) + (a2 + a3);
                        }
                    }
                }
#pragma unroll
                for (int i = 0; i < 16; ++i) st1(L + B_T * MB + oD + i * MPB + r * 2, tc[i]);
            }
            vb0 = ldf(L + B_VTT * MB + 16 * vs * MPB + o16); vb1 = ldf(L + B_VTT * MB + 16 * vs * MPB + 64 + o16);
            if (wv < 4) {
                Sb0 = packfrag(S[0], S[1]); Sb1 = packfrag(S[2], S[3]);
                *(LAS bf16x8*)(L + B_BT * MB + vs * 2048 + lane * 16) = Sb0; *(LAS bf16x8*)(L + B_BT * MB + vs * 2048 + 1024 + lane * 16) = Sb1;
#pragma unroll
                for (int t = 0; t < 4; ++t) {
                    f32x4 d = z4;
                    d = mma(ldf(L + B_NAK * MB + 16 * t * MPB + o16), vb0, d); d = mma(ldf(L + B_NAK * MB + 16 * t * MPB + 64 + o16), vb1, d);
                    d = mma(ldfp(L + B_AT * MB + 16 * t * MPB + o8), Sb0, d); d = mma(ldfp(L + B_AT * MB + 16 * t * MPB + 64 + o8), Sb1, d); W2[t] = d;
                    f32x4 e2 = S[t];
                    e2 = mma(ldf(L + B_KTT * MB + 16 * t * MPB + o16), vb0, e2); e2 = mma(ldf(L + B_KTT * MB + 16 * t * MPB + 64 + o16), vb1, e2); S[t] = e2;
                    asm volatile("" : "+v"(W2[t]), "+v"(S[t]) :: "memory");
                }
            } else if (seg) {
#pragma unroll
                for (int t = 0; t < 4; ++t) { f32x4 y = z4;
                    y = mma(ldf(L + B_MRK * MB + 16 * t * MPB + o16), vb0, y); y = mma(ldf(L + B_MRK * MB + 16 * t * MPB + 64 + o16), vb1, y); Y[t] = y; }
            }
            WGBAR();
            if (wv < 4) {
#define DMUL(q_, x_) mma(__builtin_bit_cast(bf16x8, (u32x4){dq_[q_].x, dq_[q_].y, 0u, 0u}), packfrag((x_), z4), z4)
                u32x2 dq_[4];
#pragma unroll
                for (int q = 0; q < 4; ++q) dq_[q] = *(const LAS u32x2*)(L + B_T * MB + 16 * q * MPB + 32 * q + o8);
                U[0] = DMUL(0, W2[0]);
                { f32x4 x = mma(ldfp(L + B_NAB * MB + 16 * MPB + o8), packfrag(U[0], z4), W2[1]); U[1] = DMUL(1, x); }
                u0 = packfrag(U[0], U[1]);
                { f32x4 x = mma(ldfp(L + B_NAB * MB + 32 * MPB + o8), u0, W2[2]); U[2] = DMUL(2, x); }
                { f32x4 x = mma(ldfp(L + B_NAB * MB + 48 * MPB + o8), u0, W2[3]); x = mma(ldfp(L + B_NAB * MB + 48 * MPB + 64 + o8), packfrag(U[2], z4), x); U[3] = DMUL(3, x); }
#undef DMUL
                u1 = packfrag(U[2], U[3]);
                *(LAS bf16x8*)(L + B_KT * MB + vs * 2048 + lane * 16) = u0; *(LAS bf16x8*)(L + B_KT * MB + vs * 2048 + 1024 + lane * 16) = u1;
            } else if (seg) {
                Sb0 = *(const LAS bf16x8*)(L + B_BT * MB + vs * 2048 + lane * 16); Sb1 = *(const LAS bf16x8*)(L + B_BT * MB + vs * 2048 + 1024 + lane * 16);
#pragma unroll
                for (int t = 0; t < 4; ++t) { Y[t] = mma(ldfp(L + B_RT * MB + 16 * t * MPB + o8), Sb0, Y[t]); Y[t] = mma(ldfp(L + B_RT * MB + 16 * t * MPB + 64 + o8), Sb1, Y[t]); }
            }
            WGBAR();
            if (wv < 4) {
#pragma unroll
                for (int t = 0; t < 4; ++t) {
                    f32x4 e2 = mma(ldfp(L + B_BTT * MB + 16 * t * MPB + o8), u0, S[t]); e2 = mma(ldfp(L + B_BTT * MB + 16 * t * MPB + 64 + o8), u1, e2);
                    S[t] = e2 * *(const LAS f32x4*)(L + O_PV + 64 * t + g * 16);
                }
            } else if (seg) {
                u0 = *(const LAS bf16x8*)(L + B_KT * MB + vs * 2048 + lane * 16); u1 = *(const LAS bf16x8*)(L + B_KT * MB + vs * 2048 + 1024 + lane * 16);
                const int vcol = c0 + 16 * vs + r;
#pragma unroll
                for (int t = 0; t < 4; ++t) {
                    f32x4 y = Y[t];
                    y = mma(ldfp(L + B_MRB * MB + 16 * t * MPB + o8), u0, y); y = mma(ldfp(L + B_MRB * MB + 16 * t * MPB + 64 + o8), u1, y);
                    const f32x4 bon = *(const LAS f32x4*)(L + O_BON + 64 * t + g * 16);
                    const u32x2 vv = *(const LAS u32x2*)(L + B_VTT * MB + 16 * vs * MPB + 32 * t + o8);
                    y[0] += bon[0] * bflo(vv.x); y[1] += bon[1] * bfhi(vv.x); y[2] += bon[2] * bflo(vv.y); y[3] += bon[3] * bfhi(vv.y);
#pragma unroll
                    for (int q = 0; q < 4; ++q) { const int tl = ci * 64 + 16 * t + 4 * g + q, tt = dir ? (Tseg - 1 - tl) : tl;
                        Yg[((size_t)b * TL + tt) * D + vcol] = (bf16_t)f2bf(y[q]); }
                    asm volatile("" ::: "memory");
                }
            }
            WGBAR();
        }
#undef SCAN_PREFETCH
#undef GRAM_ROW
    }
#undef WGBAR
    __syncthreads();
}

__device__ __forceinline__ void moe_convert(const Frame& F, const Args& A, const int l) {
    unsigned char* mw = A.ws + (l ? WS_MOEW1 : WS_MOEW0);
    LAS float* scr = (LAS float*)(F.lds + F.wave * 16384);
    constexpr int NIT = 16 * 3 * 256;
    for (int it = F.gw; it < NIT; it += F.NGW) {
        const int mat = it >> 8, item = it & 255;
        const int kind = mat % 3, e = mat / 3, le = l * 16 + e;
        if (kind == 0) tr_job_item(A.in[I_MGATE] + (size_t)le * D * ED, ED, ED, (bf16_t*)mw, D, e * 1024, true, nullptr, item, scr, F.lane);
        else if (kind == 1) tr_job_item(A.in[I_MUP] + (size_t)le * D * ED, ED, ED, (bf16_t*)mw, D, e * 1024 + 128, true, nullptr, item, scr, F.lane);
        else tr_job_item(A.in[I_MDOWN] + (size_t)le * ED * D, D, D, (bf16_t*)(mw + 32 * MiB), ED, e * 1024, false, nullptr, item, scr, F.lane);
    }
}
__device__ __forceinline__ void p4_readout(const Frame& F, const Args& A) {
    unsigned char* ws = A.ws;
    const bf16_t* Y0 = (const bf16_t*)(ws + WS_Y0); const bf16_t* Y1 = (const bf16_t*)(ws + WS_Y1); const bf16_t* Gt = (const bf16_t*)(ws + WS_G);
    bf16_t* ZO = (bf16_t*)(ws + WS_ZO);
    float gw_[16], gb_[16];
#pragma unroll
    for (int j = 0; j < 2; ++j)
#pragma unroll
        for (int q = 0; q < 8; ++q) { const int c = 8 * F.lane + 512 * j + q; gw_[j * 8 + q] = A.in[I_GNW][c]; gb_[j * 8 + q] = A.in[I_GNB][c]; }
    for (int t = F.gw; t < ML; t += F.NGW) {
#pragma unroll
        for (int j = 0; j < 2; ++j) {
            const size_t off = (size_t)t * D + 8 * F.lane + 512 * j;
            const u32x4 a = *(const u32x4*)(Y0 + off), b = *(const u32x4*)(Y1 + off), g = *(const u32x4*)(Gt + off);
            float y[8] = {bflo(a.x) + bflo(b.x), bfhi(a.x) + bfhi(b.x), bflo(a.y) + bflo(b.y), bfhi(a.y) + bfhi(b.y), bflo(a.z) + bflo(b.z), bfhi(a.z) + bfhi(b.z), bflo(a.w) + bflo(b.w), bfhi(a.w) + bfhi(b.w)};
            float gg[8] = {bflo(g.x), bfhi(g.x), bflo(g.y), bfhi(g.y), bflo(g.z), bfhi(g.z), bflo(g.w), bfhi(g.w)};
            float s = 0.f;
#pragma unroll
            for (int q = 0; q < 8; ++q) s += y[q];
            s += __shfl_xor(s, 1); s += __shfl_xor(s, 2); s += __shfl_xor(s, 4);
            const float mean = s * (1.f / 64.f); float s2 = 0.f;
#pragma unroll
            for (int q = 0; q < 8; ++q) { y[q] -= mean; s2 += y[q] * y[q]; }
            s2 += __shfl_xor(s2, 1); s2 += __shfl_xor(s2, 2); s2 += __shfl_xor(s2, 4);
            const float rstd = rsqrtf(s2 * (1.f / 64.f) + GN_EPS);
            float z[8];
#pragma unroll
            for (int q = 0; q < 8; ++q) z[q] = (y[q] * rstd * gw_[j * 8 + q] + gb_[j * 8 + q]) * gg[q];
            u32x4 w; w.x = pk2(z[0], z[1]); w.y = pk2(z[2], z[3]); w.z = pk2(z[4], z[5]); w.w = pk2(z[6], z[7]);
            *(u32x4*)(ZO + off) = w;
        }
    }
}

__device__ __forceinline__ void p6_route(const Frame& F, const Args& A, const int layer) {
    unsigned char* ws = A.ws;
    LAS unsigned char* L = F.lds;
    constexpr int WPB = 2064;
    constexpr int O_WH = 0, O_WL = 16 * WPB, O_GS = 2 * 16 * WPB, O_SH = O_GS + 4096, O_LG = O_SH + 4096, O_CN = O_LG + 8 * 1024;
    __syncthreads();
    for (int i = F.tid; i < D * NE; i += NTHREADS) { const int d = i >> 4, e = i & 15; const float w = A.in[I_ROUTW][i]; const unsigned hi = f2bf(w);
        *(LAS unsigned short*)(L + O_WH + e * WPB + d * 2) = (unsigned short)hi; *(LAS unsigned short*)(L + O_WL + e * WPB + d * 2) = (unsigned short)f2bf(w - __builtin_bit_cast(float, hi << 16)); }
    const float* MOD = (const float*)(ws + WS_MOD) + (size_t)layer * 9 * 6144;
    const float* ng = A.in[I_NORMG] + (size_t)(layer * 2 + 1) * D;
    const bf16_t* h = (const bf16_t*)(ws + WS_HB);
    bf16_t* XN = (bf16_t*)(ws + WS_XN);
    unsigned* EIDX = (unsigned*)(ws + WS_EIDX); float* GATE = (float*)(ws + WS_GATE); int* CC = (int*)(ws + WS_CC);
    const int r = F.lane & 15, g = F.lane >> 4;
    const f32x4 z4 = (f32x4){0.f, 0.f, 0.f, 0.f};
    int bcur = -1;
    for (int ch0 = F.vcu * NWAVES; ch0 < 2048; ch0 += F.NGW) {
        const int ch = ch0 + F.wave, t0 = ch * 16, b = ch0 / 256;
        if (b != bcur) {
            __syncthreads();
            const float* mrow = MOD + (size_t)b * 6144;
            for (int c = F.tid; c < D; c += NTHREADS) { *(LAS float*)(L + O_GS + c * 4) = ng[c] * (1.f + mrow[4096 + c]); *(LAS float*)(L + O_SH + c * 4) = mrow[3072 + c]; }
            bcur = b;
            __syncthreads();
        }
        const bf16_t* hrow = h + (size_t)(t0 + r) * D + 8 * g;
        float ss = 0.f;
#pragma unroll 8
        for (int ks = 0; ks < 32; ++ks) { const u32x4 q = *(const u32x4*)(hrow + 32 * ks);
            const float v0 = bflo(q.x), v1 = bfhi(q.x), v2 = bflo(q.y), v3 = bfhi(q.y), v4 = bflo(q.z), v5 = bfhi(q.z), v6 = bflo(q.w), v7 = bfhi(q.w);
            ss += (v0 * v0 + v1 * v1) + (v2 * v2 + v3 * v3) + (v4 * v4 + v5 * v5) + (v6 * v6 + v7 * v7); }
        ss += __shfl_xor(ss, 16); ss += __shfl_xor(ss, 32);
        const float rstd = rsqrtf(ss * (1.f / D) + RMS_EPS);
        f32x4 acc0 = z4, acc1 = z4, acc2 = z4;
        bf16_t* orow = XN + (size_t)(t0 + r) * D + 8 * g;
#pragma unroll 4
        for (int ks = 0; ks < 32; ++ks) {
            const u32x4 q = *(const u32x4*)(hrow + 32 * ks);
            const f32x4 g0 = *(const LAS f32x4*)(L + O_GS + (32 * ks + 8 * g) * 4), g1 = *(const LAS f32x4*)(L + O_GS + (32 * ks + 8 * g) * 4 + 16);
            const f32x4 s0 = *(const LAS f32x4*)(L + O_SH + (32 * ks + 8 * g) * 4), s1 = *(const LAS f32x4*)(L + O_SH + (32 * ks + 8 * g) * 4 + 16);
            const f32x4 x0 = (f32x4){bflo(q.x), bfhi(q.x), bflo(q.y), bfhi(q.y)} * rstd * g0 + s0, x1 = (f32x4){bflo(q.z), bfhi(q.z), bflo(q.w), bfhi(q.w)} * rstd * g1 + s1;
            const u32x4 hi = (u32x4){pk2(x0[0], x0[1]), pk2(x0[2], x0[3]), pk2(x1[0], x1[1]), pk2(x1[2], x1[3])};
            *(u32x4*)(orow + 32 * ks) = hi;
            const f32x4 l0 = x0 - (f32x4){bflo(hi.x), bfhi(hi.x), bflo(hi.y), bfhi(hi.y)}, l1 = x1 - (f32x4){bflo(hi.z), bfhi(hi.z), bflo(hi.w), bfhi(hi.w)};
            const u32x4 lo = (u32x4){pk2(l0[0], l0[1]), pk2(l0[2], l0[3]), pk2(l1[0], l1[1]), pk2(l1[2], l1[3])};
            const bf16x8 wh = *(const LAS bf16x8*)(L + O_WH + r * WPB + (32 * ks + 8 * g) * 2), wl = *(const LAS bf16x8*)(L + O_WL + r * WPB + (32 * ks + 8 * g) * 2);
            acc0 = __builtin_amdgcn_mfma_f32_16x16x32_bf16(__builtin_bit_cast(bf16x8, hi), wh, acc0, 0, 0, 0);
            acc1 = __builtin_amdgcn_mfma_f32_16x16x32_bf16(__builtin_bit_cast(bf16x8, hi), wl, acc1, 0, 0, 0);
            acc2 = __builtin_amdgcn_mfma_f32_16x16x32_bf16(__builtin_bit_cast(bf16x8, lo), wh, acc2, 0, 0, 0);
        }
        const f32x4 lgt = acc0 + (acc1 + acc2);
        LAS float* lgw = (LAS float*)(L + O_LG + F.wave * 1024);
        LAS int* cnw = (LAS int*)(L + O_CN + F.wave * 64);
#pragma unroll
        for (int q = 0; q < 4; ++q) lgw[(4 * g + q) * 16 + r] = lgt[q];
        if (F.lane < 16) cnw[F.lane] = 0;
        LDS_WAIT(); asm volatile("" ::: "memory");
        if (F.lane < 16) {
            const int t = t0 + F.lane;
            float lg[16];
#pragma unroll
            for (int q = 0; q < 4; ++q) { const f32x4 v = *(const LAS f32x4*)(lgw + F.lane * 16 + 4 * q); lg[4 * q] = v[0]; lg[4 * q + 1] = v[1]; lg[4 * q + 2] = v[2]; lg[4 * q + 3] = v[3]; }
            float best = -3.0e38f; int be0 = 0, be1 = 1; float bs0 = 0.f, bs1 = 0.f;
#pragma unroll
            for (int gg = 0; gg < 4; ++gg) {
                float sg[4], sel[4];
#pragma unroll
                for (int q = 0; q < 4; ++q) { sg[q] = 1.f / (1.f + expf(-lg[4 * gg + q])); sel[q] = sg[q] + A.in[I_ROUTB][4 * gg + q]; }
                int i1 = 0; float v1 = sel[0], s1 = sg[0];
#pragma unroll
                for (int q = 1; q < 4; ++q) if (sel[q] > v1) { i1 = q; v1 = sel[q]; s1 = sg[q]; }
                int i2 = -1; float v2 = -3.0e38f, s2 = 0.f;
#pragma unroll
                for (int q = 0; q < 4; ++q) if (q != i1 && sel[q] > v2) { i2 = q; v2 = sel[q]; s2 = sg[q]; }
                const float gs = v1 + v2;
                if (gs > best) { best = gs; be0 = 4 * gg + i1; be1 = 4 * gg + i2; bs0 = s1; bs1 = s2; }
            }
            const float inv = 1.f / (bs0 + bs1);
            EIDX[t] = (unsigned)be0 | ((unsigned)be1 << 8); GATE[2 * t] = bs0 * inv; GATE[2 * t + 1] = bs1 * inv;
            __hip_atomic_fetch_add(cnw + be0, 1, __ATOMIC_RELAXED, __HIP_MEMORY_SCOPE_WORKGROUP); __hip_atomic_fetch_add(cnw + be1, 1, __ATOMIC_RELAXED, __HIP_MEMORY_SCOPE_WORKGROUP);
        }
        LDS_WAIT(); asm volatile("" ::: "memory");
        if (F.lane < 16) CC[ch * 16 + F.lane] = cnw[F.lane];
    }
    __syncthreads();
}

__device__ __forceinline__ void p7_permute(const Frame& F, const Args& A) {
    unsigned char* ws = A.ws;
    LAS int* cc = (LAS int*)F.lds;
    LAS int* ps = (LAS int*)(F.lds + LDS_X_OFF);
    LAS int* seg = ps + 512;
    LAS int* tot = seg + 16;
    const int* CC = (const int*)(ws + WS_CC);
    const unsigned* EIDX = (const unsigned*)(ws + WS_EIDX); int* POS = (int*)(ws + WS_POS); int* TILE = (int*)(ws + WS_TILE); int* INV = (int*)(ws + WS_INV);
    __syncthreads();
    for (int i = F.tid; i < 2048 * 16 / 4; i += NTHREADS) ((LAS u32x4*)cc)[i] = ((const u32x4*)CC)[i];
    __syncthreads();
    { const int e = F.tid & 15, part = F.tid >> 4; int s = 0; for (int q = 0; q < 64; ++q) s += cc[(part * 64 + q) * 16 + e]; ps[part * 16 + e] = s; }
    __syncthreads();
    if (F.tid < 16) { int run = 0; for (int p = 0; p < 32; ++p) { const int v = ps[p * 16 + F.tid]; ps[p * 16 + F.tid] = run; run += v; } tot[F.tid] = run; }
    __syncthreads();
    if (F.tid == 0) { int off = 0, nt = 0;
        for (int e = 0; e < 16; ++e) { const int tl = (tot[e] + 255) >> 8; seg[e] = off;
            if (blockIdx.x == 0) for (int q = 0; q < tl; ++q) TILE[16 + nt + q] = e;
            nt += tl; off += tl * 256; }
        if (blockIdx.x == 0) TILE[0] = nt; }
    __syncthreads();
    if (blockIdx.x == 0) {
        for (int e = 0; e < 16; ++e) { const int n0 = seg[e] + tot[e], n1 = seg[e] + (((tot[e] + 255) >> 8) << 8);
            for (int j = n0 + F.tid; j < n1; j += NTHREADS) INV[j] = 0; } }
    for (int ch = F.gw; ch < 2048; ch += F.NGW) {
        int base = 0;
        if (F.lane < 16) { base = seg[F.lane] + ps[(ch >> 6) * 16 + F.lane]; for (int q = (ch & ~63); q < ch; ++q) base += cc[q * 16 + F.lane]; }
        int myp = 0;
        for (int i = 0; i < 16; ++i) {
            const int t = ch * 16 + i; const unsigned ei = EIDX[t]; const int e0 = ei & 255, e1 = (ei >> 8) & 255;
            const int p0 = __shfl(base, e0); base += (F.lane == e0);
            const int p1 = __shfl(base, e1); base += (F.lane == e1);
            if (F.lane == 2 * i) myp = p0; if (F.lane == 2 * i + 1) myp = p1;
        }
        if (F.lane < 32) { POS[ch * 32 + F.lane] = myp; INV[myp] = ch * 16 + (F.lane >> 1); }
    }
    __syncthreads();
}

template <bool FINAL>
__device__ __forceinline__ void p10_combine(const Frame& F, const Args& A, const int layer) {
    unsigned char* ws = A.ws;
    const float* MOD = (const float*)(ws + WS_MOD);
    const bf16_t* O = (const bf16_t*)(ws + WS_XP); const int* POS = (const int*)(ws + WS_POS); const float* GATE = (const float*)(ws + WS_GATE);
    bf16_t* XN = (bf16_t*)(ws + WS_XN);
    bf16_t* h = (bf16_t*)(ws + WS_HB); float* outp = A.out;
    for (int ch = F.gw; ch < 2048; ch += F.NGW) {
        const int t0 = ch * 16, b = t0 / TL;
        const float* mcur = MOD + ((size_t)layer * 9 + b) * 6144;
        f32x4 gt2[4], gsc[4], sh[4];
#pragma unroll
        for (int j = 0; j < 4; ++j) { const int c = 4 * F.lane + 256 * j; gt2[j] = *(const f32x4*)(mcur + 5120 + c);
            if (FINAL) { gsc[j] = *(const f32x4*)(A.in[I_FINALG] + c); sh[j] = (f32x4){0.f, 0.f, 0.f, 0.f}; }
            else { const float* mn = MOD + ((size_t)9 + b) * 6144; gsc[j] = *(const f32x4*)(A.in[I_NORMG] + 2 * D + c) * (1.f + *(const f32x4*)(mn + 1024 + c)); sh[j] = *(const f32x4*)(mn + c); } }
        for (int i = 0; i < 16; ++i) {
            const int t = t0 + i; const int p0 = POS[2 * t], p1 = POS[2 * t + 1]; const float w0 = GATE[2 * t], w1 = GATE[2 * t + 1];
            f32x4 v[4]; float s = 0.f;
#pragma unroll
            for (int j = 0; j < 4; ++j) { const int c = 4 * F.lane + 256 * j;
                const u32x2 oa = *(const u32x2*)(O + (size_t)p0 * D + c), ob = *(const u32x2*)(O + (size_t)p1 * D + c);
                const f32x4 m = w0 * (f32x4){bflo(oa.x), bfhi(oa.x), bflo(oa.y), bfhi(oa.y)} + w1 * (f32x4){bflo(ob.x), bfhi(ob.x), bflo(ob.y), bfhi(ob.y)};
                const u32x2 hq = *(const u32x2*)(h + (size_t)t * D + c);
                v[j] = (f32x4){bflo(hq.x), bfhi(hq.x), bflo(hq.y), bfhi(hq.y)} + gt2[j] * m;
                s += (v[j].x * v[j].x + v[j].y * v[j].y) + (v[j].z * v[j].z + v[j].w * v[j].w); }
            const float rstd = rsqrtf(wave_sum(s) * (1.f / D) + RMS_EPS);
            if (FINAL) {
#pragma unroll
                for (int j = 0; j < 4; ++j) *(f32x4*)(outp + (size_t)t * D + 4 * F.lane + 256 * j) = v[j] * rstd * gsc[j];
            } else {
#pragma unroll
                for (int j = 0; j < 4; ++j) { st_bf4(h + (size_t)t * D + 4 * F.lane + 256 * j, v[j]); st_bf4(XN + (size_t)t * D + 4 * F.lane + 256 * j, v[j] * rstd * gsc[j] + sh[j]); }
            }
        }
    }
}

__device__ __forceinline__ void ld_bf16row(const bf16_t* row, float (&o)[16], int lane) {
#pragma unroll
    for (int j = 0; j < 2; ++j) { const u32x4 a = *(const u32x4*)(row + 8 * lane + 512 * j);
        o[8 * j] = bflo(a.x); o[8 * j + 1] = bfhi(a.x); o[8 * j + 2] = bflo(a.y); o[8 * j + 3] = bfhi(a.y); o[8 * j + 4] = bflo(a.z); o[8 * j + 5] = bfhi(a.z); o[8 * j + 6] = bflo(a.w); o[8 * j + 7] = bfhi(a.w); }
}
__device__ __forceinline__ void p12_conv(const Frame& F, const Args& A) {
    unsigned char* ws = A.ws;
    const bf16_t* BG = (const bf16_t*)(ws + WS_BG); const bf16_t* U = (const bf16_t*)(ws + WS_U); bf16_t* Z = (bf16_t*)(ws + WS_Z);
    float c0[16], c1[16], c2[16];
#pragma unroll
    for (int j = 0; j < 2; ++j)
#pragma unroll
        for (int q = 0; q < 8; ++q) { const int c = 8 * F.lane + 512 * j + q; c0[8 * j + q] = A.in[I_CONV][c]; c1[8 * j + q] = A.in[I_CONV][D + c]; c2[8 * j + q] = A.in[I_CONV][2 * D + c]; }
    for (int u = F.gw; u < 2048; u += F.NGW) {
        const int t0 = u * 16, pos0 = t0 % GRIDW;
        float prev[16], cur[16], nxt[16], bg[16];
        if (pos0 > 0) ld_bf16row(U + (size_t)(t0 - 1) * D, prev, F.lane);
        else {
#pragma unroll
            for (int q = 0; q < 16; ++q) prev[q] = 0.f; }
        ld_bf16row(U + (size_t)t0 * D, cur, F.lane);
        for (int i = 0; i < 16; ++i) {
            if (pos0 + i + 1 < GRIDW) ld_bf16row(U + (size_t)(t0 + i + 1) * D, nxt, F.lane);
            else {
#pragma unroll
                for (int q = 0; q < 16; ++q) nxt[q] = 0.f; }
            ld_bf16row(BG + (size_t)(t0 + i) * D, bg, F.lane);
            float z[16];
#pragma unroll
            for (int q = 0; q < 16; ++q) { z[q] = bg[q] * (c0[q] * prev[q] + c1[q] * cur[q] + c2[q] * nxt[q]); prev[q] = cur[q]; cur[q] = nxt[q]; }
#pragma unroll
            for (int j = 0; j < 2; ++j) { u32x4 w; w.x = pk2(z[8 * j], z[8 * j + 1]); w.y = pk2(z[8 * j + 2], z[8 * j + 3]); w.z = pk2(z[8 * j + 4], z[8 * j + 5]); w.w = pk2(z[8 * j + 6], z[8 * j + 7]);
                *(u32x4*)(Z + (size_t)(t0 + i) * D + 8 * F.lane + 512 * j) = w; }
        }
    }
}

constexpr int N_PHASES = 20;
__global__ void __launch_bounds__(NTHREADS, 2) fwd(Args args) {
    extern __shared__ __attribute__((aligned(16))) unsigned char lds_raw[];
    Frame F;
    F.lds = (LAS unsigned char*)lds_raw;
    F.tid = threadIdx.x; F.lane = F.tid & 63; F.wave = __builtin_amdgcn_readfirstlane(F.tid >> 6);
    F.G = gridDim.x; { const int bx = blockIdx.x; F.vcu = (F.G % 8 == 0) ? (bx % 8) * (F.G / 8) + bx / 8 : bx; }
    F.gw = F.vcu * NWAVES + F.wave; F.NGW = F.G * NWAVES;
    unsigned char* ws = args.ws;
    for (int u = F.tid; u < (LDS_BYTES - LDSCTL_OFF) / 4; u += NTHREADS) ((LAS unsigned*)(F.lds + LDSCTL_OFF))[u] = 0u;
    __syncthreads();
    volatile LAS unsigned* MISC = (volatile LAS unsigned*)(F.lds + MISC_OFF);
    XcdBarrier bar; bar.bar = (unsigned*)(ws + WS_CTL) + CW_BAR; bar.x = 0; bar.st = nullptr;
    const int lo = args.ph_lo, hi = args.ph_hi;
    if (hi - lo > 1) bar = xcd_barrier_post((unsigned*)(ws + WS_CTL) + CW_BAR, MISC + 8);
#ifndef PH_MASK
#define PH_MASK 0xFFFFFu
#endif
#define IN(k) (((PH_MASK >> (k)) & 1u) && lo <= (k) && (k) < hi)
#define SEAM(k) do { if (IN(k) && IN((k) + 1)) xcd_barrier(bar); } while (0)
#ifndef PROBE_MASK
#define PROBE_MASK 0u
#endif
#define RUNPH(k, ...) do { __VA_ARGS__ if constexpr (((PROBE_MASK >> (k)) & 1u) != 0u) { if (hi - lo > 1) xcd_barrier(bar); __VA_ARGS__ } } while (0)
    const float* MOD = (const float*)(ws + WS_MOD);
    const int bx = (int)blockIdx.x;
#ifdef PHASE_TIME
    unsigned long long pt_acc = 0, pt_t0 = 0;
#define PT_BEGIN(k) do { if ((k) == PHASE_TIME) pt_t0 = __builtin_amdgcn_s_memrealtime(); } while (0)
#define PT_END(k) do { if ((k) == PHASE_TIME) pt_acc += __builtin_amdgcn_s_memrealtime() - pt_t0; } while (0)
#else
#define PT_BEGIN(k) do { } while (0)
#define PT_END(k) do { } while (0)
#endif

    PT_END(99); if (IN(0)) { PT_BEGIN(0); RUNPH(0, p0_prologue(F, args);); SEAM(0); }
    PT_END(0); if (IN(1)) { PT_BEGIN(1); RUNPH(1, p1_mix(F, args);); SEAM(1); }
    PT_END(1); if (IN(2)) { PT_BEGIN(2);
      RUNPH(2,
        { SchedRKV S{(const char*)(ws + WS_XM), (const char*)(ws + WS_WRKV), F.G, bx};
          EpiRKV E{(bf16_t*)args.out, (bf16_t*)args.out + (size_t)ML * D, (bf16_t*)(ws + WS_KC), (bf16_t*)(ws + WS_V)};
          pg8::gemm_phase<EpiRKV, SchedRKV>(F.lds, D, D, S, E); }
        { SchedLora S{(const char*)(ws + WS_XM), (const char*)(ws + WS_WL), F.G, F.G == 256 ? bx : (bx + F.G / 2) % F.G};
          EpiLora E{(bf16_t*)(ws + WS_LWA), (bf16_t*)(ws + WS_LG)};
          pg8::gemm_phase<EpiLora, SchedLora>(F.lds, 2 * D, 2048, S, E); }
      );
        SEAM(2);
    }
    PT_END(2); if (IN(3)) { PT_BEGIN(3);
      RUNPH(3,
        SchedPlain S{(const char*)(ws + WS_LG), (const char*)(ws + WS_G2), 128, 4, 256, 256, 4, F.G, bx};
        EpiBf16 E{(bf16_t*)(ws + WS_G), D};
        pg8::gemm_phase<EpiBf16, SchedPlain>(F.lds, 256, 256, S, E);
      );
        SEAM(3);
    }
    PT_END(3); if (IN(4)) { PT_BEGIN(4); RUNPH(4, p3_scan(F, args);); SEAM(4); }
    PT_END(4); if (IN(5)) { PT_BEGIN(5); RUNPH(5, p4_readout(F, args);); SEAM(5); }
    PT_END(5); if (IN(6)) { PT_BEGIN(6);
      RUNPH(6,
        SchedPlain S{(const char*)(ws + WS_ZO), (const char*)(ws + WS_WO), 128, 4, D, D, 16, F.G, bx};
        EpiRes E{args.in[I_X], (bf16_t*)(ws + WS_HB), MOD + 2048};
        pg8::gemm_phase<EpiRes, SchedPlain>(F.lds, D, D, S, E);
      );
        SEAM(6);
    }
    PT_END(6); if (IN(7)) { PT_BEGIN(7); RUNPH(7, p6_route(F, args, 0);); SEAM(7); }
    PT_END(7); if (IN(8)) { PT_BEGIN(8); moe_convert(F, args, 0); RUNPH(8, p7_permute(F, args);); SEAM(8); }
    PT_END(8); if (IN(9)) { PT_BEGIN(9);
        unsigned* const rdy = (unsigned*)(ws + WS_CTL + CTL_RDY + 0 * 128 * 1024);
        { const SchedMoeG S{(const char*)(ws + WS_XN), (const char*)(ws + WS_MOEW0), (const int*)(ws + WS_TILE), (const int*)(ws + WS_INV), D, 16, F.G, bx, (size_t)2 * MiB};
          const EpiGateUpPub E{(unsigned char*)(ws + WS_H), rdy};
          pg8::gemm_phase<EpiGateUpPub, SchedMoeG, true>(F.lds, D, D, S, E); }
        { const SchedMoeD S{(const char*)(ws + WS_H), (const char*)(ws + WS_MOEW0 + 32 * MiB), (const int*)(ws + WS_TILE), rdy, (unsigned*)(ws + WS_CTL) + CW_TMO2, F.G, bx};
          const EpiBf16 E{(bf16_t*)(ws + WS_XP), D};
          pg8::gemm_phase<EpiBf16, SchedMoeD, true, 1>(F.lds, ED, ED, S, E); }
        if (IN(9) && IN(10 + 1)) xcd_barrier(bar);
    }
    PT_END(9); if (IN(11)) { PT_BEGIN(11); p10_combine<false>(F, args, 0); SEAM(11); }
    PT_END(11); if (IN(12)) { PT_BEGIN(12);
      RUNPH(12,
        SchedPlain S{(const char*)(ws + WS_XN), (const char*)(ws + WS_WIN), 128, 12, D, D, 16, F.G, bx};
        EpiWin E{(bf16_t*)(ws + WS_BG), (bf16_t*)(ws + WS_U)};
        pg8::gemm_phase<EpiWin, SchedPlain>(F.lds, D, D, S, E);
      );
        SEAM(12);
    }
    PT_END(12); if (IN(13)) { PT_BEGIN(13); RUNPH(13, p12_conv(F, args);); SEAM(13); }
    PT_END(13); if (IN(14)) { PT_BEGIN(14);
        SchedPlain S{(const char*)(ws + WS_Z), (const char*)(ws + WS_WOUT), 128, 4, D, D, 16, F.G, bx};
        EpiRes E{nullptr, (bf16_t*)(ws + WS_HB), MOD + 9 * 6144 + 2048};
        pg8::gemm_phase<EpiRes, SchedPlain>(F.lds, D, D, S, E);
        SEAM(14);
    }
    PT_END(14); if (IN(15)) { PT_BEGIN(15); RUNPH(15, p6_route(F, args, 1);); SEAM(15); }
    PT_END(15); if (IN(16)) { PT_BEGIN(16); moe_convert(F, args, 1); RUNPH(16, p7_permute(F, args);); SEAM(16); }
    PT_END(16); if (IN(17)) { PT_BEGIN(17);
        unsigned* const rdy = (unsigned*)(ws + WS_CTL + CTL_RDY + 1 * 128 * 1024);
        { const SchedMoeG S{(const char*)(ws + WS_XN), (const char*)(ws + WS_MOEW1), (const int*)(ws + WS_TILE), (const int*)(ws + WS_INV), D, 16, F.G, bx, (size_t)2 * MiB};
          const EpiGateUpPub E{(unsigned char*)(ws + WS_H), rdy};
          pg8::gemm_phase<EpiGateUpPub, SchedMoeG, true>(F.lds, D, D, S, E); }
        { const SchedMoeD S{(const char*)(ws + WS_H), (const char*)(ws + WS_MOEW1 + 32 * MiB), (const int*)(ws + WS_TILE), rdy, (unsigned*)(ws + WS_CTL) + CW_TMO2, F.G, bx};
          const EpiBf16 E{(bf16_t*)(ws + WS_XP), D};
          pg8::gemm_phase<EpiBf16, SchedMoeD, true, 1>(F.lds, ED, ED, S, E); }
        if (IN(17) && IN(18 + 1)) xcd_barrier(bar);
    }
    PT_END(17); if (IN(19)) { PT_BEGIN(19); p10_combine<true>(F, args, 1); }
    PT_END(19);
#ifdef PHASE_TIME
    if (blockIdx.x == 0 && F.tid == 0) { const unsigned long long te = __builtin_amdgcn_s_memrealtime() + 4ull * pt_acc; while (__builtin_amdgcn_s_memrealtime() < te) __builtin_amdgcn_s_sleep(8); }
#endif
}

extern "C" void kernel_launch(void* const* d_in, const int* in_sizes, int n_in, void* d_out, int out_size, void* d_ws, size_t ws_size, hipStream_t stream) {
    static int grid = 0;
    if (grid == 0) {
        if (n_in != 32 || out_size != ML * D || ws_size < WS_END) { fprintf(stderr, "kernel_launch: unexpected problem (n_in %d, out %d, ws %zu)\n", n_in, out_size, ws_size); grid = -1; return; }
        int dev = 0, cus = 0;
        if (hipGetDevice(&dev) != hipSuccess || hipDeviceGetAttribute(&cus, hipDeviceAttributeMultiprocessorCount, dev) != hipSuccess) { grid = -1; return; }
        if (hipFuncSetAttribute((const void*)fwd, hipFuncAttributeMaxDynamicSharedMemorySize, LDS_BYTES) != hipSuccess) { grid = -1; return; }
        int per_cu = 0;
        if (hipOccupancyMaxActiveBlocksPerMultiprocessor(&per_cu, (const void*)fwd, NTHREADS, LDS_BYTES) != hipSuccess || per_cu < 1) { fprintf(stderr, "kernel_launch: occupancy query says %d\n", per_cu); grid = -1; return; }
        grid = cus > 256 ? 256 : cus;
    }
    if (grid < 0) return;
    (void)in_sizes;
    hipMemsetAsync((char*)d_ws + WS_CTL, 0, CTL_ZERO_BYTES, stream);
    Args a{};
    for (int i = 0; i < 32; ++i) a.in[i] = (const float*)d_in[i];
    a.out = (float*)d_out; a.ws = (unsigned char*)d_ws;
#if MK_N_LAUNCHES == 1
    a.ph_lo = 0; a.ph_hi = N_PHASES;
    hipLaunchKernelGGL(fwd, dim3(grid), dim3(NTHREADS), LDS_BYTES, stream, a);
#else
    for (int k = 0; k < N_PHASES; ++k) { a.ph_lo = k; a.ph_hi = k + 1; hipLaunchKernelGGL(fwd, dim3(grid), dim3(NTHREADS), LDS_BYTES, stream, a); }
#endif
}
```

```cpp
#include <hip/hip_runtime.h>
#include <cstdio>
#include <cstdint>

#ifndef MK_N_LAUNCHES
#define MK_N_LAUNCHES 1
#endif

#define GAS __attribute__((address_space(1)))
#define LAS __attribute__((address_space(3)))
typedef unsigned short bf16_t;
typedef short bf16x8 __attribute__((ext_vector_type(8)));
typedef float f32x4 __attribute__((ext_vector_type(4)));
typedef float f32x2 __attribute__((ext_vector_type(2)));
typedef unsigned u32x4 __attribute__((ext_vector_type(4)));
typedef unsigned u32x2 __attribute__((ext_vector_type(2)));

constexpr int D = 1024, NBATCH = 8, TL = 4096, TCX = 256, ML = NBATCH * TL, MC = NBATCH * TCX, MA = ML + MC;
constexpr int NH = 16, HD = 64, NE = 16, ED = 512, GRIDW = 64;
constexpr int XM_LD = 5 * D;
constexpr int NWAVES = 8, NTHREADS = 512;
constexpr float RMS_EPS = 1e-6f, GN_EPS = 64e-5f;
constexpr int MAXTILES = 272;

constexpr size_t MiB = 1u << 20;
constexpr size_t WS_CTL = 0, CTL_ZERO_BYTES = 1 * MiB;
constexpr size_t WS_MOD = 1 * MiB;
constexpr size_t WS_EIDX = 2 * MiB;
constexpr size_t WS_GATE = WS_EIDX + 128 * 1024;
constexpr size_t WS_POS = WS_GATE + 256 * 1024;
constexpr size_t WS_CC = WS_POS + 256 * 1024;
constexpr size_t WS_TILE = WS_CC + 128 * 1024;
constexpr size_t WS_INV = WS_TILE + 4 * 1024;
static_assert(WS_INV + 69632 * 4 <= 4 * MiB, "ws map");
constexpr size_t WS_WRKV = 4 * MiB;
constexpr size_t WS_WL = 16 * MiB;
constexpr size_t WS_G2 = 18 * MiB;
constexpr size_t WS_WO = 19 * MiB;
constexpr size_t WS_WIN = 21 * MiB;
constexpr size_t WS_WOUT = 27 * MiB;
constexpr size_t WS_ACT = 32 * MiB;
constexpr size_t WS_XM = WS_ACT;
constexpr size_t WS_LP = 304 * MiB;
constexpr size_t WS_V = 372 * MiB;
constexpr size_t WS_KC = 440 * MiB;
constexpr size_t WS_LWA = 444 * MiB;
constexpr size_t WS_LG = 461 * MiB;
constexpr size_t WS_G = 32 * MiB;
constexpr size_t WS_Y0 = 96 * MiB, WS_Y1 = 160 * MiB;
constexpr size_t WS_ZO = 272 * MiB;
constexpr size_t WS_MOEW0 = 416 * MiB, WS_MOEW1 = 464 * MiB;
constexpr size_t WS_XN = 32 * MiB;
constexpr size_t WS_XP = 96 * MiB;
constexpr size_t WS_H = 232 * MiB;
constexpr size_t WS_BG = 232 * MiB, WS_U = 160 * MiB;
constexpr size_t WS_HB = 336 * MiB;
constexpr size_t WS_Z = 96 * MiB;
constexpr size_t WS_END = 512 * MiB;

constexpr int CW_BAR = 4096;
constexpr int CW_TMO2 = 16;
constexpr size_t CTL_RDY = 256 * 1024;

constexpr int RING_BYTES = 131072;
constexpr int LDS_BYTES = 163840;
constexpr int LDSCTL_OFF = LDS_BYTES - 512, MISC_OFF = LDSCTL_OFF + 64;
constexpr int LDS_X_OFF = RING_BYTES;

typedef __bf16 bf16x2v __attribute__((ext_vector_type(2)));
__device__ __forceinline__ unsigned pk2(float lo, float hi) { const f32x2 v = {lo, hi}; return __builtin_bit_cast(unsigned, __builtin_convertvector(v, bf16x2v)); }
__device__ __forceinline__ unsigned f2bf(float f) { return pk2(f, 0.f) & 0xffffu; }
__device__ __forceinline__ float bflo(unsigned u) { return __builtin_bit_cast(float, u << 16); }
__device__ __forceinline__ float bfhi(unsigned u) { return __builtin_bit_cast(float, u & 0xffff0000u); }
__device__ __forceinline__ float wave_sum(float v) {
#pragma unroll
    for (int o = 1; o < 64; o <<= 1) v += __shfl_xor(v, o);
    return v;
}
__device__ __forceinline__ float sigmoidf_(float x) { return 1.f / (1.f + __expf(-x)); }
#define LDS_WAIT() asm volatile("s_waitcnt lgkmcnt(0)" ::: "memory")

namespace pg8 {
constexpr int BM = 256, BK = 64, HALF = 128, HTB = HALF * BK * 2, STAGE_BYTES = 8 * HTB, NXCD = 8, WGM = 8;
__host__ __device__ __forceinline__ int lds_byte(int r, int c) { const int st = (r >> 4) * 2 + (c >> 5), rr = r & 15, cc = c & 31, ob = rr * 64 + cc * 2; return st * 1024 + (ob ^ (((ob >> 9) & 1) << 5)); }
__host__ __device__ __forceinline__ void stage_rc(int b, int& R, int& C) { const int st = b / 1024, sb = b % 1024, swz = sb ^ (((sb >> 9) & 1) << 5); R = (st >> 1) * 16 + swz / 64; C = (st & 1) * 32 + (swz % 64) / 2; }
__host__ __device__ __forceinline__ int perm32(int rho) { const int n = rho >> 4, i = rho & 15; return 8 * (i >> 2) + 4 * n + (i & 3); }

struct Unit { int pm, pn; const char* a; const char* b; int nt; const int* rows; int kind, pa, pb, row0; };

__device__ __forceinline__ void swz_tile(int L, int nM, int nN, int& pm, int& pn) {
    const int nwg = nM * nN; int wgid = L;
    { const int q = nwg / NXCD, r = nwg % NXCD, xcd = wgid % NXCD, off = wgid / NXCD; wgid = (xcd < r ? xcd * (q + 1) : r * (q + 1) + (xcd - r) * q) + off; }
    const int nig = WGM * nN, gid = wgid / nig, fm = gid * WGM, gsz = (nM - fm) < WGM ? (nM - fm) : WGM;
    pm = fm + ((wgid % nig) % gsz); pn = (wgid % nig) / gsz;
}

__device__ __forceinline__ unsigned cvt_pk_bf16(float lo, float hi) { return pk2(lo, hi); }

template <class Epi, class Sched, bool GATHER = false, int FUSED = 0  , bool ALIGN_EPI = true, bool SP2 = true>
__device__ __forceinline__ void gemm_phase(LAS unsigned char* lds, const int lda, const int ldb, const Sched& S, const Epi& E) {
    const int tid = threadIdx.x, wid = __builtin_amdgcn_readfirstlane(tid >> 6), lane = tid & 63, wr = wid >> 2, wc = wid & 3, fr = lane & 15, fq = lane >> 4;
    unsigned vA[2][2], vN[2][2], voffB[2], vBn[2]; int gR[2], gC[2], gRb[2]; size_t hsBc = 0, hsBn = 0;
#pragma unroll
    for (int i = 0; i < 2; ++i) { int R, C; stage_rc(tid * 16 + i * 8192, R, C); const int Rb = Epi::PERM ? ((R & ~31) + perm32(R & 31)) : R;
        gR[i] = R; gC[i] = C * 2; gRb[i] = Rb; vBn[i] = 0;
        vA[0][i] = (unsigned)(R * lda + C) * 2u; vA[1][i] = (unsigned)((R + HALF) * lda + C) * 2u; vN[0][i] = vA[0][i]; vN[1][i] = vA[1][i];
        voffB[i] = (unsigned)(Rb * ldb + C) * 2u; }
#define PG8_GATHER(dst, u) do { if constexpr (GATHER) { _Pragma("unroll") for (int _h = 0; _h < 2; ++_h) _Pragma("unroll") for (int _i = 0; _i < 2; ++_i) { \
        if constexpr (FUSED != 0) { const int ri_ = gR[_i] + _h * HALF; const unsigned rr_ = (u).rows ? (unsigned)(u).rows[ri_] : (unsigned)((u).row0 + ri_); dst[_h][_i] = rr_ * (unsigned)(u).pa + (unsigned)gC[_i]; } \
        else dst[_h][_i] = (unsigned)(u).rows[gR[_i] + _h * HALF] * (unsigned)(lda * 2) + (unsigned)gC[_i]; } } } while (0)
#define PG8_BOFF(dst, u) do { if constexpr (FUSED == 2) { _Pragma("unroll") for (int _i = 0; _i < 2; ++_i) dst[_i] = (unsigned)gRb[_i] * (unsigned)(u).pb + (unsigned)gC[_i]; } } while (0)
#define PG8_STAGE_B(bufoff, gbase, hh, nx) do { if constexpr (FUSED == 2) { if ((nx) && last) PG8_STAGE(bufoff, (gbase) + (hh) * hsBn, vBn); else PG8_STAGE(bufoff, (gbase) + (hh) * hsBc, voffB); } \
        else PG8_STAGE(bufoff, (gbase) + (hh) * hstepB, voffB); } while (0)
    const size_t kstep = (size_t)(BK * 2);
    const size_t hstepB = (size_t)HALF * ldb * 2;
    const unsigned ldsw = (unsigned)wid * 1024u;
    const int aoff = lds_byte(wr * 64 + fr, fq * 8), boff = lds_byte(wc * 32 + fr, fq * 8);
#define PG8_SA(b, h) (((b) * 2 + (h)) * HTB)
#define PG8_SB(b, h) ((4 + (b) * 2 + (h)) * HTB)
#define PG8_STAGE(bufoff, gbase, voff) do { _Pragma("unroll") for (int _i = 0; _i < 2; ++_i) \
        __builtin_amdgcn_global_load_lds((const unsigned*)((const char*)(gbase) + (voff)[_i]), (LAS unsigned*)(lds + (bufoff) + ldsw + _i * 8192), 16, 0, 0); } while (0)
#define PG8_LDA(dst, b, h) do { _Pragma("unroll") for (int m = 0; m < 4; ++m) _Pragma("unroll") for (int k = 0; k < 2; ++k) dst[m][k] = *(const LAS bf16x8*)(lds + PG8_SA(b, h) + aoff + m * 2048 + k * 1024); } while (0)
#define PG8_LDB(dst, b, h) do { _Pragma("unroll") for (int n = 0; n < 2; ++n) _Pragma("unroll") for (int k = 0; k < 2; ++k) dst[n][k] = *(const LAS bf16x8*)(lds + PG8_SB(b, h) + boff + n * 2048 + k * 1024); } while (0)
#define PG8_MMA(ai, bj, At, Bt) do { __builtin_amdgcn_s_setprio(1); _Pragma("unroll") for (int m = 0; m < 4; ++m) _Pragma("unroll") for (int n = 0; n < 2; ++n) _Pragma("unroll") for (int k = 0; k < 2; ++k) \
        acc[ai][bj][m][n] = __builtin_amdgcn_mfma_f32_16x16x32_bf16(Bt[n][k], At[m][k], acc[ai][bj][m][n], 0, 0, 0); __builtin_amdgcn_s_setprio(0); } while (0)
#define PG8_WAIT_V(n) asm volatile("s_waitcnt vmcnt(" #n ")" ::: "memory")
#define PG8_WAIT_L(n) asm volatile("s_waitcnt lgkmcnt(" #n ")" ::: "memory")
#define PG8_BAR __builtin_amdgcn_s_barrier()
#define PG8_SCHED __builtin_amdgcn_sched_barrier(0)
    Unit cur, nxt; int ui = 0;
    if (!S.next(0, cur)) return;
    f32x4 acc[2][2][4][2];
#pragma unroll
    for (int a = 0; a < 2; ++a)
#pragma unroll
        for (int b = 0; b < 2; ++b)
#pragma unroll
            for (int m = 0; m < 4; ++m)
#pragma unroll
                for (int n = 0; n < 2; ++n) acc[a][b][m][n] = (f32x4){0.f, 0.f, 0.f, 0.f};
    bf16x8 At[4][2], B0[2][2], B1[2][2];
    const char* cA = cur.a; const char* cB = cur.b;
    PG8_GATHER(vA, cur);
    if constexpr (FUSED == 2) { PG8_BOFF(voffB, cur); hsBc = (size_t)HALF * cur.pb; }
    if constexpr (FUSED != 0) S.a_ready(cur);
    { const bool last = false;
    if constexpr (SP2) {
        PG8_STAGE_B(PG8_SB(0, 0), cB, 0, false); PG8_STAGE_B(PG8_SB(0, 1), cB, 1, false); PG8_STAGE(PG8_SA(0, 0), cA, vA[0]); PG8_STAGE(PG8_SA(0, 1), cA, vA[1]);
        if (wr == 1) PG8_BAR;
        PG8_WAIT_V(2); PG8_BAR;
        PG8_STAGE_B(PG8_SB(1, 0), cB + kstep, 0, false); PG8_STAGE(PG8_SA(1, 0), cA + kstep, vA[0]); PG8_STAGE_B(PG8_SB(1, 1), cB + kstep, 1, false);
        PG8_WAIT_V(6); PG8_BAR;
    } else {
        PG8_STAGE_B(PG8_SB(0, 0), cB, 0, false); PG8_STAGE(PG8_SA(0, 0), cA, vA[0]); PG8_STAGE_B(PG8_SB(0, 1), cB, 1, false); PG8_STAGE(PG8_SA(0, 1), cA, vA[1]);
        if (wr == 1) PG8_BAR;
        PG8_WAIT_V(4); PG8_BAR;
        PG8_STAGE_B(PG8_SB(1, 0), cB + kstep, 0, false); PG8_STAGE(PG8_SA(1, 0), cA + kstep, vA[0]); PG8_STAGE_B(PG8_SB(1, 1), cB + kstep, 1, false);
        PG8_WAIT_V(6); PG8_BAR;
    }
    }
    for (;;) {
        const bool has_next = S.next(ui + 1, nxt);
        const char* nA = has_next ? nxt.a : cA; const char* nB = has_next ? nxt.b : cB;
        if (has_next) { PG8_GATHER(vN, nxt); if constexpr (FUSED == 2) { PG8_BOFF(vBn, nxt); hsBn = (size_t)HALF * nxt.pb; } }
        const int nt = cur.nt;
        for (int t = 0; t < nt; t += 2) {
            const bool last = (t == nt - 2);
            const char* a1 = cA + (size_t)(t + 1) * kstep;
            const char* a2 = last ? nA : cA + (size_t)(t + 2) * kstep; const char* b2 = last ? nB : cB + (size_t)(t + 2) * kstep;
            const char* a3 = a2 + kstep; const char* b3 = b2 + kstep;
            if constexpr (FUSED != 0) { if (last && has_next) S.a_ready(nxt); }
            unsigned vX[2][2];
#pragma unroll
            for (int _h = 0; _h < 2; ++_h)
#pragma unroll
                for (int _i = 0; _i < 2; ++_i) vX[_h][_i] = (GATHER && last) ? vN[_h][_i] : vA[_h][_i];
            if constexpr (SP2) {
            PG8_LDB(B0, 0, 0); PG8_LDB(B1, 0, 1); PG8_SCHED; PG8_LDA(At, 0, 0); PG8_STAGE(PG8_SA(1, 1), a1, vA[1]);
            PG8_WAIT_V(8); PG8_WAIT_L(0); PG8_BAR; PG8_MMA(0, 0, At, B0); PG8_MMA(0, 1, At, B1); PG8_BAR; PG8_SCHED;
            PG8_LDA(At, 0, 1); PG8_STAGE_B(PG8_SB(0, 0), b2, 0, true); PG8_STAGE_B(PG8_SB(0, 1), b2, 1, true); PG8_STAGE(PG8_SA(0, 0), a2, vX[0]);
            PG8_WAIT_V(8); PG8_WAIT_L(0); PG8_BAR; PG8_MMA(1, 0, At, B0); PG8_MMA(1, 1, At, B1); PG8_BAR; PG8_SCHED;
            PG8_LDB(B0, 1, 0); PG8_LDB(B1, 1, 1); PG8_SCHED; PG8_LDA(At, 1, 0); PG8_STAGE(PG8_SA(0, 1), a2, vX[1]);
            PG8_WAIT_V(8); PG8_WAIT_L(0); PG8_BAR; PG8_MMA(0, 0, At, B0); PG8_MMA(0, 1, At, B1); PG8_BAR; PG8_SCHED;
            PG8_LDA(At, 1, 1); PG8_STAGE_B(PG8_SB(1, 0), b3, 0, true); PG8_STAGE_B(PG8_SB(1, 1), b3, 1, true); PG8_STAGE(PG8_SA(1, 0), a3, vX[0]);
            PG8_WAIT_V(8); PG8_WAIT_L(0); PG8_BAR; PG8_MMA(1, 0, At, B0); PG8_MMA(1, 1, At, B1); PG8_BAR; PG8_SCHED;
            } else {
            PG8_LDB(B0, 0, 0); PG8_SCHED; PG8_LDA(At, 0, 0); PG8_STAGE(PG8_SA(1, 1), a1, vA[1]);
            PG8_WAIT_L(8); PG8_BAR; PG8_WAIT_L(0); PG8_MMA(0, 0, At, B0); PG8_BAR; PG8_SCHED;
            PG8_LDB(B1, 0, 1); PG8_STAGE_B(PG8_SB(0, 0), b2, 0, true);
            PG8_BAR; PG8_WAIT_L(0); PG8_MMA(0, 1, At, B1); PG8_BAR;
            PG8_LDA(At, 0, 1); PG8_STAGE(PG8_SA(0, 0), a2, vX[0]);
            PG8_BAR; PG8_WAIT_L(0); PG8_MMA(1, 0, At, B0); PG8_BAR; PG8_SCHED;
            PG8_STAGE_B(PG8_SB(0, 1), b2, 1, true);
            PG8_WAIT_V(6); PG8_BAR; PG8_MMA(1, 1, At, B1); PG8_BAR;
            PG8_LDB(B0, 1, 0); PG8_SCHED; PG8_LDA(At, 1, 0); PG8_STAGE(PG8_SA(0, 1), a2, vX[1]);
            PG8_WAIT_L(8); PG8_BAR; PG8_WAIT_L(0); PG8_MMA(0, 0, At, B0); PG8_BAR; PG8_SCHED;
            PG8_LDB(B1, 1, 1); PG8_STAGE_B(PG8_SB(1, 0), b3, 0, true);
            PG8_BAR; PG8_WAIT_L(0); PG8_MMA(0, 1, At, B1); PG8_BAR;
            PG8_LDA(At, 1, 1); PG8_STAGE(PG8_SA(1, 0), a3, vX[0]);
            PG8_BAR; PG8_WAIT_L(0); PG8_MMA(1, 0, At, B0); PG8_BAR; PG8_SCHED;
            PG8_STAGE_B(PG8_SB(1, 1), b3, 1, true);
            PG8_WAIT_V(6); PG8_BAR; PG8_MMA(1, 1, At, B1); PG8_BAR;
            }
        }
        if constexpr (ALIGN_EPI) { if (wr == 0) PG8_BAR; }
        E(acc, cur, wr, wc, fr, fq);
        if (!has_next) break;
#pragma unroll
        for (int a = 0; a < 2; ++a)
#pragma unroll
            for (int b = 0; b < 2; ++b)
#pragma unroll
                for (int m = 0; m < 4; ++m)
#pragma unroll
                    for (int n = 0; n < 2; ++n) acc[a][b][m][n] = (f32x4){0.f, 0.f, 0.f, 0.f};
        cur = nxt; cA = nA; cB = nB; ++ui;
        if constexpr (GATHER) {
#pragma unroll
            for (int _h = 0; _h < 2; ++_h)
#pragma unroll
                for (int _i = 0; _i < 2; ++_i) vA[_h][_i] = vN[_h][_i]; }
        if constexpr (FUSED == 2) { voffB[0] = vBn[0]; voffB[1] = vBn[1]; hsBc = hsBn; }
        if constexpr (ALIGN_EPI) { if (wr == 1) PG8_BAR; }
    }
    PG8_WAIT_V(0);
    if constexpr (!ALIGN_EPI) { if (wr == 0) PG8_BAR; }
    PG8_BAR;
#undef PG8_GATHER
#undef PG8_BOFF
#undef PG8_STAGE_B
#undef PG8_SA
#undef PG8_SB
#undef PG8_STAGE
#undef PG8_LDA
#undef PG8_LDB
#undef PG8_MMA
#undef PG8_WAIT_V
#undef PG8_WAIT_L
#undef PG8_BAR
#undef PG8_SCHED
}
}

#define XB_TMO      128
#define XB_XCNT(j)  (256  + 64 * (j))
#define XB_XSUB(j)  (1280 + 64 * (j))
#define XB_XGEN(j)  (2304 + 64 * (j))
#define XB_TOP      3328
#define XB_TOPGEN   3392
#define XCD_BAR_WORDS 3456
#define XB_SPIN_CAP (1u << 18)

__device__ __forceinline__ unsigned xb_ld(unsigned* p)              { return __hip_atomic_load(p, __ATOMIC_RELAXED, __HIP_MEMORY_SCOPE_AGENT); }
__device__ __forceinline__ unsigned xb_add(unsigned* p, unsigned v) { return __hip_atomic_fetch_add(p, v, __ATOMIC_RELAXED, __HIP_MEMORY_SCOPE_AGENT); }
__device__ __forceinline__ unsigned xb_xcc_id() { return (unsigned)__builtin_amdgcn_s_getreg((3 << 11) | 20) & 0xFu; }
#define XB_SPIN(cond, bar) do { unsigned _sp = 0; while (cond) { __builtin_amdgcn_s_sleep(1); \
    if ((++_sp & 255u) == 0u) { if (xb_ld(&(bar)[XB_TMO])) break; if (_sp > XB_SPIN_CAP) { atomicAdd(&(bar)[XB_TMO], 1u); break; } } } } while (0)

struct XcdBarrier { unsigned* bar; unsigned x; volatile LAS unsigned* st; };

__device__ __forceinline__ XcdBarrier xcd_barrier_post(unsigned* bar, volatile LAS unsigned* st) {
    XcdBarrier b; b.bar = bar; b.x = xb_xcc_id(); b.st = st;
    if (threadIdx.x == 0) (void)xb_add(&bar[XB_XCNT(b.x)], 1u);
    return b;
}
__device__ __forceinline__ void xcd_barrier_complete(unsigned* bar, unsigned x, unsigned& nloc, unsigned& nx) {
    const unsigned G = gridDim.x * gridDim.y * gridDim.z;
    unsigned sum, cnt, mine, sp = 0u;
    for (;;) {
        sum = 0u; cnt = 0u; mine = 0u;
#pragma unroll
        for (unsigned j = 0; j < 16; ++j) { const unsigned c = xb_ld(&bar[XB_XCNT(j)]); sum += c; cnt += (c > 0u) ? 1u : 0u; mine = (j == x) ? c : mine; }
        if (sum == G) break;
        __builtin_amdgcn_s_sleep(1);
        if ((++sp & 255u) == 0u) { if (xb_ld(&bar[XB_TMO])) break; if (sp > XB_SPIN_CAP) { atomicAdd(&bar[XB_TMO], 1u); break; } }
    }
    nloc = mine > 0u ? mine : 1u; nx = cnt > 0u ? cnt : 1u;
}
__device__ __forceinline__ void xcd_barrier(const XcdBarrier& b) {
    asm volatile("s_waitcnt vmcnt(0)" ::: "memory");
    __syncthreads();
    if (threadIdx.x == 0) {
        unsigned* bar = b.bar;
        __builtin_amdgcn_s_waitcnt(0);
        unsigned nloc = b.st[0], nx = b.st[1];
        if (nloc == 0u) { xcd_barrier_complete(bar, b.x, nloc, nx); b.st[0] = nloc; b.st[1] = nx; }
        const unsigned old = xb_add(&bar[XB_XSUB(b.x)], 1u);
        const unsigned gen = old / nloc;
        if (old + 1u == (gen + 1u) * nloc) {
            __builtin_amdgcn_fence(__ATOMIC_RELEASE, "agent");
            asm volatile("s_waitcnt vmcnt(0)" ::: "memory");
            const unsigned og = xb_add(&bar[XB_TOP], 1u);
            const unsigned tg = og / nx;
            if (og + 1u == (tg + 1u) * nx) xb_add(&bar[XB_TOPGEN], 1u);
            else XB_SPIN(xb_ld(&bar[XB_TOPGEN]) == tg, bar);
            __builtin_amdgcn_fence(__ATOMIC_ACQUIRE, "agent");
            xb_add(&bar[XB_XGEN(b.x)], 1u);
            asm volatile("s_waitcnt vmcnt(0)" ::: "memory");
        } else {
            XB_SPIN(xb_ld(&bar[XB_XGEN(b.x)]) == gen, bar);
            __builtin_amdgcn_fence(__ATOMIC_ACQUIRE, "agent");
            asm volatile("s_waitcnt vmcnt(0)" ::: "memory");
        }
    }
    __syncthreads();
}

struct Args { const float* in[32]; float* out; unsigned char* ws; int ph_lo, ph_hi; };
enum { I_X = 0, I_C, I_CTX, I_CCTX, I_ADAW, I_ADAB, I_NORMG, I_MU, I_WRKV, I_W0, I_W1, I_W2, I_A0, I_A1, I_A2, I_G1, I_G2, I_KK, I_KA, I_RK, I_GNW, I_GNB, I_WO,
       I_WIN, I_CONV, I_WOUT, I_ROUTW, I_ROUTB, I_MGATE, I_MUP, I_MDOWN, I_FINALG };

struct Frame {
    LAS unsigned char* lds;
    int tid, lane, wave, G, vcu, gw, NGW;
};


__device__ __forceinline__ void tr_item(const float* W, int ldw, int k0, int n0, bf16_t* dst, int ldd, int drow0, const float* mu, LAS float* scr, int lane) {
#pragma unroll 8
    for (int i = 0; i < 32; ++i) { const int kk = 2 * i + (lane >> 5); scr[kk * 33 + (lane & 31)] = W[(size_t)(k0 + kk) * ldw + n0 + (lane & 31)]; }
    LDS_WAIT(); asm volatile("" ::: "memory");
    const int c = lane & 7;
    float m[8];
#pragma unroll
    for (int q = 0; q < 8; ++q) m[q] = mu ? mu[k0 + 8 * c + q] : 0.f;
#pragma unroll
    for (int j = 0; j < 4; ++j) { const int n = (lane >> 3) + 8 * j; const LAS float* s = scr + (8 * c) * 33 + n;
        float v[8];
#pragma unroll
        for (int q = 0; q < 8; ++q) v[q] = s[q * 33];
        bf16_t* drow = dst + (size_t)(drow0 + n) * ldd + k0 + 8 * c;
        if (!mu) {
            u32x4 o; o.x = pk2(v[0], v[1]); o.y = pk2(v[2], v[3]); o.z = pk2(v[4], v[5]); o.w = pk2(v[6], v[7]);
            *(u32x4*)drow = o;
        } else {
            u32x4 o; o.x = pk2(v[0] * (1.f - m[0]), v[1] * (1.f - m[1])); o.y = pk2(v[2] * (1.f - m[2]), v[3] * (1.f - m[3]));
            o.z = pk2(v[4] * (1.f - m[4]), v[5] * (1.f - m[5])); o.w = pk2(v[6] * (1.f - m[6]), v[7] * (1.f - m[7]));
            *(u32x4*)drow = o;
            u32x4 p; p.x = pk2(v[0] * 0.5f * m[0], v[1] * 0.5f * m[1]); p.y = pk2(v[2] * 0.5f * m[2], v[3] * 0.5f * m[3]);
            p.z = pk2(v[4] * 0.5f * m[4], v[5] * 0.5f * m[5]); p.w = pk2(v[6] * 0.5f * m[6], v[7] * 0.5f * m[7]);
            *(u32x4*)(drow + (size_t)384 * ldd) = p;
        }
    }
    LDS_WAIT(); asm volatile("" ::: "memory");
}
__device__ __forceinline__ void tr_job_item(const float* W, int ldw, int N, bf16_t* dst, int ldd, int drow_base, bool il, const float* mu, int item, LAS float* scr, int lane) {
    const int nblk = N / 32, kb = item / nblk, nb = item % nblk, n0 = 32 * nb;
    const int dr = drow_base + (il ? ((n0 >> 7) * 256 + (n0 & 127)) : n0);
    tr_item(W, ldw, 64 * kb, n0, dst, ldd, dr, mu, scr, lane);
}

__device__ __forceinline__ void p0_prologue(const Frame& F, const Args& A) {
    unsigned char* ws = A.ws;
    LAS float* scr = (LAS float*)(F.lds + F.wave * 16384);
    bf16_t* WRKV = (bf16_t*)(ws + WS_WRKV); bf16_t* WL = (bf16_t*)(ws + WS_WL); bf16_t* G2 = (bf16_t*)(ws + WS_G2);
    bf16_t* WO = (bf16_t*)(ws + WS_WO); bf16_t* WIN = (bf16_t*)(ws + WS_WIN); bf16_t* WOUT = (bf16_t*)(ws + WS_WOUT);
    const float* mu = A.in[I_MU];
    constexpr int NIT = 3 * 512 + 4 * 32 + 64 + 64 + 512 + 3 * 512 + 512;
    for (int it = F.gw; it < NIT; it += F.NGW) {
        int r = it;
        if (r < 1536) { const int p = r / 512; tr_job_item(A.in[I_WRKV] + (size_t)p * D * D, D, D, WRKV, D, p * 1024, false, nullptr, r % 512, scr, F.lane); continue; } r -= 1536;
        if (r < 64) { const int dir = r / 32; tr_job_item(A.in[I_W1] + (size_t)dir * D * 64, 64, 64, WL, D, dir * 64, false, mu + 3 * D, r % 32, scr, F.lane); continue; } r -= 64;
        if (r < 64) { const int dir = r / 32; tr_job_item(A.in[I_A1] + (size_t)dir * D * 64, 64, 64, WL, D, 128 + dir * 64, false, mu + 4 * D, r % 32, scr, F.lane); continue; } r -= 64;
        if (r < 64) { tr_job_item(A.in[I_G1], 128, 128, WL, D, 256, false, mu + 5 * D, r, scr, F.lane); continue; } r -= 64;
        if (r < 64) { tr_job_item(A.in[I_G2], D, D, G2, 256, 0, false, nullptr, r, scr, F.lane); continue; } r -= 64;
        if (r < 512) { tr_job_item(A.in[I_WO], D, D, WO, D, 0, false, nullptr, r, scr, F.lane); continue; } r -= 512;
        if (r < 512) { tr_job_item(A.in[I_WIN], 3 * D, D, WIN, D, 0, false, nullptr, r, scr, F.lane); continue; } r -= 512;
        if (r < 512) { tr_job_item(A.in[I_WIN] + D, 3 * D, D, WIN, D, 1024, true, nullptr, r, scr, F.lane); continue; } r -= 512;
        if (r < 512) { tr_job_item(A.in[I_WIN] + 2 * D, 3 * D, D, WIN, D, 1024 + 128, true, nullptr, r, scr, F.lane); continue; } r -= 512;
        tr_job_item(A.in[I_WOUT], D, D, WOUT, D, 0, false, nullptr, r, scr, F.lane);
    }
    {
        const int gt = F.vcu * NTHREADS + F.tid, NGT = F.G * NTHREADS;
        u32x4 z = (u32x4){0u, 0u, 0u, 0u};
        for (int i = gt; i < 16384; i += NGT) { const int row = i >> 4, q = i & 15; *(u32x4*)(G2 + (size_t)row * 256 + 128 + q * 8) = z; }
    }
    __syncthreads();
    {
        LAS float* st = (LAS float*)F.lds;
        LAS float* red = st + 9 * 1024;
        for (int i = F.tid; i < 9 * 1024; i += NTHREADS) { const float v = (i < 8192) ? A.in[I_C][i] : A.in[I_CCTX][i - 8192]; st[i] = v / (1.f + __expf(-v)); }
        __syncthreads();
        float* MOD = (float*)(ws + WS_MOD);
        for (int u = blockIdx.x; u < 256; u += F.G) {
            const int l = u >> 7, e0 = (u & 127) * 48;
            if (F.tid < 384) {
                const int q = F.tid % 12, dg = F.tid / 12;
                f32x4 acc[9];
#pragma unroll
                for (int r = 0; r < 9; ++r) acc[r] = (f32x4){0.f, 0.f, 0.f, 0.f};
                const float* wb = A.in[I_ADAW] + (size_t)l * D * 6144 + e0 + 4 * q;
#pragma unroll 4
                for (int i = 0; i < 32; ++i) { const int d = dg + 32 * i; const f32x4 w = *(const f32x4*)(wb + (size_t)d * 6144);
#pragma unroll
                    for (int r = 0; r < 9; ++r) acc[r] += st[r * 1024 + d] * w; }
#pragma unroll
                for (int r = 0; r < 9; ++r) *(LAS f32x4*)(red + (dg * 9 + r) * 48 + 4 * q) = acc[r];
            }
            __syncthreads();
            if (F.tid < 432) { const int r = F.tid / 48, ci = F.tid % 48; float s = A.in[I_ADAB][l * 6144 + e0 + ci];
                for (int dg = 0; dg < 32; ++dg) s += red[(dg * 9 + r) * 48 + ci];
                MOD[((size_t)l * 9 + r) * 6144 + e0 + ci] = s; }
            __syncthreads();
        }
    }
}

__device__ __forceinline__ void p1_load_norm(const float* row, const f32x4 (&gsc)[4], const f32x4 (&sh)[4], f32x4 (&o)[4], int lane) {
    const f32x4* xr = (const f32x4*)row + lane; float s = 0.f;
#pragma unroll
    for (int j = 0; j < 4; ++j) { o[j] = xr[64 * j]; s += (o[j].x * o[j].x + o[j].y * o[j].y) + (o[j].z * o[j].z + o[j].w * o[j].w); }
    const float rstd = rsqrtf(wave_sum(s) * (1.f / D) + RMS_EPS);
#pragma unroll
    for (int j = 0; j < 4; ++j) o[j] = o[j] * rstd * gsc[j] + sh[j];
}
__device__ __forceinline__ void ld_row_bf16(const bf16_t* row, f32x4 (&o)[4], int lane) {
#pragma unroll
    for (int j = 0; j < 4; ++j) { const u32x2 q = *(const u32x2*)(row + 4 * lane + 256 * j); o[j] = (f32x4){bflo(q.x), bfhi(q.x), bflo(q.y), bfhi(q.y)}; }
}
__device__ __forceinline__ void norm_rows(f32x4 (&o)[4], const f32x4 (&gsc)[4], const f32x4 (&sh)[4]) {
    float s = 0.f;
#pragma unroll
    for (int j = 0; j < 4; ++j) s += (o[j].x * o[j].x + o[j].y * o[j].y) + (o[j].z * o[j].z + o[j].w * o[j].w);
    const float rstd = rsqrtf(wave_sum(s) * (1.f / D) + RMS_EPS);
#pragma unroll
    for (int j = 0; j < 4; ++j) o[j] = o[j] * rstd * gsc[j] + sh[j];
}
__device__ __forceinline__ void st_bf4(bf16_t* p, const f32x4 v) { u32x2 w; w.x = pk2(v.x, v.y); w.y = pk2(v.z, v.w); *(u32x2*)p = w; }

__device__ __forceinline__ void p1_mix(const Frame& F, const Args& A) {
    const float* MOD = (const float*)(A.ws + WS_MOD);
    bf16_t* XM = (bf16_t*)(A.ws + WS_XM);
    const float* mu = A.in[I_MU]; const float* ng = A.in[I_NORMG];
    for (int u = F.gw; u < 2176; u += F.NGW) {
        const bool isctx = u >= 2048; int t0, rowlen, modrow; const float* src; size_t orow0;
        if (!isctx) { t0 = u * 16; rowlen = GRIDW; modrow = t0 / TL; src = A.in[I_X] + (size_t)t0 * D; orow0 = t0; }
        else { t0 = (u - 2048) * 16; rowlen = TCX; modrow = 8; src = A.in[I_CTX] + (size_t)t0 * D; orow0 = (size_t)ML + t0; }
        const int pos0 = t0 % rowlen;
        const float* mrow = MOD + (size_t)modrow * 6144;
        f32x4 gsc[4], sh[4], m0[4], m1[4], m2[4];
#pragma unroll
        for (int j = 0; j < 4; ++j) { const int c = 4 * F.lane + 256 * j;
            const f32x4 g = *(const f32x4*)(ng + c), sc = *(const f32x4*)(mrow + 1024 + c);
            gsc[j] = g * (1.f + sc); sh[j] = *(const f32x4*)(mrow + c);
            m0[j] = *(const f32x4*)(mu + c); m1[j] = *(const f32x4*)(mu + D + c); m2[j] = *(const f32x4*)(mu + 2 * D + c); }
        f32x4 prev[4], cur[4], nxt[4];
        if (pos0 > 0) p1_load_norm(src - D, gsc, sh, prev, F.lane);
        else {
#pragma unroll
            for (int j = 0; j < 4; ++j) prev[j] = (f32x4){0.f, 0.f, 0.f, 0.f}; }
        p1_load_norm(src, gsc, sh, cur, F.lane);
        for (int i = 0; i < 16; ++i) {
            if (pos0 + i + 1 < rowlen) p1_load_norm(src + (size_t)(i + 1) * D, gsc, sh, nxt, F.lane);
            else {
#pragma unroll
                for (int j = 0; j < 4; ++j) nxt[j] = (f32x4){0.f, 0.f, 0.f, 0.f}; }
            bf16_t* orow = XM + (orow0 + i) * D + 4 * F.lane;
#pragma unroll
            for (int j = 0; j < 4; ++j) {
                const f32x4 s = prev[j] + nxt[j], xx = 0.5f * s - cur[j];
                st_bf4(orow + 256 * j, cur[j] + xx * m0[j]);
                st_bf4(orow + (size_t)MA * D + 256 * j, cur[j] + xx * m1[j]);
                st_bf4(orow + (size_t)2 * MA * D + 256 * j, cur[j] + xx * m2[j]);
                st_bf4(orow + (size_t)3 * MA * D + 256 * j, cur[j]);
                prev[j] = cur[j]; cur[j] = nxt[j];
            }
        }
    }
}

struct SchedRKV {
    const char* xm; const char* w; const char* wl; int G, c;
    __device__ __forceinline__ bool next(int i, pg8::Unit& u) const {
        int L;
        if (G == 256) { if (i >= (c < 216 ? 8 : 7)) return false; L = c + 256 * i; }
        else { L = i * G + c; if (L >= 2008) return false; }
        if (L < 1536) pg8::swz_tile(L, 128, 12, u.pm, u.pn);
        else if (L < 1600) { const int r = L - 1536; u.pm = 128 + (r >> 3); u.pn = 4 + (r & 7); }
        else { const int q = L - 1600, x = q & 7, off = q >> 3; u.pm = 17 * x + off / 3; u.pn = 12 + off % 3; }
        if (u.pn < 12) { u.a = xm + (size_t)(u.pn >> 2) * MA * D * 2 + (size_t)u.pm * 256 * D * 2; u.b = w + (size_t)u.pn * 256 * D * 2; }
        else { u.a = xm + (size_t)3 * MA * D * 2 + (size_t)u.pm * 256 * D * 2; u.b = wl + (size_t)(u.pn - 12) * 256 * D * 2; }
        u.nt = 16; u.rows = nullptr; return true;
    }
};
struct EpiRKV {
    static constexpr bool PERM = true;
    bf16_t *R, *K, *KC, *V, *LP;
    __device__ __forceinline__ void operator()(const f32x4 (&acc)[2][2][4][2], const pg8::Unit& u, int wr, int wc, int fr, int fq) const {
        const int grp = u.pn >> 2; int prow = u.pm * 256; bf16_t* base;
        if (grp == 0) base = R; else if (grp == 1) { if (u.pm < 128) base = K; else { base = KC; prow -= ML; } } else if (grp == 2) base = V; else base = LP;
        const int ldc = grp == 3 ? 768 : D;
        const int row0 = prow + wr * 64 + fr, col0 = (u.pn & 3) * 256 + wc * 32 + 8 * fq;
#pragma unroll
        for (int ai = 0; ai < 2; ++ai)
#pragma unroll
            for (int m = 0; m < 4; ++m) { bf16_t* rowp = base + (size_t)(row0 + ai * 128 + m * 16) * ldc + col0;
#pragma unroll
                for (int bj = 0; bj < 2; ++bj) { const f32x4 v0 = acc[ai][bj][m][0], v1 = acc[ai][bj][m][1];
                    u32x4 w; w.x = pg8::cvt_pk_bf16(v0[0], v0[1]); w.y = pg8::cvt_pk_bf16(v0[2], v0[3]); w.z = pg8::cvt_pk_bf16(v1[0], v1[1]); w.w = pg8::cvt_pk_bf16(v1[2], v1[3]);
                    *(u32x4*)(rowp + bj * 128) = w; } }
    }
};
__device__ __forceinline__ void p2b_combine(const Frame& F, const Args& A) {
    const bf16_t* LP = (const bf16_t*)(A.ws + WS_LP); bf16_t* LWA = (bf16_t*)(A.ws + WS_LWA); bf16_t* LG = (bf16_t*)(A.ws + WS_LG);
    if (F.lane >= 48) return;
    const int c = 8 * F.lane, kind = F.lane >> 4;
    const float ks = kind == 0 ? -2.f : -1.f, al = kind == 0 ? 2.f : 1.f, be = kind == 0 ? -1.f : 0.f;
    for (int u = F.gw; u < MA / 8; u += F.NGW) {
        const int t0 = u * 8, rowlen = t0 >= ML ? TCX : GRIDW, pos0 = (t0 >= ML ? t0 - ML : t0) % rowlen;
        const bf16_t* p = LP + (size_t)t0 * 768 + c;
        u32x4 a[8], b[10];
#pragma unroll
        for (int i = 0; i < 8; ++i) { a[i] = *(const u32x4*)(p + (size_t)i * 768); b[i + 1] = *(const u32x4*)(p + (size_t)i * 768 + 384); }
        b[0] = (u32x4){0u, 0u, 0u, 0u}; b[9] = b[0];
        if (pos0 > 0) b[0] = *(const u32x4*)(p - 768 + 384);
        if (pos0 + 8 < rowlen) b[9] = *(const u32x4*)(p + (size_t)8 * 768 + 384);
#pragma unroll
        for (int i = 0; i < 8; ++i) {
            const unsigned aw[4] = {a[i].x, a[i].y, a[i].z, a[i].w}, lw[4] = {b[i].x, b[i].y, b[i].z, b[i].w}, rw[4] = {b[i + 2].x, b[i + 2].y, b[i + 2].z, b[i + 2].w};
            unsigned o[4];
#pragma unroll
            for (int q = 0; q < 4; ++q) {
                float v0 = bflo(aw[q]) + (bflo(lw[q]) + bflo(rw[q])), v1 = bfhi(aw[q]) + (bfhi(lw[q]) + bfhi(rw[q]));
                if (kind != 1) { v0 = al * __builtin_amdgcn_rcpf(1.f + __expf(ks * v0)) + be; v1 = al * __builtin_amdgcn_rcpf(1.f + __expf(ks * v1)) + be; }
                o[q] = pk2(v0, v1); }
            const u32x4 ow = (u32x4){o[0], o[1], o[2], o[3]};
            if (kind < 2) *(u32x4*)(LWA + (size_t)(t0 + i) * 256 + c) = ow;
            else if (t0 < ML) { *(u32x4*)(LG + (size_t)(t0 + i) * 256 + (c - 256)) = ow; *(u32x4*)(LG + (size_t)(t0 + i) * 256 + (c - 128)) = (u32x4){0u, 0u, 0u, 0u}; }
        }
    }
}
struct SchedPlain {
    const char* a; const char* b; int nM, nN, lda, ldb, nt, G, c;
    __device__ __forceinline__ bool next(int i, pg8::Unit& u) const {
        const int L = i * G + c; if (L >= nM * nN) return false;
        pg8::swz_tile(L, nM, nN, u.pm, u.pn);
        u.a = a + (size_t)u.pm * 256 * lda * 2; u.b = b + (size_t)u.pn * 256 * ldb * 2; u.nt = nt; u.rows = nullptr; return true;
    }
};
struct EpiBf16 {
    static constexpr bool PERM = true;
    bf16_t* O; int ldc;
    __device__ __forceinline__ void operator()(const f32x4 (&acc)[2][2][4][2], const pg8::Unit& u, int wr, int wc, int fr, int fq) const {
        const int row0 = u.pm * 256 + wr * 64 + fr, col0 = u.pn * 256 + wc * 32 + 8 * fq;
#pragma unroll
        for (int ai = 0; ai < 2; ++ai)
#pragma unroll
            for (int m = 0; m < 4; ++m) { bf16_t* rowp = O + (size_t)(row0 + ai * 128 + m * 16) * ldc + col0;
#pragma unroll
                for (int bj = 0; bj < 2; ++bj) { const f32x4 v0 = acc[ai][bj][m][0], v1 = acc[ai][bj][m][1];
                    u32x4 w; w.x = pg8::cvt_pk_bf16(v0[0], v0[1]); w.y = pg8::cvt_pk_bf16(v0[2], v0[3]); w.z = pg8::cvt_pk_bf16(v1[0], v1[1]); w.w = pg8::cvt_pk_bf16(v1[2], v1[3]);
                    *(u32x4*)(rowp + bj * 128) = w; } }
    }
};
struct EpiRes {
    static constexpr bool PERM = true;
    const float* basef; bf16_t* hb; const float* gate;
    __device__ __forceinline__ void operator()(const f32x4 (&acc)[2][2][4][2], const pg8::Unit& u, int wr, int wc, int fr, int fq) const {
        const int row0 = u.pm * 256 + wr * 64 + fr, col0 = u.pn * 256 + wc * 32 + 8 * fq;
        const float* gp = gate + (size_t)(u.pm >> 4) * 6144 + col0;
        f32x4 gv[2][2];
#pragma unroll
        for (int bj = 0; bj < 2; ++bj)
#pragma unroll
            for (int n = 0; n < 2; ++n) gv[bj][n] = *(const f32x4*)(gp + bj * 128 + n * 4);
#pragma unroll
        for (int ai = 0; ai < 2; ++ai)
#pragma unroll
            for (int m = 0; m < 4; ++m) { const size_t ro = (size_t)(row0 + ai * 128 + m * 16) * D + col0;
#pragma unroll
                for (int bj = 0; bj < 2; ++bj) {
                    f32x4 b0, b1;
                    if (basef) { b0 = *(const f32x4*)(basef + ro + bj * 128); b1 = *(const f32x4*)(basef + ro + bj * 128 + 4); }
                    else { const u32x4 q = *(const u32x4*)(hb + ro + bj * 128); b0 = (f32x4){bflo(q.x), bfhi(q.x), bflo(q.y), bfhi(q.y)}; b1 = (f32x4){bflo(q.z), bfhi(q.z), bflo(q.w), bfhi(q.w)}; }
                    const f32x4 v0 = b0 + gv[bj][0] * acc[ai][bj][m][0], v1 = b1 + gv[bj][1] * acc[ai][bj][m][1];
                    u32x4 w; w.x = pg8::cvt_pk_bf16(v0[0], v0[1]); w.y = pg8::cvt_pk_bf16(v0[2], v0[3]); w.z = pg8::cvt_pk_bf16(v1[0], v1[1]); w.w = pg8::cvt_pk_bf16(v1[2], v1[3]);
                    *(u32x4*)(hb + ro + bj * 128) = w; } }
    }
};
struct SchedMoe {
    const char* a; const char* b; const int* tile; int lda, ldb, nt, G, c; size_t estride;
    __device__ __forceinline__ bool next(int i, pg8::Unit& u) const {
        const int ntl = tile[0]; const int L = i * G + c; if (L >= ntl * 4) return false;
        u.pm = L >> 2; u.pn = L & 3; const int e = tile[16 + u.pm];
        u.a = a + (size_t)u.pm * 256 * lda * 2; u.b = b + (size_t)e * estride + (size_t)u.pn * 256 * ldb * 2; u.nt = nt; u.rows = nullptr; return true;
    }
};
struct SchedMoeG {
    const char* a; const char* b; const int* tile; const int* inv; int ldb, nt, G, c; size_t estride;
    __device__ __forceinline__ bool next(int i, pg8::Unit& u) const {
        const int ntl = tile[0]; const int L = i * G + c; if (L >= ntl * 4) return false;
        const int ng = ntl >> 3;
        if ((L >> 5) < ng) { u.pm = (L >> 5) * 8 + (L & 7); u.pn = (L >> 3) & 3; } else { const int r_ = L - ng * 32; u.pm = ng * 8 + (r_ >> 2); u.pn = r_ & 3; }
        const int e = tile[16 + u.pm];
        u.a = a; u.b = b + (size_t)e * estride + (size_t)u.pn * 256 * ldb * 2; u.nt = nt; u.rows = inv + u.pm * 256; return true;
    }
};
struct EpiGateUp {
    static constexpr bool PERM = true;
    bf16_t* H;
    __device__ __forceinline__ void operator()(const f32x4 (&acc)[2][2][4][2], const pg8::Unit& u, int wr, int wc, int fr, int fq) const {
        const int row0 = u.pm * 256 + wr * 64 + fr, col0 = u.pn * 128 + wc * 32 + 8 * fq;
#pragma unroll
        for (int ai = 0; ai < 2; ++ai)
#pragma unroll
            for (int m = 0; m < 4; ++m) { bf16_t* rowp = H + (size_t)(row0 + ai * 128 + m * 16) * ED + col0;
                f32x4 h0, h1;
#pragma unroll
                for (int q = 0; q < 4; ++q) { const float g0 = acc[ai][0][m][0][q], g1 = acc[ai][0][m][1][q];
                    h0[q] = g0 / (1.f + __expf(-g0)) * acc[ai][1][m][0][q]; h1[q] = g1 / (1.f + __expf(-g1)) * acc[ai][1][m][1][q]; }
                u32x4 w; w.x = pg8::cvt_pk_bf16(h0[0], h0[1]); w.y = pg8::cvt_pk_bf16(h0[2], h0[3]); w.z = pg8::cvt_pk_bf16(h1[0], h1[1]); w.w = pg8::cvt_pk_bf16(h1[2], h1[3]);
                *(u32x4*)rowp = w; }
    }
};
struct EpiGateUpPub {
    static constexpr bool PERM = true;
    unsigned char* H; unsigned* rdy;
    __device__ __forceinline__ void operator()(const f32x4 (&acc)[2][2][4][2], const pg8::Unit& u, int wr, int wc, int fr, int fq) const {
        const int row0 = u.pm * 256 + wr * 64 + fr, col0 = u.pn * 128 + wc * 32 + 8 * fq;
        const __amdgpu_buffer_rsrc_t rsrc = __builtin_amdgcn_make_buffer_rsrc(H, 0, 69632 * ED * 2, 0x00020000);
#pragma unroll
        for (int ai = 0; ai < 2; ++ai)
#pragma unroll
            for (int m = 0; m < 4; ++m) {
                f32x4 h0, h1;
#pragma unroll
                for (int q = 0; q < 4; ++q) { const float g0 = acc[ai][0][m][0][q], g1 = acc[ai][0][m][1][q];
                    h0[q] = g0 / (1.f + __expf(-g0)) * acc[ai][1][m][0][q]; h1[q] = g1 / (1.f + __expf(-g1)) * acc[ai][1][m][1][q]; }
                u32x4 w; w.x = pg8::cvt_pk_bf16(h0[0], h0[1]); w.y = pg8::cvt_pk_bf16(h0[2], h0[3]); w.z = pg8::cvt_pk_bf16(h1[0], h1[1]); w.w = pg8::cvt_pk_bf16(h1[2], h1[3]);
                __builtin_amdgcn_raw_buffer_store_b128(w, rsrc, ((row0 + ai * 128 + m * 16) * ED + col0) * 2, 0, 16);
            }
        asm volatile("s_waitcnt vmcnt(0)" ::: "memory");
        if ((threadIdx.x & 63) == 0) __hip_atomic_fetch_add(rdy + 64 * u.pm, 1u, __ATOMIC_RELAXED, __HIP_MEMORY_SCOPE_AGENT);
    }
};
struct SchedMoeD {
    const char* hh; const char* wdn; const int* tile; unsigned* rdy; unsigned* tmo; int G, c;
    __device__ __forceinline__ bool next(int j, pg8::Unit& u) const {
        const int n1 = tile[0] * 4, q = n1 / G, x = n1 - q * G; int L;
        if (q >= 1 && 3 * x <= G) {
            int nd, base;
            if (c < x) { nd = q - 1; base = c * (q - 1); } else if (c < 3 * x) { nd = q + 1; base = x * (q - 1) + (c - x) * (q + 1); } else { nd = q; base = x * (q - 1) + 2 * x * (q + 1) + (c - 3 * x) * q; }
            if (j >= nd) return false; L = base + j;
        } else { L = j * G + (G - 1 - c); if (L >= n1) return false; }
        u.pm = L >> 2; u.pn = L & 3; u.kind = 1; const int e = tile[16 + u.pm];
        u.a = hh; u.rows = nullptr; u.row0 = u.pm * 256; u.pa = ED * 2; u.pb = ED * 2; u.b = wdn + (size_t)e * (1 * MiB) + (size_t)u.pn * 256 * ED * 2; u.nt = 8;
        return true;
    }
    __device__ __forceinline__ void a_ready(const pg8::Unit& u) const {
        if (threadIdx.x < 64) {
            unsigned* w = rdy + 64 * u.pm; unsigned polls = 0;
            while ((unsigned)__builtin_amdgcn_readfirstlane(__hip_atomic_load(w, __ATOMIC_RELAXED, __HIP_MEMORY_SCOPE_AGENT)) < 32u) {
                if ((++polls & 255u) == 0u) { if (__builtin_amdgcn_readfirstlane(__hip_atomic_load(tmo, __ATOMIC_RELAXED, __HIP_MEMORY_SCOPE_AGENT)) != 0u) break;
                    if (polls > (1u << 22)) { if (threadIdx.x == 0) __hip_atomic_store(tmo, 1u, __ATOMIC_RELAXED, __HIP_MEMORY_SCOPE_AGENT); break; } }
                __builtin_amdgcn_s_sleep(2); }
            __builtin_amdgcn_fence(__ATOMIC_ACQUIRE, "agent");
            asm volatile("s_waitcnt vmcnt(0)" ::: "memory");
        }
        asm volatile("" ::: "memory"); __builtin_amdgcn_s_barrier(); asm volatile("" ::: "memory");
    }
};
struct EpiWin {
    static constexpr bool PERM = true;
    bf16_t *BG, *U;
    __device__ __forceinline__ void operator()(const f32x4 (&acc)[2][2][4][2], const pg8::Unit& u, int wr, int wc, int fr, int fq) const {
        const int row0 = u.pm * 256 + wr * 64 + fr;
        if (u.pn < 4) {
            const int col0 = u.pn * 256 + wc * 32 + 8 * fq;
#pragma unroll
            for (int ai = 0; ai < 2; ++ai)
#pragma unroll
                for (int m = 0; m < 4; ++m) { bf16_t* rowp = BG + (size_t)(row0 + ai * 128 + m * 16) * D + col0;
#pragma unroll
                    for (int bj = 0; bj < 2; ++bj) { const f32x4 v0 = acc[ai][bj][m][0], v1 = acc[ai][bj][m][1];
                        u32x4 w; w.x = pg8::cvt_pk_bf16(v0[0], v0[1]); w.y = pg8::cvt_pk_bf16(v0[2], v0[3]); w.z = pg8::cvt_pk_bf16(v1[0], v1[1]); w.w = pg8::cvt_pk_bf16(v1[2], v1[3]);
                        *(u32x4*)(rowp + bj * 128) = w; } }
        } else {
            const int col0 = (u.pn - 4) * 128 + wc * 32 + 8 * fq;
#pragma unroll
            for (int ai = 0; ai < 2; ++ai)
#pragma unroll
                for (int m = 0; m < 4; ++m) { bf16_t* rowp = U + (size_t)(row0 + ai * 128 + m * 16) * D + col0;
                    const f32x4 v0 = acc[ai][0][m][0] * acc[ai][1][m][0], v1 = acc[ai][0][m][1] * acc[ai][1][m][1];
                    u32x4 w; w.x = pg8::cvt_pk_bf16(v0[0], v0[1]); w.y = pg8::cvt_pk_bf16(v0[2], v0[3]); w.z = pg8::cvt_pk_bf16(v1[0], v1[1]); w.w = pg8::cvt_pk_bf16(v1[2], v1[3]);
                    *(u32x4*)rowp = w; }
        }
    }
};

namespace sc {
constexpr int MPB = 144;
constexpr int MB = 64 * MPB;
constexpr int B_RAWK = 0, B_NAB = 0, B_RAWR = 1, B_NAK = 1, B_LW = 2, B_MRB = 2, B_LA = 3, B_MRK = 3, B_AT = 4, B_BT = 5, B_KT = 6,
              B_RT = 7, B_EL = 8, B_BTT = 9, B_KTT = 10, B_VTT = 11, B_T = 12, B_EH = 12, B_W2T = 13, B_A2T = 14, B_RK = 15;
constexpr int O_INVN = 16 * MB, O_BON = O_INVN + 256, O_PV = O_BON + 1024, O_KKS = O_PV + 256, O_NF = O_KKS + 256;
static_assert(O_NF + 4096 <= LDSCTL_OFF, "scan LDS");
__device__ __forceinline__ bf16x8 ldf(const LAS unsigned char* p) { return *(const LAS bf16x8*)p; }
__device__ __forceinline__ bf16x8 ldfp(const LAS unsigned char* p) {
    const u32x2 lo = *(const LAS u32x2*)p, hi = *(const LAS u32x2*)(p + 32);
    return __builtin_bit_cast(bf16x8, (u32x4){lo.x, lo.y, hi.x, hi.y});
}
__device__ __forceinline__ bf16x8 packfrag(const f32x4 x0, const f32x4 x1) {
    return __builtin_bit_cast(bf16x8, (u32x4){pg8::cvt_pk_bf16(x0[0], x0[1]), pg8::cvt_pk_bf16(x0[2], x0[3]), pg8::cvt_pk_bf16(x1[0], x1[1]), pg8::cvt_pk_bf16(x1[2], x1[3])});
}
__device__ __forceinline__ void st4(LAS unsigned char* p, const f32x4 d) { *(LAS u32x2*)p = (u32x2){pg8::cvt_pk_bf16(d[0], d[1]), pg8::cvt_pk_bf16(d[2], d[3])}; }
__device__ __forceinline__ f32x4 mma(const bf16x8 a, const bf16x8 b, const f32x4 c) { return __builtin_amdgcn_mfma_f32_16x16x32_bf16(a, b, c, 0, 0, 0); }
__device__ __forceinline__ float ld1(const LAS unsigned char* p) { return __builtin_bit_cast(float, (unsigned)(*(const LAS unsigned short*)p) << 16); }
__device__ __forceinline__ void st1(LAS unsigned char* p, float v) { *(LAS unsigned short*)p = (unsigned short)f2bf(v); }
__device__ __forceinline__ float fsig(float x) { return __builtin_amdgcn_rcpf(1.f + __expf(-x)); }
template <int CTRL> __device__ __forceinline__ float dppf(float v) { return __builtin_bit_cast(float, __builtin_amdgcn_update_dpp(0, __builtin_bit_cast(int, v), CTRL, 0xF, 0xF, true)); }
__device__ __forceinline__ float sum8(float v) { v += dppf<0xB1>(v); v += dppf<0x4E>(v); v += dppf<0x141>(v); return v; }
__device__ __forceinline__ float sum16(float v) { v = sum8(v); v += dppf<0x140>(v); return v; }
}

#ifndef SCAN_REP_E1
#define SCAN_REP_E1 1
#endif
#ifndef SCAN_REP_G
#define SCAN_REP_G 1
#endif
#ifndef SCAN_REP_V
#define SCAN_REP_V 1
#endif
#ifndef SCAN_REP_E0
#define SCAN_REP_E0 1
#endif
__device__ __forceinline__ void p3_scan(const Frame& F, const Args& A) {
    using namespace sc;
#define WGBAR() do { asm volatile("s_waitcnt lgkmcnt(0)" ::: "memory"); __builtin_amdgcn_s_barrier(); asm volatile("" ::: "memory"); } while (0)
    unsigned char* ws = A.ws;
    LAS unsigned char* L = F.lds;
    const bf16_t* Rg = (const bf16_t*)A.out; const bf16_t* Kg = Rg + (size_t)ML * D;
    const bf16_t* KCg = (const bf16_t*)(ws + WS_KC); const bf16_t* Vg = (const bf16_t*)(ws + WS_V); const bf16_t* LWAg = (const bf16_t*)(ws + WS_LWA);
    const int wv = F.wave;
    const f32x4 z4 = (f32x4){0.f, 0.f, 0.f, 0.f};
    for (int s = blockIdx.x; s < 256; s += F.G) {
        const int dir = s & 1, h = (s >> 1) & 15, b = s >> 5, c0 = h * HD;
        bf16_t* Yg = (bf16_t*)(ws + (dir ? WS_Y1 : WS_Y0));
        __syncthreads();
        for (int q = F.tid; q < 4096; q += NTHREADS) { const int j = q >> 6, c = q & 63;
            sc::st1(L + B_W2T * MB + c * MPB + j * 2, A.in[I_W2][((size_t)dir * 64 + j) * D + c0 + c]); sc::st1(L + B_A2T * MB + c * MPB + j * 2, A.in[I_A2][((size_t)dir * 64 + j) * D + c0 + c]); }
        if (F.tid < 64) *(LAS float*)(L + O_KKS + F.tid * 4) = A.in[I_KK][c0 + F.tid];
        const int ce = c0 + 16 * (wv & 3) + (F.lane & 15);
        const float w0c = A.in[I_W0][dir * D + ce], a0c = A.in[I_A0][dir * D + ce], kkc = A.in[I_KK][ce], kac = A.in[I_KA][ce], rkc = A.in[I_RK][ce];
        f32x4 S[4];
#pragma unroll
        for (int q = 0; q < 4; ++q) S[q] = z4;
        u32x4 pk_, pr_, pv_, plw_, pla_;
#define SCAN_PREFETCH(gc_, ti_, cg_) do { const int seg_ = (gc_) >= 4, ci_ = seg_ ? (gc_) - 4 : (gc_), Ts_ = seg_ ? TL : TCX; \
            const int t0_ = dir ? (Ts_ - 1 - ci_ * 64) : ci_ * 64;                                     \
            const size_t rl_ = (size_t)b * TL + t0_, ra_ = seg_ ? rl_ : ((size_t)ML + (size_t)b * TCX + t0_);    \
            const int lt_ = dir ? -(ti_) : (ti_);                                                          \
            const int lo_ = lt_ * D + c0 + 8 * (cg_), ll_ = lt_ * 256 + dir * 64 + 8 * (cg_); \
            const bf16_t* kb_ = seg_ ? (Kg + rl_ * D) : (KCg + ((size_t)b * TCX + t0_) * D); \
            pk_ = *(const u32x4*)(kb_ + lo_); pv_ = *(const u32x4*)(Vg + ra_ * D + lo_); \
            pr_ = (u32x4){0u, 0u, 0u, 0u}; if (seg_) pr_ = *(const u32x4*)(Rg + rl_ * D + lo_); \
            plw_ = *(const u32x4*)(LWAg + ra_ * 256 + ll_); pla_ = *(const u32x4*)(LWAg + ra_ * 256 + 128 + ll_); } while (0)
        SCAN_PREFETCH(0, (F.tid >> 3), (F.tid & 7));
        __syncthreads();
#pragma unroll 1
        for (int gc = 0; gc < 68; ++gc) {
            const int seg = gc >= 4, ci = seg ? gc - 4 : gc, Tseg = seg ? TL : TCX;
            int tz = F.tid; asm volatile("" : "+v"(tz));
            const int lane = tz & 63, r = lane & 15, g = lane >> 4, ti_ = tz >> 3, cg = tz & 7;
            const int o16 = r * MPB + g * 16;
            const int o8 = r * MPB + g * 8;
            const int oE = g * (4 * MPB) + r * 2;
#pragma unroll 1
            for (int rep_ = 0; rep_ < SCAN_REP_E0; ++rep_)
            {
                LAS unsigned char* st = L + ti_ * MPB + cg * 16;
                *(LAS u32x4*)(st + B_RAWK * MB) = pk_; *(LAS u32x4*)(st + B_RAWR * MB) = pr_; *(LAS u32x4*)(st + B_LW * MB) = plw_; *(LAS u32x4*)(st + B_LA * MB) = pla_;
                const unsigned vw[4] = {pv_.x, pv_.y, pv_.z, pv_.w}, kw[4] = {pk_.x, pk_.y, pk_.z, pk_.w};
                LAS unsigned char* vt = L + B_VTT * MB + cg * (8 * MPB) + ti_ * 2;
                const f32x4 kk0 = *(const LAS f32x4*)(L + O_KKS + cg * 32), kk1 = *(const LAS f32x4*)(L + O_KKS + cg * 32 + 16);
                const float kks[8] = {kk0[0], kk0[1], kk0[2], kk0[3], kk1[0], kk1[1], kk1[2], kk1[3]};
                float ss = 0.f;
#pragma unroll
                for (int q = 0; q < 4; ++q) {
                    *(LAS unsigned short*)(vt + (2 * q) * MPB) = (unsigned short)(vw[q] & 0xffffu);
                    *(LAS unsigned short*)(vt + (2 * q + 1) * MPB) = (unsigned short)(vw[q] >> 16);
                    const float k0 = bflo(kw[q]) * kks[2 * q], k1 = bfhi(kw[q]) * kks[2 * q + 1]; ss += k0 * k0 + k1 * k1; }
                ss = sum8(ss);
                if (cg == 0) *(LAS float*)(L + O_INVN + ti_ * 4) = rsqrtf(fmaxf(ss, 1e-24f));
            }
            WGBAR();
            if (gc + 1 < 68) SCAN_PREFETCH(gc + 1, ti_, cg);
            const int ct = wv & 3, th = wv >> 2;
#pragma unroll 1
            for (int rep_ = 0; rep_ < SCAN_REP_E1; ++rep_) {
            f32x4 aacc[2]; float ev[8];
            {
                f32x4 wacc[2];
                bf16x8 w2f[2], a2f[2];
#pragma unroll
                for (int ks = 0; ks < 2; ++ks) { w2f[ks] = ldf(L + B_W2T * MB + 16 * ct * MPB + 64 * ks + o16); a2f[ks] = ldf(L + B_A2T * MB + 16 * ct * MPB + 64 * ks + o16); }
                const LAS unsigned char* lwb = L + 32 * th * MPB + o16;
#pragma unroll
                for (int tt = 0; tt < 2; ++tt) { wacc[tt] = z4; aacc[tt] = z4;
#pragma unroll
                    for (int ks = 0; ks < 2; ++ks) { wacc[tt] = mma(ldf(lwb + B_LW * MB + 16 * tt * MPB + 64 * ks), w2f[ks], wacc[tt]); aacc[tt] = mma(ldf(lwb + B_LA * MB + 16 * tt * MPB + 64 * ks), a2f[ks], aacc[tt]); } }
                LAS unsigned char* eb2 = L + 16 * ct * MPB + 64 * th + o8;
#pragma unroll
                for (int tt = 0; tt < 2; ++tt) { f32x4 lo;
#pragma unroll
                    for (int q = 0; q < 4; ++q) { const float e = 0.60653066f * fsig(wacc[tt][q] + w0c); ev[4 * tt + q] = e; lo[q] = e - __builtin_bit_cast(float, f2bf(e) << 16); wacc[tt][q] = e; }
                    st4(eb2 + B_EH * MB + 32 * tt, wacc[tt]); st4(eb2 + B_EL * MB + 32 * tt, lo); }
            }
            WGBAR();
            {
                f32x4 Li4[2]; f32x4 tot4 = z4;
                const LAS unsigned char* ehb = L + B_EH * MB + 16 * ct * MPB + o16; const LAS unsigned char* elb = L + B_EL * MB + 16 * ct * MPB + o16;
                const bf16x8 eh0 = ldf(ehb), eh1 = ldf(ehb + 64), el0 = ldf(elb), el1 = ldf(elb + 64);
                const bf16x8 ones = __builtin_bit_cast(bf16x8, (u32x4){0x3F803F80u, 0x3F803F80u, 0x3F803F80u, 0x3F803F80u});
                tot4 = mma(ones, eh0, tot4); tot4 = mma(ones, el0, tot4); tot4 = mma(ones, eh1, tot4); tot4 = mma(ones, el1, tot4);
#pragma unroll
                for (int tt = 0; tt < 2; ++tt) {
                    const int irow = 16 * (2 * th + tt) + r;
                    unsigned tw[2][4];
#pragma unroll
                    for (int ks = 0; ks < 2; ++ks)
#pragma unroll
                        for (int p = 0; p < 4; ++p) { const int j0 = 32 * ks + 8 * g + 2 * p; tw[ks][p] = (j0 <= irow ? 0x3F80u : 0u) | (j0 + 1 <= irow ? 0x3F800000u : 0u); }
                    const bf16x8 t0 = __builtin_bit_cast(bf16x8, (u32x4){tw[0][0], tw[0][1], tw[0][2], tw[0][3]}), t1 = __builtin_bit_cast(bf16x8, (u32x4){tw[1][0], tw[1][1], tw[1][2], tw[1][3]});
                    f32x4 d = z4; d = mma(t0, eh0, d); d = mma(t0, el0, d);
                    if (th) { d = mma(t1, eh1, d); d = mma(t1, el1, d); }
                    Li4[tt] = d;
                }
                const float Pc = __expf(-tot4[0]);
                if (g == 0 && th == 0) *(LAS float*)(L + O_PV + (16 * ct + r) * 4) = Pc;
                LAS unsigned char* eb = L + oE + 32 * ct + 32 * th * MPB;
                LAS unsigned char* cb = L + o8 + 16 * ct * MPB + 64 * th;
#pragma unroll
                for (int tt = 0; tt < 2; ++tt) {
                    const f32x4 inv4 = *(const LAS f32x4*)(L + O_INVN + 128 * th + 64 * tt + g * 16);
                    f32x4 btv, ktv;
                    const float em0 = __expf(-Li4[tt][0]), em1 = __expf(-Li4[tt][1]), em2 = __expf(-Li4[tt][2]), em3 = __expf(-Li4[tt][3]);
                    const float emv[4] = {em0, em1, em2, em3}, exv[4] = {__expf(ev[4 * tt] - Li4[tt][0]), em0, em1, em2};
#pragma unroll
                    for (int q = 0; q < 4; ++q) {
                        const int ro = (16 * tt + q) * MPB;
                        const float kv = ld1(eb + B_RAWK * MB + ro), rv = ld1(eb + B_RAWR * MB + ro);
                        const float a = fsig(aacc[tt][q] + a0c);
                        const float kkn = kv * kkc * inv4[q];
                        const float beta = kkn * a, kd = kv * (1.f + (a - 1.f) * kac);
                        const float em = emv[q], ep = __builtin_amdgcn_rcpf(em);
                        const float at = -kkn * exv[q], bt = beta * ep, kt = kd * ep, rt = rv * em;
                        btv[q] = bt; ktv[q] = kt;
                        st1(eb + B_AT * MB + ro, at); st1(eb + B_BT * MB + ro, bt); st1(eb + B_KT * MB + ro, kt); st1(eb + B_RT * MB + ro, rt); st1(eb + B_RK * MB + ro, rt * rkc);
                    }
                    st4(cb + B_BTT * MB + 32 * tt, btv); st4(cb + B_KTT * MB + 32 * tt, ktv);
                    asm volatile("" ::: "memory");
                }
            }
            WGBAR();
            }
#pragma unroll 1
            for (int rep_ = 0; rep_ < SCAN_REP_G; ++rep_) {
#define GRAM_ROW(m_, ti_) do { const int mm_ = (m_); \
                const LAS unsigned char* Xb_ = L + ((mm_ & 1) ? B_KT : B_BT) * MB + o16; const LAS unsigned char* Zb_ = L + (mm_ < 2 ? B_AT : B_RT) * MB + 16 * (ti_) * MPB + o16; \
                const bf16x8 zf0_ = ldf(Zb_), zf1_ = ldf(Zb_ + 64); const int i_ = 16 * (ti_) + r, st_ = (mm_ < 2) ? 1 : 0; \
                _Pragma("unroll") for (int ts_ = 0; ts_ < 4; ++ts_) { f32x4 d_ = z4; \
                    if (ts_ <= (ti_)) { d_ = mma(ldf(Xb_ + 16 * ts_ * MPB), zf0_, d_); d_ = mma(ldf(Xb_ + 16 * ts_ * MPB + 64), zf1_, d_); \
                        _Pragma("unroll") for (int q_ = 0; q_ < 4; ++q_) d_[q_] = (16 * ts_ + 4 * g + st_ + q_ <= i_) ? d_[q_] : 0.f; } \
                    st4(L + mm_ * MB + 16 * (ti_) * MPB + 32 * ts_ + o8, d_); } } while (0)
            if (wv < 6) {
                const int m = wv >> 1;
                if (wv & 1) { GRAM_ROW(m, 1); GRAM_ROW(m, 2); } else { GRAM_ROW(m, 0); GRAM_ROW(m, 3); }
                if (wv == 0) GRAM_ROW(3, 0);
                if (wv == 1) GRAM_ROW(3, 1);
            } else if (wv == 6) {
                GRAM_ROW(3, 2); GRAM_ROW(3, 3);
            } else {
#pragma unroll
                for (int q2 = 0; q2 < 4; ++q2) {
                    f32x4 d = z4;
                    d = mma(ldf(L + B_BT * MB + 16 * q2 * MPB + o16), ldf(L + B_AT * MB + 16 * q2 * MPB + o16), d); d = mma(ldf(L + B_BT * MB + 16 * q2 * MPB + 64 + o16), ldf(L + B_AT * MB + 16 * q2 * MPB + 64 + o16), d);
#pragma unroll
                    for (int q = 0; q < 4; ++q) d[q] = (4 * g + q < r) ? d[q] : 0.f;
                    st4(L + B_NAB * MB + 16 * q2 * MPB + 32 * q2 + o8, d);
                    *(LAS f32x4*)(L + O_NF + q2 * 1024 + r * 64 + g * 16) = d;
                    f32x4 bd = z4;
                    bd = mma(ldf(L + B_KT * MB + 16 * q2 * MPB + o16), ldf(L + B_RK * MB + 16 * q2 * MPB + o16), bd); bd = mma(ldf(L + B_KT * MB + 16 * q2 * MPB + 64 + o16), ldf(L + B_RK * MB + 16 * q2 * MPB + 64 + o16), bd);
                    const int rq = r & 3; const float bv = rq == 0 ? bd[0] : (rq == 1 ? bd[1] : (rq == 2 ? bd[2] : bd[3]));
                    if (g == (r >> 2)) *(LAS float*)(L + O_BON + (16 * q2 + r) * 4) = bv;
                }
            }
            LDS_WAIT(); asm volatile("" ::: "memory");
            }
            WGBAR();
            f32x4 W2[4], Y[4], U[4]; bf16x8 Sb0, Sb1, vb0, vb1, u0, u1;
            const int vs = wv & 3;
            if (wv == 7) {
                const int oD = g * (16 * MPB + 32);
                const LAS unsigned char* nf = L + O_NF + g * 1024;
                float tc[16];
                tc[0] = (r == 0) ? 1.f : 0.f;
#pragma unroll
                for (int half = 0; half < 2; ++half) {
                    f32x4 rw[8][4];
#pragma unroll
                    for (int ii = 0; ii < 8; ++ii) { const int i = 8 * half + ii;
#pragma unroll
                        for (int c4 = 0; c4 < 4; ++c4) if (i > 0 && 4 * c4 < i) rw[ii][c4] = *(const LAS f32x4*)(nf + i * 64 + c4 * 16); }
#pragma unroll
                    for (int ii = 0; ii < 8; ++ii) { const int i = 8 * half + ii;
                        if (i > 0) {
                            float a0 = (i == r) ? 1.f : 0.f, a1 = 0.f, a2 = 0.f, a3 = 0.f;
#pragma unroll
                            for (int s2 = 0; s2 < i; ++s2) { const float nvv = rw[ii][s2 >> 2][s2 & 3];
                                if ((s2 & 3) == 0) a0 += nvv * tc[s2]; else if ((s2 & 3) == 1) a1 += nvv * tc[s2]; else if ((s2 & 3) == 2) a2 += nvv * tc[s2]; else a3 += nvv * tc[s2]; }
                            tc[i] = (a0 + a1) + (a2 + a3);
                        }
                    }
                }
#pragma unroll
                for (int i = 0; i < 16; ++i) st1(L + B_T * MB + oD + i * MPB + r * 2, tc[i]);
            }
            vb0 = ldf(L + B_VTT * MB + 16 * vs * MPB + o16); vb1 = ldf(L + B_VTT * MB + 16 * vs * MPB + 64 + o16);
            if (wv < 4) {
                Sb0 = packfrag(S[0], S[1]); Sb1 = packfrag(S[2], S[3]);
                *(LAS bf16x8*)(L + B_BT * MB + vs * 2048 + lane * 16) = Sb0; *(LAS bf16x8*)(L + B_BT * MB + vs * 2048 + 1024 + lane * 16) = Sb1;
#pragma unroll
                for (int t = 0; t < 4; ++t) {
                    f32x4 d = z4;
                    d = mma(ldf(L + B_NAK * MB + 16 * t * MPB + o16), vb0, d); d = mma(ldf(L + B_NAK * MB + 16 * t * MPB + 64 + o16), vb1, d);
                    d = mma(ldfp(L + B_AT * MB + 16 * t * MPB + o8), Sb0, d); d = mma(ldfp(L + B_AT * MB + 16 * t * MPB + 64 + o8), Sb1, d); W2[t] = d;
                    f32x4 e2 = S[t];
                    e2 = mma(ldf(L + B_KTT * MB + 16 * t * MPB + o16), vb0, e2); e2 = mma(ldf(L + B_KTT * MB + 16 * t * MPB + 64 + o16), vb1, e2); S[t] = e2;
                    asm volatile("" : "+v"(W2[t]), "+v"(S[t]) :: "memory");
                }
            } else if (seg) {
#pragma unroll
                for (int t = 0; t < 4; ++t) { f32x4 y = z4;
                    y = mma(ldf(L + B_MRK * MB + 16 * t * MPB + o16), vb0, y); y = mma(ldf(L + B_MRK * MB + 16 * t * MPB + 64 + o16), vb1, y); Y[t] = y; }
            }
            WGBAR();
            if (wv < 4) {
#define DMUL(q_, x_) mma(__builtin_bit_cast(bf16x8, (u32x4){dq_[q_].x, dq_[q_].y, 0u, 0u}), packfrag((x_), z4), z4)
                u32x2 dq_[4];
#pragma unroll
                for (int q = 0; q < 4; ++q) dq_[q] = *(const LAS u32x2*)(L + B_T * MB + 16 * q * MPB + 32 * q + o8);
                U[0] = DMUL(0, W2[0]);
                { f32x4 x = mma(ldfp(L + B_NAB * MB + 16 * MPB + o8), packfrag(U[0], z4), W2[1]); U[1] = DMUL(1, x); }
                u0 = packfrag(U[0], U[1]);
                { f32x4 x = mma(ldfp(L + B_NAB * MB + 32 * MPB + o8), u0, W2[2]); U[2] = DMUL(2, x); }
                { f32x4 x = mma(ldfp(L + B_NAB * MB + 48 * MPB + o8), u0, W2[3]); x = mma(ldfp(L + B_NAB * MB + 48 * MPB + 64 + o8), packfrag(U[2], z4), x); U[3] = DMUL(3, x); }
#undef DMUL
                u1 = packfrag(U[2], U[3]);
                *(LAS bf16x8*)(L + B_KT * MB + vs * 2048 + lane * 16) = u0; *(LAS bf16x8*)(L + B_KT * MB + vs * 2048 + 1024 + lane * 16) = u1;
            } else if (seg) {
                Sb0 = *(const LAS bf16x8*)(L + B_BT * MB + vs * 2048 + lane * 16); Sb1 = *(const LAS bf16x8*)(L + B_BT * MB + vs * 2048 + 1024 + lane * 16);
#pragma unroll
                for (int t = 0; t < 4; ++t) { Y[t] = mma(ldfp(L + B_RT * MB + 16 * t * MPB + o8), Sb0, Y[t]); Y[t] = mma(ldfp(L + B_RT * MB + 16 * t * MPB + 64 + o8), Sb1, Y[t]); }
            }
            WGBAR();
            if (wv < 4) {
#pragma unroll
                for (int t = 0; t < 4; ++t) {
                    f32x4 e2 = mma(ldfp(L + B_BTT * MB + 16 * t * MPB + o8), u0, S[t]); e2 = mma(ldfp(L + B_BTT * MB + 16 * t * MPB + 64 + o8), u1, e2);
                    S[t] = e2 * *(const LAS f32x4*)(L + O_PV + 64 * t + g * 16);
                }
            } else if (seg) {
                u0 = *(const LAS bf16x8*)(L + B_KT * MB + vs * 2048 + lane * 16); u1 = *(const LAS bf16x8*)(L + B_KT * MB + vs * 2048 + 1024 + lane * 16);
                const int vcol = c0 + 16 * vs + r;
#pragma unroll
                for (int t = 0; t < 4; ++t) {
                    f32x4 y = Y[t];
                    y = mma(ldfp(L + B_MRB * MB + 16 * t * MPB + o8), u0, y); y = mma(ldfp(L + B_MRB * MB + 16 * t * MPB + 64 + o8), u1, y);
                    const f32x4 bon = *(const LAS f32x4*)(L + O_BON + 64 * t + g * 16);
                    const u32x2 vv = *(const LAS u32x2*)(L + B_VTT * MB + 16 * vs * MPB + 32 * t + o8);
                    y[0] += bon[0] * bflo(vv.x); y[1] += bon[1] * bfhi(vv.x); y[2] += bon[2] * bflo(vv.y); y[3] += bon[3] * bfhi(vv.y);
#pragma unroll
                    for (int q = 0; q < 4; ++q) { const int tl = ci * 64 + 16 * t + 4 * g + q, tt = dir ? (Tseg - 1 - tl) : tl;
                        Yg[((size_t)b * TL + tt) * D + vcol] = (bf16_t)f2bf(y[q]); }
                    asm volatile("" ::: "memory");
                }
            }
            WGBAR();
        }
#undef SCAN_PREFETCH
#undef GRAM_ROW
    }
#undef WGBAR
    __syncthreads();
}

__device__ __forceinline__ void p4_readout(const Frame& F, const Args& A) {
    unsigned char* ws = A.ws;
    {
        LAS float* scr = (LAS float*)(F.lds + F.wave * 16384);
        constexpr int NIT = 2 * 16 * 3 * 256;
        for (int it = F.gw; it < NIT; it += F.NGW) {
            const int mat = it >> 8, item = it & 255;
            const int kind = mat % 3, le = mat / 3, l = le >> 4, e = le & 15;
            unsigned char* mw = ws + (l ? WS_MOEW1 : WS_MOEW0);
            if (kind == 0) tr_job_item(A.in[I_MGATE] + (size_t)le * D * ED, ED, ED, (bf16_t*)mw, D, e * 1024, true, nullptr, item, scr, F.lane);
            else if (kind == 1) tr_job_item(A.in[I_MUP] + (size_t)le * D * ED, ED, ED, (bf16_t*)mw, D, e * 1024 + 128, true, nullptr, item, scr, F.lane);
            else tr_job_item(A.in[I_MDOWN] + (size_t)le * ED * D, D, D, (bf16_t*)(mw + 32 * MiB), ED, e * 1024, false, nullptr, item, scr, F.lane);
        }
    }
    const bf16_t* Y0 = (const bf16_t*)(ws + WS_Y0); const bf16_t* Y1 = (const bf16_t*)(ws + WS_Y1); const bf16_t* Gt = (const bf16_t*)(ws + WS_G);
    bf16_t* ZO = (bf16_t*)(ws + WS_ZO);
    float gw_[16], gb_[16];
#pragma unroll
    for (int j = 0; j < 2; ++j)
#pragma unroll
        for (int q = 0; q < 8; ++q) { const int c = 8 * F.lane + 512 * j + q; gw_[j * 8 + q] = A.in[I_GNW][c]; gb_[j * 8 + q] = A.in[I_GNB][c]; }
    for (int t = F.gw; t < ML; t += F.NGW) {
#pragma unroll
        for (int j = 0; j < 2; ++j) {
            const size_t off = (size_t)t * D + 8 * F.lane + 512 * j;
            const u32x4 a = *(const u32x4*)(Y0 + off), b = *(const u32x4*)(Y1 + off), g = *(const u32x4*)(Gt + off);
            float y[8] = {bflo(a.x) + bflo(b.x), bfhi(a.x) + bfhi(b.x), bflo(a.y) + bflo(b.y), bfhi(a.y) + bfhi(b.y), bflo(a.z) + bflo(b.z), bfhi(a.z) + bfhi(b.z), bflo(a.w) + bflo(b.w), bfhi(a.w) + bfhi(b.w)};
            float gg[8] = {bflo(g.x), bfhi(g.x), bflo(g.y), bfhi(g.y), bflo(g.z), bfhi(g.z), bflo(g.w), bfhi(g.w)};
            float s = 0.f;
#pragma unroll
            for (int q = 0; q < 8; ++q) s += y[q];
            s += __shfl_xor(s, 1); s += __shfl_xor(s, 2); s += __shfl_xor(s, 4);
            const float mean = s * (1.f / 64.f); float s2 = 0.f;
#pragma unroll
            for (int q = 0; q < 8; ++q) { y[q] -= mean; s2 += y[q] * y[q]; }
            s2 += __shfl_xor(s2, 1); s2 += __shfl_xor(s2, 2); s2 += __shfl_xor(s2, 4);
            const float rstd = rsqrtf(s2 * (1.f / 64.f) + GN_EPS);
            float z[8];
#pragma unroll
            for (int q = 0; q < 8; ++q) z[q] = (y[q] * rstd * gw_[j * 8 + q] + gb_[j * 8 + q]) * gg[q];
            u32x4 w; w.x = pk2(z[0], z[1]); w.y = pk2(z[2], z[3]); w.z = pk2(z[4], z[5]); w.w = pk2(z[6], z[7]);
            *(u32x4*)(ZO + off) = w;
        }
    }
}

__device__ __forceinline__ void p6_route(const Frame& F, const Args& A, const int layer) {
    unsigned char* ws = A.ws;
    LAS unsigned char* L = F.lds;
    constexpr int WPB = 2064;
    constexpr int O_WH = 0, O_WL = 16 * WPB, O_GS = 2 * 16 * WPB, O_SH = O_GS + 4096, O_LG = O_SH + 4096, O_CN = O_LG + 8 * 1024;
    __syncthreads();
    for (int i = F.tid; i < D * NE; i += NTHREADS) { const int d = i >> 4, e = i & 15; const float w = A.in[I_ROUTW][i]; const unsigned hi = f2bf(w);
        *(LAS unsigned short*)(L + O_WH + e * WPB + d * 2) = (unsigned short)hi; *(LAS unsigned short*)(L + O_WL + e * WPB + d * 2) = (unsigned short)f2bf(w - __builtin_bit_cast(float, hi << 16)); }
    const float* MOD = (const float*)(ws + WS_MOD) + (size_t)layer * 9 * 6144;
    const float* ng = A.in[I_NORMG] + (size_t)(layer * 2 + 1) * D;
    const bf16_t* h = (const bf16_t*)(ws + WS_HB);
    bf16_t* XN = (bf16_t*)(ws + WS_XN);
    unsigned* EIDX = (unsigned*)(ws + WS_EIDX); float* GATE = (float*)(ws + WS_GATE); int* CC = (int*)(ws + WS_CC);
    const int r = F.lane & 15, g = F.lane >> 4;
    const f32x4 z4 = (f32x4){0.f, 0.f, 0.f, 0.f};
    int bcur = -1;
    for (int ch0 = F.vcu * NWAVES; ch0 < 2048; ch0 += F.NGW) {
        const int ch = ch0 + F.wave, t0 = ch * 16, b = ch0 / 256;
        if (b != bcur) {
            __syncthreads();
            const float* mrow = MOD + (size_t)b * 6144;
            for (int c = F.tid; c < D; c += NTHREADS) { *(LAS float*)(L + O_GS + c * 4) = ng[c] * (1.f + mrow[4096 + c]); *(LAS float*)(L + O_SH + c * 4) = mrow[3072 + c]; }
            bcur = b;
            __syncthreads();
        }
        const bf16_t* hrow = h + (size_t)(t0 + r) * D + 8 * g;
        float ss = 0.f;
#pragma unroll 8
        for (int ks = 0; ks < 32; ++ks) { const u32x4 q = *(const u32x4*)(hrow + 32 * ks);
            const float v0 = bflo(q.x), v1 = bfhi(q.x), v2 = bflo(q.y), v3 = bfhi(q.y), v4 = bflo(q.z), v5 = bfhi(q.z), v6 = bflo(q.w), v7 = bfhi(q.w);
            ss += (v0 * v0 + v1 * v1) + (v2 * v2 + v3 * v3) + (v4 * v4 + v5 * v5) + (v6 * v6 + v7 * v7); }
        ss += __shfl_xor(ss, 16); ss += __shfl_xor(ss, 32);
        const float rstd = rsqrtf(ss * (1.f / D) + RMS_EPS);
        f32x4 acc0 = z4, acc1 = z4, acc2 = z4;
        bf16_t* orow = XN + (size_t)(t0 + r) * D + 8 * g;
#pragma unroll 4
        for (int ks = 0; ks < 32; ++ks) {
            const u32x4 q = *(const u32x4*)(hrow + 32 * ks);
            const f32x4 g0 = *(const LAS f32x4*)(L + O_GS + (32 * ks + 8 * g) * 4), g1 = *(const LAS f32x4*)(L + O_GS + (32 * ks + 8 * g) * 4 + 16);
            const f32x4 s0 = *(const LAS f32x4*)(L + O_SH + (32 * ks + 8 * g) * 4), s1 = *(const LAS f32x4*)(L + O_SH + (32 * ks + 8 * g) * 4 + 16);
            const f32x4 x0 = (f32x4){bflo(q.x), bfhi(q.x), bflo(q.y), bfhi(q.y)} * rstd * g0 + s0, x1 = (f32x4){bflo(q.z), bfhi(q.z), bflo(q.w), bfhi(q.w)} * rstd * g1 + s1;
            const u32x4 hi = (u32x4){pk2(x0[0], x0[1]), pk2(x0[2], x0[3]), pk2(x1[0], x1[1]), pk2(x1[2], x1[3])};
            *(u32x4*)(orow + 32 * ks) = hi;
            const f32x4 l0 = x0 - (f32x4){bflo(hi.x), bfhi(hi.x), bflo(hi.y), bfhi(hi.y)}, l1 = x1 - (f32x4){bflo(hi.z), bfhi(hi.z), bflo(hi.w), bfhi(hi.w)};
            const u32x4 lo = (u32x4){pk2(l0[0], l0[1]), pk2(l0[2], l0[3]), pk2(l1[0], l1[1]), pk2(l1[2], l1[3])};
            const bf16x8 wh = *(const LAS bf16x8*)(L + O_WH + r * WPB + (32 * ks + 8 * g) * 2), wl = *(const LAS bf16x8*)(L + O_WL + r * WPB + (32 * ks + 8 * g) * 2);
            acc0 = __builtin_amdgcn_mfma_f32_16x16x32_bf16(__builtin_bit_cast(bf16x8, hi), wh, acc0, 0, 0, 0);
            acc1 = __builtin_amdgcn_mfma_f32_16x16x32_bf16(__builtin_bit_cast(bf16x8, hi), wl, acc1, 0, 0, 0);
            acc2 = __builtin_amdgcn_mfma_f32_16x16x32_bf16(__builtin_bit_cast(bf16x8, lo), wh, acc2, 0, 0, 0);
        }
        const f32x4 lgt = acc0 + (acc1 + acc2);
        LAS float* lgw = (LAS float*)(L + O_LG + F.wave * 1024);
        LAS int* cnw = (LAS int*)(L + O_CN + F.wave * 64);
#pragma unroll
        for (int q = 0; q < 4; ++q) lgw[(4 * g + q) * 16 + r] = lgt[q];
        if (F.lane < 16) cnw[F.lane] = 0;
        LDS_WAIT(); asm volatile("" ::: "memory");
        if (F.lane < 16) {
            const int t = t0 + F.lane;
            float lg[16];
#pragma unroll
            for (int q = 0; q < 4; ++q) { const f32x4 v = *(const LAS f32x4*)(lgw + F.lane * 16 + 4 * q); lg[4 * q] = v[0]; lg[4 * q + 1] = v[1]; lg[4 * q + 2] = v[2]; lg[4 * q + 3] = v[3]; }
            float best = -3.0e38f; int be0 = 0, be1 = 1; float bs0 = 0.f, bs1 = 0.f;
#pragma unroll
            for (int gg = 0; gg < 4; ++gg) {
                float sg[4], sel[4];
#pragma unroll
                for (int q = 0; q < 4; ++q) { sg[q] = 1.f / (1.f + expf(-lg[4 * gg + q])); sel[q] = sg[q] + A.in[I_ROUTB][4 * gg + q]; }
                int i1 = 0; float v1 = sel[0], s1 = sg[0];
#pragma unroll
                for (int q = 1; q < 4; ++q) if (sel[q] > v1) { i1 = q; v1 = sel[q]; s1 = sg[q]; }
                int i2 = -1; float v2 = -3.0e38f, s2 = 0.f;
#pragma unroll
                for (int q = 0; q < 4; ++q) if (q != i1 && sel[q] > v2) { i2 = q; v2 = sel[q]; s2 = sg[q]; }
                const float gs = v1 + v2;
                if (gs > best) { best = gs; be0 = 4 * gg + i1; be1 = 4 * gg + i2; bs0 = s1; bs1 = s2; }
            }
            const float inv = 1.f / (bs0 + bs1);
            EIDX[t] = (unsigned)be0 | ((unsigned)be1 << 8); GATE[2 * t] = bs0 * inv; GATE[2 * t + 1] = bs1 * inv;
            __hip_atomic_fetch_add(cnw + be0, 1, __ATOMIC_RELAXED, __HIP_MEMORY_SCOPE_WORKGROUP); __hip_atomic_fetch_add(cnw + be1, 1, __ATOMIC_RELAXED, __HIP_MEMORY_SCOPE_WORKGROUP);
        }
        LDS_WAIT(); asm volatile("" ::: "memory");
        if (F.lane < 16) CC[ch * 16 + F.lane] = cnw[F.lane];
    }
    __syncthreads();
}

__device__ __forceinline__ void p7_permute(const Frame& F, const Args& A) {
    unsigned char* ws = A.ws;
    LAS int* cc = (LAS int*)F.lds;
    LAS int* ps = (LAS int*)(F.lds + LDS_X_OFF);
    LAS int* seg = ps + 512;
    LAS int* tot = seg + 16;
    const int* CC = (const int*)(ws + WS_CC);
    const unsigned* EIDX = (const unsigned*)(ws + WS_EIDX); int* POS = (int*)(ws + WS_POS); int* TILE = (int*)(ws + WS_TILE); int* INV = (int*)(ws + WS_INV);
    __syncthreads();
    for (int i = F.tid; i < 2048 * 16 / 4; i += NTHREADS) ((LAS u32x4*)cc)[i] = ((const u32x4*)CC)[i];
    __syncthreads();
    { const int e = F.tid & 15, part = F.tid >> 4; int s = 0; for (int q = 0; q < 64; ++q) s += cc[(part * 64 + q) * 16 + e]; ps[part * 16 + e] = s; }
    __syncthreads();
    if (F.tid < 16) { int run = 0; for (int p = 0; p < 32; ++p) { const int v = ps[p * 16 + F.tid]; ps[p * 16 + F.tid] = run; run += v; } tot[F.tid] = run; }
    __syncthreads();
    if (F.tid == 0) { int off = 0, nt = 0;
        for (int e = 0; e < 16; ++e) { const int tl = (tot[e] + 255) >> 8; seg[e] = off;
            if (blockIdx.x == 0) for (int q = 0; q < tl; ++q) TILE[16 + nt + q] = e;
            nt += tl; off += tl * 256; }
        if (blockIdx.x == 0) TILE[0] = nt; }
    __syncthreads();
    if (blockIdx.x == 0) {
        for (int e = 0; e < 16; ++e) { const int n0 = seg[e] + tot[e], n1 = seg[e] + (((tot[e] + 255) >> 8) << 8);
            for (int j = n0 + F.tid; j < n1; j += NTHREADS) INV[j] = 0; } }
    for (int ch = F.gw; ch < 2048; ch += F.NGW) {
        int base = 0;
        if (F.lane < 16) { base = seg[F.lane] + ps[(ch >> 6) * 16 + F.lane]; for (int q = (ch & ~63); q < ch; ++q) base += cc[q * 16 + F.lane]; }
        int myp = 0;
        for (int i = 0; i < 16; ++i) {
            const int t = ch * 16 + i; const unsigned ei = EIDX[t]; const int e0 = ei & 255, e1 = (ei >> 8) & 255;
            const int p0 = __shfl(base, e0); base += (F.lane == e0);
            const int p1 = __shfl(base, e1); base += (F.lane == e1);
            if (F.lane == 2 * i) myp = p0; if (F.lane == 2 * i + 1) myp = p1;
        }
        if (F.lane < 32) { POS[ch * 32 + F.lane] = myp; INV[myp] = ch * 16 + (F.lane >> 1); }
    }
    __syncthreads();
}

template <bool FINAL>
__device__ __forceinline__ void p10_combine(const Frame& F, const Args& A, const int layer) {
    unsigned char* ws = A.ws;
    const float* MOD = (const float*)(ws + WS_MOD);
    const bf16_t* O = (const bf16_t*)(ws + WS_XP); const int* POS = (const int*)(ws + WS_POS); const float* GATE = (const float*)(ws + WS_GATE);
    bf16_t* XN = (bf16_t*)(ws + WS_XN);
    bf16_t* h = (bf16_t*)(ws + WS_HB); float* outp = A.out;
    for (int ch = F.gw; ch < 2048; ch += F.NGW) {
        const int t0 = ch * 16, b = t0 / TL;
        const float* mcur = MOD + ((size_t)layer * 9 + b) * 6144;
        f32x4 gt2[4], gsc[4], sh[4];
#pragma unroll
        for (int j = 0; j < 4; ++j) { const int c = 4 * F.lane + 256 * j; gt2[j] = *(const f32x4*)(mcur + 5120 + c);
            if (FINAL) { gsc[j] = *(const f32x4*)(A.in[I_FINALG] + c); sh[j] = (f32x4){0.f, 0.f, 0.f, 0.f}; }
            else { const float* mn = MOD + ((size_t)9 + b) * 6144; gsc[j] = *(const f32x4*)(A.in[I_NORMG] + 2 * D + c) * (1.f + *(const f32x4*)(mn + 1024 + c)); sh[j] = *(const f32x4*)(mn + c); } }
        for (int i = 0; i < 16; ++i) {
            const int t = t0 + i; const int p0 = POS[2 * t], p1 = POS[2 * t + 1]; const float w0 = GATE[2 * t], w1 = GATE[2 * t + 1];
            f32x4 v[4]; float s = 0.f;
#pragma unroll
            for (int j = 0; j < 4; ++j) { const int c = 4 * F.lane + 256 * j;
                const u32x2 oa = *(const u32x2*)(O + (size_t)p0 * D + c), ob = *(const u32x2*)(O + (size_t)p1 * D + c);
                const f32x4 m = w0 * (f32x4){bflo(oa.x), bfhi(oa.x), bflo(oa.y), bfhi(oa.y)} + w1 * (f32x4){bflo(ob.x), bfhi(ob.x), bflo(ob.y), bfhi(ob.y)};
                const u32x2 hq = *(const u32x2*)(h + (size_t)t * D + c);
                v[j] = (f32x4){bflo(hq.x), bfhi(hq.x), bflo(hq.y), bfhi(hq.y)} + gt2[j] * m;
                s += (v[j].x * v[j].x + v[j].y * v[j].y) + (v[j].z * v[j].z + v[j].w * v[j].w); }
            const float rstd = rsqrtf(wave_sum(s) * (1.f / D) + RMS_EPS);
            if (FINAL) {
#pragma unroll
                for (int j = 0; j < 4; ++j) *(f32x4*)(outp + (size_t)t * D + 4 * F.lane + 256 * j) = v[j] * rstd * gsc[j];
            } else {
#pragma unroll
                for (int j = 0; j < 4; ++j) { st_bf4(h + (size_t)t * D + 4 * F.lane + 256 * j, v[j]); st_bf4(XN + (size_t)t * D + 4 * F.lane + 256 * j, v[j] * rstd * gsc[j] + sh[j]); }
            }
        }
    }
}

__device__ __forceinline__ void ld_bf16row(const bf16_t* row, float (&o)[16], int lane) {
#pragma unroll
    for (int j = 0; j < 2; ++j) { const u32x4 a = *(const u32x4*)(row + 8 * lane + 512 * j);
        o[8 * j] = bflo(a.x); o[8 * j + 1] = bfhi(a.x); o[8 * j + 2] = bflo(a.y); o[8 * j + 3] = bfhi(a.y); o[8 * j + 4] = bflo(a.z); o[8 * j + 5] = bfhi(a.z); o[8 * j + 6] = bflo(a.w); o[8 * j + 7] = bfhi(a.w); }
}
__device__ __forceinline__ void p12_conv(const Frame& F, const Args& A) {
    unsigned char* ws = A.ws;
    const bf16_t* BG = (const bf16_t*)(ws + WS_BG); const bf16_t* U = (const bf16_t*)(ws + WS_U); bf16_t* Z = (bf16_t*)(ws + WS_Z);
    float c0[16], c1[16], c2[16];
#pragma unroll
    for (int j = 0; j < 2; ++j)
#pragma unroll
        for (int q = 0; q < 8; ++q) { const int c = 8 * F.lane + 512 * j + q; c0[8 * j + q] = A.in[I_CONV][c]; c1[8 * j + q] = A.in[I_CONV][D + c]; c2[8 * j + q] = A.in[I_CONV][2 * D + c]; }
    for (int u = F.gw; u < 2048; u += F.NGW) {
        const int t0 = u * 16, pos0 = t0 % GRIDW;
        float prev[16], cur[16], nxt[16], bg[16];
        if (pos0 > 0) ld_bf16row(U + (size_t)(t0 - 1) * D, prev, F.lane);
        else {
#pragma unroll
            for (int q = 0; q < 16; ++q) prev[q] = 0.f; }
        ld_bf16row(U + (size_t)t0 * D, cur, F.lane);
        for (int i = 0; i < 16; ++i) {
            if (pos0 + i + 1 < GRIDW) ld_bf16row(U + (size_t)(t0 + i + 1) * D, nxt, F.lane);
            else {
#pragma unroll
                for (int q = 0; q < 16; ++q) nxt[q] = 0.f; }
            ld_bf16row(BG + (size_t)(t0 + i) * D, bg, F.lane);
            float z[16];
#pragma unroll
            for (int q = 0; q < 16; ++q) { z[q] = bg[q] * (c0[q] * prev[q] + c1[q] * cur[q] + c2[q] * nxt[q]); prev[q] = cur[q]; cur[q] = nxt[q]; }
#pragma unroll
            for (int j = 0; j < 2; ++j) { u32x4 w; w.x = pk2(z[8 * j], z[8 * j + 1]); w.y = pk2(z[8 * j + 2], z[8 * j + 3]); w.z = pk2(z[8 * j + 4], z[8 * j + 5]); w.w = pk2(z[8 * j + 6], z[8 * j + 7]);
                *(u32x4*)(Z + (size_t)(t0 + i) * D + 8 * F.lane + 512 * j) = w; }
        }
    }
}

constexpr int N_PHASES = 20;
__global__ void __launch_bounds__(NTHREADS, 2) fwd(Args args) {
    extern __shared__ __attribute__((aligned(16))) unsigned char lds_raw[];
    Frame F;
    F.lds = (LAS unsigned char*)lds_raw;
    F.tid = threadIdx.x; F.lane = F.tid & 63; F.wave = __builtin_amdgcn_readfirstlane(F.tid >> 6);
    F.G = gridDim.x; { const int bx = blockIdx.x; F.vcu = (F.G % 8 == 0) ? (bx % 8) * (F.G / 8) + bx / 8 : bx; }
    F.gw = F.vcu * NWAVES + F.wave; F.NGW = F.G * NWAVES;
    unsigned char* ws = args.ws;
    for (int u = F.tid; u < (LDS_BYTES - LDSCTL_OFF) / 4; u += NTHREADS) ((LAS unsigned*)(F.lds + LDSCTL_OFF))[u] = 0u;
    __syncthreads();
    volatile LAS unsigned* MISC = (volatile LAS unsigned*)(F.lds + MISC_OFF);
    XcdBarrier bar; bar.bar = (unsigned*)(ws + WS_CTL) + CW_BAR; bar.x = 0; bar.st = nullptr;
    const int lo = args.ph_lo, hi = args.ph_hi;
    if (hi - lo > 1) bar = xcd_barrier_post((unsigned*)(ws + WS_CTL) + CW_BAR, MISC + 8);
#ifndef PH_MASK
#define PH_MASK 0xFFFFFu
#endif
#define IN(k) (((PH_MASK >> (k)) & 1u) && lo <= (k) && (k) < hi)
#define SEAM(k) do { if (IN(k) && IN((k) + 1)) xcd_barrier(bar); } while (0)
#ifndef PROBE_MASK
#define PROBE_MASK 0u
#endif
#define RUNPH(k, ...) do { __VA_ARGS__ if constexpr (((PROBE_MASK >> (k)) & 1u) != 0u) { if (hi - lo > 1) xcd_barrier(bar); __VA_ARGS__ } } while (0)
    const float* MOD = (const float*)(ws + WS_MOD);
    const int bx = (int)blockIdx.x;
#ifdef PHASE_TIME
    unsigned long long pt_acc = 0, pt_t0 = 0;
#define PT_BEGIN(k) do { if ((k) == PHASE_TIME) pt_t0 = __builtin_amdgcn_s_memrealtime(); } while (0)
#define PT_END(k) do { if ((k) == PHASE_TIME) pt_acc += __builtin_amdgcn_s_memrealtime() - pt_t0; } while (0)
#else
#define PT_BEGIN(k) do { } while (0)
#define PT_END(k) do { } while (0)
#endif

    PT_END(99); if (IN(0)) { PT_BEGIN(0); RUNPH(0, p0_prologue(F, args);); SEAM(0); }
    PT_END(0); if (IN(1)) { PT_BEGIN(1); RUNPH(1, p1_mix(F, args);); SEAM(1); }
    PT_END(1); if (IN(2)) { PT_BEGIN(2);
      RUNPH(2,
        { SchedRKV S{(const char*)(ws + WS_XM), (const char*)(ws + WS_WRKV), (const char*)(ws + WS_WL), F.G, bx};
          EpiRKV E{(bf16_t*)args.out, (bf16_t*)args.out + (size_t)ML * D, (bf16_t*)(ws + WS_KC), (bf16_t*)(ws + WS_V), (bf16_t*)(ws + WS_LP)};
          pg8::gemm_phase<EpiRKV, SchedRKV>(F.lds, D, D, S, E); }
      );
        SEAM(2);
    }
    PT_END(2); if (IN(3)) { PT_BEGIN(3); RUNPH(3, p2b_combine(F, args);); SEAM(3); }
    PT_END(3); if (IN(4)) { PT_BEGIN(4);
      RUNPH(4,
        { SchedPlain S{(const char*)(ws + WS_LG), (const char*)(ws + WS_G2), 128, 4, 256, 256, 4, F.G, bx};
          EpiBf16 E{(bf16_t*)(ws + WS_G), D};
          pg8::gemm_phase<EpiBf16, SchedPlain>(F.lds, 256, 256, S, E); }
        p3_scan(F, args);
      );
        SEAM(4); }
    PT_END(4); if (IN(5)) { PT_BEGIN(5); RUNPH(5, p4_readout(F, args);); SEAM(5); }
    PT_END(5); if (IN(6)) { PT_BEGIN(6);
      RUNPH(6,
        SchedPlain S{(const char*)(ws + WS_ZO), (const char*)(ws + WS_WO), 128, 4, D, D, 16, F.G, bx};
        EpiRes E{args.in[I_X], (bf16_t*)(ws + WS_HB), MOD + 2048};
        pg8::gemm_phase<EpiRes, SchedPlain>(F.lds, D, D, S, E);
      );
        SEAM(6);
    }
    PT_END(6); if (IN(7)) { PT_BEGIN(7); RUNPH(7, p6_route(F, args, 0);); SEAM(7); }
    PT_END(7); if (IN(8)) { PT_BEGIN(8); RUNPH(8, p7_permute(F, args);); SEAM(8); }
    PT_END(8); if (IN(9)) { PT_BEGIN(9);
        unsigned* const rdy = (unsigned*)(ws + WS_CTL + CTL_RDY + 0 * 128 * 1024);
        { const SchedMoeG S{(const char*)(ws + WS_XN), (const char*)(ws + WS_MOEW0), (const int*)(ws + WS_TILE), (const int*)(ws + WS_INV), D, 16, F.G, bx, (size_t)2 * MiB};
          const EpiGateUpPub E{(unsigned char*)(ws + WS_H), rdy};
          pg8::gemm_phase<EpiGateUpPub, SchedMoeG, true>(F.lds, D, D, S, E); }
        { const SchedMoeD S{(const char*)(ws + WS_H), (const char*)(ws + WS_MOEW0 + 32 * MiB), (const int*)(ws + WS_TILE), rdy, (unsigned*)(ws + WS_CTL) + CW_TMO2, F.G, bx};
          const EpiBf16 E{(bf16_t*)(ws + WS_XP), D};
          pg8::gemm_phase<EpiBf16, SchedMoeD, true, 1>(F.lds, ED, ED, S, E); }
        if (IN(9) && IN(10 + 1)) xcd_barrier(bar);
    }
    PT_END(9); if (IN(11)) { PT_BEGIN(11); p10_combine<false>(F, args, 0); SEAM(11); }
    PT_END(11); if (IN(12)) { PT_BEGIN(12);
      RUNPH(12,
        SchedPlain S{(const char*)(ws + WS_XN), (const char*)(ws + WS_WIN), 128, 12, D, D, 16, F.G, bx};
        EpiWin E{(bf16_t*)(ws + WS_BG), (bf16_t*)(ws + WS_U)};
        pg8::gemm_phase<EpiWin, SchedPlain>(F.lds, D, D, S, E);
      );
        SEAM(12);
    }
    PT_END(12); if (IN(13)) { PT_BEGIN(13); RUNPH(13, p12_conv(F, args);); SEAM(13); }
    PT_END(13); if (IN(14)) { PT_BEGIN(14);
        SchedPlain S{(const char*)(ws + WS_Z), (const char*)(ws + WS_WOUT), 128, 4, D, D, 16, F.G, bx};
        EpiRes E{nullptr, (bf16_t*)(ws + WS_HB), MOD + 9 * 6144 + 2048};
        pg8::gemm_phase<EpiRes, SchedPlain>(F.lds, D, D, S, E);
        SEAM(14);
    }
    PT_END(14); if (IN(15)) { PT_BEGIN(15); RUNPH(15, p6_route(F, args, 1);); SEAM(15); }
    PT_END(15); if (IN(16)) { PT_BEGIN(16); RUNPH(16, p7_permute(F, args);); SEAM(16); }
    PT_END(16); if (IN(17)) { PT_BEGIN(17);
        unsigned* const rdy = (unsigned*)(ws + WS_CTL + CTL_RDY + 1 * 128 * 1024);
        { const SchedMoeG S{(const char*)(ws + WS_XN), (const char*)(ws + WS_MOEW1), (const int*)(ws + WS_TILE), (const int*)(ws + WS_INV), D, 16, F.G, bx, (size_t)2 * MiB};
          const EpiGateUpPub E{(unsigned char*)(ws + WS_H), rdy};
          pg8::gemm_phase<EpiGateUpPub, SchedMoeG, true>(F.lds, D, D, S, E); }
        { const SchedMoeD S{(const char*)(ws + WS_H), (const char*)(ws + WS_MOEW1 + 32 * MiB), (const int*)(ws + WS_TILE), rdy, (unsigned*)(ws + WS_CTL) + CW_TMO2, F.G, bx};
          const EpiBf16 E{(bf16_t*)(ws + WS_XP), D};
          pg8::gemm_phase<EpiBf16, SchedMoeD, true, 1>(F.lds, ED, ED, S, E); }
        if (IN(17) && IN(18 + 1)) xcd_barrier(bar);
    }
    PT_END(17); if (IN(19)) { PT_BEGIN(19); p10_combine<true>(F, args, 1); }
    PT_END(19);
#ifdef PHASE_TIME
    if (blockIdx.x == 0 && F.tid == 0) { const unsigned long long te = __builtin_amdgcn_s_memrealtime() + 4ull * pt_acc; while (__builtin_amdgcn_s_memrealtime() < te) __builtin_amdgcn_s_sleep(8); }
#endif
}

extern "C" void kernel_launch(void* const* d_in, const int* in_sizes, int n_in, void* d_out, int out_size, void* d_ws, size_t ws_size, hipStream_t stream) {
    static int grid = 0;
    if (grid == 0) {
        if (n_in != 32 || out_size != ML * D || ws_size < WS_END) { fprintf(stderr, "kernel_launch: unexpected problem (n_in %d, out %d, ws %zu)\n", n_in, out_size, ws_size); grid = -1; return; }
        int dev = 0, cus = 0;
        if (hipGetDevice(&dev) != hipSuccess || hipDeviceGetAttribute(&cus, hipDeviceAttributeMultiprocessorCount, dev) != hipSuccess) { grid = -1; return; }
        if (hipFuncSetAttribute((const void*)fwd, hipFuncAttributeMaxDynamicSharedMemorySize, LDS_BYTES) != hipSuccess) { grid = -1; return; }
        int per_cu = 0;
        if (hipOccupancyMaxActiveBlocksPerMultiprocessor(&per_cu, (const void*)fwd, NTHREADS, LDS_BYTES) != hipSuccess || per_cu < 1) { fprintf(stderr, "kernel_launch: occupancy query says %d\n", per_cu); grid = -1; return; }
        grid = cus > 256 ? 256 : cus;
    }
    if (grid < 0) return;
    (void)in_sizes;
    hipMemsetAsync((char*)d_ws + WS_CTL, 0, CTL_ZERO_BYTES, stream);
    Args a{};
    for (int i = 0; i < 32; ++i) a.in[i] = (const float*)d_in[i];
    a.out = (float*)d_out; a.ws = (unsigned char*)d_ws;
#if MK_N_LAUNCHES == 1
    a.ph_lo = 0; a.ph_hi = N_PHASES;
    hipLaunchKernelGGL(fwd, dim3(grid), dim3(NTHREADS), LDS_BYTES, stream, a);
#else
    for (int k = 0; k < N_PHASES; ++k) { a.ph_lo = k; a.ph_hi = k + 1; hipLaunchKernelGGL(fwd, dim3(grid), dim3(NTHREADS), LDS_BYTES, stream, a); }
#endif
}
```

```cpp
#include <hip/hip_runtime.h>
#include <cstdio>
#include <cstdint>

#ifndef MK_N_LAUNCHES
#define MK_N_LAUNCHES 1
#endif

#define GAS __attribute__((address_space(1)))
#define LAS __attribute__((address_space(3)))
typedef unsigned short bf16_t;
typedef short bf16x8 __attribute__((ext_vector_type(8)));
typedef float f32x4 __attribute__((ext_vector_type(4)));
typedef float f32x2 __attribute__((ext_vector_type(2)));
typedef unsigned u32x4 __attribute__((ext_vector_type(4)));
typedef unsigned u32x2 __attribute__((ext_vector_type(2)));

constexpr int D = 1024, NBATCH = 8, TL = 4096, TCX = 256, ML = NBATCH * TL, MC = NBATCH * TCX, MA = ML + MC;
constexpr int NH = 16, HD = 64, NE = 16, ED = 512, GRIDW = 64;
constexpr int XM_LD = 5 * D;
constexpr int NWAVES = 8, NTHREADS = 512;
constexpr float RMS_EPS = 1e-6f, GN_EPS = 64e-5f;
constexpr int MAXTILES = 272;

constexpr size_t MiB = 1u << 20;
constexpr size_t WS_CTL = 0, CTL_ZERO_BYTES = 1 * MiB;
constexpr size_t WS_MOD = 1 * MiB;
constexpr size_t WS_EIDX = 2 * MiB;
constexpr size_t WS_GATE = WS_EIDX + 128 * 1024;
constexpr size_t WS_POS = WS_GATE + 256 * 1024;
constexpr size_t WS_CC = WS_POS + 256 * 1024;
constexpr size_t WS_TILE = WS_CC + 128 * 1024;
constexpr size_t WS_INV = WS_TILE + 4 * 1024;
static_assert(WS_INV + 69632 * 4 <= 4 * MiB, "ws map");
constexpr size_t WS_WRKV = 4 * MiB;
constexpr size_t WS_WL = 16 * MiB;
constexpr size_t WS_G2 = 18 * MiB;
constexpr size_t WS_WO = 19 * MiB;
constexpr size_t WS_WIN = 21 * MiB;
constexpr size_t WS_WOUT = 27 * MiB;
constexpr size_t WS_ACT = 32 * MiB;
constexpr size_t WS_XM = WS_ACT;
constexpr size_t WS_LP = 304 * MiB;
constexpr size_t WS_V = 372 * MiB;
constexpr size_t WS_KC = 440 * MiB;
constexpr size_t WS_LWA = 444 * MiB;
constexpr size_t WS_LG = 461 * MiB;
constexpr size_t WS_G = 32 * MiB;
constexpr size_t WS_Y0 = 96 * MiB, WS_Y1 = 160 * MiB;
constexpr size_t WS_ZO = 272 * MiB;
constexpr size_t WS_MOEW0 = 416 * MiB, WS_MOEW1 = 464 * MiB;
constexpr size_t WS_XN = 32 * MiB;
constexpr size_t WS_XP = 96 * MiB;
constexpr size_t WS_H = 232 * MiB;
constexpr size_t WS_BG = 232 * MiB, WS_U = 160 * MiB;
constexpr size_t WS_HB = 336 * MiB;
constexpr size_t WS_Z = 96 * MiB;
constexpr size_t WS_END = 512 * MiB;

constexpr int CW_BAR = 4096;
constexpr int CW_TMO2 = 16;
constexpr size_t CTL_RDY = 256 * 1024;

constexpr int RING_BYTES = 131072;
constexpr int LDS_BYTES = 163840;
constexpr int LDSCTL_OFF = LDS_BYTES - 512, MISC_OFF = LDSCTL_OFF + 64;
constexpr int LDS_X_OFF = RING_BYTES;

typedef __bf16 bf16x2v __attribute__((ext_vector_type(2)));
__device__ __forceinline__ unsigned pk2(float lo, float hi) { const f32x2 v = {lo, hi}; return __builtin_bit_cast(unsigned, __builtin_convertvector(v, bf16x2v)); }
__device__ __forceinline__ unsigned f2bf(float f) { return pk2(f, 0.f) & 0xffffu; }
__device__ __forceinline__ float bflo(unsigned u) { return __builtin_bit_cast(float, u << 16); }
__device__ __forceinline__ float bfhi(unsigned u) { return __builtin_bit_cast(float, u & 0xffff0000u); }
__device__ __forceinline__ float wave_sum(float v) {
#pragma unroll
    for (int o = 1; o < 64; o <<= 1) v += __shfl_xor(v, o);
    return v;
}
__device__ __forceinline__ float sigmoidf_(float x) { return 1.f / (1.f + __expf(-x)); }
#define LDS_WAIT() asm volatile("s_waitcnt lgkmcnt(0)" ::: "memory")

namespace pg8 {
constexpr int BM = 256, BK = 64, HALF = 128, HTB = HALF * BK * 2, STAGE_BYTES = 8 * HTB, NXCD = 8, WGM = 8;
__host__ __device__ __forceinline__ int lds_byte(int r, int c) { const int st = (r >> 4) * 2 + (c >> 5), rr = r & 15, cc = c & 31, ob = rr * 64 + cc * 2; return st * 1024 + (ob ^ (((ob >> 9) & 1) << 5)); }
__host__ __device__ __forceinline__ void stage_rc(int b, int& R, int& C) { const int st = b / 1024, sb = b % 1024, swz = sb ^ (((sb >> 9) & 1) << 5); R = (st >> 1) * 16 + swz / 64; C = (st & 1) * 32 + (swz % 64) / 2; }
__host__ __device__ __forceinline__ int perm32(int rho) { const int n = rho >> 4, i = rho & 15; return 8 * (i >> 2) + 4 * n + (i & 3); }

struct Unit { int pm, pn; const char* a; const char* b; int nt; const int* rows; int kind, pa, pb, row0; };

__device__ __forceinline__ void swz_tile(int L, int nM, int nN, int& pm, int& pn) {
    const int nwg = nM * nN; int wgid = L;
    { const int q = nwg / NXCD, r = nwg % NXCD, xcd = wgid % NXCD, off = wgid / NXCD; wgid = (xcd < r ? xcd * (q + 1) : r * (q + 1) + (xcd - r) * q) + off; }
    const int nig = WGM * nN, gid = wgid / nig, fm = gid * WGM, gsz = (nM - fm) < WGM ? (nM - fm) : WGM;
    pm = fm + ((wgid % nig) % gsz); pn = (wgid % nig) / gsz;
}

__device__ __forceinline__ unsigned cvt_pk_bf16(float lo, float hi) { return pk2(lo, hi); }

template <class Epi, class Sched, bool GATHER = false, int FUSED = 0  , bool ALIGN_EPI = true, bool SP2 = true>
__device__ __forceinline__ void gemm_phase(LAS unsigned char* lds, const int lda, const int ldb, const Sched& S, const Epi& E, const size_t kstepA = (size_t)(BK * 2)) {
    const int tid = threadIdx.x, wid = __builtin_amdgcn_readfirstlane(tid >> 6), lane = tid & 63, wr = wid >> 2, wc = wid & 3, fr = lane & 15, fq = lane >> 4;
    unsigned vA[2][2], vN[2][2], voffB[2], vBn[2]; int gR[2], gC[2], gRb[2]; size_t hsBc = 0, hsBn = 0;
#pragma unroll
    for (int i = 0; i < 2; ++i) { int R, C; stage_rc(tid * 16 + i * 8192, R, C); const int Rb = Epi::PERM ? ((R & ~31) + perm32(R & 31)) : R;
        gR[i] = R; gC[i] = C * 2; gRb[i] = Rb; vBn[i] = 0;
        vA[0][i] = (unsigned)(R * lda + C) * 2u; vA[1][i] = (unsigned)((R + HALF) * lda + C) * 2u; vN[0][i] = vA[0][i]; vN[1][i] = vA[1][i];
        voffB[i] = (unsigned)(Rb * ldb + C) * 2u; }
#define PG8_GATHER(dst, u) do { if constexpr (GATHER) { _Pragma("unroll") for (int _h = 0; _h < 2; ++_h) _Pragma("unroll") for (int _i = 0; _i < 2; ++_i) { \
        if constexpr (FUSED != 0) { const int ri_ = gR[_i] + _h * HALF; const unsigned rr_ = (u).rows ? (unsigned)(u).rows[ri_] : (unsigned)((u).row0 + ri_); dst[_h][_i] = rr_ * (unsigned)(u).pa + (unsigned)gC[_i]; } \
        else dst[_h][_i] = (unsigned)(u).rows[gR[_i] + _h * HALF] * (unsigned)(lda * 2) + (unsigned)gC[_i]; } } } while (0)
#define PG8_BOFF(dst, u) do { if constexpr (FUSED == 2) { _Pragma("unroll") for (int _i = 0; _i < 2; ++_i) dst[_i] = (unsigned)gRb[_i] * (unsigned)(u).pb + (unsigned)gC[_i]; } } while (0)
#define PG8_STAGE_B(bufoff, gbase, hh, nx) do { if constexpr (FUSED == 2) { if ((nx) && last) PG8_STAGE(bufoff, (gbase) + (hh) * hsBn, vBn); else PG8_STAGE(bufoff, (gbase) + (hh) * hsBc, voffB); } \
        else PG8_STAGE(bufoff, (gbase) + (hh) * hstepB, voffB); } while (0)
    const size_t kstep = (size_t)(BK * 2);
    const size_t hstepB = (size_t)HALF * ldb * 2;
    const unsigned ldsw = (unsigned)wid * 1024u;
    const int aoff = lds_byte(wr * 64 + fr, fq * 8), boff = lds_byte(wc * 32 + fr, fq * 8);
#define PG8_SA(b, h) (((b) * 2 + (h)) * HTB)
#define PG8_SB(b, h) ((4 + (b) * 2 + (h)) * HTB)
#define PG8_STAGE(bufoff, gbase, voff) do { _Pragma("unroll") for (int _i = 0; _i < 2; ++_i) \
        __builtin_amdgcn_global_load_lds((const unsigned*)((const char*)(gbase) + (voff)[_i]), (LAS unsigned*)(lds + (bufoff) + ldsw + _i * 8192), 16, 0, 0); } while (0)
#define PG8_LDA(dst, b, h) do { _Pragma("unroll") for (int m = 0; m < 4; ++m) _Pragma("unroll") for (int k = 0; k < 2; ++k) dst[m][k] = *(const LAS bf16x8*)(lds + PG8_SA(b, h) + aoff + m * 2048 + k * 1024); } while (0)
#define PG8_LDB(dst, b, h) do { _Pragma("unroll") for (int n = 0; n < 2; ++n) _Pragma("unroll") for (int k = 0; k < 2; ++k) dst[n][k] = *(const LAS bf16x8*)(lds + PG8_SB(b, h) + boff + n * 2048 + k * 1024); } while (0)
#define PG8_MMA(ai, bj, At, Bt) do { __builtin_amdgcn_s_setprio(1); _Pragma("unroll") for (int m = 0; m < 4; ++m) _Pragma("unroll") for (int n = 0; n < 2; ++n) _Pragma("unroll") for (int k = 0; k < 2; ++k) \
        acc[ai][bj][m][n] = __builtin_amdgcn_mfma_f32_16x16x32_bf16(Bt[n][k], At[m][k], acc[ai][bj][m][n], 0, 0, 0); __builtin_amdgcn_s_setprio(0); } while (0)
#define PG8_WAIT_V(n) asm volatile("s_waitcnt vmcnt(" #n ")" ::: "memory")
#define PG8_WAIT_L(n) asm volatile("s_waitcnt lgkmcnt(" #n ")" ::: "memory")
#define PG8_BAR __builtin_amdgcn_s_barrier()
#define PG8_SCHED __builtin_amdgcn_sched_barrier(0)
    Unit cur, nxt; int ui = 0;
    if (!S.next(0, cur)) return;
    f32x4 acc[2][2][4][2];
#pragma unroll
    for (int a = 0; a < 2; ++a)
#pragma unroll
        for (int b = 0; b < 2; ++b)
#pragma unroll
            for (int m = 0; m < 4; ++m)
#pragma unroll
                for (int n = 0; n < 2; ++n) acc[a][b][m][n] = (f32x4){0.f, 0.f, 0.f, 0.f};
    bf16x8 At[4][2], B0[2][2], B1[2][2];
    const char* cA = cur.a; const char* cB = cur.b;
    PG8_GATHER(vA, cur);
    if constexpr (FUSED == 2) { PG8_BOFF(voffB, cur); hsBc = (size_t)HALF * cur.pb; }
    if constexpr (FUSED != 0) S.a_ready(cur);
    { const bool last = false;
    if constexpr (SP2) {
        PG8_STAGE_B(PG8_SB(0, 0), cB, 0, false); PG8_STAGE_B(PG8_SB(0, 1), cB, 1, false); PG8_STAGE(PG8_SA(0, 0), cA, vA[0]); PG8_STAGE(PG8_SA(0, 1), cA, vA[1]);
        if (wr == 1) PG8_BAR;
        PG8_WAIT_V(2); PG8_BAR;
        PG8_STAGE_B(PG8_SB(1, 0), cB + kstep, 0, false); PG8_STAGE(PG8_SA(1, 0), cA + kstepA, vA[0]); PG8_STAGE_B(PG8_SB(1, 1), cB + kstep, 1, false);
        PG8_WAIT_V(6); PG8_BAR;
    } else {
        PG8_STAGE_B(PG8_SB(0, 0), cB, 0, false); PG8_STAGE(PG8_SA(0, 0), cA, vA[0]); PG8_STAGE_B(PG8_SB(0, 1), cB, 1, false); PG8_STAGE(PG8_SA(0, 1), cA, vA[1]);
        if (wr == 1) PG8_BAR;
        PG8_WAIT_V(4); PG8_BAR;
        PG8_STAGE_B(PG8_SB(1, 0), cB + kstep, 0, false); PG8_STAGE(PG8_SA(1, 0), cA + kstepA, vA[0]); PG8_STAGE_B(PG8_SB(1, 1), cB + kstep, 1, false);
        PG8_WAIT_V(6); PG8_BAR;
    }
    }
    for (;;) {
        const bool has_next = S.next(ui + 1, nxt);
        const char* nA = has_next ? nxt.a : cA; const char* nB = has_next ? nxt.b : cB;
        if (has_next) { PG8_GATHER(vN, nxt); if constexpr (FUSED == 2) { PG8_BOFF(vBn, nxt); hsBn = (size_t)HALF * nxt.pb; } }
        const int nt = cur.nt;
#ifdef KLOOP_PROBE
        unsigned long long kp0_ = 0; volatile LAS unsigned* kp_ = (volatile LAS unsigned*)(lds + MISC_OFF);
        if (wid == 0) kp0_ = (KLOOP_PROBE == 1) ? __builtin_amdgcn_s_memrealtime() : __builtin_amdgcn_s_memtime();
#endif
        for (int t = 0; t < nt; t += 2) {
            const bool last = (t == nt - 2);
            const char* a1 = cA + (size_t)(t + 1) * kstepA;
            const char* a2 = last ? nA : cA + (size_t)(t + 2) * kstepA; const char* b2 = last ? nB : cB + (size_t)(t + 2) * kstep;
            const char* a3 = a2 + kstepA; const char* b3 = b2 + kstep;
            if constexpr (FUSED != 0) { if (last && has_next) S.a_ready(nxt); }
            unsigned vX[2][2];
#pragma unroll
            for (int _h = 0; _h < 2; ++_h)
#pragma unroll
                for (int _i = 0; _i < 2; ++_i) vX[_h][_i] = (GATHER && last) ? vN[_h][_i] : vA[_h][_i];
            if constexpr (SP2) {
            PG8_LDB(B0, 0, 0); PG8_LDB(B1, 0, 1); PG8_SCHED; PG8_LDA(At, 0, 0); PG8_STAGE(PG8_SA(1, 1), a1, vA[1]);
            PG8_WAIT_V(8); PG8_WAIT_L(0); PG8_BAR; PG8_MMA(0, 0, At, B0); PG8_MMA(0, 1, At, B1); PG8_BAR; PG8_SCHED;
            PG8_LDA(At, 0, 1); PG8_STAGE_B(PG8_SB(0, 0), b2, 0, true); PG8_STAGE_B(PG8_SB(0, 1), b2, 1, true); PG8_STAGE(PG8_SA(0, 0), a2, vX[0]);
            PG8_WAIT_V(8); PG8_WAIT_L(0); PG8_BAR; PG8_MMA(1, 0, At, B0); PG8_MMA(1, 1, At, B1); PG8_BAR; PG8_SCHED;
            PG8_LDB(B0, 1, 0); PG8_LDB(B1, 1, 1); PG8_SCHED; PG8_LDA(At, 1, 0); PG8_STAGE(PG8_SA(0, 1), a2, vX[1]);
            PG8_WAIT_V(8); PG8_WAIT_L(0); PG8_BAR; PG8_MMA(0, 0, At, B0); PG8_MMA(0, 1, At, B1); PG8_BAR; PG8_SCHED;
            PG8_LDA(At, 1, 1); PG8_STAGE_B(PG8_SB(1, 0), b3, 0, true); PG8_STAGE_B(PG8_SB(1, 1), b3, 1, true); PG8_STAGE(PG8_SA(1, 0), a3, vX[0]);
            PG8_WAIT_V(8); PG8_WAIT_L(0); PG8_BAR; PG8_MMA(1, 0, At, B0); PG8_MMA(1, 1, At, B1); PG8_BAR; PG8_SCHED;
            } else {
            PG8_LDB(B0, 0, 0); PG8_SCHED; PG8_LDA(At, 0, 0); PG8_STAGE(PG8_SA(1, 1), a1, vA[1]);
            PG8_WAIT_L(8); PG8_BAR; PG8_WAIT_L(0); PG8_MMA(0, 0, At, B0); PG8_BAR; PG8_SCHED;
            PG8_LDB(B1, 0, 1); PG8_STAGE_B(PG8_SB(0, 0), b2, 0, true);
            PG8_BAR; PG8_WAIT_L(0); PG8_MMA(0, 1, At, B1); PG8_BAR;
            PG8_LDA(At, 0, 1); PG8_STAGE(PG8_SA(0, 0), a2, vX[0]);
            PG8_BAR; PG8_WAIT_L(0); PG8_MMA(1, 0, At, B0); PG8_BAR; PG8_SCHED;
            PG8_STAGE_B(PG8_SB(0, 1), b2, 1, true);
            PG8_WAIT_V(6); PG8_BAR; PG8_MMA(1, 1, At, B1); PG8_BAR;
            PG8_LDB(B0, 1, 0); PG8_SCHED; PG8_LDA(At, 1, 0); PG8_STAGE(PG8_SA(0, 1), a2, vX[1]);
            PG8_WAIT_L(8); PG8_BAR; PG8_WAIT_L(0); PG8_MMA(0, 0, At, B0); PG8_BAR; PG8_SCHED;
            PG8_LDB(B1, 1, 1); PG8_STAGE_B(PG8_SB(1, 0), b3, 0, true);
            PG8_BAR; PG8_WAIT_L(0); PG8_MMA(0, 1, At, B1); PG8_BAR;
            PG8_LDA(At, 1, 1); PG8_STAGE(PG8_SA(1, 0), a3, vX[0]);
            PG8_BAR; PG8_WAIT_L(0); PG8_MMA(1, 0, At, B0); PG8_BAR; PG8_SCHED;
            PG8_STAGE_B(PG8_SB(1, 1), b3, 1, true);
            PG8_WAIT_V(6); PG8_BAR; PG8_MMA(1, 1, At, B1); PG8_BAR;
            }
        }
#ifdef KLOOP_PROBE
        if (wid == 0) { const unsigned long long kp1_ = (KLOOP_PROBE == 1) ? __builtin_amdgcn_s_memrealtime() : __builtin_amdgcn_s_memtime();
            if (tid == 0 && kp_[20]) { kp_[21] += (unsigned)(kp1_ - kp0_); kp_[22] += (unsigned)nt; } }
#endif
        if constexpr (ALIGN_EPI) { if (wr == 0) PG8_BAR; }
        E(acc, cur, wr, wc, fr, fq);
        if (!has_next) break;
#pragma unroll
        for (int a = 0; a < 2; ++a)
#pragma unroll
            for (int b = 0; b < 2; ++b)
#pragma unroll
                for (int m = 0; m < 4; ++m)
#pragma unroll
                    for (int n = 0; n < 2; ++n) acc[a][b][m][n] = (f32x4){0.f, 0.f, 0.f, 0.f};
        cur = nxt; cA = nA; cB = nB; ++ui;
        if constexpr (GATHER) {
#pragma unroll
            for (int _h = 0; _h < 2; ++_h)
#pragma unroll
                for (int _i = 0; _i < 2; ++_i) vA[_h][_i] = vN[_h][_i]; }
        if constexpr (FUSED == 2) { voffB[0] = vBn[0]; voffB[1] = vBn[1]; hsBc = hsBn; }
        if constexpr (ALIGN_EPI) { if (wr == 1) PG8_BAR; }
    }
    PG8_WAIT_V(0);
    if constexpr (!ALIGN_EPI) { if (wr == 0) PG8_BAR; }
    PG8_BAR;
#undef PG8_GATHER
#undef PG8_BOFF
#undef PG8_STAGE_B
#undef PG8_SA
#undef PG8_SB
#undef PG8_STAGE
#undef PG8_LDA
#undef PG8_LDB
#undef PG8_MMA
#undef PG8_WAIT_V
#undef PG8_WAIT_L
#undef PG8_BAR
#undef PG8_SCHED
}
}

#define XB_TMO      128
#define XB_XCNT(j)  (256  + 64 * (j))
#define XB_XSUB(j)  (1280 + 64 * (j))
#define XB_XGEN(j)  (2304 + 64 * (j))
#define XB_TOP      3328
#define XB_TOPGEN   3392
#define XCD_BAR_WORDS 3456
#define XB_SPIN_CAP (1u << 18)
#ifndef XB_SLEEP
#define XB_SLEEP 4
#endif

__device__ __forceinline__ unsigned xb_ld(unsigned* p)              { return __hip_atomic_load(p, __ATOMIC_RELAXED, __HIP_MEMORY_SCOPE_AGENT); }
__device__ __forceinline__ unsigned xb_add(unsigned* p, unsigned v) { return __hip_atomic_fetch_add(p, v, __ATOMIC_RELAXED, __HIP_MEMORY_SCOPE_AGENT); }
__device__ __forceinline__ unsigned xb_xcc_id() { return (unsigned)__builtin_amdgcn_s_getreg((3 << 11) | 20) & 0xFu; }
#define XB_SPIN(cond, bar) do { unsigned _sp = 0; while (cond) { __builtin_amdgcn_s_sleep(XB_SLEEP); \
    if ((++_sp & 255u) == 0u) { if (xb_ld(&(bar)[XB_TMO])) break; if (_sp > XB_SPIN_CAP) { atomicAdd(&(bar)[XB_TMO], 1u); break; } } } } while (0)

struct XcdBarrier { unsigned* bar; unsigned x; volatile LAS unsigned* st; };

__device__ __forceinline__ XcdBarrier xcd_barrier_post(unsigned* bar, volatile LAS unsigned* st) {
    XcdBarrier b; b.bar = bar; b.x = xb_xcc_id(); b.st = st;
    if (threadIdx.x == 0) (void)xb_add(&bar[XB_XCNT(b.x)], 1u);
    return b;
}
__device__ __forceinline__ void xcd_barrier_complete(unsigned* bar, unsigned x, unsigned& nloc, unsigned& nx) {
    const unsigned G = gridDim.x * gridDim.y * gridDim.z;
    unsigned sum, cnt, mine, sp = 0u;
    for (;;) {
        sum = 0u; cnt = 0u; mine = 0u;
#pragma unroll
        for (unsigned j = 0; j < 16; ++j) { const unsigned c = xb_ld(&bar[XB_XCNT(j)]); sum += c; cnt += (c > 0u) ? 1u : 0u; mine = (j == x) ? c : mine; }
        if (sum == G) break;
        __builtin_amdgcn_s_sleep(XB_SLEEP);
        if ((++sp & 255u) == 0u) { if (xb_ld(&bar[XB_TMO])) break; if (sp > XB_SPIN_CAP) { atomicAdd(&bar[XB_TMO], 1u); break; } }
    }
    nloc = mine > 0u ? mine : 1u; nx = cnt > 0u ? cnt : 1u;
}
__device__ __forceinline__ void xcd_barrier(const XcdBarrier& b) {
    asm volatile("s_waitcnt vmcnt(0)" ::: "memory");
    __syncthreads();
    if (threadIdx.x == 0) {
        unsigned* bar = b.bar;
        __builtin_amdgcn_s_waitcnt(0);
        unsigned nloc = b.st[0], nx = b.st[1];
        if (nloc == 0u) { xcd_barrier_complete(bar, b.x, nloc, nx); b.st[0] = nloc; b.st[1] = nx; }
        const unsigned old = xb_add(&bar[XB_XSUB(b.x)], 1u);
        const unsigned gen = old / nloc;
        if (old + 1u == (gen + 1u) * nloc) {
            __builtin_amdgcn_fence(__ATOMIC_RELEASE, "agent");
            asm volatile("s_waitcnt vmcnt(0)" ::: "memory");
            const unsigned og = xb_add(&bar[XB_TOP], 1u);
            const unsigned tg = og / nx;
            if (og + 1u != (tg + 1u) * nx) XB_SPIN(xb_ld(&bar[XB_TOP]) < (tg + 1u) * nx, bar);
            xb_add(&bar[XB_XGEN(b.x)], 1u);
            asm volatile("buffer_inv sc1" ::: "memory");
            asm volatile("s_waitcnt vmcnt(0)" ::: "memory");
        } else {
            asm volatile("buffer_inv sc1" ::: "memory");
            XB_SPIN(xb_ld(&bar[XB_XGEN(b.x)]) == gen, bar);
            asm volatile("s_waitcnt vmcnt(0)" ::: "memory");
        }
    }
    __syncthreads();
}

struct Args { const float* in[32]; float* out; unsigned char* ws; int ph_lo, ph_hi; };
enum { I_X = 0, I_C, I_CTX, I_CCTX, I_ADAW, I_ADAB, I_NORMG, I_MU, I_WRKV, I_W0, I_W1, I_W2, I_A0, I_A1, I_A2, I_G1, I_G2, I_KK, I_KA, I_RK, I_GNW, I_GNB, I_WO,
       I_WIN, I_CONV, I_WOUT, I_ROUTW, I_ROUTB, I_MGATE, I_MUP, I_MDOWN, I_FINALG };

struct Frame {
    LAS unsigned char* lds;
    int tid, lane, wave, G, vcu, gw, NGW;
};


__device__ __forceinline__ void tr_item(const float* W, int ldw, int k0, int n0, bf16_t* dst, int ldd, int drow0, const float* mu, LAS float* scr, int lane) {
#pragma unroll 8
    for (int i = 0; i < 32; ++i) { const int kk = 2 * i + (lane >> 5); scr[kk * 33 + (lane & 31)] = __builtin_nontemporal_load(W + (size_t)(k0 + kk) * ldw + n0 + (lane & 31)); }
    LDS_WAIT(); asm volatile("" ::: "memory");
    const int c = lane & 7;
    float m[8];
#pragma unroll
    for (int q = 0; q < 8; ++q) m[q] = mu ? mu[k0 + 8 * c + q] : 0.f;
#pragma unroll
    for (int j = 0; j < 4; ++j) { const int n = (lane >> 3) + 8 * j; const LAS float* s = scr + (8 * c) * 33 + n;
        float v[8];
#pragma unroll
        for (int q = 0; q < 8; ++q) v[q] = s[q * 33];
        bf16_t* drow = dst + (size_t)(drow0 + n) * ldd + k0 + 8 * c;
        if (!mu) {
            u32x4 o; o.x = pk2(v[0], v[1]); o.y = pk2(v[2], v[3]); o.z = pk2(v[4], v[5]); o.w = pk2(v[6], v[7]);
            __builtin_nontemporal_store(o, (u32x4*)drow);
        } else {
            u32x4 o; o.x = pk2(v[0] * (1.f - m[0]), v[1] * (1.f - m[1])); o.y = pk2(v[2] * (1.f - m[2]), v[3] * (1.f - m[3]));
            o.z = pk2(v[4] * (1.f - m[4]), v[5] * (1.f - m[5])); o.w = pk2(v[6] * (1.f - m[6]), v[7] * (1.f - m[7]));
            *(u32x4*)drow = o;
            u32x4 p; p.x = pk2(v[0] * 0.5f * m[0], v[1] * 0.5f * m[1]); p.y = pk2(v[2] * 0.5f * m[2], v[3] * 0.5f * m[3]);
            p.z = pk2(v[4] * 0.5f * m[4], v[5] * 0.5f * m[5]); p.w = pk2(v[6] * 0.5f * m[6], v[7] * 0.5f * m[7]);
            *(u32x4*)(drow + (size_t)384 * ldd) = p;
        }
    }
    LDS_WAIT(); asm volatile("" ::: "memory");
}
__device__ __forceinline__ void tr_job_item(const float* W, int ldw, int N, bf16_t* dst, int ldd, int drow_base, bool il, const float* mu, int item, LAS float* scr, int lane) {
    const int nblk = N / 32, kb = item / nblk, nb = item % nblk, n0 = 32 * nb;
    const int dr = drow_base + (il ? ((n0 >> 7) * 256 + (n0 & 127)) : n0);
    tr_item(W, ldw, 64 * kb, n0, dst, ldd, dr, mu, scr, lane);
}

__device__ __forceinline__ void p0_prologue(const Frame& F, const Args& A) {
    unsigned char* ws = A.ws;
    LAS float* scr = (LAS float*)(F.lds + F.wave * 16384);
    bf16_t* WRKV = (bf16_t*)(ws + WS_WRKV); bf16_t* WL = (bf16_t*)(ws + WS_WL); bf16_t* G2 = (bf16_t*)(ws + WS_G2);
    bf16_t* WO = (bf16_t*)(ws + WS_WO); bf16_t* WIN = (bf16_t*)(ws + WS_WIN); bf16_t* WOUT = (bf16_t*)(ws + WS_WOUT);
    const float* mu = A.in[I_MU];
    constexpr int NIT = 3 * 512 + 4 * 32 + 64 + 64 + 512 + 3 * 512 + 512;
    for (int it = F.gw; it < NIT; it += F.NGW) {
        int r = it;
        if (r < 1536) { const int p = r / 512; tr_job_item(A.in[I_WRKV] + (size_t)p * D * D, D, D, WRKV, D, p * 1024, false, nullptr, r % 512, scr, F.lane); continue; } r -= 1536;
        if (r < 64) { const int dir = r / 32; tr_job_item(A.in[I_W1] + (size_t)dir * D * 64, 64, 64, WL, D, dir * 64, false, mu + 3 * D, r % 32, scr, F.lane); continue; } r -= 64;
        if (r < 64) { const int dir = r / 32; tr_job_item(A.in[I_A1] + (size_t)dir * D * 64, 64, 64, WL, D, 128 + dir * 64, false, mu + 4 * D, r % 32, scr, F.lane); continue; } r -= 64;
        if (r < 64) { tr_job_item(A.in[I_G1], 128, 128, WL, D, 256, false, mu + 5 * D, r, scr, F.lane); continue; } r -= 64;
        if (r < 64) { tr_job_item(A.in[I_G2], D, D, G2, 256, 0, false, nullptr, r, scr, F.lane); continue; } r -= 64;
        if (r < 512) { tr_job_item(A.in[I_WO], D, D, WO, D, 0, false, nullptr, r, scr, F.lane); continue; } r -= 512;
        if (r < 512) { tr_job_item(A.in[I_WIN], 3 * D, D, WIN, D, 0, false, nullptr, r, scr, F.lane); continue; } r -= 512;
        if (r < 512) { tr_job_item(A.in[I_WIN] + D, 3 * D, D, WIN, D, 1024, true, nullptr, r, scr, F.lane); continue; } r -= 512;
        if (r < 512) { tr_job_item(A.in[I_WIN] + 2 * D, 3 * D, D, WIN, D, 1024 + 128, true, nullptr, r, scr, F.lane); continue; } r -= 512;
        tr_job_item(A.in[I_WOUT], D, D, WOUT, D, 0, false, nullptr, r, scr, F.lane);
    }
    {
        const int gt = F.vcu * NTHREADS + F.tid, NGT = F.G * NTHREADS;
        u32x4 z = (u32x4){0u, 0u, 0u, 0u};
        for (int i = gt; i < 16384; i += NGT) { const int row = i >> 4, q = i & 15; *(u32x4*)(G2 + (size_t)row * 256 + 128 + q * 8) = z; }
    }
    __syncthreads();
    {
        LAS float* st = (LAS float*)F.lds;
        LAS float* red = st + 9 * 1024;
#pragma unroll 6
        for (int i = F.tid; i < 9 * 1024; i += NTHREADS) { const float v = (i < 8192) ? A.in[I_C][i] : A.in[I_CCTX][i - 8192]; st[i] = v / (1.f + __expf(-v)); }
        __syncthreads();
        float* MOD = (float*)(ws + WS_MOD);
        for (int u = blockIdx.x; u < 256; u += F.G) {
            const int l = u >> 7, e0 = (u & 127) * 48;
            if (F.tid < 384) {
                const int q = F.tid % 12, dg = F.tid / 12;
                f32x4 acc[9];
#pragma unroll
                for (int r = 0; r < 9; ++r) acc[r] = (f32x4){0.f, 0.f, 0.f, 0.f};
                const float* wb = A.in[I_ADAW] + (size_t)l * D * 6144 + e0 + 4 * q;
#pragma unroll 4
                for (int i = 0; i < 32; ++i) { const int d = dg + 32 * i; const f32x4 w = __builtin_nontemporal_load((const f32x4*)(wb + (size_t)d * 6144));
#pragma unroll
                    for (int r = 0; r < 9; ++r) acc[r] += st[r * 1024 + d] * w; }
#pragma unroll
                for (int r = 0; r < 9; ++r) *(LAS f32x4*)(red + (dg * 9 + r) * 48 + 4 * q) = acc[r];
            }
            __syncthreads();
            if (F.tid < 432) { const int r = F.tid / 48, ci = F.tid % 48; float s = A.in[I_ADAB][l * 6144 + e0 + ci];
                for (int dg = 0; dg < 32; ++dg) s += red[(dg * 9 + r) * 48 + ci];
                MOD[((size_t)l * 9 + r) * 6144 + e0 + ci] = s; }
            __syncthreads();
        }
    }
}

__device__ __forceinline__ void p1_load_norm(const float* row, const f32x4 (&gsc)[4], const f32x4 (&sh)[4], f32x4 (&o)[4], int lane) {
    const f32x4* xr = (const f32x4*)row + lane; float s = 0.f;
#pragma unroll
    for (int j = 0; j < 4; ++j) { o[j] = __builtin_nontemporal_load(xr + 64 * j); s += (o[j].x * o[j].x + o[j].y * o[j].y) + (o[j].z * o[j].z + o[j].w * o[j].w); }
    const float rstd = rsqrtf(wave_sum(s) * (1.f / D) + RMS_EPS);
#pragma unroll
    for (int j = 0; j < 4; ++j) o[j] = o[j] * rstd * gsc[j] + sh[j];
}
__device__ __forceinline__ void ld_row_bf16(const bf16_t* row, f32x4 (&o)[4], int lane) {
#pragma unroll
    for (int j = 0; j < 4; ++j) { const u32x2 q = *(const u32x2*)(row + 4 * lane + 256 * j); o[j] = (f32x4){bflo(q.x), bfhi(q.x), bflo(q.y), bfhi(q.y)}; }
}
__device__ __forceinline__ void norm_rows(f32x4 (&o)[4], const f32x4 (&gsc)[4], const f32x4 (&sh)[4]) {
    float s = 0.f;
#pragma unroll
    for (int j = 0; j < 4; ++j) s += (o[j].x * o[j].x + o[j].y * o[j].y) + (o[j].z * o[j].z + o[j].w * o[j].w);
    const float rstd = rsqrtf(wave_sum(s) * (1.f / D) + RMS_EPS);
#pragma unroll
    for (int j = 0; j < 4; ++j) o[j] = o[j] * rstd * gsc[j] + sh[j];
}
__device__ __forceinline__ void st_bf4(bf16_t* p, const f32x4 v) { u32x2 w; w.x = pk2(v.x, v.y); w.y = pk2(v.z, v.w); *(u32x2*)p = w; }

__device__ __forceinline__ void p1_mix(const Frame& F, const Args& A) {
    const float* MOD = (const float*)(A.ws + WS_MOD);
    bf16_t* XM = (bf16_t*)(A.ws + WS_XM);
    const float* mu = A.in[I_MU]; const float* ng = A.in[I_NORMG];
    for (int u = F.gw; u < 4096; u += F.NGW) {
        const bool isctx = u >= 2048; int t0, rowlen, modrow, nrows; const float* src; size_t orow0;
        if (!isctx) { t0 = u * 16; rowlen = GRIDW; modrow = t0 / TL; src = A.in[I_X] + (size_t)t0 * D; orow0 = t0; nrows = 16; }
        else { t0 = u - 2048; rowlen = TCX; modrow = 8; src = A.in[I_CTX] + (size_t)t0 * D; orow0 = (size_t)ML + t0; nrows = 1; }
        const int pos0 = t0 % rowlen;
        const float* mrow = MOD + (size_t)modrow * 6144;
        f32x4 gsc[4], sh[4], m0[4], m1[4], m2[4];
#pragma unroll
        for (int j = 0; j < 4; ++j) { const int c = 4 * F.lane + 256 * j;
            const f32x4 g = *(const f32x4*)(ng + c), sc = *(const f32x4*)(mrow + 1024 + c);
            gsc[j] = g * (1.f + sc); sh[j] = *(const f32x4*)(mrow + c);
            m0[j] = *(const f32x4*)(mu + c); m1[j] = *(const f32x4*)(mu + D + c); m2[j] = *(const f32x4*)(mu + 2 * D + c); }
        f32x4 prev[4], cur[4], nxt[4];
        if (pos0 > 0) p1_load_norm(src - D, gsc, sh, prev, F.lane);
        else {
#pragma unroll
            for (int j = 0; j < 4; ++j) prev[j] = (f32x4){0.f, 0.f, 0.f, 0.f}; }
        p1_load_norm(src, gsc, sh, cur, F.lane);
        for (int i = 0; i < nrows; ++i) {
            if (pos0 + i + 1 < rowlen) p1_load_norm(src + (size_t)(i + 1) * D, gsc, sh, nxt, F.lane);
            else {
#pragma unroll
                for (int j = 0; j < 4; ++j) nxt[j] = (f32x4){0.f, 0.f, 0.f, 0.f}; }
            const size_t orw = orow0 + i; bf16_t* orow = XM + ((orw >> 8) * 16 * 256 + (orw & 255)) * 64 + (size_t)(F.lane >> 4) * (256 * 64) + 4 * (F.lane & 15);
#pragma unroll
            for (int j = 0; j < 4; ++j) {
                const f32x4 s = prev[j] + nxt[j], xx = 0.5f * s - cur[j];
                st_bf4(orow + (size_t)j * (4 * 256 * 64), cur[j] + xx * m0[j]);
                st_bf4(orow + (size_t)MA * D + (size_t)j * (4 * 256 * 64), cur[j] + xx * m1[j]);
                st_bf4(orow + (size_t)2 * MA * D + (size_t)j * (4 * 256 * 64), cur[j] + xx * m2[j]);
                st_bf4(orow + (size_t)3 * MA * D + (size_t)j * (4 * 256 * 64), cur[j]);
                prev[j] = cur[j]; cur[j] = nxt[j];
            }
        }
    }
}

struct SchedRKV {
    const char* xm; const char* w; const char* wl; int G, c;
    __device__ __forceinline__ bool next(int i, pg8::Unit& u) const {
        int L;
        if (G == 256) { if (i >= (c < 216 ? 8 : 7)) return false; L = c + 256 * i; }
        else { L = i * G + c; if (L >= 2008) return false; }
        if (L < 1536) pg8::swz_tile(L, 128, 12, u.pm, u.pn);
        else if (L < 1600) { const int r = L - 1536; u.pm = 128 + (r >> 3); u.pn = 4 + (r & 7); }
        else { const int q = L - 1600, x = q & 7, off = q >> 3; u.pm = 17 * x + off / 3; u.pn = 12 + off % 3; }
        if (u.pn < 12) { u.a = xm + (size_t)(u.pn >> 2) * MA * D * 2 + (size_t)u.pm * 256 * D * 2; u.b = w + (size_t)u.pn * 256 * D * 2; }
        else { u.a = xm + (size_t)3 * MA * D * 2 + (size_t)u.pm * 256 * D * 2; u.b = wl + (size_t)(u.pn - 12) * 256 * D * 2; }
        u.nt = 16; u.rows = nullptr; return true;
    }
};
struct EpiRKV {
    static constexpr bool PERM = true;
    bf16_t *R, *K, *KC, *V, *LP;
    __device__ __forceinline__ void operator()(const f32x4 (&acc)[2][2][4][2], const pg8::Unit& u, int wr, int wc, int fr, int fq) const {
        const int grp = u.pn >> 2; int prow = u.pm * 256; bf16_t* base;
        if (grp == 0) base = R; else if (grp == 1) { if (u.pm < 128) base = K; else { base = KC; prow -= ML; } } else if (grp == 2) base = V; else base = LP;
        const int ldc = grp == 3 ? 768 : D;
        const int row0 = prow + wr * 64 + fr, col0 = (u.pn & 3) * 256 + wc * 32 + 8 * fq;
#pragma unroll
        for (int ai = 0; ai < 2; ++ai)
#pragma unroll
            for (int m = 0; m < 4; ++m) { bf16_t* rowp = base + (size_t)(row0 + ai * 128 + m * 16) * ldc + col0;
#pragma unroll
                for (int bj = 0; bj < 2; ++bj) { const f32x4 v0 = acc[ai][bj][m][0], v1 = acc[ai][bj][m][1];
                    u32x4 w; w.x = pg8::cvt_pk_bf16(v0[0], v0[1]); w.y = pg8::cvt_pk_bf16(v0[2], v0[3]); w.z = pg8::cvt_pk_bf16(v1[0], v1[1]); w.w = pg8::cvt_pk_bf16(v1[2], v1[3]);
                    *(u32x4*)(rowp + bj * 128) = w; } }
    }
};
__device__ __forceinline__ void p2b_combine(const Frame& F, const Args& A) {
    const bf16_t* LP = (const bf16_t*)(A.ws + WS_LP); bf16_t* LWA = (bf16_t*)(A.ws + WS_LWA); bf16_t* LG = (bf16_t*)(A.ws + WS_LG);
    if (F.lane >= 48) return;
    const int c = 8 * F.lane, kind = F.lane >> 4;
    const float ks = kind == 0 ? -2.f : -1.f, al = kind == 0 ? 2.f : 1.f, be = kind == 0 ? -1.f : 0.f;
    const u32x4 zz = (u32x4){0u, 0u, 0u, 0u};
#define P2B_ROW(t_, a_, l_, r_) do { \
        const unsigned aw[4] = {(a_).x, (a_).y, (a_).z, (a_).w}, lw[4] = {(l_).x, (l_).y, (l_).z, (l_).w}, rw[4] = {(r_).x, (r_).y, (r_).z, (r_).w}; unsigned o[4]; \
        _Pragma("unroll") for (int q = 0; q < 4; ++q) { \
            float v0 = bflo(aw[q]) + (bflo(lw[q]) + bflo(rw[q])), v1 = bfhi(aw[q]) + (bfhi(lw[q]) + bfhi(rw[q])); \
            if (kind != 1) { v0 = al * __builtin_amdgcn_rcpf(1.f + __expf(ks * v0)) + be; v1 = al * __builtin_amdgcn_rcpf(1.f + __expf(ks * v1)) + be; } \
            o[q] = pk2(v0, v1); } \
        const u32x4 ow = (u32x4){o[0], o[1], o[2], o[3]}; \
        if (kind < 2) *(u32x4*)(LWA + (size_t)(t_) * 256 + c) = ow; \
        else if ((t_) < ML) *(u32x4*)(LG + (size_t)(t_) * 256 + (c - 256)) = ow; } while (0)
    for (int u = F.gw; u < 4096; u += F.NGW) {
        const int t0 = u * 8, pos0 = t0 % GRIDW;
        const bf16_t* p = LP + (size_t)t0 * 768 + c;
        u32x4 a[8], b[10];
#pragma unroll
        for (int i = 0; i < 8; ++i) { a[i] = *(const u32x4*)(p + (size_t)i * 768); b[i + 1] = *(const u32x4*)(p + (size_t)i * 768 + 384); }
        b[0] = zz; b[9] = zz;
        if (pos0 > 0) b[0] = *(const u32x4*)(p - 768 + 384);
        if (pos0 + 8 < GRIDW) b[9] = *(const u32x4*)(p + (size_t)8 * 768 + 384);
#pragma unroll
        for (int i = 0; i < 8; ++i) P2B_ROW(t0 + i, a[i], b[i], b[i + 2]);
    }
    for (int u = F.gw; u < MC; u += F.NGW) {
        const int t = ML + u, pos = u % TCX;
        const bf16_t* p = LP + (size_t)t * 768 + c;
        const u32x4 a0 = *(const u32x4*)p; u32x4 bl = zz, br = zz;
        if (pos > 0) bl = *(const u32x4*)(p - 768 + 384);
        if (pos + 1 < TCX) br = *(const u32x4*)(p + 768 + 384);
        P2B_ROW(t, a0, bl, br);
    }
#undef P2B_ROW
}
struct SchedPlain {
    const char* a; const char* b; int nM, nN, lda, ldb, nt, G, c;
    __device__ __forceinline__ bool next(int i, pg8::Unit& u) const {
        const int L = i * G + c; if (L >= nM * nN) return false;
        pg8::swz_tile(L, nM, nN, u.pm, u.pn);
        u.a = a + (size_t)u.pm * 256 * lda * 2; u.b = b + (size_t)u.pn * 256 * ldb * 2; u.nt = nt; u.rows = nullptr; return true;
    }
};
struct EpiBf16 {
    static constexpr bool PERM = true;
    bf16_t* O; int ldc;
    __device__ __forceinline__ void operator()(const f32x4 (&acc)[2][2][4][2], const pg8::Unit& u, int wr, int wc, int fr, int fq) const {
        const int row0 = u.pm * 256 + wr * 64 + fr, col0 = u.pn * 256 + wc * 32 + 8 * fq;
#pragma unroll
        for (int ai = 0; ai < 2; ++ai)
#pragma unroll
            for (int m = 0; m < 4; ++m) { bf16_t* rowp = O + (size_t)(row0 + ai * 128 + m * 16) * ldc + col0;
#pragma unroll
                for (int bj = 0; bj < 2; ++bj) { const f32x4 v0 = acc[ai][bj][m][0], v1 = acc[ai][bj][m][1];
                    u32x4 w; w.x = pg8::cvt_pk_bf16(v0[0], v0[1]); w.y = pg8::cvt_pk_bf16(v0[2], v0[3]); w.z = pg8::cvt_pk_bf16(v1[0], v1[1]); w.w = pg8::cvt_pk_bf16(v1[2], v1[3]);
                    *(u32x4*)(rowp + bj * 128) = w; } }
    }
};
struct EpiRes {
    static constexpr bool PERM = true;
    const float* basef; bf16_t* hb; const float* gate;
    __device__ __forceinline__ void operator()(const f32x4 (&acc)[2][2][4][2], const pg8::Unit& u, int wr, int wc, int fr, int fq) const {
        const int row0 = u.pm * 256 + wr * 64 + fr, col0 = u.pn * 256 + wc * 32 + 8 * fq;
        const float* gp = gate + (size_t)(u.pm >> 4) * 6144 + col0;
        f32x4 gv[2][2];
#pragma unroll
        for (int bj = 0; bj < 2; ++bj)
#pragma unroll
            for (int n = 0; n < 2; ++n) gv[bj][n] = *(const f32x4*)(gp + bj * 128 + n * 4);
#pragma unroll
        for (int ai = 0; ai < 2; ++ai)
#pragma unroll
            for (int m = 0; m < 4; ++m) { const size_t ro = (size_t)(row0 + ai * 128 + m * 16) * D + col0;
#pragma unroll
                for (int bj = 0; bj < 2; ++bj) {
                    f32x4 b0, b1;
                    if (basef) { b0 = __builtin_nontemporal_load((const f32x4*)(basef + ro + bj * 128)); b1 = __builtin_nontemporal_load((const f32x4*)(basef + ro + bj * 128 + 4)); }
                    else { const u32x4 q = *(const u32x4*)(hb + ro + bj * 128); b0 = (f32x4){bflo(q.x), bfhi(q.x), bflo(q.y), bfhi(q.y)}; b1 = (f32x4){bflo(q.z), bfhi(q.z), bflo(q.w), bfhi(q.w)}; }
                    const f32x4 v0 = b0 + gv[bj][0] * acc[ai][bj][m][0], v1 = b1 + gv[bj][1] * acc[ai][bj][m][1];
                    u32x4 w; w.x = pg8::cvt_pk_bf16(v0[0], v0[1]); w.y = pg8::cvt_pk_bf16(v0[2], v0[3]); w.z = pg8::cvt_pk_bf16(v1[0], v1[1]); w.w = pg8::cvt_pk_bf16(v1[2], v1[3]);
                    *(u32x4*)(hb + ro + bj * 128) = w; } }
    }
};
struct SchedMoe {
    const char* a; const char* b; const int* tile; int lda, ldb, nt, G, c; size_t estride;
    __device__ __forceinline__ bool next(int i, pg8::Unit& u) const {
        const int ntl = tile[0]; const int L = i * G + c; if (L >= ntl * 4) return false;
        u.pm = L >> 2; u.pn = L & 3; const int e = tile[16 + u.pm];
        u.a = a + (size_t)u.pm * 256 * lda * 2; u.b = b + (size_t)e * estride + (size_t)u.pn * 256 * ldb * 2; u.nt = nt; u.rows = nullptr; return true;
    }
};
struct SchedMoeG {
    const char* a; const char* b; const int* tile; const int* inv; int ldb, nt, G, c; size_t estride;
    __device__ __forceinline__ bool next(int i, pg8::Unit& u) const {
        const int ntl = tile[0]; const int L = i * G + c; if (L >= ntl * 4) return false;
        const int ng = ntl >> 3;
        if ((L >> 5) < ng) { u.pm = (L >> 5) * 8 + (L & 7); u.pn = (L >> 3) & 3; } else { const int r_ = L - ng * 32; u.pm = ng * 8 + (r_ >> 2); u.pn = r_ & 3; }
        const int e = tile[16 + u.pm];
        u.a = a; u.b = b + (size_t)e * estride + (size_t)u.pn * 256 * ldb * 2; u.nt = nt; u.rows = inv + u.pm * 256; return true;
    }
};
struct EpiGateUp {
    static constexpr bool PERM = true;
    bf16_t* H;
    __device__ __forceinline__ void operator()(const f32x4 (&acc)[2][2][4][2], const pg8::Unit& u, int wr, int wc, int fr, int fq) const {
        const int row0 = u.pm * 256 + wr * 64 + fr, col0 = u.pn * 128 + wc * 32 + 8 * fq;
#pragma unroll
        for (int ai = 0; ai < 2; ++ai)
#pragma unroll
            for (int m = 0; m < 4; ++m) { bf16_t* rowp = H + (size_t)(row0 + ai * 128 + m * 16) * ED + col0;
                f32x4 h0, h1;
#pragma unroll
                for (int q = 0; q < 4; ++q) { const float g0 = acc[ai][0][m][0][q], g1 = acc[ai][0][m][1][q];
                    h0[q] = g0 * __builtin_amdgcn_rcpf(1.f + __expf(-g0)) * acc[ai][1][m][0][q]; h1[q] = g1 * __builtin_amdgcn_rcpf(1.f + __expf(-g1)) * acc[ai][1][m][1][q]; }
                u32x4 w; w.x = pg8::cvt_pk_bf16(h0[0], h0[1]); w.y = pg8::cvt_pk_bf16(h0[2], h0[3]); w.z = pg8::cvt_pk_bf16(h1[0], h1[1]); w.w = pg8::cvt_pk_bf16(h1[2], h1[3]);
                *(u32x4*)rowp = w; }
    }
};
struct EpiGateUpPub {
    static constexpr bool PERM = true;
    unsigned char* H; unsigned* rdy;
    __device__ __forceinline__ void operator()(const f32x4 (&acc)[2][2][4][2], const pg8::Unit& u, int wr, int wc, int fr, int fq) const {
        const int row0 = u.pm * 256 + wr * 64 + fr, col0 = u.pn * 128 + wc * 32 + 8 * fq;
        const __amdgpu_buffer_rsrc_t rsrc = __builtin_amdgcn_make_buffer_rsrc(H, 0, 69632 * ED * 2, 0x00020000);
#pragma unroll
        for (int ai = 0; ai < 2; ++ai)
#pragma unroll
            for (int m = 0; m < 4; ++m) {
                f32x4 h0, h1;
#pragma unroll
                for (int q = 0; q < 4; ++q) { const float g0 = acc[ai][0][m][0][q], g1 = acc[ai][0][m][1][q];
                    h0[q] = g0 * __builtin_amdgcn_rcpf(1.f + __expf(-g0)) * acc[ai][1][m][0][q]; h1[q] = g1 * __builtin_amdgcn_rcpf(1.f + __expf(-g1)) * acc[ai][1][m][1][q]; }
                u32x4 w; w.x = pg8::cvt_pk_bf16(h0[0], h0[1]); w.y = pg8::cvt_pk_bf16(h0[2], h0[3]); w.z = pg8::cvt_pk_bf16(h1[0], h1[1]); w.w = pg8::cvt_pk_bf16(h1[2], h1[3]);
                __builtin_amdgcn_raw_buffer_store_b128(w, rsrc, ((row0 + ai * 128 + m * 16) * ED + col0) * 2, 0, 16);
            }
        asm volatile("s_waitcnt vmcnt(0)" ::: "memory");
        if ((threadIdx.x & 63) == 0) __hip_atomic_fetch_add(rdy + 64 * u.pm, 1u, __ATOMIC_RELAXED, __HIP_MEMORY_SCOPE_AGENT);
    }
};
struct SchedMoeD {
    const char* hh; const char* wdn; const int* tile; unsigned* rdy; unsigned* tmo; int G, c;
    __device__ __forceinline__ bool next(int j, pg8::Unit& u) const {
        const int n1 = tile[0] * 4, q = n1 / G, x = n1 - q * G; int L;
        if (q >= 1 && 3 * x <= G) {
            int nd, base;
            if (c < x) { nd = q - 1; base = c * (q - 1); } else if (c < 3 * x) { nd = q + 1; base = x * (q - 1) + (c - x) * (q + 1); } else { nd = q; base = x * (q - 1) + 2 * x * (q + 1) + (c - 3 * x) * q; }
            if (j >= nd) return false; L = base + j;
        } else { L = j * G + (G - 1 - c); if (L >= n1) return false; }
        u.pm = L >> 2; u.pn = L & 3; u.kind = 1; const int e = tile[16 + u.pm];
        u.a = hh; u.rows = nullptr; u.row0 = u.pm * 256; u.pa = ED * 2; u.pb = ED * 2; u.b = wdn + (size_t)e * (1 * MiB) + (size_t)u.pn * 256 * ED * 2; u.nt = 8;
        return true;
    }
    __device__ __forceinline__ void a_ready(const pg8::Unit& u) const {
        if (threadIdx.x < 64) {
            asm volatile("buffer_inv sc1" ::: "memory");
            unsigned* w = rdy + 64 * u.pm; unsigned polls = 0;
            while ((unsigned)__builtin_amdgcn_readfirstlane(__hip_atomic_load(w, __ATOMIC_RELAXED, __HIP_MEMORY_SCOPE_AGENT)) < 32u) {
                if ((++polls & 255u) == 0u) { if (__builtin_amdgcn_readfirstlane(__hip_atomic_load(tmo, __ATOMIC_RELAXED, __HIP_MEMORY_SCOPE_AGENT)) != 0u) break;
                    if (polls > (1u << 22)) { if (threadIdx.x == 0) __hip_atomic_store(tmo, 1u, __ATOMIC_RELAXED, __HIP_MEMORY_SCOPE_AGENT); break; } }
                __builtin_amdgcn_s_sleep(8); }
            asm volatile("s_waitcnt vmcnt(0)" ::: "memory");
        }
        asm volatile("" ::: "memory"); __builtin_amdgcn_s_barrier(); asm volatile("" ::: "memory");
    }
};
struct EpiWin {
    static constexpr bool PERM = true;
    bf16_t *BG, *U;
    __device__ __forceinline__ void operator()(const f32x4 (&acc)[2][2][4][2], const pg8::Unit& u, int wr, int wc, int fr, int fq) const {
        const int row0 = u.pm * 256 + wr * 64 + fr;
        if (u.pn < 4) {
            const int col0 = u.pn * 256 + wc * 32 + 8 * fq;
#pragma unroll
            for (int ai = 0; ai < 2; ++ai)
#pragma unroll
                for (int m = 0; m < 4; ++m) { bf16_t* rowp = BG + (size_t)(row0 + ai * 128 + m * 16) * D + col0;
#pragma unroll
                    for (int bj = 0; bj < 2; ++bj) { const f32x4 v0 = acc[ai][bj][m][0], v1 = acc[ai][bj][m][1];
                        u32x4 w; w.x = pg8::cvt_pk_bf16(v0[0], v0[1]); w.y = pg8::cvt_pk_bf16(v0[2], v0[3]); w.z = pg8::cvt_pk_bf16(v1[0], v1[1]); w.w = pg8::cvt_pk_bf16(v1[2], v1[3]);
                        *(u32x4*)(rowp + bj * 128) = w; } }
        } else {
            const int col0 = (u.pn - 4) * 128 + wc * 32 + 8 * fq;
#pragma unroll
            for (int ai = 0; ai < 2; ++ai)
#pragma unroll
                for (int m = 0; m < 4; ++m) { bf16_t* rowp = U + (size_t)(row0 + ai * 128 + m * 16) * D + col0;
                    const f32x4 v0 = acc[ai][0][m][0] * acc[ai][1][m][0], v1 = acc[ai][0][m][1] * acc[ai][1][m][1];
                    u32x4 w; w.x = pg8::cvt_pk_bf16(v0[0], v0[1]); w.y = pg8::cvt_pk_bf16(v0[2], v0[3]); w.z = pg8::cvt_pk_bf16(v1[0], v1[1]); w.w = pg8::cvt_pk_bf16(v1[2], v1[3]);
                    *(u32x4*)rowp = w; }
        }
    }
};

namespace sc {
constexpr int MPB = 144;
constexpr int MB = 64 * MPB;
constexpr int B_RAWK = 0, B_NAB = 0, B_RAWR = 1, B_NAK = 1, B_LW = 2, B_MRB = 2, B_LA = 3, B_MRK = 3, B_AT = 4, B_BT = 5, B_KT = 6,
              B_RT = 7, B_EL = 8, B_BTT = 9, B_KTT = 10, B_VTT = 11, B_T = 12, B_EH = 12, B_W2T = 13, B_A2T = 14, B_RK = 15;
constexpr int O_INVN = 16 * MB, O_BON = O_INVN + 256, O_PV = O_BON + 1024, O_KKS = O_PV + 256, O_NF = O_KKS + 256, O_TRI = O_NF + 4096, O_YX = O_TRI + 2048, O_TC = O_YX + 4096;
static_assert(O_TC + 2048 <= LDSCTL_OFF, "scan LDS");
__device__ __forceinline__ bf16x8 ldf(const LAS unsigned char* p) { return *(const LAS bf16x8*)p; }
__device__ __forceinline__ bf16x8 ldfp(const LAS unsigned char* p) {
    const LAS unsigned char* p2 = p + 32; asm volatile("" : "+v"(p2));
    const u32x2 lo = *(const LAS u32x2*)p, hi = *(const LAS u32x2*)p2;
    return __builtin_bit_cast(bf16x8, (u32x4){lo.x, lo.y, hi.x, hi.y});
}
__device__ __forceinline__ bf16x8 packfrag(const f32x4 x0, const f32x4 x1) {
    return __builtin_bit_cast(bf16x8, (u32x4){pg8::cvt_pk_bf16(x0[0], x0[1]), pg8::cvt_pk_bf16(x0[2], x0[3]), pg8::cvt_pk_bf16(x1[0], x1[1]), pg8::cvt_pk_bf16(x1[2], x1[3])});
}
__device__ __forceinline__ void st4(LAS unsigned char* p, const f32x4 d) { *(LAS u32x2*)p = (u32x2){pg8::cvt_pk_bf16(d[0], d[1]), pg8::cvt_pk_bf16(d[2], d[3])}; }
__device__ __forceinline__ f32x4 mma(const bf16x8 a, const bf16x8 b, const f32x4 c) { return __builtin_amdgcn_mfma_f32_16x16x32_bf16(a, b, c, 0, 0, 0); }
__device__ __forceinline__ float ld1(const LAS unsigned char* p) { return __builtin_bit_cast(float, (unsigned)(*(const LAS unsigned short*)p) << 16); }
__device__ __forceinline__ void st1(LAS unsigned char* p, float v) { *(LAS unsigned short*)p = (unsigned short)f2bf(v); }
__device__ __forceinline__ float fsig(float x) { return __builtin_amdgcn_rcpf(1.f + __expf(-x)); }
template <int CTRL> __device__ __forceinline__ float dppf(float v) { return __builtin_bit_cast(float, __builtin_amdgcn_update_dpp(0, __builtin_bit_cast(int, v), CTRL, 0xF, 0xF, true)); }
__device__ __forceinline__ float sum8(float v) { v += dppf<0xB1>(v); v += dppf<0x4E>(v); v += dppf<0x141>(v); return v; }
__device__ __forceinline__ float sum16(float v) { v = sum8(v); v += dppf<0x140>(v); return v; }
}

#ifndef SCAN_REP_E1
#define SCAN_REP_E1 1
#endif
#ifndef SCAN_REP_G
#define SCAN_REP_G 1
#endif
#ifndef SCAN_REP_V
#define SCAN_REP_V 1
#endif
#ifndef SCAN_REP_E0
#define SCAN_REP_E0 1
#endif
__device__ __forceinline__ void p3_scan(const Frame& F, const Args& A) {
    using namespace sc;
#define WGBAR() do { asm volatile("s_waitcnt lgkmcnt(0)" ::: "memory"); __builtin_amdgcn_s_barrier(); asm volatile("" ::: "memory"); } while (0)
#ifdef SCAN_STAGE
#define SCAN_TS(k_) do { if (blockIdx.x == 0 && threadIdx.x == 0) { volatile LAS unsigned* ms_ = (volatile LAS unsigned*)(F.lds + MISC_OFF); const unsigned now_ = (unsigned)__builtin_amdgcn_s_memrealtime(); \
        ms_[24 + (k_)] += now_ - ms_[40]; ms_[40] = now_; } } while (0)
#else
#define SCAN_TS(k_) do { } while (0)
#endif
#ifdef SCAN_WSTAGE
    unsigned wt0_ = 0;
#define SCAN_WT_BEGIN(k_) do { if ((k_) == SCAN_WSTAGE) wt0_ = (unsigned)__builtin_amdgcn_s_memrealtime(); } while (0)
#define SCAN_WT_END(k_) do { if ((k_) == SCAN_WSTAGE && blockIdx.x == 0) { asm volatile("s_waitcnt lgkmcnt(0)" ::: "memory"); const unsigned dt_ = (unsigned)__builtin_amdgcn_s_memrealtime() - wt0_; \
        if ((threadIdx.x & 63) == 0 && wt0_ != 0) ((volatile LAS unsigned*)(F.lds + MISC_OFF))[48 + (threadIdx.x >> 6)] += dt_; } } while (0)
#else
#define SCAN_WT_BEGIN(k_) do { } while (0)
#define SCAN_WT_END(k_) do { } while (0)
#endif
    unsigned char* ws = A.ws;
    LAS unsigned char* L = F.lds;
    const bf16_t* Rg = (const bf16_t*)A.out; const bf16_t* Kg = Rg + (size_t)ML * D;
    const bf16_t* KCg = (const bf16_t*)(ws + WS_KC); const bf16_t* Vg = (const bf16_t*)(ws + WS_V); const bf16_t* LWAg = (const bf16_t*)(ws + WS_LWA);
    const int wv = F.wave;
    const f32x4 z4 = (f32x4){0.f, 0.f, 0.f, 0.f};
    for (int s = blockIdx.x; s < 256; s += F.G) {
        const int dir = s & 1, h = (s >> 1) & 15, b = s >> 5, c0 = h * HD;
        bf16_t* Yg = (bf16_t*)(ws + (dir ? WS_Y1 : WS_Y0));
        __syncthreads();
#pragma unroll 8
        for (int q = F.tid; q < 4096; q += NTHREADS) { const int j = q >> 6, c = q & 63;
            sc::st1(L + B_W2T * MB + c * MPB + j * 2, A.in[I_W2][((size_t)dir * 64 + j) * D + c0 + c]); sc::st1(L + B_A2T * MB + c * MPB + j * 2, A.in[I_A2][((size_t)dir * 64 + j) * D + c0 + c]); }
        if (F.tid < 64) *(LAS float*)(L + O_KKS + F.tid * 4) = A.in[I_KK][c0 + F.tid];
        if (F.tid < 64) {
            const int r_ = F.tid & 15, g_ = F.tid >> 4; unsigned tw_[8];
#pragma unroll
            for (int tt = 0; tt < 2; ++tt)
#pragma unroll
                for (int p_ = 0; p_ < 4; ++p_) { const int d_ = 16 * tt + r_ - 8 * g_ - 2 * p_; tw_[4 * tt + p_] = d_ >= 1 ? 0x3F803F80u : (d_ == 0 ? 0x00003F80u : 0u); }
            *(LAS u32x4*)(L + O_TRI + F.tid * 32) = (u32x4){tw_[0], tw_[1], tw_[2], tw_[3]}; *(LAS u32x4*)(L + O_TRI + F.tid * 32 + 16) = (u32x4){tw_[4], tw_[5], tw_[6], tw_[7]};
        }
        const int ce = c0 + 16 * (wv & 3) + (F.lane & 15);
        const float w0c = A.in[I_W0][dir * D + ce], a0c = A.in[I_A0][dir * D + ce], kkc = A.in[I_KK][ce], kac = A.in[I_KA][ce], rkc = A.in[I_RK][ce];
        f32x4 S[4];
#pragma unroll
        for (int q = 0; q < 4; ++q) S[q] = z4;
        u32x4 pk_, pr_, pv_, plw_, pla_;
#define SCAN_PREFETCH(gc_, ti_, cg_) do { const int seg_ = (gc_) >= 4, ci_ = seg_ ? (gc_) - 4 : (gc_), Ts_ = seg_ ? TL : TCX; \
            const int t0_ = dir ? (Ts_ - 1 - ci_ * 64) : ci_ * 64;                                     \
            const size_t rl_ = (size_t)b * TL + t0_, ra_ = seg_ ? rl_ : ((size_t)ML + (size_t)b * TCX + t0_);    \
            const int lt_ = dir ? -(ti_) : (ti_);                                                          \
            const int lo_ = lt_ * D + c0 + 8 * (cg_), ll_ = lt_ * 256 + dir * 64 + 8 * (cg_); \
            const bf16_t* kb_ = seg_ ? (Kg + rl_ * D) : (KCg + ((size_t)b * TCX + t0_) * D); \
            pk_ = __builtin_nontemporal_load((const u32x4*)(kb_ + lo_)); pv_ = __builtin_nontemporal_load((const u32x4*)(Vg + ra_ * D + lo_)); \
            pr_ = (u32x4){0u, 0u, 0u, 0u}; if (seg_) pr_ = __builtin_nontemporal_load((const u32x4*)(Rg + rl_ * D + lo_)); \
            plw_ = __builtin_nontemporal_load((const u32x4*)(LWAg + ra_ * 256 + ll_)); pla_ = __builtin_nontemporal_load((const u32x4*)(LWAg + ra_ * 256 + 128 + ll_)); } while (0)
        SCAN_PREFETCH(0, (F.tid >> 3), (F.tid & 7));
        __syncthreads();
#ifdef SCAN_STAGE
        if (blockIdx.x == 0 && threadIdx.x == 0) ((volatile LAS unsigned*)(F.lds + MISC_OFF))[40] = (unsigned)__builtin_amdgcn_s_memrealtime();
#endif
#pragma unroll 1
        for (int gc = 0; gc < 68; ++gc) {
            const int seg = gc >= 4, ci = seg ? gc - 4 : gc, Tseg = seg ? TL : TCX;
            int tz = F.tid; asm volatile("" : "+v"(tz));
            const int lane = tz & 63, r = lane & 15, g = lane >> 4, ti_ = tz >> 3, cg = tz & 7;
            const int o16 = r * MPB + g * 16;
            const int o8 = r * MPB + g * 8;
            const int oE = g * (4 * MPB) + r * 2;
#pragma unroll 1
            for (int rep_ = 0; rep_ < SCAN_REP_E0; ++rep_)
            {
                LAS unsigned char* st = L + ti_ * MPB + cg * 16;
                *(LAS u32x4*)(st + B_RAWK * MB) = pk_; *(LAS u32x4*)(st + B_RAWR * MB) = pr_; *(LAS u32x4*)(st + B_LW * MB) = plw_; *(LAS u32x4*)(st + B_LA * MB) = pla_;
                const unsigned vw[4] = {pv_.x, pv_.y, pv_.z, pv_.w}, kw[4] = {pk_.x, pk_.y, pk_.z, pk_.w};
                LAS unsigned char* vt = L + B_VTT * MB + cg * (8 * MPB) + ti_ * 2;
                const f32x4 kk0 = *(const LAS f32x4*)(L + O_KKS + cg * 32), kk1 = *(const LAS f32x4*)(L + O_KKS + cg * 32 + 16);
                const float kks[8] = {kk0[0], kk0[1], kk0[2], kk0[3], kk1[0], kk1[1], kk1[2], kk1[3]};
                float ss = 0.f;
#pragma unroll
                for (int q = 0; q < 4; ++q) {
                    *(LAS unsigned short*)(vt + (2 * q) * MPB) = (unsigned short)(vw[q] & 0xffffu);
                    *(LAS unsigned short*)(vt + (2 * q + 1) * MPB) = (unsigned short)(vw[q] >> 16);
                    const float k0 = bflo(kw[q]) * kks[2 * q], k1 = bfhi(kw[q]) * kks[2 * q + 1]; ss += k0 * k0 + k1 * k1; }
                ss = sum8(ss);
                if (cg == 0) *(LAS float*)(L + O_INVN + ti_ * 4) = rsqrtf(fmaxf(ss, 1e-24f));
            }
            SCAN_WT_END(0);
            WGBAR();
            SCAN_WT_BEGIN(1);
            SCAN_TS(0);
            if (gc + 1 < 68) SCAN_PREFETCH(gc + 1, ti_, cg);
            const int ct = wv & 3, th = wv >> 2;
#pragma unroll 1
            for (int rep_ = 0; rep_ < SCAN_REP_E1; ++rep_) {
            f32x4 aacc[2]; float ev[8];
            {
                f32x4 wacc[2];
                bf16x8 w2f[2], a2f[2];
#pragma unroll
                for (int ks = 0; ks < 2; ++ks) { w2f[ks] = ldf(L + B_W2T * MB + 16 * ct * MPB + 64 * ks + o16); a2f[ks] = ldf(L + B_A2T * MB + 16 * ct * MPB + 64 * ks + o16); }
                const LAS unsigned char* lwb = L + 32 * th * MPB + o16;
#pragma unroll
                for (int tt = 0; tt < 2; ++tt) { wacc[tt] = z4; aacc[tt] = z4;
#pragma unroll
                    for (int ks = 0; ks < 2; ++ks) { wacc[tt] = mma(ldf(lwb + B_LW * MB + 16 * tt * MPB + 64 * ks), w2f[ks], wacc[tt]); aacc[tt] = mma(ldf(lwb + B_LA * MB + 16 * tt * MPB + 64 * ks), a2f[ks], aacc[tt]); } }
                LAS unsigned char* eb2 = L + 16 * ct * MPB + 64 * th + o8;
#pragma unroll
                for (int tt = 0; tt < 2; ++tt) { f32x4 lo;
#pragma unroll
                    for (int q = 0; q < 4; ++q) { const float e = 0.60653066f * fsig(wacc[tt][q] + w0c); ev[4 * tt + q] = e; lo[q] = e - __builtin_bit_cast(float, f2bf(e) << 16); wacc[tt][q] = e; }
                    st4(eb2 + B_EH * MB + 32 * tt, wacc[tt]); st4(eb2 + B_EL * MB + 32 * tt, lo); }
            }
            SCAN_WT_END(1);
            WGBAR();
            SCAN_WT_BEGIN(2);
            SCAN_TS(1);
            {
                f32x4 Li4[2]; f32x4 tot4 = z4;
                const LAS unsigned char* ehb = L + B_EH * MB + 16 * ct * MPB + o16; const LAS unsigned char* elb = L + B_EL * MB + 16 * ct * MPB + o16;
                const bf16x8 eh0 = ldf(ehb), eh1 = ldf(ehb + 64), el0 = ldf(elb), el1 = ldf(elb + 64);
                const bf16x8 ones = __builtin_bit_cast(bf16x8, (u32x4){0x3F803F80u, 0x3F803F80u, 0x3F803F80u, 0x3F803F80u});
                f32x4 s32 = z4; s32 = mma(ones, eh0, s32); s32 = mma(ones, el0, s32);
                tot4 = s32; tot4 = mma(ones, eh1, tot4); tot4 = mma(ones, el1, tot4);
                const bf16x8 ehs = th ? eh1 : eh0, els = th ? el1 : el0;
                const bf16x8 tr0 = __builtin_bit_cast(bf16x8, *(const LAS u32x4*)(L + O_TRI + lane * 32)), tr1 = __builtin_bit_cast(bf16x8, *(const LAS u32x4*)(L + O_TRI + lane * 32 + 16));
                { f32x4 d = th ? s32 : z4; d = mma(tr0, ehs, d); d = mma(tr0, els, d); Li4[0] = d; }
                { f32x4 d = th ? s32 : z4; d = mma(tr1, ehs, d); d = mma(tr1, els, d); Li4[1] = d; }
                const float Pc = __expf(-tot4[0]);
                if (g == 0 && th == 0) *(LAS float*)(L + O_PV + (16 * ct + r) * 4) = Pc;
                LAS unsigned char* eb = L + oE + 32 * ct + 32 * th * MPB;
                LAS unsigned char* cb = L + o8 + 16 * ct * MPB + 64 * th;
#pragma unroll
                for (int tt = 0; tt < 2; ++tt) {
                    const f32x4 inv4 = *(const LAS f32x4*)(L + O_INVN + 128 * th + 64 * tt + g * 16);
                    f32x4 btv, ktv;
                    const float em0 = __expf(-Li4[tt][0]), em1 = __expf(-Li4[tt][1]), em2 = __expf(-Li4[tt][2]), em3 = __expf(-Li4[tt][3]);
                    const float emv[4] = {em0, em1, em2, em3}, exv[4] = {__expf(ev[4 * tt] - Li4[tt][0]), em0, em1, em2};
#pragma unroll
                    for (int q = 0; q < 4; ++q) {
                        const int ro = (16 * tt + q) * MPB;
                        const float kv = ld1(eb + B_RAWK * MB + ro), rv = ld1(eb + B_RAWR * MB + ro);
                        const float a = fsig(aacc[tt][q] + a0c);
                        const float kkn = kv * kkc * inv4[q];
                        const float beta = kkn * a, kd = kv * (1.f + (a - 1.f) * kac);
                        const float em = emv[q], ep = __builtin_amdgcn_rcpf(em);
                        const float at = -kkn * exv[q], bt = beta * ep, kt = kd * ep, rt = rv * em;
                        btv[q] = bt; ktv[q] = kt;
                        st1(eb + B_AT * MB + ro, at); st1(eb + B_BT * MB + ro, bt); st1(eb + B_KT * MB + ro, kt); st1(eb + B_RT * MB + ro, rt); st1(eb + B_RK * MB + ro, rt * rkc);
                    }
                    st4(cb + B_BTT * MB + 32 * tt, btv); st4(cb + B_KTT * MB + 32 * tt, ktv);
                    asm volatile("" ::: "memory");
                }
            }
            SCAN_WT_END(2);
            WGBAR();
            SCAN_WT_BEGIN(3);
            SCAN_TS(2);
            }
            float tc[16];
#define SCAN_INV_HALF(half_) do { const LAS unsigned char* nf_ = L + O_NF + g * 1024; if ((half_) == 0) tc[0] = (r == 0) ? 1.f : 0.f; \
                f32x4 rw_[8][4]; \
                _Pragma("unroll") for (int ii = 0; ii < 8; ++ii) { const int i = 8 * (half_) + ii; \
                    _Pragma("unroll") for (int c4 = 0; c4 < 4; ++c4) if (i > 0 && 4 * c4 < i) rw_[ii][c4] = *(const LAS f32x4*)(nf_ + i * 64 + c4 * 16); } \
                _Pragma("unroll") for (int ii = 0; ii < 8; ++ii) { const int i = 8 * (half_) + ii; \
                    if (i > 0) { float a0 = (i == r) ? 1.f : 0.f, a1 = 0.f, a2 = 0.f, a3 = 0.f; \
                        _Pragma("unroll") for (int s2 = 0; s2 < i; ++s2) { const float nvv = rw_[ii][s2 >> 2][s2 & 3]; \
                            if ((s2 & 3) == 0) a0 += nvv * tc[s2]; else if ((s2 & 3) == 1) a1 += nvv * tc[s2]; else if ((s2 & 3) == 2) a2 += nvv * tc[s2]; else a3 += nvv * tc[s2]; } \
                        tc[i] = (a0 + a1) + (a2 + a3); } } } while (0)
#pragma unroll 1
            for (int rep_ = 0; rep_ < SCAN_REP_G; ++rep_) {
#define GRAM_PAIR(x_, ti_) do { const int xx_ = (x_); \
                const LAS unsigned char* Xb_ = L + (xx_ ? B_KT : B_BT) * MB + o16; const LAS unsigned char* Za_ = L + B_AT * MB + 16 * (ti_) * MPB + o16; const LAS unsigned char* Zr_ = L + B_RT * MB + 16 * (ti_) * MPB + o16; \
                const bf16x8 za0_ = ldf(Za_), za1_ = ldf(Za_ + 64), zr0_ = ldf(Zr_), zr1_ = ldf(Zr_ + 64); const int i_ = 16 * (ti_) + r; \
                _Pragma("unroll") for (int ts_ = 0; ts_ < 4; ++ts_) { f32x4 dn_ = z4, dm_ = z4; \
                    if (ts_ <= (ti_)) { const bf16x8 x0_ = ldf(Xb_ + 16 * ts_ * MPB), x1_ = ldf(Xb_ + 16 * ts_ * MPB + 64); \
                        dn_ = mma(x0_, za0_, dn_); dm_ = mma(x0_, zr0_, dm_); dn_ = mma(x1_, za1_, dn_); dm_ = mma(x1_, zr1_, dm_); \
                        if (ts_ == (ti_)) { _Pragma("unroll") for (int q_ = 0; q_ < 4; ++q_) { dn_[q_] = (16 * ts_ + 4 * g + 1 + q_ <= i_) ? dn_[q_] : 0.f; dm_[q_] = (16 * ts_ + 4 * g + q_ <= i_) ? dm_[q_] : 0.f; } } } \
                    st4(L + xx_ * MB + 16 * (ti_) * MPB + 32 * ts_ + o8, dn_); st4(L + (2 + xx_) * MB + 16 * (ti_) * MPB + 32 * ts_ + o8, dm_); } } while (0)
            if (wv < 6) {
                const int xs = wv & 1;
                if (wv < 2) GRAM_PAIR(xs, 3); else if (wv < 4) GRAM_PAIR(xs, 2); else { GRAM_PAIR(xs, 1); GRAM_PAIR(xs, 0); }
            } else if (wv == 6) {
#pragma unroll
                for (int q2 = 0; q2 < 4; ++q2) {
                    f32x4 bd = z4;
                    bd = mma(ldf(L + B_KT * MB + 16 * q2 * MPB + o16), ldf(L + B_RK * MB + 16 * q2 * MPB + o16), bd); bd = mma(ldf(L + B_KT * MB + 16 * q2 * MPB + 64 + o16), ldf(L + B_RK * MB + 16 * q2 * MPB + 64 + o16), bd);
                    const int rq = r & 3; const float bv = rq == 0 ? bd[0] : (rq == 1 ? bd[1] : (rq == 2 ? bd[2] : bd[3]));
                    if (g == (r >> 2)) *(LAS float*)(L + O_BON + (16 * q2 + r) * 4) = bv; }
            } else {
#pragma unroll
                for (int q2 = 0; q2 < 4; ++q2) {
                    f32x4 d = z4;
                    d = mma(ldf(L + B_BT * MB + 16 * q2 * MPB + o16), ldf(L + B_AT * MB + 16 * q2 * MPB + o16), d); d = mma(ldf(L + B_BT * MB + 16 * q2 * MPB + 64 + o16), ldf(L + B_AT * MB + 16 * q2 * MPB + 64 + o16), d);
#pragma unroll
                    for (int q = 0; q < 4; ++q) d[q] = (4 * g + q < r) ? d[q] : 0.f;
                    st4(L + B_NAB * MB + 16 * q2 * MPB + 32 * q2 + o8, d);
                    *(LAS f32x4*)(L + O_NF + q2 * 1024 + r * 64 + g * 16) = d;
                }
                LDS_WAIT(); asm volatile("" ::: "memory");
                SCAN_INV_HALF(0);
                *(LAS f32x4*)(L + O_TC + lane * 32) = (f32x4){tc[0], tc[1], tc[2], tc[3]}; *(LAS f32x4*)(L + O_TC + lane * 32 + 16) = (f32x4){tc[4], tc[5], tc[6], tc[7]};
            }
            LDS_WAIT(); asm volatile("" ::: "memory");
            }
            SCAN_WT_END(3);
            WGBAR();
            SCAN_WT_BEGIN(4);
            SCAN_TS(3);
            f32x4 W2[4], Y[4], U[4]; bf16x8 Sb0, Sb1, vb0, vb1, u0, u1;
            const int vs = wv & 3;
            if (wv == 7) {
                const int oD = g * (16 * MPB + 32);
                { const f32x4 t0_ = *(const LAS f32x4*)(L + O_TC + lane * 32), t1_ = *(const LAS f32x4*)(L + O_TC + lane * 32 + 16);
                  tc[0] = t0_[0]; tc[1] = t0_[1]; tc[2] = t0_[2]; tc[3] = t0_[3]; tc[4] = t1_[0]; tc[5] = t1_[1]; tc[6] = t1_[2]; tc[7] = t1_[3]; }
                SCAN_INV_HALF(1);
#pragma unroll
                for (int i = 0; i < 16; ++i) st1(L + B_T * MB + oD + i * MPB + r * 2, tc[i]);
            }
            vb0 = ldf(L + B_VTT * MB + 16 * vs * MPB + o16); vb1 = ldf(L + B_VTT * MB + 16 * vs * MPB + 64 + o16);
            if (wv < 4) {
                Sb0 = packfrag(S[0], S[1]); Sb1 = packfrag(S[2], S[3]);
                *(LAS bf16x8*)(L + B_BT * MB + vs * 2048 + lane * 16) = Sb0; *(LAS bf16x8*)(L + B_BT * MB + vs * 2048 + 1024 + lane * 16) = Sb1;
#pragma unroll
                for (int t = 0; t < 4; ++t) {
                    f32x4 d = z4;
                    d = mma(ldf(L + B_NAK * MB + 16 * t * MPB + o16), vb0, d); d = mma(ldf(L + B_NAK * MB + 16 * t * MPB + 64 + o16), vb1, d);
                    d = mma(ldfp(L + B_AT * MB + 16 * t * MPB + o8), Sb0, d); d = mma(ldfp(L + B_AT * MB + 16 * t * MPB + 64 + o8), Sb1, d); W2[t] = d;
                    f32x4 e2 = S[t];
                    e2 = mma(ldf(L + B_KTT * MB + 16 * t * MPB + o16), vb0, e2); e2 = mma(ldf(L + B_KTT * MB + 16 * t * MPB + 64 + o16), vb1, e2); S[t] = e2;
                    asm volatile("" : "+v"(W2[t]), "+v"(S[t]) :: "memory");
                }
            } else if (seg && wv < 7) {
#pragma unroll
                for (int t = 0; t < 4; ++t) { f32x4 y = z4;
                    y = mma(ldf(L + B_MRK * MB + 16 * t * MPB + o16), vb0, y); y = mma(ldf(L + B_MRK * MB + 16 * t * MPB + 64 + o16), vb1, y); Y[t] = y; }
                const bf16x8 v30 = ldf(L + B_VTT * MB + 48 * MPB + o16), v31 = ldf(L + B_VTT * MB + 48 * MPB + 64 + o16);
                const int tx0 = wv == 4 ? 0 : wv - 3, ntx = wv == 4 ? 2 : 1;
#pragma unroll 1
                for (int t = tx0; t < tx0 + ntx; ++t) { f32x4 y = z4;
                    y = mma(ldf(L + B_MRK * MB + 16 * t * MPB + o16), v30, y); y = mma(ldf(L + B_MRK * MB + 16 * t * MPB + 64 + o16), v31, y);
                    *(LAS f32x4*)(L + O_YX + t * 1024 + lane * 16) = y; }
            }
            SCAN_WT_END(4);
            WGBAR();
            SCAN_WT_BEGIN(5);
            SCAN_TS(4);
            if (wv < 4) {
#define DMUL(q_, x_) mma(__builtin_bit_cast(bf16x8, (u32x4){dq_[q_].x, dq_[q_].y, 0u, 0u}), packfrag((x_), z4), z4)
                u32x2 dq_[4];
#pragma unroll
                for (int q = 0; q < 4; ++q) dq_[q] = *(const LAS u32x2*)(L + B_T * MB + 16 * q * MPB + 32 * q + o8);
                U[0] = DMUL(0, W2[0]);
                { f32x4 x = mma(ldfp(L + B_NAB * MB + 16 * MPB + o8), packfrag(U[0], z4), W2[1]); U[1] = DMUL(1, x); }
                u0 = packfrag(U[0], U[1]);
                { f32x4 x = mma(ldfp(L + B_NAB * MB + 32 * MPB + o8), u0, W2[2]); U[2] = DMUL(2, x); }
                { f32x4 x = mma(ldfp(L + B_NAB * MB + 48 * MPB + o8), u0, W2[3]); x = mma(ldfp(L + B_NAB * MB + 48 * MPB + 64 + o8), packfrag(U[2], z4), x); U[3] = DMUL(3, x); }
#undef DMUL
                u1 = packfrag(U[2], U[3]);
                *(LAS bf16x8*)(L + B_KT * MB + vs * 2048 + lane * 16) = u0; *(LAS bf16x8*)(L + B_KT * MB + vs * 2048 + 1024 + lane * 16) = u1;
            } else if (seg) {
                if (wv == 7) {
#pragma unroll
                    for (int t = 0; t < 4; ++t) Y[t] = *(const LAS f32x4*)(L + O_YX + t * 1024 + lane * 16); }
                Sb0 = *(const LAS bf16x8*)(L + B_BT * MB + vs * 2048 + lane * 16); Sb1 = *(const LAS bf16x8*)(L + B_BT * MB + vs * 2048 + 1024 + lane * 16);
#pragma unroll
                for (int t = 0; t < 4; ++t) { Y[t] = mma(ldfp(L + B_RT * MB + 16 * t * MPB + o8), Sb0, Y[t]); Y[t] = mma(ldfp(L + B_RT * MB + 16 * t * MPB + 64 + o8), Sb1, Y[t]); }
            }
            SCAN_WT_END(5);
            WGBAR();
            SCAN_WT_BEGIN(6);
            SCAN_TS(5);
            if (wv < 4) {
#pragma unroll
                for (int t = 0; t < 4; ++t) {
                    f32x4 e2 = mma(ldfp(L + B_BTT * MB + 16 * t * MPB + o8), u0, S[t]); e2 = mma(ldfp(L + B_BTT * MB + 16 * t * MPB + 64 + o8), u1, e2);
                    S[t] = e2 * *(const LAS f32x4*)(L + O_PV + 64 * t + g * 16);
                }
            } else if (seg) {
                u0 = *(const LAS bf16x8*)(L + B_KT * MB + vs * 2048 + lane * 16); u1 = *(const LAS bf16x8*)(L + B_KT * MB + vs * 2048 + 1024 + lane * 16);
                const int vcol = c0 + 16 * vs + r;
#pragma unroll
                for (int t = 0; t < 4; ++t) {
                    f32x4 y = Y[t];
                    y = mma(ldfp(L + B_MRB * MB + 16 * t * MPB + o8), u0, y); y = mma(ldfp(L + B_MRB * MB + 16 * t * MPB + 64 + o8), u1, y);
                    const f32x4 bon = *(const LAS f32x4*)(L + O_BON + 64 * t + g * 16);
                    const u32x2 vv = *(const LAS u32x2*)(L + B_VTT * MB + 16 * vs * MPB + 32 * t + o8);
                    y[0] += bon[0] * bflo(vv.x); y[1] += bon[1] * bfhi(vv.x); y[2] += bon[2] * bflo(vv.y); y[3] += bon[3] * bfhi(vv.y);
#pragma unroll
                    for (int q = 0; q < 4; ++q) { const int tl = ci * 64 + 16 * t + 4 * g + q, tt = dir ? (Tseg - 1 - tl) : tl;
                        Yg[((size_t)b * TL + tt) * D + vcol] = (bf16_t)f2bf(y[q]); }
                    asm volatile("" ::: "memory");
                }
            }
            SCAN_WT_END(6);
            WGBAR();
            SCAN_WT_BEGIN(0);
            SCAN_TS(6);
        }
#undef SCAN_PREFETCH
#undef GRAM_PAIR
#undef SCAN_INV_HALF
    }
#undef WGBAR
    __syncthreads();
}

__device__ __forceinline__ void p4_readout(const Frame& F, const Args& A) {
    unsigned char* ws = A.ws;
    {
        LAS float* scr = (LAS float*)(F.lds + F.wave * 16384);
        constexpr int NIT = 2 * 16 * 3 * 256;
        for (int it = F.gw; it < NIT; it += F.NGW) {
            const int mat = it >> 8, item = it & 255;
            const int kind = mat % 3, le = mat / 3, l = le >> 4, e = le & 15;
            unsigned char* mw = ws + (l ? WS_MOEW1 : WS_MOEW0);
            if (kind == 0) tr_job_item(A.in[I_MGATE] + (size_t)le * D * ED, ED, ED, (bf16_t*)mw, D, e * 1024, true, nullptr, item, scr, F.lane);
            else if (kind == 1) tr_job_item(A.in[I_MUP] + (size_t)le * D * ED, ED, ED, (bf16_t*)mw, D, e * 1024 + 128, true, nullptr, item, scr, F.lane);
            else tr_job_item(A.in[I_MDOWN] + (size_t)le * ED * D, D, D, (bf16_t*)(mw + 32 * MiB), ED, e * 1024, false, nullptr, item, scr, F.lane);
        }
    }
    const bf16_t* Y0 = (const bf16_t*)(ws + WS_Y0); const bf16_t* Y1 = (const bf16_t*)(ws + WS_Y1); const bf16_t* Gt = (const bf16_t*)(ws + WS_G);
    bf16_t* ZO = (bf16_t*)(ws + WS_ZO);
    float gw_[16], gb_[16];
#pragma unroll
    for (int j = 0; j < 2; ++j)
#pragma unroll
        for (int q = 0; q < 8; ++q) { const int c = 8 * F.lane + 512 * j + q; gw_[j * 8 + q] = A.in[I_GNW][c]; gb_[j * 8 + q] = A.in[I_GNB][c]; }
    for (int t = F.gw; t < ML; t += F.NGW) {
#pragma unroll
        for (int j = 0; j < 2; ++j) {
            const size_t off = (size_t)t * D + 8 * F.lane + 512 * j;
            const u32x4 a = __builtin_nontemporal_load((const u32x4*)(Y0 + off)), b = __builtin_nontemporal_load((const u32x4*)(Y1 + off)), g = __builtin_nontemporal_load((const u32x4*)(Gt + off));
            float y[8] = {bflo(a.x) + bflo(b.x), bfhi(a.x) + bfhi(b.x), bflo(a.y) + bflo(b.y), bfhi(a.y) + bfhi(b.y), bflo(a.z) + bflo(b.z), bfhi(a.z) + bfhi(b.z), bflo(a.w) + bflo(b.w), bfhi(a.w) + bfhi(b.w)};
            float gg[8] = {bflo(g.x), bfhi(g.x), bflo(g.y), bfhi(g.y), bflo(g.z), bfhi(g.z), bflo(g.w), bfhi(g.w)};
            float s = 0.f;
#pragma unroll
            for (int q = 0; q < 8; ++q) s += y[q];
            s += __shfl_xor(s, 1); s += __shfl_xor(s, 2); s += __shfl_xor(s, 4);
            const float mean = s * (1.f / 64.f); float s2 = 0.f;
#pragma unroll
            for (int q = 0; q < 8; ++q) { y[q] -= mean; s2 += y[q] * y[q]; }
            s2 += __shfl_xor(s2, 1); s2 += __shfl_xor(s2, 2); s2 += __shfl_xor(s2, 4);
            const float rstd = rsqrtf(s2 * (1.f / 64.f) + GN_EPS);
            float z[8];
#pragma unroll
            for (int q = 0; q < 8; ++q) z[q] = (y[q] * rstd * gw_[j * 8 + q] + gb_[j * 8 + q]) * gg[q];
            u32x4 w; w.x = pk2(z[0], z[1]); w.y = pk2(z[2], z[3]); w.z = pk2(z[4], z[5]); w.w = pk2(z[6], z[7]);
            *(u32x4*)(ZO + off) = w;
        }
    }
}

__device__ __forceinline__ void p6_route_stage(const Frame& F, const Args& A) {
    LAS unsigned char* L = F.lds;
    constexpr int WPB = 2064, O_WH = 0, O_WL = 16 * WPB;
    __syncthreads();
    {
        f32x4 wv[8];
#pragma unroll
        for (int j = 0; j < 8; ++j) wv[j] = *(const f32x4*)(A.in[I_ROUTW] + 4 * (F.tid + NTHREADS * j));
#pragma unroll
        for (int j = 0; j < 8; ++j) { const int i = 4 * (F.tid + NTHREADS * j), d = i >> 4, e0 = i & 15;
#pragma unroll
            for (int q = 0; q < 4; ++q) { const float w = wv[j][q]; const unsigned hi = f2bf(w);
                *(LAS unsigned short*)(L + O_WH + (e0 + q) * WPB + d * 2) = (unsigned short)hi; *(LAS unsigned short*)(L + O_WL + (e0 + q) * WPB + d * 2) = (unsigned short)f2bf(w - __builtin_bit_cast(float, hi << 16)); } }
    }
}
__device__ __forceinline__ void p6_route(const Frame& F, const Args& A, const int layer, const bool staged) {
    unsigned char* ws = A.ws;
    LAS unsigned char* L = F.lds;
    constexpr int WPB = 2064;
    constexpr int O_WH = 0, O_WL = 16 * WPB, O_GS = 2 * 16 * WPB, O_SH = O_GS + 4096, O_LG = O_SH + 4096, O_CN = O_LG + 8 * 1024;
    if (!staged) p6_route_stage(F, A);
    __syncthreads();
    const float* MOD = (const float*)(ws + WS_MOD) + (size_t)layer * 9 * 6144;
    const float* ng = A.in[I_NORMG] + (size_t)(layer * 2 + 1) * D;
    const bf16_t* h = (const bf16_t*)(ws + WS_HB);
    bf16_t* XN = (bf16_t*)(ws + WS_XN);
    unsigned* EIDX = (unsigned*)(ws + WS_EIDX); float* GATE = (float*)(ws + WS_GATE); int* CC = (int*)(ws + WS_CC);
    const f32x4 z4 = (f32x4){0.f, 0.f, 0.f, 0.f};
    int bcur = -1;
    for (int ch0 = F.vcu * NWAVES; ch0 < 2048; ch0 += F.NGW) {
        const int ch = ch0 + F.wave, t0 = ch * 16, b = ch0 / 256;
        if (b != bcur) {
            __syncthreads();
            const float* mrow = MOD + (size_t)b * 6144;
            for (int c = F.tid; c < D; c += NTHREADS) { *(LAS float*)(L + O_GS + c * 4) = ng[c] * (1.f + mrow[4096 + c]); *(LAS float*)(L + O_SH + c * 4) = mrow[3072 + c]; }
            bcur = b;
            __syncthreads();
        }
        int lz = F.lane; asm volatile("" : "+v"(lz));
        const int r = lz & 15, g = lz >> 4;
        const bf16_t* hrow = h + (size_t)(t0 + r) * D + 8 * g;
        u32x4 qv[32];
#pragma unroll
        for (int ks = 0; ks < 32; ++ks) qv[ks] = *(const u32x4*)(hrow + 32 * ks);
        float ss = 0.f;
#pragma unroll
        for (int ks = 0; ks < 32; ++ks) { const u32x4 q = qv[ks];
            const float v0 = bflo(q.x), v1 = bfhi(q.x), v2 = bflo(q.y), v3 = bfhi(q.y), v4 = bflo(q.z), v5 = bfhi(q.z), v6 = bflo(q.w), v7 = bfhi(q.w);
            ss += (v0 * v0 + v1 * v1) + (v2 * v2 + v3 * v3) + (v4 * v4 + v5 * v5) + (v6 * v6 + v7 * v7); }
        ss += __shfl_xor(ss, 16); ss += __shfl_xor(ss, 32);
        const float rstd = rsqrtf(ss * (1.f / D) + RMS_EPS);
        f32x4 acc0 = z4, acc1 = z4, acc2 = z4;
        bf16_t* orow = XN + (size_t)(t0 + r) * D + 8 * g;
#pragma unroll
        for (int ks = 0; ks < 32; ++ks) {
            u32x4 q = qv[ks]; asm volatile("" : "+v"(q));
            const f32x4 g0 = *(const LAS f32x4*)(L + O_GS + (32 * ks + 8 * g) * 4), g1 = *(const LAS f32x4*)(L + O_GS + (32 * ks + 8 * g) * 4 + 16);
            const f32x4 s0 = *(const LAS f32x4*)(L + O_SH + (32 * ks + 8 * g) * 4), s1 = *(const LAS f32x4*)(L + O_SH + (32 * ks + 8 * g) * 4 + 16);
            const f32x4 x0 = (f32x4){bflo(q.x), bfhi(q.x), bflo(q.y), bfhi(q.y)} * rstd * g0 + s0, x1 = (f32x4){bflo(q.z), bfhi(q.z), bflo(q.w), bfhi(q.w)} * rstd * g1 + s1;
            const u32x4 hi = (u32x4){pk2(x0[0], x0[1]), pk2(x0[2], x0[3]), pk2(x1[0], x1[1]), pk2(x1[2], x1[3])};
            *(u32x4*)(orow + 32 * ks) = hi;
            const f32x4 l0 = x0 - (f32x4){bflo(hi.x), bfhi(hi.x), bflo(hi.y), bfhi(hi.y)}, l1 = x1 - (f32x4){bflo(hi.z), bfhi(hi.z), bflo(hi.w), bfhi(hi.w)};
            const u32x4 lo = (u32x4){pk2(l0[0], l0[1]), pk2(l0[2], l0[3]), pk2(l1[0], l1[1]), pk2(l1[2], l1[3])};
            const bf16x8 wh = *(const LAS bf16x8*)(L + O_WH + r * WPB + (32 * ks + 8 * g) * 2), wl = *(const LAS bf16x8*)(L + O_WL + r * WPB + (32 * ks + 8 * g) * 2);
            acc0 = __builtin_amdgcn_mfma_f32_16x16x32_bf16(__builtin_bit_cast(bf16x8, hi), wh, acc0, 0, 0, 0);
            acc1 = __builtin_amdgcn_mfma_f32_16x16x32_bf16(__builtin_bit_cast(bf16x8, hi), wl, acc1, 0, 0, 0);
            acc2 = __builtin_amdgcn_mfma_f32_16x16x32_bf16(__builtin_bit_cast(bf16x8, lo), wh, acc2, 0, 0, 0);
            asm volatile("" ::: "memory");
        }
        const f32x4 lgt = acc0 + (acc1 + acc2);
        LAS float* lgw = (LAS float*)(L + O_LG + F.wave * 1024);
        LAS int* cnw = (LAS int*)(L + O_CN + F.wave * 64);
#pragma unroll
        for (int q = 0; q < 4; ++q) lgw[(4 * g + q) * 16 + r] = lgt[q];
        if (F.lane < 16) cnw[F.lane] = 0;
        LDS_WAIT(); asm volatile("" ::: "memory");
        if (F.lane < 16) {
            const int t = t0 + F.lane;
            float lg[16];
#pragma unroll
            for (int q = 0; q < 4; ++q) { const f32x4 v = *(const LAS f32x4*)(lgw + F.lane * 16 + 4 * q); lg[4 * q] = v[0]; lg[4 * q + 1] = v[1]; lg[4 * q + 2] = v[2]; lg[4 * q + 3] = v[3]; }
            float best = -3.0e38f; int be0 = 0, be1 = 1; float bs0 = 0.f, bs1 = 0.f;
#pragma unroll
            for (int gg = 0; gg < 4; ++gg) {
                float sg[4], sel[4];
#pragma unroll
                for (int q = 0; q < 4; ++q) { sg[q] = 1.f / (1.f + expf(-lg[4 * gg + q])); sel[q] = sg[q] + A.in[I_ROUTB][4 * gg + q]; }
                int i1 = 0; float v1 = sel[0], s1 = sg[0];
#pragma unroll
                for (int q = 1; q < 4; ++q) if (sel[q] > v1) { i1 = q; v1 = sel[q]; s1 = sg[q]; }
                int i2 = -1; float v2 = -3.0e38f, s2 = 0.f;
#pragma unroll
                for (int q = 0; q < 4; ++q) if (q != i1 && sel[q] > v2) { i2 = q; v2 = sel[q]; s2 = sg[q]; }
                const float gs = v1 + v2;
                if (gs > best) { best = gs; be0 = 4 * gg + i1; be1 = 4 * gg + i2; bs0 = s1; bs1 = s2; }
            }
            const float inv = 1.f / (bs0 + bs1);
            EIDX[t] = (unsigned)be0 | ((unsigned)be1 << 8); GATE[2 * t] = bs0 * inv; GATE[2 * t + 1] = bs1 * inv;
            __hip_atomic_fetch_add(cnw + be0, 1, __ATOMIC_RELAXED, __HIP_MEMORY_SCOPE_WORKGROUP); __hip_atomic_fetch_add(cnw + be1, 1, __ATOMIC_RELAXED, __HIP_MEMORY_SCOPE_WORKGROUP);
        }
        LDS_WAIT(); asm volatile("" ::: "memory");
        if (F.lane < 16) CC[ch * 16 + F.lane] = cnw[F.lane];
    }
    __syncthreads();
}

__device__ __forceinline__ void p7_permute(const Frame& F, const Args& A) {
    unsigned char* ws = A.ws;
    LAS int* cc = (LAS int*)F.lds;
    LAS int* ps = (LAS int*)(F.lds + LDS_X_OFF);
    LAS int* seg = ps + 512;
    LAS int* tot = seg + 16;
    const int* CC = (const int*)(ws + WS_CC);
    const unsigned* EIDX = (const unsigned*)(ws + WS_EIDX); int* POS = (int*)(ws + WS_POS); int* TILE = (int*)(ws + WS_TILE); int* INV = (int*)(ws + WS_INV);
    __syncthreads();
#pragma unroll 8
    for (int i = F.tid; i < 2048 * 16 / 4; i += NTHREADS) ((LAS u32x4*)cc)[i] = ((const u32x4*)CC)[i];
    __syncthreads();
    { const int e = F.tid & 15, part = F.tid >> 4; int s = 0; for (int q = 0; q < 64; ++q) s += cc[(part * 64 + q) * 16 + e]; ps[part * 16 + e] = s; }
    __syncthreads();
    if (F.tid < 16) { int run = 0; for (int p = 0; p < 32; ++p) { const int v = ps[p * 16 + F.tid]; ps[p * 16 + F.tid] = run; run += v; } tot[F.tid] = run; }
    __syncthreads();
    if (F.tid == 0) { int off = 0, nt = 0;
        for (int e = 0; e < 16; ++e) { const int tl = (tot[e] + 255) >> 8; seg[e] = off;
            if (blockIdx.x == 0) for (int q = 0; q < tl; ++q) TILE[16 + nt + q] = e;
            nt += tl; off += tl * 256; }
        if (blockIdx.x == 0) TILE[0] = nt; }
    __syncthreads();
    if (blockIdx.x == 0) {
        for (int e = 0; e < 16; ++e) { const int n0 = seg[e] + tot[e], n1 = seg[e] + (((tot[e] + 255) >> 8) << 8);
            for (int j = n0 + F.tid; j < n1; j += NTHREADS) INV[j] = 0; } }
    for (int ch = F.gw; ch < 2048; ch += F.NGW) {
        int base = 0;
        { const int e = F.lane & 15, part = F.lane >> 4, q0 = (ch & ~63) + 16 * part; int sm = 0;
#pragma unroll 4
          for (int q = q0; q < q0 + 16; ++q) sm += (q < ch) ? cc[q * 16 + e] : 0;
          sm += __shfl_xor(sm, 16); sm += __shfl_xor(sm, 32);
          if (F.lane < 16) base = seg[F.lane] + ps[(ch >> 6) * 16 + F.lane] + sm; }
        int myp = 0;
        for (int i = 0; i < 16; ++i) {
            const int t = ch * 16 + i; const unsigned ei = EIDX[t]; const int e0 = ei & 255, e1 = (ei >> 8) & 255;
            const int p0 = __shfl(base, e0); base += (F.lane == e0);
            const int p1 = __shfl(base, e1); base += (F.lane == e1);
            if (F.lane == 2 * i) myp = p0; if (F.lane == 2 * i + 1) myp = p1;
        }
        if (F.lane < 32) { POS[ch * 32 + F.lane] = myp; INV[myp] = ch * 16 + (F.lane >> 1); }
    }
    __syncthreads();
}

template <bool FINAL>
__device__ __forceinline__ void p10_combine(const Frame& F, const Args& A, const int layer) {
    unsigned char* ws = A.ws;
    const float* MOD = (const float*)(ws + WS_MOD);
    const bf16_t* O = (const bf16_t*)(ws + WS_XP); const int* POS = (const int*)(ws + WS_POS); const float* GATE = (const float*)(ws + WS_GATE);
    bf16_t* XN = (bf16_t*)(ws + WS_XN);
    bf16_t* h = (bf16_t*)(ws + WS_HB); float* outp = A.out;
    for (int ch = F.gw; ch < 2048; ch += F.NGW) {
        const int t0 = ch * 16, b = t0 / TL;
        const float* mcur = MOD + ((size_t)layer * 9 + b) * 6144;
        f32x4 gt2[4], gsc[4], sh[4];
#pragma unroll
        for (int j = 0; j < 4; ++j) { const int c = 4 * F.lane + 256 * j; gt2[j] = *(const f32x4*)(mcur + 5120 + c);
            if (FINAL) { gsc[j] = *(const f32x4*)(A.in[I_FINALG] + c); sh[j] = (f32x4){0.f, 0.f, 0.f, 0.f}; }
            else { const float* mn = MOD + ((size_t)9 + b) * 6144; gsc[j] = *(const f32x4*)(A.in[I_NORMG] + 2 * D + c) * (1.f + *(const f32x4*)(mn + 1024 + c)); sh[j] = *(const f32x4*)(mn + c); } }
        for (int i = 0; i < 16; ++i) {
            const int t = t0 + i; const int p0 = POS[2 * t], p1 = POS[2 * t + 1]; const float w0 = GATE[2 * t], w1 = GATE[2 * t + 1];
            f32x4 v[4]; float s = 0.f;
#pragma unroll
            for (int j = 0; j < 4; ++j) { const int c = 4 * F.lane + 256 * j;
                const u32x2 oa = __builtin_nontemporal_load((const u32x2*)(O + (size_t)p0 * D + c)), ob = __builtin_nontemporal_load((const u32x2*)(O + (size_t)p1 * D + c));
                const f32x4 m = w0 * (f32x4){bflo(oa.x), bfhi(oa.x), bflo(oa.y), bfhi(oa.y)} + w1 * (f32x4){bflo(ob.x), bfhi(ob.x), bflo(ob.y), bfhi(ob.y)};
                const u32x2 hq = FINAL ? __builtin_nontemporal_load((const u32x2*)(h + (size_t)t * D + c)) : *(const u32x2*)(h + (size_t)t * D + c);
                v[j] = (f32x4){bflo(hq.x), bfhi(hq.x), bflo(hq.y), bfhi(hq.y)} + gt2[j] * m;
                s += (v[j].x * v[j].x + v[j].y * v[j].y) + (v[j].z * v[j].z + v[j].w * v[j].w); }
            const float rstd = rsqrtf(wave_sum(s) * (1.f / D) + RMS_EPS);
            if (FINAL) {
#pragma unroll
                for (int j = 0; j < 4; ++j) __builtin_nontemporal_store(v[j] * rstd * gsc[j], (f32x4*)(outp + (size_t)t * D + 4 * F.lane + 256 * j));
            } else {
#pragma unroll
                for (int j = 0; j < 4; ++j) { st_bf4(h + (size_t)t * D + 4 * F.lane + 256 * j, v[j]); st_bf4(XN + (size_t)t * D + 4 * F.lane + 256 * j, v[j] * rstd * gsc[j] + sh[j]); }
            }
        }
    }
}

__device__ __forceinline__ void ld_bf16row(const bf16_t* row, float (&o)[16], int lane) {
#pragma unroll
    for (int j = 0; j < 2; ++j) { const u32x4 a = __builtin_nontemporal_load((const u32x4*)(row + 8 * lane + 512 * j));
        o[8 * j] = bflo(a.x); o[8 * j + 1] = bfhi(a.x); o[8 * j + 2] = bflo(a.y); o[8 * j + 3] = bfhi(a.y); o[8 * j + 4] = bflo(a.z); o[8 * j + 5] = bfhi(a.z); o[8 * j + 6] = bflo(a.w); o[8 * j + 7] = bfhi(a.w); }
}
__device__ __forceinline__ void p12_conv(const Frame& F, const Args& A) {
    unsigned char* ws = A.ws;
    const bf16_t* BG = (const bf16_t*)(ws + WS_BG); const bf16_t* U = (const bf16_t*)(ws + WS_U); bf16_t* Z = (bf16_t*)(ws + WS_Z);
    float c0[16], c1[16], c2[16];
#pragma unroll
    for (int j = 0; j < 2; ++j)
#pragma unroll
        for (int q = 0; q < 8; ++q) { const int c = 8 * F.lane + 512 * j + q; c0[8 * j + q] = A.in[I_CONV][c]; c1[8 * j + q] = A.in[I_CONV][D + c]; c2[8 * j + q] = A.in[I_CONV][2 * D + c]; }
    for (int u = F.gw; u < 2048; u += F.NGW) {
        const int t0 = u * 16, pos0 = t0 % GRIDW;
        float prev[16], cur[16], nxt[16], bg[16];
        if (pos0 > 0) ld_bf16row(U + (size_t)(t0 - 1) * D, prev, F.lane);
        else {
#pragma unroll
            for (int q = 0; q < 16; ++q) prev[q] = 0.f; }
        ld_bf16row(U + (size_t)t0 * D, cur, F.lane);
        for (int i = 0; i < 16; ++i) {
            if (pos0 + i + 1 < GRIDW) ld_bf16row(U + (size_t)(t0 + i + 1) * D, nxt, F.lane);
            else {
#pragma unroll
                for (int q = 0; q < 16; ++q) nxt[q] = 0.f; }
            ld_bf16row(BG + (size_t)(t0 + i) * D, bg, F.lane);
            float z[16];
#pragma unroll
            for (int q = 0; q < 16; ++q) { z[q] = bg[q] * (c0[q] * prev[q] + c1[q] * cur[q] + c2[q] * nxt[q]); prev[q] = cur[q]; cur[q] = nxt[q]; }
#pragma unroll
            for (int j = 0; j < 2; ++j) { u32x4 w; w.x = pk2(z[8 * j], z[8 * j + 1]); w.y = pk2(z[8 * j + 2], z[8 * j + 3]); w.z = pk2(z[8 * j + 4], z[8 * j + 5]); w.w = pk2(z[8 * j + 6], z[8 * j + 7]);
                *(u32x4*)(Z + (size_t)(t0 + i) * D + 8 * F.lane + 512 * j) = w; }
        }
    }
}

constexpr int N_PHASES = 20;
__global__ void __launch_bounds__(NTHREADS, 2) fwd(Args args) {
    extern __shared__ __attribute__((aligned(16))) unsigned char lds_raw[];
    Frame F;
    F.lds = (LAS unsigned char*)lds_raw;
    F.tid = threadIdx.x; F.lane = F.tid & 63; F.wave = __builtin_amdgcn_readfirstlane(F.tid >> 6);
    F.G = gridDim.x; { const int bx = blockIdx.x; F.vcu = (F.G % 8 == 0) ? (bx % 8) * (F.G / 8) + bx / 8 : bx; }
    F.gw = F.vcu * NWAVES + F.wave; F.NGW = F.G * NWAVES;
    unsigned char* ws = args.ws;
    for (int u = F.tid; u < (LDS_BYTES - LDSCTL_OFF) / 4; u += NTHREADS) ((LAS unsigned*)(F.lds + LDSCTL_OFF))[u] = 0u;
    __syncthreads();
    volatile LAS unsigned* MISC = (volatile LAS unsigned*)(F.lds + MISC_OFF);
    XcdBarrier bar; bar.bar = (unsigned*)(ws + WS_CTL) + CW_BAR; bar.x = 0; bar.st = nullptr;
    const int lo = args.ph_lo, hi = args.ph_hi;
    if (hi - lo > 1) bar = xcd_barrier_post((unsigned*)(ws + WS_CTL) + CW_BAR, MISC + 8);
#ifndef PH_MASK
#define PH_MASK 0xFFFFFu
#endif
#define IN(k) (((PH_MASK >> (k)) & 1u) && lo <= (k) && (k) < hi)
#define SEAM(k) do { if (IN(k) && IN((k) + 1)) xcd_barrier(bar); } while (0)
#ifndef PROBE_MASK
#define PROBE_MASK 0u
#endif
#define RUNPH(k, ...) do { __VA_ARGS__ if constexpr (((PROBE_MASK >> (k)) & 1u) != 0u) { if (hi - lo > 1) xcd_barrier(bar); __VA_ARGS__ } } while (0)
    const float* MOD = (const float*)(ws + WS_MOD);
    const int bx = (int)blockIdx.x;
#ifdef PHASE_TIME
#ifndef PT_BLOCK
#define PT_BLOCK 0
#endif
    unsigned long long pt_acc = 0, pt_t0 = 0;
#define PT_BEGIN(k) do { if ((k) == PHASE_TIME) pt_t0 = __builtin_amdgcn_s_memrealtime(); } while (0)
#define PT_END(k) do { if ((k) == PHASE_TIME && pt_t0 != 0) { pt_acc += __builtin_amdgcn_s_memrealtime() - pt_t0; pt_t0 = 0; } } while (0)
#else
#define PT_BEGIN(k) do { } while (0)
#define PT_END(k) do { } while (0)
#endif

    PT_END(99); if (IN(0)) { PT_BEGIN(0); RUNPH(0, p0_prologue(F, args);); SEAM(0); }
    PT_END(0); if (IN(1)) { PT_BEGIN(1); RUNPH(1, p1_mix(F, args);); SEAM(1); }
    PT_END(1); if (IN(2)) { PT_BEGIN(2);
      RUNPH(2,
        { SchedRKV S{(const char*)(ws + WS_XM), (const char*)(ws + WS_WRKV), (const char*)(ws + WS_WL), F.G, bx};
          EpiRKV E{(bf16_t*)args.out, (bf16_t*)args.out + (size_t)ML * D, (bf16_t*)(ws + WS_KC), (bf16_t*)(ws + WS_V), (bf16_t*)(ws + WS_LP)};
          pg8::gemm_phase<EpiRKV, SchedRKV>(F.lds, 64, D, S, E, (size_t)256 * 128); }
      );
        SEAM(2);
    }
    PT_END(2); if (IN(3)) { PT_BEGIN(3); RUNPH(3, p2b_combine(F, args);); SEAM(3); }
    PT_END(3); if (IN(4)) { PT_BEGIN(4);
      RUNPH(4,
        { int ntg = 2; asm volatile("" : "+s"(ntg));
          SchedPlain S{(const char*)(ws + WS_LG), (const char*)(ws + WS_G2), 128, 4, 256, 256, ntg, F.G, bx};
          EpiBf16 E{(bf16_t*)(ws + WS_G), D};
          pg8::gemm_phase<EpiBf16, SchedPlain>(F.lds, 256, 256, S, E); }
        p3_scan(F, args);
      );
#ifdef PT_PRE4
        PT_END(4);
#endif
        SEAM(4); }
    PT_END(4); if (IN(5)) { PT_BEGIN(5); RUNPH(5, p4_readout(F, args);); SEAM(5); }
    PT_END(5); if (IN(6)) { PT_BEGIN(6);
      RUNPH(6,
        SchedPlain S{(const char*)(ws + WS_ZO), (const char*)(ws + WS_WO), 128, 4, D, D, 16, F.G, bx};
        EpiRes E{args.in[I_X], (bf16_t*)(ws + WS_HB), MOD + 2048};
        pg8::gemm_phase<EpiRes, SchedPlain>(F.lds, D, D, S, E);
      );
        if (IN(7)) p6_route_stage(F, args);
        SEAM(6);
    }
    PT_END(6); if (IN(7)) { PT_BEGIN(7); RUNPH(7, p6_route(F, args, 0, IN(6) && PROBE_MASK == 0u);); SEAM(7); }
    PT_END(7); if (IN(8)) { PT_BEGIN(8); RUNPH(8, p7_permute(F, args);); SEAM(8); }
    PT_END(8); if (IN(9)) { PT_BEGIN(9);
        unsigned* const rdy = (unsigned*)(ws + WS_CTL + CTL_RDY + 0 * 128 * 1024);
        { const SchedMoeG S{(const char*)(ws + WS_XN), (const char*)(ws + WS_MOEW0), (const int*)(ws + WS_TILE), (const int*)(ws + WS_INV), D, 16, F.G, bx, (size_t)2 * MiB};
          const EpiGateUpPub E{(unsigned char*)(ws + WS_H), rdy};
          pg8::gemm_phase<EpiGateUpPub, SchedMoeG, true>(F.lds, D, D, S, E); }
        { const SchedMoeD S{(const char*)(ws + WS_H), (const char*)(ws + WS_MOEW0 + 32 * MiB), (const int*)(ws + WS_TILE), rdy, (unsigned*)(ws + WS_CTL) + CW_TMO2, F.G, bx};
          const EpiBf16 E{(bf16_t*)(ws + WS_XP), D};
          pg8::gemm_phase<EpiBf16, SchedMoeD, true, 1>(F.lds, ED, ED, S, E); }
        if (IN(9) && IN(10 + 1)) xcd_barrier(bar);
    }
    PT_END(9); if (IN(11)) { PT_BEGIN(11); p10_combine<false>(F, args, 0); SEAM(11); }
    PT_END(11); if (IN(12)) { PT_BEGIN(12);
#ifdef KLOOP_PROBE
        if (F.tid == 0) MISC[20] = 1u;
#endif
      RUNPH(12,
        SchedPlain S{(const char*)(ws + WS_XN), (const char*)(ws + WS_WIN), 128, 12, D, D, 16, F.G, bx};
        EpiWin E{(bf16_t*)(ws + WS_BG), (bf16_t*)(ws + WS_U)};
        pg8::gemm_phase<EpiWin, SchedPlain>(F.lds, D, D, S, E);
      );
        SEAM(12);
    }
#ifdef KLOOP_PROBE
    if (F.tid == 0) MISC[20] = 0u;
#endif
    PT_END(12); if (IN(13)) { PT_BEGIN(13); RUNPH(13, p12_conv(F, args);); SEAM(13); }
    PT_END(13); if (IN(14)) { PT_BEGIN(14);
        SchedPlain S{(const char*)(ws + WS_Z), (const char*)(ws + WS_WOUT), 128, 4, D, D, 16, F.G, bx};
        EpiRes E{nullptr, (bf16_t*)(ws + WS_HB), MOD + 9 * 6144 + 2048};
        pg8::gemm_phase<EpiRes, SchedPlain>(F.lds, D, D, S, E);
        if (IN(15)) p6_route_stage(F, args);
        SEAM(14);
    }
    PT_END(14); if (IN(15)) { PT_BEGIN(15); RUNPH(15, p6_route(F, args, 1, IN(14) && PROBE_MASK == 0u);); SEAM(15); }
    PT_END(15); if (IN(16)) { PT_BEGIN(16); RUNPH(16, p7_permute(F, args);); SEAM(16); }
    PT_END(16); if (IN(17)) { PT_BEGIN(17);
        unsigned* const rdy = (unsigned*)(ws + WS_CTL + CTL_RDY + 1 * 128 * 1024);
        { const SchedMoeG S{(const char*)(ws + WS_XN), (const char*)(ws + WS_MOEW1), (const int*)(ws + WS_TILE), (const int*)(ws + WS_INV), D, 16, F.G, bx, (size_t)2 * MiB};
          const EpiGateUpPub E{(unsigned char*)(ws + WS_H), rdy};
          pg8::gemm_phase<EpiGateUpPub, SchedMoeG, true>(F.lds, D, D, S, E); }
        { const SchedMoeD S{(const char*)(ws + WS_H), (const char*)(ws + WS_MOEW1 + 32 * MiB), (const int*)(ws + WS_TILE), rdy, (unsigned*)(ws + WS_CTL) + CW_TMO2, F.G, bx};
          const EpiBf16 E{(bf16_t*)(ws + WS_XP), D};
          pg8::gemm_phase<EpiBf16, SchedMoeD, true, 1>(F.lds, ED, ED, S, E); }
        if (IN(17) && IN(18 + 1)) xcd_barrier(bar);
    }
    PT_END(17); if (IN(19)) { PT_BEGIN(19); p10_combine<true>(F, args, 1); }
    PT_END(19);
#ifdef KLOOP_PROBE
    if (blockIdx.x == 0 && F.tid == 0) { const unsigned long long te = __builtin_amdgcn_s_memrealtime() + ((KLOOP_PROBE == 1) ? 4ull * MISC[21] : (unsigned long long)(MISC[21] / 4u)); while (__builtin_amdgcn_s_memrealtime() < te) __builtin_amdgcn_s_sleep(8); }
#endif
#ifdef SCAN_WSTAGE
    if (blockIdx.x == 0 && F.tid == 0) { const unsigned long long te = __builtin_amdgcn_s_memrealtime() + 4ull * MISC[48 + SCAN_WAVE]; while (__builtin_amdgcn_s_memrealtime() < te) __builtin_amdgcn_s_sleep(8); }
#endif
#ifdef SCAN_STAGE
    if (blockIdx.x == 0 && F.tid == 0) { const unsigned long long te = __builtin_amdgcn_s_memrealtime() + 4ull * MISC[24 + SCAN_STAGE]; while (__builtin_amdgcn_s_memrealtime() < te) __builtin_amdgcn_s_sleep(8); }
#endif
#ifdef PHASE_TIME
    if (blockIdx.x == PT_BLOCK && F.tid == 0) { const unsigned long long te = __builtin_amdgcn_s_memrealtime() + 4ull * pt_acc; while (__builtin_amdgcn_s_memrealtime() < te) __builtin_amdgcn_s_sleep(8); }
#endif
}

extern "C" void kernel_launch(void* const* d_in, const int* in_sizes, int n_in, void* d_out, int out_size, void* d_ws, size_t ws_size, hipStream_t stream) {
    static int grid = 0;
    if (grid == 0) {
        if (n_in != 32 || out_size != ML * D || ws_size < WS_END) { fprintf(stderr, "kernel_launch: unexpected problem (n_in %d, out %d, ws %zu)\n", n_in, out_size, ws_size); grid = -1; return; }
        int dev = 0, cus = 0;
        if (hipGetDevice(&dev) != hipSuccess || hipDeviceGetAttribute(&cus, hipDeviceAttributeMultiprocessorCount, dev) != hipSuccess) { grid = -1; return; }
        if (hipFuncSetAttribute((const void*)fwd, hipFuncAttributeMaxDynamicSharedMemorySize, LDS_BYTES) != hipSuccess) { grid = -1; return; }
        int per_cu = 0;
        if (hipOccupancyMaxActiveBlocksPerMultiprocessor(&per_cu, (const void*)fwd, NTHREADS, LDS_BYTES) != hipSuccess || per_cu < 1) { fprintf(stderr, "kernel_launch: occupancy query says %d\n", per_cu); grid = -1; return; }
        grid = cus > 256 ? 256 : cus;
    }
    if (grid < 0) return;
    (void)in_sizes;
    hipMemsetAsync((char*)d_ws + WS_CTL, 0, CTL_ZERO_BYTES, stream);
    Args a{};
    for (int i = 0; i < 32; ++i) a.in[i] = (const float*)d_in[i];
    a.out = (float*)d_out; a.ws = (unsigned char*)d_ws;
#if MK_N_LAUNCHES == 1
    a.ph_lo = 0; a.ph_hi = N_PHASES;
    hipLaunchKernelGGL(fwd, dim3(grid), dim3(NTHREADS), LDS_BYTES, stream, a);
#else
    for (int k = 0; k < N_PHASES; ++k) { a.ph_lo = k; a.ph_hi = k + 1; hipLaunchKernelGGL(fwd, dim3(grid), dim3(NTHREADS), LDS_BYTES, stream, a); }
#endif
}
```
